# Optimizing an MI355X kernel written in HIP

```python
import jax
import jax.numpy as jnp
from jax import lax
import numpy as np

D_MODEL = 1024
BATCH = 8
SEQ = 4096
DEPTH = 2

CHUNK = 64
Q_BLOCK = 128
A_WIDTH = D_MODEL // 2
A_GROUPS = 8
A_GROUP_DIM = A_WIDTH // A_GROUPS
GMLP_CHUNK = 128
HEAD_DIM = 64
B_HEADS = 8
B_WIDTH = B_HEADS * HEAD_DIM
EVEN_IN = 2 * A_WIDTH + 3 * B_WIDTH
C_HEADS = D_MODEL // HEAD_DIM
C_KV_GROUPS = 4
C_HEADS_PER_GROUP = C_HEADS // C_KV_GROUPS
C_WIDTH = C_HEADS * HEAD_DIM
C_KV_WIDTH = C_KV_GROUPS * HEAD_DIM
IDX_HEADS = 8
IDX_DIM = 64
IDX_TOPK_MAX = 256
ODD_SPLITS = [int(s) for s in np.cumsum([C_WIDTH, C_KV_WIDTH, C_KV_WIDTH, IDX_HEADS * IDX_DIM, IDX_DIM])]
ODD_IN = ODD_SPLITS[-1] + IDX_HEADS
N_EXPERTS = 32
TOP_K = 4
D_EXPERT = D_MODEL
SWIGLU_ALPHA = 1.702
SWIGLU_LIMIT = 7.0
MOE_BLOCK = 256
PLE_DIM = 256
LN_EPS = 1e-5
N_EVEN = (DEPTH + 1) // 2
N_ODD = DEPTH // 2
DEEPNORM_ALPHA = (2 * DEPTH) ** 0.25
DEEPNORM_BETA = (8 * DEPTH) ** -0.25

kernel_name = 'hybrid_gmlp_stickbreak_dsa_moe'


def layer_norm(x, g, b):
    xf = x.astype(jnp.float32)
    mu = jnp.mean(xf, -1, keepdims=True)
    var = jnp.mean(jnp.square(xf - mu), -1, keepdims=True)
    return ((xf - mu) * lax.rsqrt(var + LN_EPS) * g + b).astype(x.dtype)


def to_blocks(t):
    b, s = t.shape[:2]
    return jnp.swapaxes(t.reshape(b, s // Q_BLOCK, Q_BLOCK, *t.shape[2:]), 0, 1)


def from_blocks(t):
    nb, b, qb = t.shape[:3]
    return jnp.swapaxes(t, 0, 1).reshape(b, nb * qb, *t.shape[3:])


def spatial_gating(u, v, ln_g, ln_b, w_s, b_s):
    b, s, _ = u.shape
    v = layer_norm(v, ln_g, ln_b)
    vg = v.reshape(b, s // GMLP_CHUNK, GMLP_CHUNK, A_GROUPS, A_GROUP_DIM)
    w = w_s * jnp.tril(jnp.ones((GMLP_CHUNK, GMLP_CHUNK), w_s.dtype))
    sv = jnp.einsum('gts,bnsgc->bntgc', w, vg) + b_s.T[:, :, None]
    return u * sv.reshape(b, s, A_WIDTH)


def stick_breaking_attention(q, k, v):
    b, s, h, dh = q.shape
    scale = dh ** -0.5
    pos = jnp.arange(s, dtype=jnp.int32)
    starts = jnp.arange(s // Q_BLOCK, dtype=jnp.int32) * Q_BLOCK

    def block(args):
        qb, t0 = args
        z = jnp.einsum('bthd,bshd->bhts', qb, k).astype(jnp.float32) * scale
        t = t0 + jnp.arange(Q_BLOCK, dtype=jnp.int32)
        strict = pos[None, :] < t[:, None]
        log_not = jnp.where(strict, jax.nn.log_sigmoid(-z), 0.0)
        after = lax.cumsum(log_not, axis=3, reverse=True) - log_not
        w = jnp.where(strict, jnp.exp(jax.nn.log_sigmoid(z) + after), 0.0)
        return jnp.einsum('bhts,bshd->bthd', w.astype(v.dtype), v)

    out = lax.map(block, (to_blocks(q), starts))
    return from_blocks(out).reshape(b, s, h * dh)


def even_mixer(x, w_in, ln_g, ln_b, w_s, b_s, w_o):
    b, s, _ = x.shape
    z = x @ w_in
    a_part = jax.nn.gelu(z[..., :2 * A_WIDTH])
    u, v = a_part[..., :A_WIDTH], a_part[..., A_WIDTH:]
    q, k, vv = jnp.split(z[..., 2 * A_WIDTH:], 3, axis=-1)
    heads = lambda t: t.reshape(b, s, B_HEADS, HEAD_DIM)
    a_out = spatial_gating(u, v, ln_g, ln_b, w_s, b_s)
    b_out = stick_breaking_attention(heads(q), heads(k), heads(vv))
    return jnp.concatenate([a_out, b_out], axis=-1) @ w_o


def odd_mixer(x, w_in, w_o):
    b, s, _ = x.shape
    z = x @ w_in
    q, k, v, q_idx, k_idx, w_idx = jnp.split(z, ODD_SPLITS, axis=-1)
    q = q.reshape(b, s, C_KV_GROUPS, C_HEADS_PER_GROUP, HEAD_DIM)
    k = k.reshape(b, s, C_KV_GROUPS, HEAD_DIM)
    v = v.reshape(b, s, C_KV_GROUPS, HEAD_DIM)
    q_idx = q_idx.reshape(b, s, IDX_HEADS, IDX_DIM)
    w_idx = w_idx * (IDX_HEADS ** -0.5)
    topk = min(IDX_TOPK_MAX, s // 4)
    slopes = (2.0 ** (-8.0 * jnp.arange(1, C_HEADS + 1, dtype=jnp.float32) / C_HEADS)).reshape(C_KV_GROUPS, C_HEADS_PER_GROUP)
    pos = jnp.arange(s, dtype=jnp.int32)
    starts = jnp.arange(s // Q_BLOCK, dtype=jnp.int32) * Q_BLOCK
    gather = jax.vmap(lambda kk, ii: kk[ii])

    def block(args):
        qb, qib, wb, t0 = args
        t = t0 + jnp.arange(Q_BLOCK, dtype=jnp.int32)
        visible_end = (t // CHUNK + 1) * CHUNK
        admissible = pos[None, :] < visible_end[:, None]
        rel = jax.nn.relu(jnp.einsum('bthc,bsc->bths', qib, k_idx).astype(jnp.float32) * (IDX_DIM ** -0.5))
        iscore = jnp.einsum('bth,bths->bts', wb.astype(jnp.float32), rel)
        iscore = jnp.where(admissible[None], iscore, -jnp.inf)
        _, idx = lax.top_k(iscore, topk)
        valid = idx < visible_end[None, :, None]
        k_sel = gather(k, idx)
        v_sel = gather(v, idx)
        logits = jnp.einsum('btgrd,btkgd->btgrk', qb, k_sel).astype(jnp.float32) * (HEAD_DIM ** -0.5)
        dist = jnp.abs(t[None, :, None] - idx).astype(jnp.float32)
        logits = logits - slopes[None, None, :, :, None] * dist[:, :, None, None, :]
        logits = jnp.where(valid[:, :, None, None, :], logits, -jnp.inf)
        probs = jax.nn.softmax(logits, axis=-1)
        o = jnp.einsum('btgrk,btkgd->btgrd', probs.astype(v.dtype), v_sel)
        return o.reshape(b, Q_BLOCK, C_WIDTH)

    out = lax.map(block, (to_blocks(q), to_blocks(q_idx), to_blocks(w_idx), starts))
    return from_blocks(out) @ w_o


def moe(h, w_router, b_router, w_gu, b_gu, w_down, b_down):
    b, s, d = h.shape
    n_tok = b * s
    n_asg = n_tok * TOP_K
    xt = h.reshape(n_tok, d)
    logits = (xt @ w_router + b_router).astype(jnp.float32)
    top_vals, top_idx = lax.top_k(logits, TOP_K)
    gates = jax.nn.softmax(top_vals, axis=-1)
    flat_e = top_idx.reshape(-1)
    flat_tok = jnp.arange(n_asg, dtype=jnp.int32) // TOP_K
    flat_gate = gates.reshape(-1)
    order = jnp.argsort(flat_e)
    sorted_e = flat_e[order]
    counts = jnp.bincount(flat_e, length=N_EXPERTS)
    padded = (counts + MOE_BLOCK - 1) // MOE_BLOCK * MOE_BLOCK
    grp_starts = jnp.cumsum(counts) - counts
    pad_ends = jnp.cumsum(padded)
    pad_starts = pad_ends - padded
    dest = pad_starts[sorted_e] + jnp.arange(n_asg, dtype=jnp.int32) - grp_starts[sorted_e]
    n_blocks = n_asg // MOE_BLOCK + N_EXPERTS
    n_rows = n_blocks * MOE_BLOCK
    row_tok = jnp.full((n_rows,), n_tok, jnp.int32).at[dest].set(flat_tok[order])
    row_gate = jnp.zeros((n_rows,), jnp.float32).at[dest].set(flat_gate[order])
    block_e = jnp.minimum(jnp.searchsorted(pad_ends, jnp.arange(n_blocks, dtype=pad_ends.dtype) * MOE_BLOCK, side='right'), N_EXPERTS - 1)
    x_pad = jnp.concatenate([xt, jnp.zeros((1, d), xt.dtype)], axis=0)

    def expert_block(args):
        tok, g, e = args
        xb = x_pad[tok]
        gu = xb @ w_gu[e] + b_gu[e]
        gate = jnp.minimum(gu[:, :D_EXPERT], SWIGLU_LIMIT)
        up = jnp.clip(gu[:, D_EXPERT:], -SWIGLU_LIMIT, SWIGLU_LIMIT)
        act = gate * jax.nn.sigmoid(SWIGLU_ALPHA * gate) * (up + 1.0)
        y = act @ w_down[e] + b_down[e]
        return y * g[:, None].astype(y.dtype)

    ys = lax.map(expert_block, (row_tok.reshape(n_blocks, MOE_BLOCK), row_gate.reshape(n_blocks, MOE_BLOCK), block_e))
    out = jax.ops.segment_sum(ys.reshape(n_rows, d), row_tok, num_segments=n_tok + 1)[:n_tok]
    return out.reshape(b, s, d)


def _normal(key, shape, scale):
    return jax.random.normal(key, shape, jnp.float32) * scale


def setup_inputs(seed: int = 0) -> dict:
    key = jax.random.key(seed)
    ks = jax.random.split(key, 24)
    D = D_MODEL
    return {
        'x': _normal(ks[0], (BATCH, SEQ, D), 1.0),
        'p': _normal(ks[1], (DEPTH, BATCH, SEQ, PLE_DIM), 1.0),
        'even_w_in': _normal(ks[2], (N_EVEN, D, EVEN_IN), D ** -0.5),
        'even_gmlp_ln_g': 1.0 + _normal(ks[3], (N_EVEN, A_WIDTH), 0.02),
        'even_gmlp_ln_b': _normal(ks[4], (N_EVEN, A_WIDTH), 0.02),
        'even_w_s': _normal(ks[5], (N_EVEN, A_GROUPS, GMLP_CHUNK, GMLP_CHUNK), GMLP_CHUNK ** -0.5),
        'even_b_s': 1.0 + _normal(ks[6], (N_EVEN, A_GROUPS, GMLP_CHUNK), 0.1),
        'even_w_o': _normal(ks[7], (N_EVEN, D, D), DEEPNORM_BETA * D ** -0.5),
        'odd_w_in': _normal(ks[8], (N_ODD, D, ODD_IN), D ** -0.5),
        'odd_w_o': _normal(ks[9], (N_ODD, C_WIDTH, D), DEEPNORM_BETA * C_WIDTH ** -0.5),
        'ln1_g': 1.0 + _normal(ks[10], (DEPTH, D), 0.02),
        'ln1_b': _normal(ks[11], (DEPTH, D), 0.02),
        'w_router': _normal(ks[12], (DEPTH, D, N_EXPERTS), D ** -0.5),
        'b_router': _normal(ks[13], (DEPTH, N_EXPERTS), 0.01),
        'w_gu': _normal(ks[14], (DEPTH, N_EXPERTS, D, 2 * D_EXPERT), D ** -0.5),
        'b_gu': _normal(ks[15], (DEPTH, N_EXPERTS, 2 * D_EXPERT), 0.01),
        'w_down': _normal(ks[16], (DEPTH, N_EXPERTS, D_EXPERT, D), DEEPNORM_BETA * D_EXPERT ** -0.5),
        'b_down': _normal(ks[17], (DEPTH, N_EXPERTS, D), 0.01),
        'ln2_g': 1.0 + _normal(ks[18], (DEPTH, D), 0.02),
        'ln2_b': _normal(ks[19], (DEPTH, D), 0.02),
        'w_ple': _normal(ks[20], (DEPTH, PLE_DIM, D), PLE_DIM ** -0.5),
        'w_ple_gate': _normal(ks[21], (DEPTH, D, D), D ** -0.5),
        'b_ple_gate': _normal(ks[22], (DEPTH, D), 0.01),
    }


def reference(x, p, even_w_in, even_gmlp_ln_g, even_gmlp_ln_b, even_w_s, even_b_s, even_w_o, odd_w_in, odd_w_o, ln1_g, ln1_b, w_router, b_router, w_gu, b_gu, w_down, b_down, ln2_g, ln2_b, w_ple, w_ple_gate, b_ple_gate):
    for i in range(DEPTH):
        j = i // 2
        if i % 2 == 0:
            mix = even_mixer(x, even_w_in[j], even_gmlp_ln_g[j], even_gmlp_ln_b[j], even_w_s[j], even_b_s[j], even_w_o[j])
        else:
            mix = odd_mixer(x, odd_w_in[j], odd_w_o[j])
        h = layer_norm(DEEPNORM_ALPHA * x + mix, ln1_g[i], ln1_b[i])
        mid = DEEPNORM_ALPHA * h + moe(h, w_router[i], b_router[i], w_gu[i], b_gu[i], w_down[i], b_down[i])
        gate = jax.nn.sigmoid(mid @ w_ple_gate[i] + b_ple_gate[i])
        x = layer_norm(mid + gate * (p[i] @ w_ple[i]), ln2_g[i], ln2_b[i])
    return x
```

```cpp
#include <hip/hip_runtime.h>
#include <cstdio>
#include <cstdint>

#define LAS __attribute__((address_space(3)))
#define GAS __attribute__((address_space(1)))
typedef unsigned short bf16_t;
typedef short bf16x8 __attribute__((ext_vector_type(8)));
typedef short s16x4 __attribute__((ext_vector_type(4)));
typedef float f32x2 __attribute__((ext_vector_type(2)));
typedef float f32x4 __attribute__((ext_vector_type(4)));
typedef float f32x16 __attribute__((ext_vector_type(16)));
typedef unsigned u32x2 __attribute__((ext_vector_type(2)));
typedef unsigned u32x4 __attribute__((ext_vector_type(4)));

constexpr int DM = 1024, NB = 8, SEQ = 4096, NTOK = NB * SEQ;
constexpr int ZE = 2560;
constexpr int ZO = 2304, ZO_REAL = 2120;
constexpr int OQ = 0, OK_ = 1024, OV = 1280, OQI = 1536, OKI = 2048, OWI = 2112;
constexpr int NEXP = 32, PLE = 256;
constexpr int NGRP = NTOK / 128;
constexpr int MAXTILES = NTOK * 4 / 256 + NEXP;
constexpr int MAXROWS = MAXTILES * 256;
constexpr float LN_EPS = 1e-5f;
constexpr float ALPHA = 1.4142135623730951f;
constexpr float LOG2E = 1.4426950408889634f;
constexpr float WSC = 64.f, WSC_INV = 1.f / 64.f;

#ifndef FP8_IN0
#define FP8_IN0 0
#endif
#ifndef Y_FP8
#define Y_FP8 1
#endif
#ifndef MOE_ALIGN
#define MOE_ALIGN true
#endif
#ifndef FP8_IN1
#define FP8_IN1 0
#endif
#ifndef FP8_OUT
#define FP8_OUT 0
#endif
#ifndef FP8_GATE
#define FP8_GATE 1
#endif
#ifndef PROBE_DUP
#define PROBE_DUP 0
#endif
#define PM(k) (((PROBE_DUP >> (k)) & 1) ? 2 : 1)

constexpr size_t MiB = 1u << 20;
constexpr size_t WS_CTL = 0, CTL_ZERO_BYTES = 1 * MiB;
constexpr size_t WS_WRT = 1 * MiB;
constexpr size_t WS_WSB = WS_WRT + 256 * 1024;
constexpr size_t WS_CNT = WS_WSB + 256 * 1024;
constexpr size_t WS_TOPI = 2 * MiB;
constexpr size_t WS_GATE = WS_TOPI + 512 * 1024;
constexpr size_t WS_SLOT = 3 * MiB;
constexpr size_t WS_ROWG = WS_SLOT + 512 * 1024;
constexpr size_t WS_WIN0 = 8 * MiB, WS_WO0 = 13 * MiB, WS_WIN1 = 15 * MiB, WS_WO1 = 20 * MiB, WS_WG = 22 * MiB, WS_WPLE = 26 * MiB;
constexpr size_t WS_WGU = 32 * MiB, WS_WD = 288 * MiB;
constexpr size_t WS_XB = 416 * MiB, WS_PB = 480 * MiB, WS_PPLE = 512 * MiB, WS_Z = 640 * MiB, WS_CAT = 800 * MiB, WS_T1 = 864 * MiB;
constexpr size_t WS_BM = 1328 * MiB;
constexpr size_t WS_KV1 = WS_BM + 16 * MiB;
constexpr size_t WS_KI1 = WS_KV1 + 32 * MiB;
constexpr size_t WS_HB = 928 * MiB, WS_MIDB = 992 * MiB, WS_XS = 1056 * MiB, WS_ACT = 1328 * MiB;
constexpr size_t WS_XQ = 1600 * MiB, WS_MIDQ = 1632 * MiB, WS_END = 1664 * MiB;
static_assert(WS_ROWG + (size_t)MAXROWS * 4 <= WS_WIN0, "small buffers");
static_assert(WS_XS + (size_t)MAXROWS * DM * 2 <= WS_ACT && WS_ACT + (size_t)MAXROWS * DM * 2 <= WS_END, "moe buffers");

constexpr int RING_BYTES = 131072;
constexpr int MISC_OFF = RING_BYTES;
constexpr int TAB_OFF = MISC_OFF + 512;
constexpr int XTRA_OFF = TAB_OFF + 6144;
constexpr int LDS_BYTES = 147456;
static_assert(XTRA_OFF + 8192 <= LDS_BYTES, "LDS map");
constexpr int TB_TOT16 = 0, TB_BEF16 = 2048, TB_TOTAL = 4096, TB_BEFORE = 4224, TB_PADST = 4352  , TB_NTL = 4488, TB_LCUR = 4608  , TB_BASE = 4736  , TB_T2E = 5120  ;
static_assert(TB_T2E + 544 <= 6144, "tab");

#define RLX_AGENT __ATOMIC_RELAXED, __HIP_MEMORY_SCOPE_AGENT
typedef __bf16 bf16x2_t __attribute__((ext_vector_type(2)));
__device__ __forceinline__ unsigned cvt_pk_bf16(float lo, float hi) { const f32x2 v = {lo, hi}; const bf16x2_t b = __builtin_convertvector(v, bf16x2_t); return __builtin_bit_cast(unsigned, b); }
__device__ __forceinline__ unsigned char f8_1(float v) { return (unsigned char)(__builtin_amdgcn_cvt_pk_fp8_f32(v, v, 0, false) & 0xff); }
#if FP8_OUT
#define CAT_ST(cat, idx, v) ((cat)[idx] = f8_1(v))
#else
#define CAT_ST(cat, idx, v) (((bf16_t*)(cat))[idx] = (bf16_t)(cvt_pk_bf16((v), 0.f) & 0xffffu))
#endif
__device__ __forceinline__ float bf_lo(unsigned u) { return __uint_as_float(u << 16); }
__device__ __forceinline__ float bf_hi(unsigned u) { return __uint_as_float(u & 0xffff0000u); }
__device__ __forceinline__ float bf1(bf16_t u) { return __uint_as_float(((unsigned)u) << 16); }
template <int K> __device__ __forceinline__ int sxi(int v) {
    if constexpr (K == 32) { const auto rr = __builtin_amdgcn_permlane32_swap((unsigned)v, (unsigned)v, false, false); return (int)(rr[0] ^ rr[1] ^ (unsigned)v); }
    else return __builtin_amdgcn_ds_swizzle(v, (K << 10) | 0x1f);
}
template <int K> __device__ __forceinline__ float sxf(float v) { return __int_as_float(sxi<K>(__float_as_int(v))); }
__device__ __forceinline__ float wave_sum(float x) {
    int v = __float_as_int(x);
#define WSF_STEP(ctrl, rm) { const int o = __builtin_amdgcn_update_dpp(0, v, ctrl, rm, 0xf, false); v = __float_as_int(__int_as_float(v) + __int_as_float(o)); }
    WSF_STEP(0x111, 0xf) WSF_STEP(0x112, 0xf) WSF_STEP(0x114, 0xf) WSF_STEP(0x118, 0xf) WSF_STEP(0x142, 0xa) WSF_STEP(0x143, 0xc)
#undef WSF_STEP
    return __int_as_float(__builtin_amdgcn_readlane(v, 63));
}
__device__ __forceinline__ float wave_max(float v) {
    v = fmaxf(v, sxf<1>(v)); v = fmaxf(v, sxf<2>(v)); v = fmaxf(v, sxf<4>(v)); v = fmaxf(v, sxf<8>(v)); v = fmaxf(v, sxf<16>(v)); v = fmaxf(v, sxf<32>(v));
    return v;
}
__device__ __forceinline__ float wave_min(float v) {
    v = fminf(v, sxf<1>(v)); v = fminf(v, sxf<2>(v)); v = fminf(v, sxf<4>(v)); v = fminf(v, sxf<8>(v)); v = fminf(v, sxf<16>(v)); v = fminf(v, sxf<32>(v));
    return v;
}
__device__ __forceinline__ int wave_sumi(int v) {
    v += sxi<1>(v); v += sxi<2>(v); v += sxi<4>(v); v += sxi<8>(v); v += sxi<16>(v); v += sxi<32>(v);
    return v;
}
__device__ __forceinline__ int wave_sum_uniform(int v) {
    v += __builtin_amdgcn_update_dpp(0, v, 0x111, 0xf, 0xf, false);
    v += __builtin_amdgcn_update_dpp(0, v, 0x112, 0xf, 0xf, false);
    v += __builtin_amdgcn_update_dpp(0, v, 0x114, 0xf, 0xf, false);
    v += __builtin_amdgcn_update_dpp(0, v, 0x118, 0xf, 0xf, false);
    v += __builtin_amdgcn_update_dpp(0, v, 0x142, 0xa, 0xf, false);
    v += __builtin_amdgcn_update_dpp(0, v, 0x143, 0xc, 0xf, false);
    return __builtin_amdgcn_readlane(v, 63);
}
__device__ __forceinline__ float wave_max_uniform(float x) {
    int v = __float_as_int(x);
#define WMX_STEP(ctrl, rm) { const int o = __builtin_amdgcn_update_dpp(v, v, ctrl, rm, 0xf, false); v = __float_as_int(fmaxf(__int_as_float(v), __int_as_float(o))); }
    WMX_STEP(0x111, 0xf) WMX_STEP(0x112, 0xf) WMX_STEP(0x114, 0xf) WMX_STEP(0x118, 0xf) WMX_STEP(0x142, 0xa) WMX_STEP(0x143, 0xc)
#undef WMX_STEP
    return __int_as_float(__builtin_amdgcn_readlane(v, 63));
}
__device__ __forceinline__ float relu_i(float x) { const int i = __float_as_int(x); return __int_as_float(i > 0 ? i : 0); }
__device__ __forceinline__ float ex2(float x) { return __builtin_amdgcn_exp2f(x); }
__device__ __forceinline__ float lg2(float x) { return __builtin_amdgcn_logf(x); }
__device__ __forceinline__ float rcpf_(float x) { return __builtin_amdgcn_rcpf(x); }
__device__ __forceinline__ float sigmoidf_(float x) { return rcpf_(1.f + ex2(-LOG2E * x)); }
__device__ __forceinline__ float gelu_tanh(float x) { return x * rcpf_(1.f + ex2(-2.302208198f * (x + 0.044715f * x * x * x))); }

namespace pg8 {
constexpr int BM = 256, BK = 64, HALF = 128, HTB = HALF * BK * 2, STAGE_BYTES = 8 * HTB, NXCD = 8, WGM = 8;
__host__ __device__ __forceinline__ int lds_byte(int r, int c) { const int st = (r >> 4) * 2 + (c >> 5), rr = r & 15, cc = c & 31, ob = rr * 64 + cc * 2; return st * 1024 + (ob ^ (((ob >> 9) & 1) << 5)); }
__host__ __device__ __forceinline__ void stage_rc(int b, int& R, int& C) { const int st = b / 1024, sb = b % 1024, swz = sb ^ (((sb >> 9) & 1) << 5); R = (st >> 1) * 16 + swz / 64; C = (st & 1) * 32 + (swz % 64) / 2; }
__host__ __device__ __forceinline__ int perm32(int rho) { const int n = rho >> 4, i = rho & 15; return 8 * (i >> 2) + 4 * n + (i & 3); }

struct Unit { int pm, pn, e; const char* b0; };
typedef int v8i_t __attribute__((ext_vector_type(8)));
typedef int v4i_t __attribute__((ext_vector_type(4)));
__device__ __forceinline__ v8i_t cat8(const bf16x8 a, const bf16x8 b) { const v4i_t x = __builtin_bit_cast(v4i_t, a), y = __builtin_bit_cast(v4i_t, b); return __builtin_shufflevector(x, y, 0, 1, 2, 3, 4, 5, 6, 7); }

struct DenseOrder {
    int nM, nN, nwg, G, c, rep; const char* A; const char* B; size_t tstep, hstep;
    __device__ __forceinline__ void init(const void* A_, const void* B_, int M, int N, int K, int G_, int c_, int rep_ = 1) { initp(A_, B_, M, N, 2 * K, G_, c_, rep_); }
    __device__ __forceinline__ void initp(const void* A_, const void* B_, int M, int N, int pitch, int G_, int c_, int rep_ = 1) { A = (const char*)A_; B = (const char*)B_; nM = M / BM; nN = N / BM; nwg = nM * nN; G = G_; c = c_; rep = rep_; hstep = (size_t)HALF * pitch; tstep = 2 * hstep; }
    __device__ __forceinline__ bool next(int i, Unit& u) const {
        long L = (long)i * G + c; if (L >= (long)nwg * rep) return false; if (L >= nwg) L -= nwg;
        int wgid = (int)L; { const int q = nwg / NXCD, r = nwg % NXCD, xcd = wgid % NXCD, off = wgid / NXCD; wgid = (xcd < r ? xcd * (q + 1) : r * (q + 1) + (xcd - r) * q) + off; }
        const int nig = WGM * nN, gid = wgid / nig, fm = gid * WGM, gsz = (nM - fm) < WGM ? (nM - fm) : WGM;
        u.pm = fm + ((wgid % nig) % gsz); u.pn = (wgid % nig) / gsz; u.e = 0;
        u.b0 = B + (size_t)u.pn * tstep; return true;
    }
    __device__ __forceinline__ const char* aptr(const Unit& u) const { return A + (size_t)u.pm * tstep; }
    __device__ __forceinline__ size_t b1off() const { return hstep; }
};
struct PleOrder {
    DenseOrder D;
    __device__ __forceinline__ bool next(int i, Unit& u) const { if (!D.next(i, u)) return false; if (u.pm >= 32768 / BM) u.b0 += (size_t)1024 * 256 * 2; return true; }
    __device__ __forceinline__ const char* aptr(const Unit& u) const { return D.aptr(u); }
    __device__ __forceinline__ size_t b1off() const { return D.b1off(); }
};
template <int NT, bool SWIGLU>
struct MoeOrder {
    int nunits, G, c, rep; const LAS unsigned char* t2e; const char* A; const char* W;
    static constexpr size_t hstep = (size_t)HALF * 1024, tstep = 2 * hstep;
    __device__ __forceinline__ bool next(int i, Unit& u) const {
        const int vc = ((G & 7) == 0) ? (c & 7) * (G >> 3) + (c >> 3) : c;
        int L = i * G + vc; if (L >= nunits * rep) return false; if (L >= nunits) L -= nunits;
        const int rt = L / NT, pn = L % NT;
        const int e = __builtin_amdgcn_readfirstlane((int)t2e[rt]);
        u.pm = rt; u.pn = pn; u.e = e;
        if (SWIGLU) u.b0 = W + (size_t)e * (16 * hstep) + (size_t)pn * hstep;
        else u.b0 = W + (size_t)e * (8 * hstep) + (size_t)pn * tstep;
        return true;
    }
    __device__ __forceinline__ const char* aptr(const Unit& u) const { return A + (size_t)u.pm * tstep; }
    __device__ __forceinline__ size_t b1off() const { return SWIGLU ? 8 * hstep : hstep; }
};

template <class Epi, class Sched, bool FP8 = false, bool ALIGN_EPI = true>
__device__ __forceinline__ void gemm_phase(LAS unsigned char* lds, const int tid, const int pitch, const Sched& S, const Epi& E) {
    const int wid = __builtin_amdgcn_readfirstlane(tid >> 6), lane = tid & 63, wr = wid >> 2, wc = wid & 3, fr = lane & 15, fq = lane >> 4;
    const int nt = pitch / (BK * 2);
    unsigned voffA[2], voffB[2];
#pragma unroll
    for (int i = 0; i < 2; ++i) { int R, C; stage_rc(tid * 16 + i * 8192, R, C); const int Rb = (R & ~31) + perm32(R & 31);
        voffA[i] = (unsigned)(R * pitch + C * 2); voffB[i] = (unsigned)(Rb * pitch + C * 2); }
    const size_t kstep = (size_t)(BK * 2);
    const size_t hstep = (size_t)HALF * pitch;
    const unsigned ldsw = (unsigned)wid * 1024u;
    int sc127 = 127; asm volatile("" : "+v"(sc127));
    const unsigned ldsu = (unsigned)__builtin_amdgcn_readfirstlane((int)(unsigned)(uintptr_t)lds) + ldsw;
    const int aoff = lds_byte(wr * 64 + fr, fq * 8), boff = lds_byte(wc * 32 + fr, fq * 8);
#define PG8_SA(b, h) (((b) * 2 + (h)) * HTB)
#define PG8_SB(b, h) ((4 + (b) * 2 + (h)) * HTB)
#define PG8_STAGE(bufoff, gbase, voff) do { _Pragma("unroll") for (int _i = 0; _i < 2; ++_i) { unsigned _keep; \
        asm volatile("s_mov_b32 %0, m0\n\ts_mov_b32 m0, %3\n\ts_nop 0\n\tglobal_load_lds_dwordx4 %1, %2\n\ts_mov_b32 m0, %0" : "=&s"(_keep) : "v"((voff)[_i]), "s"((const char*)(gbase)), "s"(ldsu + (unsigned)((bufoff) + _i * 8192)) : "memory"); } } while (0)
#define PG8_LDA(dst, b, h) do { _Pragma("unroll") for (int m = 0; m < 4; ++m) _Pragma("unroll") for (int k = 0; k < 2; ++k) dst[m][k] = *(const LAS bf16x8*)(lds + PG8_SA(b, h) + aoff + m * 2048 + k * 1024); } while (0)
#define PG8_LDB(dst, b, h) do { _Pragma("unroll") for (int n = 0; n < 2; ++n) _Pragma("unroll") for (int k = 0; k < 2; ++k) dst[n][k] = *(const LAS bf16x8*)(lds + PG8_SB(b, h) + boff + n * 2048 + k * 1024); } while (0)
#define PG8_MMA(ai, bj, At, Bt) do { __builtin_amdgcn_s_setprio(1); _Pragma("unroll") for (int m = 0; m < 4; ++m) _Pragma("unroll") for (int n = 0; n < 2; ++n) { \
        if constexpr (FP8) { const v8i_t _a = cat8(Bt[n][0], Bt[n][1]), _b = cat8(At[m][0], At[m][1]); \
            asm volatile("v_mfma_scale_f32_16x16x128_f8f6f4 %0, %1, %2, %0, %3, %3 op_sel_hi:[0,0,0]" : "+v"(acc[ai][bj][m][n]) : "v"(_a), "v"(_b), "v"(sc127)); } \
        else { _Pragma("unroll") for (int k = 0; k < 2; ++k) acc[ai][bj][m][n] = __builtin_amdgcn_mfma_f32_16x16x32_bf16(Bt[n][k], At[m][k], acc[ai][bj][m][n], 0, 0, 0); } } __builtin_amdgcn_s_setprio(0); } while (0)
#define PG8_WAIT_V(n) asm volatile("s_waitcnt vmcnt(" #n ")" ::: "memory")
#define PG8_WAIT_L(n) asm volatile("s_waitcnt lgkmcnt(" #n ")" ::: "memory")
#define PG8_BAR __builtin_amdgcn_s_barrier()
#define PG8_SCHED __builtin_amdgcn_sched_barrier(0)
    Unit cur, nxt; int ui = 0;
    if (!S.next(0, cur)) return;
    f32x4 acc[2][2][4][2];
#pragma unroll
    for (int a = 0; a < 2; ++a)
#pragma unroll
        for (int b = 0; b < 2; ++b)
#pragma unroll
            for (int m = 0; m < 4; ++m)
#pragma unroll
                for (int n = 0; n < 2; ++n) acc[a][b][m][n] = (f32x4){0.f, 0.f, 0.f, 0.f};
    bf16x8 At[4][2], B0[2][2], B1[2][2];
    const char* cA = S.aptr(cur); const char* cB0 = cur.b0; const char* cB1 = cB0 + S.b1off();
    PG8_STAGE(PG8_SB(0, 0), cB0, voffB); PG8_STAGE(PG8_SB(0, 1), cB1, voffB); PG8_STAGE(PG8_SA(0, 0), cA, voffA); PG8_STAGE(PG8_SA(0, 1), cA + hstep, voffA);
    if (wr == 1) PG8_BAR;
    PG8_WAIT_V(2); PG8_BAR;
    PG8_STAGE(PG8_SB(1, 0), cB0 + kstep, voffB); PG8_STAGE(PG8_SA(1, 0), cA + kstep, voffA); PG8_STAGE(PG8_SB(1, 1), cB1 + kstep, voffB);
    PG8_WAIT_V(6); PG8_BAR;
    for (;;) {
        const bool has_next = S.next(ui + 1, nxt);
        const char* nA = has_next ? S.aptr(nxt) : cA; const char* nB0 = has_next ? nxt.b0 : cB0; const char* nB1 = nB0 + S.b1off();
        for (int t = 0; t < nt; t += 2) {
            const bool last = (t == nt - 2);
            const char* a1 = cA + (size_t)(t + 1) * kstep;
            const char* a2 = last ? nA : cA + (size_t)(t + 2) * kstep;
            const char* b20 = last ? nB0 : cB0 + (size_t)(t + 2) * kstep; const char* b21 = last ? nB1 : cB1 + (size_t)(t + 2) * kstep;
            const char* a3 = a2 + kstep; const char* b30 = b20 + kstep; const char* b31 = b21 + kstep;
            PG8_LDB(B0, 0, 0); PG8_LDB(B1, 0, 1); PG8_SCHED; PG8_LDA(At, 0, 0); PG8_STAGE(PG8_SA(1, 1), a1 + hstep, voffA);
            PG8_WAIT_V(8); PG8_WAIT_L(0); PG8_BAR; PG8_MMA(0, 0, At, B0); PG8_MMA(0, 1, At, B1); PG8_BAR; PG8_SCHED;
            PG8_LDA(At, 0, 1); PG8_STAGE(PG8_SB(0, 0), b20, voffB); PG8_STAGE(PG8_SB(0, 1), b21, voffB); PG8_STAGE(PG8_SA(0, 0), a2, voffA);
            PG8_WAIT_V(8); PG8_WAIT_L(0); PG8_BAR; PG8_MMA(1, 0, At, B0); PG8_MMA(1, 1, At, B1); PG8_BAR; PG8_SCHED;
            PG8_LDB(B0, 1, 0); PG8_LDB(B1, 1, 1); PG8_SCHED; PG8_LDA(At, 1, 0); PG8_STAGE(PG8_SA(0, 1), a2 + hstep, voffA);
            PG8_WAIT_V(8); PG8_WAIT_L(0); PG8_BAR; PG8_MMA(0, 0, At, B0); PG8_MMA(0, 1, At, B1); PG8_BAR; PG8_SCHED;
            PG8_LDA(At, 1, 1); PG8_STAGE(PG8_SB(1, 0), b30, voffB); PG8_STAGE(PG8_SB(1, 1), b31, voffB); PG8_STAGE(PG8_SA(1, 0), a3, voffA);
            PG8_WAIT_V(8); PG8_WAIT_L(0); PG8_BAR; PG8_MMA(1, 0, At, B0); PG8_MMA(1, 1, At, B1); PG8_BAR; PG8_SCHED;
        }
        if constexpr (ALIGN_EPI) { if (wr == 0) PG8_BAR; }
        E(acc, cur, wr, wc, fr, fq);
        if (!has_next) break;
#pragma unroll
        for (int a = 0; a < 2; ++a)
#pragma unroll
            for (int b = 0; b < 2; ++b)
#pragma unroll
                for (int m = 0; m < 4; ++m)
#pragma unroll
                    for (int n = 0; n < 2; ++n) acc[a][b][m][n] = (f32x4){0.f, 0.f, 0.f, 0.f};
        cur = nxt; cA = nA; cB0 = nB0; cB1 = nB1; ++ui;
        if constexpr (ALIGN_EPI) { if (wr == 1) PG8_BAR; }
    }
    PG8_WAIT_V(0);
    if constexpr (!ALIGN_EPI) { if (wr == 0) PG8_BAR; }
    PG8_BAR;
#undef PG8_SA
#undef PG8_SB
#undef PG8_STAGE
#undef PG8_LDA
#undef PG8_LDB
#undef PG8_MMA
#undef PG8_WAIT_V
#undef PG8_WAIT_L
#undef PG8_BAR
#undef PG8_SCHED
}

#define EPI_ROWS_BEGIN const int row0 = u.pm * BM + wr * 64 + fr; const int cl = wc * 32 + 8 * fq;
__device__ __forceinline__ void store8(bf16_t* p, const f32x4 v0, const f32x4 v1) {
    u32x4 w; w.x = cvt_pk_bf16(v0[0], v0[1]); w.y = cvt_pk_bf16(v0[2], v0[3]); w.z = cvt_pk_bf16(v1[0], v1[1]); w.w = cvt_pk_bf16(v1[2], v1[3]); *(u32x4*)p = w;
}
__device__ __forceinline__ u32x2 pack8_fp8(const f32x4 v0, const f32x4 v1) {
    int a = 0, b = 0; a = __builtin_amdgcn_cvt_pk_fp8_f32(v0[0], v0[1], a, false); a = __builtin_amdgcn_cvt_pk_fp8_f32(v0[2], v0[3], a, true);
    b = __builtin_amdgcn_cvt_pk_fp8_f32(v1[0], v1[1], b, false); b = __builtin_amdgcn_cvt_pk_fp8_f32(v1[2], v1[3], b, true); return (u32x2){(unsigned)a, (unsigned)b};
}
__device__ __forceinline__ void store8_fp8(unsigned char* p, const f32x4 v0, const f32x4 v1) { *(u32x2*)p = pack8_fp8(v0, v1); }
__device__ __forceinline__ void load8bf(const bf16_t* p, f32x4& v0, f32x4& v1) {
    const u32x4 w = *(const u32x4*)p; v0 = (f32x4){bf_lo(w.x), bf_hi(w.x), bf_lo(w.y), bf_hi(w.y)}; v1 = (f32x4){bf_lo(w.z), bf_hi(w.z), bf_lo(w.w), bf_hi(w.w)};
}
struct EpiPlain {
    bf16_t* O; int ldc;
    __device__ __forceinline__ void operator()(const f32x4 (&acc)[2][2][4][2], const Unit& u, int wr, int wc, int fr, int fq) const {
        EPI_ROWS_BEGIN
#pragma unroll
        for (int ai = 0; ai < 2; ++ai)
#pragma unroll
            for (int m = 0; m < 4; ++m) { bf16_t* rowp = O + (unsigned)((row0 + ai * HALF + m * 16) * ldc + u.pn * BM + cl);
#pragma unroll
                for (int bj = 0; bj < 2; ++bj) store8(rowp + bj * HALF, acc[ai][bj][m][0], acc[ai][bj][m][1]); asm volatile("" ::: "memory"); }
    }
};
struct EpiIn0 {
    static constexpr float WSI = FP8_IN0 ? WSC_INV : 1.f;
    bf16_t* O; float qscale;
    __device__ __forceinline__ void operator()(const f32x4 (&acc)[2][2][4][2], const Unit& u, int wr, int wc, int fr, int fq) const {
        EPI_ROWS_BEGIN
        if (u.pn < 4) {
#pragma unroll
            for (int ai = 0; ai < 2; ++ai)
#pragma unroll
                for (int m = 0; m < 4; ++m) { bf16_t* rowp = O + (unsigned)((row0 + ai * HALF + m * 16) * ZE + u.pn * BM + cl);
#pragma unroll
                    for (int bj = 0; bj < 2; ++bj) { f32x4 v0 = acc[ai][bj][m][0] * WSI, v1 = acc[ai][bj][m][1] * WSI;
#pragma unroll
                        for (int j = 0; j < 4; ++j) { v0[j] = gelu_tanh(v0[j]); v1[j] = gelu_tanh(v1[j]); }
                        store8(rowp + bj * HALF, v0, v1); asm volatile("" ::: "memory"); } }
        } else {
            const float sc = (u.pn < 6 ? qscale : 1.f) * WSI;
#pragma unroll
            for (int ai = 0; ai < 2; ++ai)
#pragma unroll
                for (int m = 0; m < 4; ++m) { bf16_t* rowp = O + (unsigned)((row0 + ai * HALF + m * 16) * ZE + u.pn * BM + cl);
#pragma unroll
                    for (int bj = 0; bj < 2; ++bj) store8(rowp + bj * HALF, acc[ai][bj][m][0] * sc, acc[ai][bj][m][1] * sc);
                    asm volatile("" ::: "memory"); }
        }
    }
};
struct EpiIn1 {
    static constexpr float WSI = FP8_IN1 ? WSC_INV : 1.f;
    bf16_t* O; bf16_t* KV; bf16_t* KI;
    __device__ __forceinline__ void operator()(const f32x4 (&acc)[2][2][4][2], const Unit& u, int wr, int wc, int fr, int fq) const {
        EPI_ROWS_BEGIN
        if (u.pn == 4 || u.pn == 5) {
            bf16_t* base = KV + (u.pn - 4) * 256 + cl;
#pragma unroll
            for (int ai = 0; ai < 2; ++ai)
#pragma unroll
                for (int m = 0; m < 4; ++m) { bf16_t* rowp = base + (unsigned)((row0 + ai * HALF + m * 16) * 512);
#pragma unroll
                    for (int bj = 0; bj < 2; ++bj) store8(rowp + bj * HALF, acc[ai][bj][m][0] * WSI, acc[ai][bj][m][1] * WSI);
                    asm volatile("" ::: "memory"); }
        } else {
            const float sc = (u.pn < 4 ? 0.125f * LOG2E : 1.f) * WSI;
#pragma unroll
            for (int ai = 0; ai < 2; ++ai)
#pragma unroll
                for (int m = 0; m < 4; ++m) { bf16_t* rowp = O + (unsigned)((row0 + ai * HALF + m * 16) * ZO + u.pn * BM + cl);
#pragma unroll
                    for (int bj = 0; bj < 2; ++bj) store8(rowp + bj * HALF, acc[ai][bj][m][0] * sc, acc[ai][bj][m][1] * sc);
                    asm volatile("" ::: "memory"); }
            if (u.pn == 8 && wc < 2) {
#pragma unroll
                for (int ai = 0; ai < 2; ++ai)
#pragma unroll
                    for (int m = 0; m < 4; ++m) { const int row = row0 + ai * HALF + m * 16;
                        store8(KI + (unsigned)(((((row >> 5) * 4 + (cl >> 4)) * 64) + (((cl >> 3) & 1) * 32 + (row & 31))) * 8), acc[ai][0][m][0] * WSI, acc[ai][0][m][1] * WSI); asm volatile("" ::: "memory"); }
            }
        }
    }
};
struct EpiOut {
    const float* xf; const bf16_t* xb; bf16_t* O;
    __device__ __forceinline__ void operator()(const f32x4 (&acc)[2][2][4][2], const Unit& u, int wr, int wc, int fr, int fq) const {
        EPI_ROWS_BEGIN
#pragma unroll
        for (int ai = 0; ai < 2; ++ai) {
            f32x4 xr[4][2][2];
#pragma unroll
            for (int m = 0; m < 4; ++m) { const unsigned off = (unsigned)((row0 + ai * HALF + m * 16) * DM + u.pn * BM + cl);
#pragma unroll
                for (int bj = 0; bj < 2; ++bj) {
                    if (xf) { xr[m][bj][0] = *(const f32x4*)(xf + off + bj * HALF); xr[m][bj][1] = *(const f32x4*)(xf + off + bj * HALF + 4); }
                    else load8bf(xb + off + bj * HALF, xr[m][bj][0], xr[m][bj][1]); } }
            asm volatile("" ::: "memory");
#pragma unroll
            for (int m = 0; m < 4; ++m) { const unsigned off = (unsigned)((row0 + ai * HALF + m * 16) * DM + u.pn * BM + cl);
#pragma unroll
                for (int bj = 0; bj < 2; ++bj)
                    store8(O + off + bj * HALF, xr[m][bj][0] * ALPHA + acc[ai][bj][m][0] * (FP8_OUT ? WSC_INV : 1.f), xr[m][bj][1] * ALPHA + acc[ai][bj][m][1] * (FP8_OUT ? WSC_INV : 1.f)); }
            asm volatile("" ::: "memory");
        }
    }
};
__device__ __forceinline__ f32x2 swiglu_pk(f32x2 g, f32x2 u) {
    f32x2 ga, ua; ga.x = fminf(g.x, 7.f); ga.y = fminf(g.y, 7.f);
    ua.x = __builtin_amdgcn_fmed3f(u.x, -7.f, 7.f); ua.y = __builtin_amdgcn_fmed3f(u.y, -7.f, 7.f);
    const f32x2 t = ga * (-1.702f * LOG2E);
    f32x2 e; e.x = __builtin_amdgcn_exp2f(t.x); e.y = __builtin_amdgcn_exp2f(t.y);
    const f32x2 d = e + 1.0f;
    f32x2 r; r.x = __builtin_amdgcn_rcpf(d.x); r.y = __builtin_amdgcn_rcpf(d.y);
    return (ga * r) * (ua + 1.0f);
}
struct EpiSwiglu {
    unsigned char* O; const float* bgu;
    __device__ __forceinline__ void operator()(const f32x4 (&acc)[2][2][4][2], const Unit& u, int wr, int wc, int fr, int fq) const {
        EPI_ROWS_BEGIN
        const int col = u.pn * HALF + cl;
        const float* bp = bgu + (unsigned)(u.e * 2048 + col);
        const f32x4 bg0 = *(const f32x4*)bp, bg1 = *(const f32x4*)(bp + 4), bu0 = *(const f32x4*)(bp + 1024), bu1 = *(const f32x4*)(bp + 1028);
#pragma unroll
        for (int ai = 0; ai < 2; ++ai)
#pragma unroll
            for (int m = 0; m < 4; ++m) { f32x4 g0 = acc[ai][0][m][0] * WSC_INV + bg0, g1 = acc[ai][0][m][1] * WSC_INV + bg1, p0 = acc[ai][1][m][0] * WSC_INV + bu0, p1 = acc[ai][1][m][1] * WSC_INV + bu1, r0, r1;
#pragma unroll
                for (int j = 0; j < 4; j += 2) { f32x2 o;
                    o = swiglu_pk((f32x2){g0[j], g0[j + 1]}, (f32x2){p0[j], p0[j + 1]}); r0[j] = o.x; r0[j + 1] = o.y;
                    o = swiglu_pk((f32x2){g1[j], g1[j + 1]}, (f32x2){p1[j], p1[j + 1]}); r1[j] = o.x; r1[j + 1] = o.y; }
                store8_fp8(O + (unsigned)((row0 + ai * HALF + m * 16) * DM + col), r0, r1); asm volatile("" ::: "memory"); }
    }
};
struct EpiDown {
    bf16_t* O; const float* bd; const float* rowgate;
    __device__ __forceinline__ void operator()(const f32x4 (&acc)[2][2][4][2], const Unit& u, int wr, int wc, int fr, int fq) const {
        EPI_ROWS_BEGIN
        const int col = u.pn * BM + cl; const float* bp = bd + (unsigned)(u.e * DM + col);
        f32x4 bv[2][2];
#pragma unroll
        for (int bj = 0; bj < 2; ++bj) { bv[bj][0] = *(const f32x4*)(bp + bj * HALF); bv[bj][1] = *(const f32x4*)(bp + bj * HALF + 4); }
        float gt[2][4];
#pragma unroll
        for (int ai = 0; ai < 2; ++ai)
#pragma unroll
            for (int m = 0; m < 4; ++m) gt[ai][m] = rowgate[row0 + ai * HALF + m * 16];
#pragma unroll
        for (int ai = 0; ai < 2; ++ai)
#pragma unroll
            for (int m = 0; m < 4; ++m) { const int row = row0 + ai * HALF + m * 16; const float g = gt[ai][m];
#pragma unroll
                for (int bj = 0; bj < 2; ++bj) {
                    if (Y_FP8) store8_fp8((unsigned char*)O + (unsigned)(row * DM + col + bj * HALF), (acc[ai][bj][m][0] * WSC_INV + bv[bj][0]) * (g * 16.f), (acc[ai][bj][m][1] * WSC_INV + bv[bj][1]) * (g * 16.f));
                    else store8(O + (unsigned)(row * DM + col + bj * HALF), (acc[ai][bj][m][0] * WSC_INV + bv[bj][0]) * g, (acc[ai][bj][m][1] * WSC_INV + bv[bj][1]) * g); }
                asm volatile("" ::: "memory"); }
    }
};
struct EpiGate {
    const bf16_t* mid; const bf16_t* P; const float* bg; bf16_t* O;
    __device__ __forceinline__ void operator()(const f32x4 (&acc)[2][2][4][2], const Unit& u, int wr, int wc, int fr, int fq) const {
        EPI_ROWS_BEGIN
        const int col = u.pn * BM + cl;
        f32x4 bv[2][2];
#pragma unroll
        for (int bj = 0; bj < 2; ++bj) { bv[bj][0] = *(const f32x4*)(bg + col + bj * HALF); bv[bj][1] = *(const f32x4*)(bg + col + bj * HALF + 4); }
#pragma unroll
        for (int ai = 0; ai < 2; ++ai) {
            u32x4 mr[4][2], pr[4][2];
#pragma unroll
            for (int m = 0; m < 4; ++m) { const unsigned off = (unsigned)((row0 + ai * HALF + m * 16) * DM + col);
#pragma unroll
                for (int bj = 0; bj < 2; ++bj) { mr[m][bj] = *(const u32x4*)(mid + off + bj * HALF); pr[m][bj] = *(const u32x4*)(P + off + bj * HALF); } }
            asm volatile("" ::: "memory");
#pragma unroll
            for (int m = 0; m < 4; ++m) { const unsigned off = (unsigned)((row0 + ai * HALF + m * 16) * DM + col);
#pragma unroll
                for (int bj = 0; bj < 2; ++bj) { const u32x4 mw = mr[m][bj], pw = pr[m][bj];
                    const f32x4 m0 = {bf_lo(mw.x), bf_hi(mw.x), bf_lo(mw.y), bf_hi(mw.y)}, m1 = {bf_lo(mw.z), bf_hi(mw.z), bf_lo(mw.w), bf_hi(mw.w)};
                    const f32x4 p0 = {bf_lo(pw.x), bf_hi(pw.x), bf_lo(pw.y), bf_hi(pw.y)}, p1 = {bf_lo(pw.z), bf_hi(pw.z), bf_lo(pw.w), bf_hi(pw.w)};
                    f32x4 r0, r1;
                    const f32x4 a0 = acc[ai][bj][m][0] * (FP8_GATE ? WSC_INV : 1.f) + bv[bj][0], a1 = acc[ai][bj][m][1] * (FP8_GATE ? WSC_INV : 1.f) + bv[bj][1];
#pragma unroll
                    for (int j = 0; j < 4; ++j) { r0[j] = m0[j] + sigmoidf_(a0[j]) * p0[j]; r1[j] = m1[j] + sigmoidf_(a1[j]) * p1[j]; }
                    store8(O + off + bj * HALF, r0, r1); } }
            asm volatile("" ::: "memory");
        }
    }
};
}

#define XB_TMO      128
#define XB_XCNT(j)  (256  + 64 * (j))
#define XB_XSUB(j)  (1280 + 64 * (j))
#define XB_XGEN(j)  (2304 + 64 * (j))
#define XB_TOP      3328
#define XB_TOPGEN   3392
#define XCD_BAR_WORDS 3456
#define XB_SPIN_CAP (1u << 18)
__device__ __forceinline__ unsigned xb_ld(unsigned* p)              { return __hip_atomic_load(p, __ATOMIC_RELAXED, __HIP_MEMORY_SCOPE_AGENT); }
__device__ __forceinline__ unsigned xb_add(unsigned* p, unsigned v) { return __hip_atomic_fetch_add(p, v, __ATOMIC_RELAXED, __HIP_MEMORY_SCOPE_AGENT); }
__device__ __forceinline__ unsigned xb_xcc_id() { return (unsigned)__builtin_amdgcn_s_getreg((3 << 11) | 20) & 0xFu; }
#define XB_SPIN(cond, bar) do { unsigned _sp = 0; while (cond) { __builtin_amdgcn_s_sleep(1); \
    if ((++_sp & 255u) == 0u) { if (xb_ld(&(bar)[XB_TMO])) break; if (_sp > XB_SPIN_CAP) { atomicAdd(&(bar)[XB_TMO], 1u); break; } } } } while (0)
struct XcdBarrier { unsigned* bar; unsigned x; volatile LAS unsigned* st; };
__device__ __forceinline__ XcdBarrier xcd_barrier_post(unsigned* bar, volatile LAS unsigned* st) {
    XcdBarrier b; b.bar = bar; b.x = xb_xcc_id(); b.st = st;
    if (threadIdx.x == 0) (void)xb_add(&bar[XB_XCNT(b.x)], 1u);
    return b;
}
__device__ __forceinline__ void xcd_barrier_complete(unsigned* bar, unsigned x, unsigned& nloc, unsigned& nx) {
    const unsigned G = gridDim.x * gridDim.y * gridDim.z;
    unsigned sum, cnt, mine, sp = 0u;
    for (;;) {
        sum = 0u; cnt = 0u; mine = 0u;
#pragma unroll
        for (unsigned j = 0; j < 16; ++j) { const unsigned c = xb_ld(&bar[XB_XCNT(j)]); sum += c; cnt += (c > 0u) ? 1u : 0u; mine = (j == x) ? c : mine; }
        if (sum == G) break;
        __builtin_amdgcn_s_sleep(1);
        if ((++sp & 255u) == 0u) { if (xb_ld(&bar[XB_TMO])) break; if (sp > XB_SPIN_CAP) { atomicAdd(&bar[XB_TMO], 1u); break; } }
    }
    nloc = mine > 0u ? mine : 1u; nx = cnt > 0u ? cnt : 1u;
}
__device__ __forceinline__ void xcd_barrier(const XcdBarrier& b) {
    asm volatile("s_waitcnt vmcnt(0)" ::: "memory");
    __syncthreads();
    if (threadIdx.x == 0) {
        unsigned* bar = b.bar; asm volatile("" : "+s"(bar));
        unsigned bx = b.x; asm volatile("" : "+s"(bx));
        __builtin_amdgcn_s_waitcnt(0);
        unsigned nloc = b.st[0], nx = b.st[1];
        if (nloc == 0u) { xcd_barrier_complete(bar, bx, nloc, nx); b.st[0] = nloc; b.st[1] = nx; }
        const unsigned old = xb_add(&bar[XB_XSUB(bx)], 1u);
        const unsigned gen = old / nloc;
        if (old + 1u == (gen + 1u) * nloc) {
            __builtin_amdgcn_fence(__ATOMIC_RELEASE, "agent");
            asm volatile("s_waitcnt vmcnt(0)" ::: "memory");
            const unsigned og = xb_add(&bar[XB_TOP], 1u);
            const unsigned tg = og / nx;
            if (og + 1u == (tg + 1u) * nx) xb_add(&bar[XB_TOPGEN], 1u);
            else XB_SPIN(xb_ld(&bar[XB_TOPGEN]) == tg, bar);
            __builtin_amdgcn_fence(__ATOMIC_ACQUIRE, "agent");
            xb_add(&bar[XB_XGEN(bx)], 1u);
            asm volatile("s_waitcnt vmcnt(0)" ::: "memory");
        } else {
            XB_SPIN(xb_ld(&bar[XB_XGEN(bx)]) == gen, bar);
            __builtin_amdgcn_fence(__ATOMIC_ACQUIRE, "agent");
            asm volatile("s_waitcnt vmcnt(0)" ::: "memory");
        }
    }
    __syncthreads();
}

constexpr int NWAVES = 8, NTHR = 512;
struct Args { const float* in[23]; float* out; unsigned char* ws; int ph_lo, ph_hi; };
struct Frame { LAS unsigned char* lds; int tid, lane, wave, G, bid; };
#define LDS_WAIT() asm volatile("s_waitcnt lgkmcnt(0)" ::: "memory")
#define LDS_BARRIER() asm volatile("s_waitcnt lgkmcnt(0)\n\ts_barrier" ::: "memory")

__device__ __forceinline__ void p0_transpose_item(const float* W, int K, int N, int Npad, bf16_t* WT, LAS float* scr, int item, int lane) {
    const int nblk = Npad / 32, kb = item / nblk, nb = item % nblk, k0 = 64 * kb, n0 = 32 * nb;
    const int n = n0 + (lane & 31);
#pragma unroll 8
    for (int i = 0; i < 32; ++i) { const int kk = 2 * i + (lane >> 5); scr[kk * 33 + (lane & 31)] = (n < N) ? W[(size_t)(k0 + kk) * N + n] : 0.f; }
    LDS_WAIT(); asm volatile("" ::: "memory");
    const int c = lane & 7;
#pragma unroll
    for (int j = 0; j < 4; ++j) { const int nn = (lane >> 3) + 8 * j; const LAS float* s = scr + (8 * c) * 33 + nn;
        u32x4 o; o.x = cvt_pk_bf16(s[0 * 33], s[1 * 33]); o.y = cvt_pk_bf16(s[2 * 33], s[3 * 33]); o.z = cvt_pk_bf16(s[4 * 33], s[5 * 33]); o.w = cvt_pk_bf16(s[6 * 33], s[7 * 33]);
        *(u32x4*)(WT + (size_t)(n0 + nn) * K + k0 + 8 * c) = o; }
    LDS_WAIT(); asm volatile("" ::: "memory");
}
__device__ __forceinline__ void p0_transpose_item_fp8(const float* W, int K, int N, int Npad, unsigned char* WT, LAS float* scr, int item, int lane) {
    const int nblk = Npad / 32, kb = item / nblk, nb = item % nblk, k0 = 64 * kb, n0 = 32 * nb;
#pragma unroll 8
    for (int i = 0; i < 32; ++i) { const int kk = 2 * i + (lane >> 5); const int n = n0 + (lane & 31); scr[kk * 33 + (lane & 31)] = (n < N) ? W[(size_t)(k0 + kk) * N + n] * WSC : 0.f; }
    LDS_WAIT(); asm volatile("" ::: "memory");
    const int c = lane & 7;
#pragma unroll
    for (int j = 0; j < 4; ++j) { const int nn = (lane >> 3) + 8 * j; const LAS float* sp = scr + (8 * c) * 33 + nn;
        const f32x4 v0 = {sp[0 * 33], sp[1 * 33], sp[2 * 33], sp[3 * 33]}, v1 = {sp[4 * 33], sp[5 * 33], sp[6 * 33], sp[7 * 33]};
        *(u32x2*)(WT + (size_t)(n0 + nn) * K + k0 + 8 * c) = pg8::pack8_fp8(v0, v1); }
    LDS_WAIT(); asm volatile("" ::: "memory");
}
__device__ __forceinline__ void cvt_f32_bf16(const float* src, bf16_t* dst, size_t n, int gtid, int gthreads) {
    for (size_t i = (size_t)gtid * 8; i < n; i += (size_t)gthreads * 8) {
        const f32x4 a = *(const f32x4*)(src + i), b = *(const f32x4*)(src + i + 4);
        u32x4 w; w.x = cvt_pk_bf16(a[0], a[1]); w.y = cvt_pk_bf16(a[2], a[3]); w.z = cvt_pk_bf16(b[0], b[1]); w.w = cvt_pk_bf16(b[2], b[3]); *(u32x4*)(dst + i) = w; }
}
__device__ __forceinline__ void p0_prologue(Frame& F, const Args& a) {
    unsigned char* ws = a.ws;
    LAS float* scr = (LAS float*)(F.lds + F.wave * 16384);
    const int gw = F.bid * NWAVES + F.wave, NGW = F.G * NWAVES;
    constexpr int I_IN0 = 16 * (ZE / 32), I_SQ = 16 * 32, I_IN1 = 16 * (ZO / 32), I_PLE = 4 * 32, I_RT = 16, I_GU = 16 * 64;
    constexpr int C0 = I_IN0, C1 = C0 + I_SQ, C2 = C1 + I_IN1, C3 = C2 + I_SQ, C4 = C3 + 2 * I_SQ, C5 = C4 + 2 * I_PLE, C6 = C5 + 2 * I_RT, C7 = C6 + 64 * I_GU, C8 = C7 + 64 * I_SQ;
    for (int it2 = gw; it2 < C8 * PM(0); it2 += NGW) { const int it = it2 >= C8 ? it2 - C8 : it2;
        if (it < C0) { if (FP8_IN0) p0_transpose_item_fp8(a.in[2], DM, ZE, ZE, (unsigned char*)(ws + WS_WIN0), scr, it, F.lane); else p0_transpose_item(a.in[2], DM, ZE, ZE, (bf16_t*)(ws + WS_WIN0), scr, it, F.lane); }
        else if (it < C1) { if (FP8_OUT) p0_transpose_item_fp8(a.in[7], DM, DM, DM, (unsigned char*)(ws + WS_WO0), scr, it - C0, F.lane); else p0_transpose_item(a.in[7], DM, DM, DM, (bf16_t*)(ws + WS_WO0), scr, it - C0, F.lane); }
        else if (it < C2) { if (FP8_IN1) p0_transpose_item_fp8(a.in[8], DM, ZO_REAL, ZO, (unsigned char*)(ws + WS_WIN1), scr, it - C1, F.lane); else p0_transpose_item(a.in[8], DM, ZO_REAL, ZO, (bf16_t*)(ws + WS_WIN1), scr, it - C1, F.lane); }
        else if (it < C3) { if (FP8_OUT) p0_transpose_item_fp8(a.in[9], DM, DM, DM, (unsigned char*)(ws + WS_WO1), scr, it - C2, F.lane); else p0_transpose_item(a.in[9], DM, DM, DM, (bf16_t*)(ws + WS_WO1), scr, it - C2, F.lane); }
        else if (it < C4) { const int r = it - C3, l = r / I_SQ; if (FP8_GATE) p0_transpose_item_fp8(a.in[21] + (size_t)l * DM * DM, DM, DM, DM, (unsigned char*)(ws + WS_WG) + (size_t)l * DM * DM, scr, r % I_SQ, F.lane); else p0_transpose_item(a.in[21] + (size_t)l * DM * DM, DM, DM, DM, (bf16_t*)(ws + WS_WG) + (size_t)l * DM * DM, scr, r % I_SQ, F.lane); }
        else if (it < C5) { const int r = it - C4, l = r / I_PLE; p0_transpose_item(a.in[20] + (size_t)l * PLE * DM, PLE, DM, DM, (bf16_t*)(ws + WS_WPLE) + (size_t)l * DM * PLE, scr, r % I_PLE, F.lane); }
        else if (it < C6) { const int r = it - C5, l = r / I_RT; p0_transpose_item(a.in[12] + (size_t)l * DM * NEXP, DM, NEXP, NEXP, (bf16_t*)(ws + WS_WRT) + (size_t)l * NEXP * DM, scr, r % I_RT, F.lane); }
        else if (it < C7) { const int r = it - C6, l = r / I_GU; p0_transpose_item_fp8(a.in[14] + (size_t)l * DM * 2048, DM, 2048, 2048, (unsigned char*)(ws + WS_WGU) + (size_t)l * 2048 * DM, scr, r % I_GU, F.lane); }
        else { const int r = it - C7, l = r / I_SQ; p0_transpose_item_fp8(a.in[16] + (size_t)l * DM * DM, DM, DM, DM, (unsigned char*)(ws + WS_WD) + (size_t)l * DM * DM, scr, r % I_SQ, F.lane); }
    }
    const int gtid = F.bid * NTHR + F.tid, gth = F.G * NTHR;
    if (!FP8_IN0) cvt_f32_bf16(a.in[0], (bf16_t*)(ws + WS_XB), (size_t)NTOK * DM, gtid, gth);
    else { unsigned char* xq = (unsigned char*)(ws + WS_XQ); const float* x = a.in[0];
      for (size_t i = (size_t)gtid * 8; i < (size_t)NTOK * DM; i += (size_t)gth * 8) { const f32x4 u = *(const f32x4*)(x + i), v = *(const f32x4*)(x + i + 4); *(u32x2*)(xq + i) = pg8::pack8_fp8(u, v); } }
    cvt_f32_bf16(a.in[1], (bf16_t*)(ws + WS_PB), (size_t)2 * NTOK * PLE, gtid, gth);
    for (int i = gtid; i < 8 * 128 * 128; i += gth) { const int t = (i >> 7) & 127, s = i & 127; const float v = (s <= t) ? a.in[5][i] : 0.f; ((bf16_t*)(ws + WS_WSB))[i] = (bf16_t)(cvt_pk_bf16(v, 0.f) & 0xffffu); }
}

__device__ __forceinline__ void gmlp_unit(Frame& F, const Args& a, int unit) {
    const bf16_t* z0 = (const bf16_t*)(a.ws + WS_Z); unsigned char* cat = (unsigned char*)(a.ws + WS_CAT); const bf16_t* wsb = (const bf16_t*)(a.ws + WS_WSB);
    const float* lng = a.in[3]; const float* lnb = a.in[4]; const float* bs = a.in[6];
    const size_t tok0 = (size_t)unit * 128;
    const int lane = F.lane, w = F.wave, r32 = lane & 31, hi = lane >> 5;
    LAS f32x2* stats = (LAS f32x2*)(F.lds + XTRA_OFF);
    for (int i = 0; i < 16; ++i) { const int tl = w * 16 + i;
        const u32x4 v = *(const u32x4*)(z0 + (tok0 + tl) * ZE + 512 + 8 * lane);
        float x[8] = {bf_lo(v.x), bf_hi(v.x), bf_lo(v.y), bf_hi(v.y), bf_lo(v.z), bf_hi(v.z), bf_lo(v.w), bf_hi(v.w)};
        float s = 0.f;
#pragma unroll
        for (int j = 0; j < 8; ++j) s += x[j];
        const float mean = wave_sum(s) * (1.f / 512.f); float q = 0.f;
#pragma unroll
        for (int j = 0; j < 8; ++j) { const float d = x[j] - mean; q += d * d; }
        const float rstd = 1.f / sqrtf(wave_sum(q) * (1.f / 512.f) + LN_EPS);
        if (lane == 0) stats[tl] = (f32x2){mean, rstd}; }
    __syncthreads();
    const int g = w;
    LAS unsigned char* vt = F.lds + w * 16384;
    { const int tl8 = lane >> 3, cc = lane & 7;
      float gg[8], bb[8];
#pragma unroll
      for (int j = 0; j < 8; ++j) { gg[j] = lng[g * 64 + 8 * cc + j]; bb[j] = lnb[g * 64 + 8 * cc + j]; }
      for (int it = 0; it < 16; ++it) { const int tl = 8 * it + tl8;
          const u32x4 v = *(const u32x4*)(z0 + (tok0 + tl) * ZE + 512 + g * 64 + 8 * cc);
          const f32x2 st = stats[tl];
          float x[8] = {bf_lo(v.x), bf_hi(v.x), bf_lo(v.y), bf_hi(v.y), bf_lo(v.z), bf_hi(v.z), bf_lo(v.w), bf_hi(v.w)};
#pragma unroll
          for (int j = 0; j < 8; ++j) { const int c = 8 * cc + j; const float y = (x[j] - st.x) * st.y * gg[j] + bb[j];
              *(LAS bf16_t*)(vt + c * 256 + ((((tl >> 3) ^ (c & 15))) << 4) + (tl & 7) * 2) = (bf16_t)(cvt_pk_bf16(y, 0.f) & 0xffffu); } } }
    LDS_WAIT(); asm volatile("" ::: "memory");
    for (int tb = 0; tb < 4; ++tb) {
        f32x16 d0 = {}, d1 = {};
        const bf16_t* wrow = wsb + ((size_t)g * 128 + tb * 32 + r32) * 128 + 8 * hi;
        bf16x8 afr[8];
#pragma unroll
        for (int ks = 0; ks < 8; ++ks) afr[ks] = *(const bf16x8*)(wrow + 16 * ks);
#pragma unroll
        for (int ks = 0; ks < 8; ++ks) { if (ks >= 2 * (tb + 1)) break;
            const bf16x8 af = afr[ks];
            const int chunk = 2 * ks + hi;
            const bf16x8 b0 = *(const LAS bf16x8*)(vt + r32 * 256 + ((chunk ^ (r32 & 15)) << 4));
            const bf16x8 b1 = *(const LAS bf16x8*)(vt + (32 + r32) * 256 + ((chunk ^ (r32 & 15)) << 4));
            d0 = __builtin_amdgcn_mfma_f32_32x32x16_bf16(af, b0, d0, 0, 0, 0);
            d1 = __builtin_amdgcn_mfma_f32_32x32x16_bf16(af, b1, d1, 0, 0, 0);
        }
#pragma unroll
        for (int r = 0; r < 16; ++r) { const int t = tb * 32 + (r & 3) + 8 * (r >> 2) + 4 * hi; const float bsv = bs[g * 128 + t];
            const size_t ro = (tok0 + t) * ZE + g * 64 + r32; const size_t co = (tok0 + t) * DM + g * 64 + r32;
            const float u0 = bf1(z0[ro]), u1 = bf1(z0[ro + 32]);
            CAT_ST(cat, co, u0 * (d0[r] + bsv)); CAT_ST(cat, co + 32, u1 * (d1[r] + bsv)); }
    }
    __syncthreads();
}

constexpr int SB_KST = 144;
constexpr int SB_TILE = 64 * SB_KST;
__device__ __forceinline__ void sb_unit(Frame& F, const Args& a, int b, int h, int qb) {
    const bf16_t* z0 = (const bf16_t*)(a.ws + WS_Z); unsigned char* cat = (unsigned char*)(a.ws + WS_CAT);
    const int tid = F.tid, lane = F.lane, wid = F.wave, r32 = lane & 31, hi = lane >> 5;
    const size_t rowbase = (size_t)b * SEQ;
    const int q0 = qb * 256, qw0 = q0 + wid * 32, tq = qw0 + r32;
    bf16x8 qr[4];
    { const bf16_t* qp = z0 + (rowbase + tq) * ZE + 1024 + h * 64 + hi * 8;
#pragma unroll
      for (int ks = 0; ks < 4; ++ks) qr[ks] = *(const bf16x8*)(qp + ks * 16); }
    f32x16 o0 = {}, o1 = {}; float C = 1.f;
    const int ntile = q0 / 64 + 4;
    LAS unsigned char* Kb = F.lds; LAS unsigned char* Vb = F.lds + 2 * SB_TILE;
    const bf16_t* kg = z0 + (rowbase + (tid >> 3)) * ZE + 1536 + h * 64 + (tid & 7) * 8;
    const unsigned ldst = (unsigned)(tid >> 3) * SB_KST + (unsigned)(tid & 7) * 16;
    { const size_t go = (size_t)(ntile - 1) * 64 * ZE; const u32x4 kn = *(const u32x4*)(kg + go), vn = *(const u32x4*)(kg + go + 512);
      *(LAS u32x4*)(Kb + ldst) = kn; *(LAS u32x4*)(Vb + ldst) = vn; }
    const int dh = (lane >> 4) & 1, q_ = (lane & 15) >> 2, p_ = lane & 3;
    for (int kt = ntile - 1; kt >= 0; --kt) {
        const int buf = (ntile - 1 - kt) & 1;
        u32x4 kn, vn;
        if (kt > 0) { const size_t go = (size_t)(kt - 1) * 64 * ZE; kn = *(const u32x4*)(kg + go); vn = *(const u32x4*)(kg + go + 512); }
        LDS_BARRIER();
        const LAS unsigned char* Kc = Kb + buf * SB_TILE; const LAS unsigned char* Vc = Vb + buf * SB_TILE;
        if (64 * kt <= qw0) {
            f32x16 p[2]; p[0] = (f32x16){}; p[1] = (f32x16){};
#pragma unroll
            for (int ks = 0; ks < 4; ++ks) {
                const bf16x8 k0 = *(const LAS bf16x8*)(Kc + r32 * SB_KST + (16 * ks + 8 * hi) * 2);
                const bf16x8 k1 = *(const LAS bf16x8*)(Kc + (32 + r32) * SB_KST + (16 * ks + 8 * hi) * 2);
                p[0] = __builtin_amdgcn_mfma_f32_32x32x16_bf16(k0, qr[ks], p[0], 0, 0, 0);
                p[1] = __builtin_amdgcn_mfma_f32_32x32x16_bf16(k1, qr[ks], p[1], 0, 0, 0);
            }
            const bool need_mask = (64 * kt + 64 > qw0);
            const int kb0 = 64 * kt + 4 * hi;
            float NB[2][16], BE[2][16];
            if (need_mask) {
#pragma unroll
                for (int bk = 0; bk < 2; ++bk)
#pragma unroll
                    for (int r = 0; r < 16; ++r) { const float rc = rcpf_(1.f + ex2(-p[bk][r]));
                        const int key = kb0 + 32 * bk + 8 * (r >> 2) + (r & 3); const bool ok = key < tq;
                        BE[bk][r] = ok ? rc : 0.f; NB[bk][r] = ok ? 1.f - rc : 1.f; }
            } else {
#pragma unroll
                for (int bk = 0; bk < 2; ++bk)
#pragma unroll
                    for (int r = 0; r < 16; ++r) { const float rc = rcpf_(1.f + ex2(-p[bk][r])); BE[bk][r] = rc; NB[bk][r] = 1.f - rc; }
            }
            float acc_c = C;
#pragma unroll
            for (int bk = 1; bk >= 0; --bk)
#pragma unroll
                for (int aa = 3; aa >= 0; --aa) {
                    const float R = (NB[bk][4 * aa] * NB[bk][4 * aa + 1]) * (NB[bk][4 * aa + 2] * NB[bk][4 * aa + 3]);
                    const auto rr = __builtin_amdgcn_permlane32_swap(__float_as_uint(R), __float_as_uint(R), false, false);
                    const float Rp = hi ? __uint_as_float(rr[0]) : __uint_as_float(rr[1]);
                    const float a3 = hi ? acc_c : acc_c * Rp, a2 = a3 * NB[bk][4 * aa + 3], a1 = a2 * NB[bk][4 * aa + 2], a0 = a1 * NB[bk][4 * aa + 1];
                    p[bk][4 * aa + 3] = BE[bk][4 * aa + 3] * a3; p[bk][4 * aa + 2] = BE[bk][4 * aa + 2] * a2;
                    p[bk][4 * aa + 1] = BE[bk][4 * aa + 1] * a1; p[bk][4 * aa + 0] = BE[bk][4 * aa + 0] * a0;
                    acc_c *= R * Rp;
                }
            C = acc_c;
            bf16x8 pa[2][2];
#pragma unroll
            for (int bk = 0; bk < 2; ++bk)
#pragma unroll
                for (int s = 0; s < 2; ++s) { u32x4 w; w.x = cvt_pk_bf16(p[bk][8 * s + 0], p[bk][8 * s + 1]); w.y = cvt_pk_bf16(p[bk][8 * s + 2], p[bk][8 * s + 3]);
                    w.z = cvt_pk_bf16(p[bk][8 * s + 4], p[bk][8 * s + 5]); w.w = cvt_pk_bf16(p[bk][8 * s + 6], p[bk][8 * s + 7]); pa[bk][s] = __builtin_bit_cast(bf16x8, w); }
#pragma unroll
            for (int bk = 0; bk < 2; ++bk)
#pragma unroll
                for (int s = 0; s < 2; ++s) {
                    const LAS unsigned char* vp = Vc + (32 * bk + 16 * s + 4 * hi + q_) * SB_KST + (16 * dh + 4 * p_) * 2;
                    const s16x4 l0 = __builtin_amdgcn_ds_read_tr16_b64_v4i16((LAS s16x4*)(vp));
                    const s16x4 h0 = __builtin_amdgcn_ds_read_tr16_b64_v4i16((LAS s16x4*)(vp + 8 * SB_KST));
                    const s16x4 l1 = __builtin_amdgcn_ds_read_tr16_b64_v4i16((LAS s16x4*)(vp + 64));
                    const s16x4 h1 = __builtin_amdgcn_ds_read_tr16_b64_v4i16((LAS s16x4*)(vp + 8 * SB_KST + 64));
                    const bf16x8 v0 = (bf16x8){l0[0], l0[1], l0[2], l0[3], h0[0], h0[1], h0[2], h0[3]};
                    const bf16x8 v1 = (bf16x8){l1[0], l1[1], l1[2], l1[3], h1[0], h1[1], h1[2], h1[3]};
                    o0 = __builtin_amdgcn_mfma_f32_32x32x16_bf16(pa[bk][s], v0, o0, 0, 0, 0);
                    o1 = __builtin_amdgcn_mfma_f32_32x32x16_bf16(pa[bk][s], v1, o1, 0, 0, 0);
                }
        }
        if (kt > 0) { *(LAS u32x4*)(Kb + (buf ^ 1) * SB_TILE + ldst) = kn; *(LAS u32x4*)(Vb + (buf ^ 1) * SB_TILE + ldst) = vn; }
    }
#pragma unroll
    for (int r = 0; r < 16; ++r) { const int q = (r & 3) + 8 * (r >> 2) + 4 * hi;
        const size_t oo = (rowbase + qw0 + q) * DM + 512 + h * 64 + r32;
        CAT_ST(cat, oo, o0[r]); CAT_ST(cat, oo + 32, o1[r]); }
    __syncthreads();
}

template <int I> struct SelStep {
    static __device__ __forceinline__ void run(const float (&v)[64], float thr, float lo, bool exact, int need_eq, int& eq_seen, unsigned& m0, unsigned& m1) {
        const bool gt = v[I] > thr; const bool eq = (!exact) && !gt && (v[I] > lo);
        const unsigned long long meq = __ballot(eq);
        const int eq_rank = eq_seen + __builtin_amdgcn_mbcnt_hi((unsigned)(meq >> 32), __builtin_amdgcn_mbcnt_lo((unsigned)meq, 0));
        const bool take = gt || (eq && eq_rank < need_eq);
        const unsigned long long mt = __ballot(take);
        const unsigned mlo = (unsigned)mt, mhi = (unsigned)(mt >> 32);
        asm volatile("s_nop 1\n\tv_writelane_b32 %0, %1, %2" : "+v"(m0) : "s"(mlo), "n"(I));
        asm volatile("s_nop 1\n\tv_writelane_b32 %0, %1, %2" : "+v"(m1) : "s"(mhi), "n"(I));
        eq_seen += __builtin_popcountll(meq);
        SelStep<I + 1>::run(v, thr, lo, exact, need_eq, eq_seen, m0, m1);
    }
};
template <> struct SelStep<64> { static __device__ __forceinline__ void run(const float (&)[64], float, float, bool, int, int&, unsigned&, unsigned&) {} };

template <int I> struct SelExact {
    static __device__ __forceinline__ void run(const float (&v)[64], float thr, unsigned& m0, unsigned& m1) {
        const unsigned long long mt = __ballot(v[I] > thr);
        const unsigned mlo = (unsigned)mt, mhi = (unsigned)(mt >> 32);
        asm volatile("s_nop 1\n\tv_writelane_b32 %0, %1, %2" : "+v"(m0) : "s"(mlo), "n"(I));
        asm volatile("s_nop 1\n\tv_writelane_b32 %0, %1, %2" : "+v"(m1) : "s"(mhi), "n"(I));
        SelExact<I + 1>::run(v, thr, m0, m1);
    }
};
template <> struct SelExact<64> { static __device__ __forceinline__ void run(const float (&)[64], float, unsigned&, unsigned&) {} };

__device__ __forceinline__ void dsa_select_unit(Frame& F, const Args& a, int unit) {
    const bf16_t* z1 = (const bf16_t*)(a.ws + WS_Z); unsigned* bm = (unsigned*)(a.ws + WS_BM);
    const int lane = F.lane, wid = F.wave, r32 = lane & 31, hi = lane >> 5;
    const int tok0 = unit * 8;
    const int b = tok0 / SEQ, t0 = tok0 % SEQ;
    const size_t rowbase = (size_t)b * SEQ;
    const int vis = (t0 / 64 + 1) * 64;
    LAS float* sc = (LAS float*)F.lds;
    if (vis > 256) {
        const int tl = 2 * (r32 >> 4) + ((r32 >> 2) & 1), hd = (r32 & 3) + 4 * ((r32 >> 3) & 1);
        bf16x8 af[2][4];
#pragma unroll
        for (int rt = 0; rt < 2; ++rt) { const bf16_t* qp = z1 + (size_t)(tok0 + 4 * rt + tl) * ZO + OQI + hd * 64 + 8 * hi;
#pragma unroll
            for (int ks = 0; ks < 4; ++ks) af[rt][ks] = *(const bf16x8*)(qp + 16 * ks); }
        float wv[4][8];
#pragma unroll
        for (int j = 0; j < 4; ++j) { const u32x4 w = *(const u32x4*)(z1 + (size_t)(tok0 + 2 * j + hi) * ZO + OWI);
            const float s = 0.35355339059f * 0.125f;
            wv[j][0] = bf_lo(w.x) * s; wv[j][1] = bf_hi(w.x) * s; wv[j][2] = bf_lo(w.y) * s; wv[j][3] = bf_hi(w.y) * s;
            wv[j][4] = bf_lo(w.z) * s; wv[j][5] = bf_hi(w.z) * s; wv[j][6] = bf_lo(w.w) * s; wv[j][7] = bf_hi(w.w) * s; }
        const int nkt = vis / 32;
        const bf16_t* kbase = (const bf16_t*)(a.ws + WS_KI1) + rowbase * 64 + (size_t)lane * 8;
        for (int rep14 = 0; rep14 < PM(14); ++rep14)
        for (int kt0 = wid; kt0 < nkt; kt0 += 8 * NWAVES) {
            bf16x8 kq[8][4];
#pragma unroll
            for (int pf = 0; pf < 8; ++pf) { const int kt = min(kt0 + pf * NWAVES, nkt - 1);
#pragma unroll
                for (int ks = 0; ks < 4; ++ks) kq[pf][ks] = *(const bf16x8*)(kbase + (size_t)(kt * 4 + ks) * 512); }
            __builtin_amdgcn_sched_barrier(0);
#pragma unroll
            for (int pf = 0; pf < 8; ++pf) { const int kt = kt0 + pf * NWAVES;
                if (kt < nkt) {
                    f32x16 d0 = {}, d1 = {};
#pragma unroll
                    for (int ks = 0; ks < 4; ++ks) { d0 = __builtin_amdgcn_mfma_f32_32x32x16_bf16(af[0][ks], kq[pf][ks], d0, 0, 0, 0); d1 = __builtin_amdgcn_mfma_f32_32x32x16_bf16(af[1][ks], kq[pf][ks], d1, 0, 0, 0); }
                    float s0 = 0.f, s1 = 0.f, s2 = 0.f, s3 = 0.f;
#pragma unroll
                    for (int r = 0; r < 8; ++r) { s0 += wv[0][r] * relu_i(d0[r]); s1 += wv[1][r] * relu_i(d0[8 + r]); s2 += wv[2][r] * relu_i(d1[r]); s3 += wv[3][r] * relu_i(d1[8 + r]); }
                    const int key = kt * 32 + r32;
                    sc[(hi) * 4096 + key] = s0; sc[(2 + hi) * 4096 + key] = s1; sc[(4 + hi) * 4096 + key] = s2; sc[(6 + hi) * 4096 + key] = s3;
                } }
        }
    }
    __syncthreads();
    for (int rep15 = 0; rep15 < PM(15); ++rep15) {
        unsigned m0 = 0u, m1 = 0u;
        if (vis <= 256) { m0 = 0xffffffffu; m1 = 0xffffffffu; }
        else {
            const LAS float* ms = sc + wid * 4096;
            float v[64];
            float mx = -INFINITY, mn = INFINITY;
#pragma unroll
            for (int i = 0; i < 64; ++i) { const bool in = (i * 64 < vis); v[i] = in ? ms[i * 64 + lane] : -INFINITY; if (in) { mx = fmaxf(mx, v[i]); mn = fminf(mn, v[i]); } }
            mx = wave_max_uniform(mx); mn = -wave_max_uniform(-mn);
            float lo = mn - 1.f - fabsf(mn), hiv = mx;
            float thr = hiv; int cgt = 0; bool exact = false;
            int c_lo = vis, c_hi = 0;
            bool dead = false;
            for (int it = 0; it < 64 && (c_lo - c_hi) > 448; ++it) {
                const float mid = 0.5f * (lo + hiv);
                if (!(mid > lo) || !(mid < hiv)) { dead = true; break; }
                int c = 0;
#pragma unroll
                for (int i = 0; i < 64; ++i) c += (v[i] > mid) ? 1 : 0;
                c = wave_sum_uniform(c);
                if (c == 256) { thr = mid; exact = true; break; }
                if (c > 256) { lo = mid; c_lo = c; } else { hiv = mid; c_hi = c; }
            }
            if (!exact && !dead) {
                LAS float* cand = sc + wid * 4096; int base = 0;
#pragma unroll
                for (int i = 0; i < 64; ++i) { const bool in = (v[i] > lo) && !(v[i] > hiv);
                    const unsigned long long mk = __ballot(in);
                    const int pos = base + __builtin_amdgcn_mbcnt_hi((unsigned)(mk >> 32), __builtin_amdgcn_mbcnt_lo((unsigned)mk, 0));
                    if (in) cand[pos] = v[i];
                    base += __builtin_popcountll(mk); }
                const int nc = c_lo - c_hi, c_hi0 = c_hi;
                float cv[8];
#pragma unroll
                for (int j = 0; j < 8; ++j) cv[j] = (lane + 64 * j < nc) ? cand[lane + 64 * j] : -INFINITY;
                for (int it = 0; it < 64; ++it) {
                    const float mid = 0.5f * (lo + hiv);
                    if (!(mid > lo) || !(mid < hiv)) break;
                    int c = 0;
#pragma unroll
                    for (int j = 0; j < 8; ++j) c += (cv[j] > mid) ? 1 : 0;
                    c = c_hi0 + wave_sum_uniform(c);
                    if (c == 256) { thr = mid; exact = true; break; }
                    if (c > 256) { lo = mid; c_lo = c; } else { hiv = mid; c_hi = c; }
                }
            }
            if (!exact) { thr = hiv; cgt = c_hi; }
            const int need_eq = exact ? 0 : (256 - cgt); int eq_seen = 0;
            if (exact) SelExact<0>::run(v, thr, m0, m1); else SelStep<0>::run(v, thr, lo, exact, need_eq, eq_seen, m0, m1);
        }
        if (lane * 64 < vis) *(u32x2*)(bm + (size_t)(tok0 + wid) * 128 + 2 * lane) = (u32x2){m0, m1};
    }
    __syncthreads();
}

template <int I> struct MaskInit {
    static __device__ __forceinline__ void run(f32x16 (&p)[2], int nw0, int nw1, float slope2, float T, int ninf) {
        constexpr int bk = I >> 4, r = I & 15, pos = 8 * (r >> 2) + (r & 3);
        const float vb = __builtin_fmaf(slope2, (float)(32 * bk + pos), T);
        int off; asm("v_bfe_i32 %0, %1, %2, 1" : "=v"(off) : "v"(bk ? nw1 : nw0), "n"(pos));
        float o; asm("v_bfi_b32 %0, %1, %2, %3" : "=v"(o) : "v"(off), "s"(ninf), "v"(vb));
        p[bk][r] = o;
        MaskInit<I + 1>::run(p, nw0, nw1, slope2, T, ninf);
    }
};
template <> struct MaskInit<32> { static __device__ __forceinline__ void run(f32x16 (&)[2], int, int, float, float, int) {} };
__device__ __forceinline__ float max3_asm(float a, float b, float c) { float r; asm("v_max3_f32 %0, %1, %2, %3" : "=v"(r) : "v"(a), "v"(b), "v"(c)); return r; }
__device__ __forceinline__ void dsa_attn_unit(Frame& F, const Args& a, int b, int ch, int g) {
    const bf16_t* z1 = (const bf16_t*)(a.ws + WS_Z); unsigned char* cat = (unsigned char*)(a.ws + WS_CAT); const unsigned* bm = (const unsigned*)(a.ws + WS_BM);
    const int tid = F.tid, lane = F.lane, wid = F.wave, r32 = lane & 31, hi = lane >> 5;
    const int hr = wid >> 1, qh = wid & 1, head = g * 4 + hr;
    const size_t rowbase = (size_t)b * SEQ;
    const int tq = ch * 64 + 32 * qh + r32;
    const float slope2 = ex2(-0.5f * (float)(head + 1)) * LOG2E;
    bf16x8 qr[4];
    { const bf16_t* qp = z1 + (rowbase + tq) * ZO + OQ + head * 64 + hi * 8;
#pragma unroll
      for (int ks = 0; ks < 4; ++ks) qr[ks] = *(const bf16x8*)(qp + ks * 16); }
    const unsigned* mrow = bm + (rowbase + tq) * 128;
    f32x16 o0 = {}, o1 = {}; float m = 0.f, l = 0.f;
    const int ntile = ch + 1;
    LAS unsigned char* Kb = F.lds; LAS unsigned char* Vb = F.lds + 2 * SB_TILE;
    LAS float* wsf = (LAS float*)(F.lds + 4 * SB_TILE) + wid * 32;
    const bf16_t* kg = (const bf16_t*)(a.ws + WS_KV1) + (rowbase + (tid >> 3)) * 512 + g * 64 + (tid & 7) * 8;
    const unsigned ldst = (unsigned)(tid >> 3) * SB_KST + (unsigned)(tid & 7) * 16;
    { const u32x4 kn = *(const u32x4*)(kg), vn = *(const u32x4*)(kg + 256);
      *(LAS u32x4*)(Kb + ldst) = kn; *(LAS u32x4*)(Vb + ldst) = vn; }
    const int dh = (lane >> 4) & 1, q_ = (lane & 15) >> 2, p_ = lane & 3;
    u32x2 mw = *(const u32x2*)(mrow);
    for (int kt = 0; kt < ntile; ++kt) {
        const int buf = kt & 1;
        u32x4 kn, vn; u32x2 mwn = mw;
        if (kt + 1 < ntile) { const size_t go = (size_t)(kt + 1) * 64 * 512; kn = *(const u32x4*)(kg + go); vn = *(const u32x4*)(kg + go + 256); mwn = *(const u32x2*)(mrow + 2 * (kt + 1)); }
        LDS_BARRIER();
        const LAS unsigned char* Kc = Kb + buf * SB_TILE; const LAS unsigned char* Vc = Vb + buf * SB_TILE;
        const float T = slope2 * (float)(64 * kt + 4 * hi) - m;
        const int nw0 = (int)~(mw.x >> (4 * hi)), nw1 = (int)~(mw.y >> (4 * hi));
        f32x16 p[2];
        MaskInit<0>::run(p, nw0, nw1, slope2, T, (int)0xff800000);
#pragma unroll
        for (int ks = 0; ks < 4; ++ks) {
            const bf16x8 k0 = *(const LAS bf16x8*)(Kc + r32 * SB_KST + (16 * ks + 8 * hi) * 2);
            const bf16x8 k1 = *(const LAS bf16x8*)(Kc + (32 + r32) * SB_KST + (16 * ks + 8 * hi) * 2);
            p[0] = __builtin_amdgcn_mfma_f32_32x32x16_bf16(k0, qr[ks], p[0], 0, 0, 0);
            p[1] = __builtin_amdgcn_mfma_f32_32x32x16_bf16(k1, qr[ks], p[1], 0, 0, 0);
        }
        if (kt == ntile - 1) {
            const float basef = (float)(tq - (64 * kt + 4 * hi));
#pragma unroll
            for (int bk = 0; bk < 2; ++bk)
#pragma unroll
                for (int r = 0; r < 16; ++r) { const float rel = (float)(32 * bk + 8 * (r >> 2) + (r & 3)) - basef; p[bk][r] -= 2.f * slope2 * fmaxf(rel, 0.f); }
        } else asm volatile("s_nop 15\n\ts_nop 7" : "+v"(p[0]), "+v"(p[1]));
        float rm;
        { float a0 = max3_asm(p[0][0], p[0][1], p[1][0]), b0 = max3_asm(p[0][2], p[0][3], p[1][1]); a0 = max3_asm(a0, p[1][2], p[1][3]);
#pragma unroll
          for (int r = 4; r < 16; r += 4) { a0 = max3_asm(a0, p[0][r], p[0][r + 1]); b0 = max3_asm(b0, p[0][r + 2], p[0][r + 3]); a0 = max3_asm(a0, p[1][r], p[1][r + 1]); b0 = max3_asm(b0, p[1][r + 2], p[1][r + 3]); }
          rm = fmaxf(a0, b0); }
        rm = fmaxf(rm, sxf<32>(rm));
        if (__any(rm > 6.f) || kt == 0) {
            const float d = (kt == 0) ? ((rm > -1e30f) ? rm : 0.f) : ((rm > 6.f) ? rm : 0.f);
            const float alpha = ex2(-d);
            l *= alpha; m += d;
#pragma unroll
            for (int bk = 0; bk < 2; ++bk)
#pragma unroll
                for (int r = 0; r < 16; ++r) p[bk][r] -= d;
            if (hi == 0) wsf[r32] = alpha;
#pragma unroll
            for (int r = 0; r < 16; ++r) { const float al = wsf[(r & 3) + 8 * (r >> 2) + 4 * hi]; o0[r] *= al; o1[r] *= al; }
        }
        float ls = 0.f;
#pragma unroll
        for (int bk = 0; bk < 2; ++bk)
#pragma unroll
            for (int r = 0; r < 16; ++r) { const float e = ex2(p[bk][r]); p[bk][r] = e; ls += e; }
        l += ls;
        bf16x8 pa[2][2];
#pragma unroll
        for (int bk = 0; bk < 2; ++bk)
#pragma unroll
            for (int s = 0; s < 2; ++s) { u32x4 w; w.x = cvt_pk_bf16(p[bk][8 * s + 0], p[bk][8 * s + 1]); w.y = cvt_pk_bf16(p[bk][8 * s + 2], p[bk][8 * s + 3]);
                w.z = cvt_pk_bf16(p[bk][8 * s + 4], p[bk][8 * s + 5]); w.w = cvt_pk_bf16(p[bk][8 * s + 6], p[bk][8 * s + 7]); pa[bk][s] = __builtin_bit_cast(bf16x8, w); }
#pragma unroll
        for (int bk = 0; bk < 2; ++bk)
#pragma unroll
            for (int s = 0; s < 2; ++s) {
                const LAS unsigned char* vp = Vc + (32 * bk + 16 * s + 4 * hi + q_) * SB_KST + (16 * dh + 4 * p_) * 2;
                const s16x4 l0 = __builtin_amdgcn_ds_read_tr16_b64_v4i16((LAS s16x4*)(vp));
                const s16x4 h0 = __builtin_amdgcn_ds_read_tr16_b64_v4i16((LAS s16x4*)(vp + 8 * SB_KST));
                const s16x4 l1 = __builtin_amdgcn_ds_read_tr16_b64_v4i16((LAS s16x4*)(vp + 64));
                const s16x4 h1 = __builtin_amdgcn_ds_read_tr16_b64_v4i16((LAS s16x4*)(vp + 8 * SB_KST + 64));
                const bf16x8 v0 = (bf16x8){l0[0], l0[1], l0[2], l0[3], h0[0], h0[1], h0[2], h0[3]};
                const bf16x8 v1 = (bf16x8){l1[0], l1[1], l1[2], l1[3], h1[0], h1[1], h1[2], h1[3]};
                o0 = __builtin_amdgcn_mfma_f32_32x32x16_bf16(pa[bk][s], v0, o0, 0, 0, 0);
                o1 = __builtin_amdgcn_mfma_f32_32x32x16_bf16(pa[bk][s], v1, o1, 0, 0, 0);
            }
        if (kt + 1 < ntile) { *(LAS u32x4*)(Kb + (buf ^ 1) * SB_TILE + ldst) = kn; *(LAS u32x4*)(Vb + (buf ^ 1) * SB_TILE + ldst) = vn; }
        mw = mwn;
    }
    l += sxf<32>(l);
    if (hi == 0) wsf[r32] = 1.f / l;
#pragma unroll
    for (int r = 0; r < 16; ++r) { const int q = (r & 3) + 8 * (r >> 2) + 4 * hi; const float inv = wsf[q];
        const size_t oo = (rowbase + ch * 64 + 32 * qh + q) * DM + head * 64 + r32;
        CAT_ST(cat, oo, o0[r] * inv); CAT_ST(cat, oo + 32, o1[r] * inv); }
    __syncthreads();
}

__device__ __forceinline__ void ln_row16(const bf16_t* src, float (&x)[16], int lane) {
    const u32x4 a = *(const u32x4*)(src + 8 * lane), b = *(const u32x4*)(src + 512 + 8 * lane);
    x[0] = bf_lo(a.x); x[1] = bf_hi(a.x); x[2] = bf_lo(a.y); x[3] = bf_hi(a.y); x[4] = bf_lo(a.z); x[5] = bf_hi(a.z); x[6] = bf_lo(a.w); x[7] = bf_hi(a.w);
    x[8] = bf_lo(b.x); x[9] = bf_hi(b.x); x[10] = bf_lo(b.y); x[11] = bf_hi(b.y); x[12] = bf_lo(b.z); x[13] = bf_hi(b.z); x[14] = bf_lo(b.w); x[15] = bf_hi(b.w);
}
__device__ __forceinline__ void ln_norm16(float (&x)[16], const float* g, const float* bta, int lane) {
    float s = 0.f;
#pragma unroll
    for (int j = 0; j < 16; ++j) s += x[j];
    const float mean = wave_sum(s) * (1.f / DM); float q = 0.f;
#pragma unroll
    for (int j = 0; j < 16; ++j) { x[j] -= mean; q += x[j] * x[j]; }
    const float rstd = 1.f / sqrtf(wave_sum(q) * (1.f / DM) + LN_EPS);
    const f32x4 g0 = *(const f32x4*)(g + 8 * lane), g1 = *(const f32x4*)(g + 8 * lane + 4), g2 = *(const f32x4*)(g + 512 + 8 * lane), g3 = *(const f32x4*)(g + 512 + 8 * lane + 4);
    const f32x4 b0 = *(const f32x4*)(bta + 8 * lane), b1 = *(const f32x4*)(bta + 8 * lane + 4), b2 = *(const f32x4*)(bta + 512 + 8 * lane), b3 = *(const f32x4*)(bta + 512 + 8 * lane + 4);
#pragma unroll
    for (int j = 0; j < 4; ++j) { x[j] = x[j] * rstd * g0[j] + b0[j]; x[4 + j] = x[4 + j] * rstd * g1[j] + b1[j]; x[8 + j] = x[8 + j] * rstd * g2[j] + b2[j]; x[12 + j] = x[12 + j] * rstd * g3[j] + b3[j]; }
}
__device__ __forceinline__ void store16bf(bf16_t* dst, const float (&x)[16], int lane) {
    u32x4 a, b; a.x = cvt_pk_bf16(x[0], x[1]); a.y = cvt_pk_bf16(x[2], x[3]); a.z = cvt_pk_bf16(x[4], x[5]); a.w = cvt_pk_bf16(x[6], x[7]);
    b.x = cvt_pk_bf16(x[8], x[9]); b.y = cvt_pk_bf16(x[10], x[11]); b.z = cvt_pk_bf16(x[12], x[13]); b.w = cvt_pk_bf16(x[14], x[15]);
    *(u32x4*)(dst + 8 * lane) = a; *(u32x4*)(dst + 512 + 8 * lane) = b;
}
__device__ __forceinline__ void store16f8(unsigned char* dst, const float (&x)[16], int lane) {
    *(u32x2*)(dst + 8 * lane) = pg8::pack8_fp8((f32x4){x[0], x[1], x[2], x[3]}, (f32x4){x[4], x[5], x[6], x[7]});
    *(u32x2*)(dst + 512 + 8 * lane) = pg8::pack8_fp8((f32x4){x[8], x[9], x[10], x[11]}, (f32x4){x[12], x[13], x[14], x[15]});
}
constexpr int HS_STRIDE = 2064;
__device__ __forceinline__ void ln1_router_phase(Frame& F, const Args& a, int layer) {
    const bf16_t* t1 = (const bf16_t*)(a.ws + WS_T1); bf16_t* hb = (bf16_t*)(a.ws + WS_HB);
    const bf16_t* wrt = (const bf16_t*)(a.ws + WS_WRT) + (size_t)layer * NEXP * DM;
    const float* g = a.in[10] + layer * DM; const float* bta = a.in[11] + layer * DM; const float* br = a.in[13] + layer * NEXP;
    int* topi = (int*)(a.ws + WS_TOPI); float* gate = (float*)(a.ws + WS_GATE); int* cnt = (int*)(a.ws + WS_CNT);
    const int lane = F.lane, w = F.wave, tid = F.tid;
    LAS unsigned char* hs = F.lds;
    LAS float* part = (LAS float*)(F.lds + 36864);
    LAS float* logit = (LAS float*)(F.lds + 36864 + 16384);
    LAS int* hist = (LAS int*)(F.lds + 36864 + 16384 + 2048);
    LAS int* topk_i = (LAS int*)(F.lds + 36864 + 16384 + 2048 + 256); LAS float* topk_v = (LAS float*)(F.lds + 36864 + 16384 + 2048 + 512);
    const int n16 = lane & 15, kg4 = lane >> 4;
    bf16x8 bw[2][4];
#pragma unroll
    for (int n = 0; n < 2; ++n)
#pragma unroll
        for (int ks = 0; ks < 4; ++ks) bw[n][ks] = *(const bf16x8*)(wrt + (size_t)(16 * n + n16) * DM + 128 * w + 32 * ks + 8 * kg4);
    for (int grp2 = F.bid; grp2 < NGRP * PM(6); grp2 += F.G) { const int grp = grp2 % NGRP;
        if (tid < 32) hist[tid] = 0;
        __syncthreads();
        for (int it = 0; it < 8; ++it) {
            const int r0 = grp * 128 + it * 16;
#pragma unroll
            for (int rr = 0; rr < 2; ++rr) { const int rl = 2 * w + rr; float x[16];
                ln_row16(t1 + (size_t)(r0 + rl) * DM, x, lane); ln_norm16(x, g, bta, lane);
                store16bf(hb + (size_t)(r0 + rl) * DM, x, lane);
                u32x4 p, q; p.x = cvt_pk_bf16(x[0], x[1]); p.y = cvt_pk_bf16(x[2], x[3]); p.z = cvt_pk_bf16(x[4], x[5]); p.w = cvt_pk_bf16(x[6], x[7]);
                q.x = cvt_pk_bf16(x[8], x[9]); q.y = cvt_pk_bf16(x[10], x[11]); q.z = cvt_pk_bf16(x[12], x[13]); q.w = cvt_pk_bf16(x[14], x[15]);
                *(LAS u32x4*)(hs + rl * HS_STRIDE + 16 * lane) = p; *(LAS u32x4*)(hs + rl * HS_STRIDE + 1024 + 16 * lane) = q; }
            __syncthreads();
            { f32x4 d0 = {0.f, 0.f, 0.f, 0.f}, d1 = {0.f, 0.f, 0.f, 0.f};
#pragma unroll
              for (int ks = 0; ks < 4; ++ks) { const bf16x8 af = *(const LAS bf16x8*)(hs + n16 * HS_STRIDE + (128 * w + 32 * ks + 8 * kg4) * 2);
                  d0 = __builtin_amdgcn_mfma_f32_16x16x32_bf16(af, bw[0][ks], d0, 0, 0, 0); d1 = __builtin_amdgcn_mfma_f32_16x16x32_bf16(af, bw[1][ks], d1, 0, 0, 0); }
#pragma unroll
              for (int r = 0; r < 4; ++r) { part[(w * 16 + 4 * kg4 + r) * 32 + n16] = d0[r]; part[(w * 16 + 4 * kg4 + r) * 32 + 16 + n16] = d1[r]; } }
            __syncthreads();
            { const int row = tid >> 5, e = tid & 31; float s = br[e];
#pragma unroll
              for (int ww = 0; ww < 8; ++ww) s += part[(ww * 16 + row) * 32 + e];
              logit[row * 32 + e] = s; }
            __syncthreads();
            { const int row = tid >> 5, e = tid & 31; const float lv = logit[row * 32 + e]; int rank = 0;
#pragma unroll
              for (int e2 = 0; e2 < 32; ++e2) { const float o = logit[row * 32 + e2]; rank += (o > lv || (o == lv && e2 < e)) ? 1 : 0; }
              if (rank < 4) { topk_i[row * 4 + rank] = e; topk_v[row * 4 + rank] = lv; } }
            __syncthreads();
            if (tid < 16) { const int tok = r0 + tid;
                const int t0 = topk_i[tid * 4 + 0], t1 = topk_i[tid * 4 + 1], t2 = topk_i[tid * 4 + 2], t3 = topk_i[tid * 4 + 3];
                const float v0 = topk_v[tid * 4 + 0];
                const float e0 = 1.f, e1 = __expf(topk_v[tid * 4 + 1] - v0), e2 = __expf(topk_v[tid * 4 + 2] - v0), e3 = __expf(topk_v[tid * 4 + 3] - v0); const float inv = 1.f / (e0 + e1 + e2 + e3);
                *(int4*)(topi + (size_t)tok * 4) = make_int4(t0, t1, t2, t3);
                *(float4*)(gate + (size_t)tok * 4) = make_float4(e0 * inv, e1 * inv, e2 * inv, e3 * inv);
                atomicAdd((int*)&hist[t0], 1); atomicAdd((int*)&hist[t1], 1); atomicAdd((int*)&hist[t2], 1); atomicAdd((int*)&hist[t3], 1); }
        }
        __syncthreads();
        if (tid < 32) cnt[grp * 32 + tid] = hist[tid];
        __syncthreads();
    }
}

__device__ __forceinline__ void moe_tables(Frame& F, const Args& a, int grp) {
    const int* cnt = (const int*)(a.ws + WS_CNT);
    LAS int* T = (LAS int*)(F.lds + TAB_OFF);
    const int tid = F.tid, e = tid & 31, j = tid >> 5;
    { int s = 0, bf = 0;
      for (int gg = j * 16; gg < j * 16 + 16; ++gg) { const int c = cnt[gg * 32 + e]; s += c; if (gg < grp) bf += c; }
      T[TB_TOT16 / 4 + j * 32 + e] = s; T[TB_BEF16 / 4 + j * 32 + e] = bf; }
    __syncthreads();
    if (tid < 32) { int s = 0, bf = 0;
#pragma unroll
        for (int jj = 0; jj < 16; ++jj) { s += T[TB_TOT16 / 4 + jj * 32 + tid]; bf += T[TB_BEF16 / 4 + jj * 32 + tid]; }
        T[TB_TOTAL / 4 + tid] = s; T[TB_BEFORE / 4 + tid] = bf; T[TB_LCUR / 4 + tid] = 0; }
    __syncthreads();
    if (tid < 32) {
        int ps = 0;
#pragma nounroll
        for (int ee = 0; ee < tid; ++ee) ps += ((T[TB_TOTAL / 4 + ee] + 255) >> 8) << 8;
        T[TB_PADST / 4 + tid] = ps; T[TB_BASE / 4 + tid] = ps + T[TB_BEFORE / 4 + tid];
        if (tid == 31) { const int end = ps + (((T[TB_TOTAL / 4 + 31] + 255) >> 8) << 8); T[TB_PADST / 4 + 32] = end; T[TB_NTL / 4] = end >> 8; } }
    __syncthreads();
    { LAS unsigned char* t2e = (LAS unsigned char*)(F.lds + TAB_OFF + TB_T2E); const int ntl = T[TB_NTL / 4];
      for (int rt = tid; rt < ntl; rt += NTHR) { int e = 0;
#pragma nounroll
          for (int ee = 1; ee < 32; ++ee) e += (T[TB_PADST / 4 + ee] <= rt * 256) ? 1 : 0;
          t2e[rt] = (unsigned char)e; } }
    __syncthreads();
}
__device__ __forceinline__ void scatter_phase(Frame& F, const Args& a) {
    const bf16_t* hb = (const bf16_t*)(a.ws + WS_HB); unsigned char* xs = (unsigned char*)(a.ws + WS_XS);
    const int* topi = (const int*)(a.ws + WS_TOPI); const float* gate = (const float*)(a.ws + WS_GATE);
    int* slot = (int*)(a.ws + WS_SLOT); float* rowg = (float*)(a.ws + WS_ROWG);
    LAS int* T = (LAS int*)(F.lds + TAB_OFF); LAS int* rows = (LAS int*)(F.lds + XTRA_OFF);
    const int tid = F.tid, lane = F.lane, w = F.wave;
    if (F.bid >= NGRP) moe_tables(F, a, -1);
    for (int grp2 = F.bid; grp2 < NGRP * PM(7); grp2 += F.G) { const int grp = grp2 % NGRP;
        moe_tables(F, a, grp);
        { const int tok = grp * 128 + (tid >> 2), k = tid & 3; const int e = topi[(size_t)tok * 4 + k];
          const int rank = atomicAdd((int*)&T[TB_LCUR / 4 + e], 1); const int row = T[TB_BASE / 4 + e] + rank;
          slot[(size_t)tok * 4 + k] = row; rowg[row] = gate[(size_t)tok * 4 + k]; rows[tid] = row; }
        __syncthreads();
        for (int i = 0; i < 16; ++i) { const int tl = w * 16 + i; const size_t tok = (size_t)grp * 128 + tl;
            float x[16]; ln_row16(hb + tok * DM, x, lane);
            const u32x2 p = pg8::pack8_fp8((f32x4){x[0], x[1], x[2], x[3]}, (f32x4){x[4], x[5], x[6], x[7]}), q = pg8::pack8_fp8((f32x4){x[8], x[9], x[10], x[11]}, (f32x4){x[12], x[13], x[14], x[15]});
#pragma unroll
            for (int k = 0; k < 4; ++k) { const size_t row = (size_t)rows[tl * 4 + k]; *(u32x2*)(xs + row * DM + 8 * lane) = p; *(u32x2*)(xs + row * DM + 512 + 8 * lane) = q; } }
        __syncthreads();
    }
}
__device__ __forceinline__ void combine_phase(Frame& F, const Args& a) {
    const bf16_t* hb = (const bf16_t*)(a.ws + WS_HB); const bf16_t* yb = (const bf16_t*)(a.ws + WS_XS); bf16_t* mid = (bf16_t*)(a.ws + WS_MIDB);
    const int* slot = (const int*)(a.ws + WS_SLOT);
    const int lane = F.lane;
    for (int tok2 = F.bid * NWAVES + F.wave; tok2 < NTOK * PM(10); tok2 += F.G * NWAVES) { const int tok = tok2 % NTOK;
        float x[16]; ln_row16(hb + (size_t)tok * DM, x, lane);
#pragma unroll
        for (int j = 0; j < 16; ++j) x[j] *= ALPHA;
        const int4 sl = *(const int4*)(slot + (size_t)tok * 4);
        const int s4[4] = {sl.x, sl.y, sl.z, sl.w};
#pragma unroll
        for (int k = 0; k < 4; ++k) {
            if (Y_FP8) { const unsigned char* yr = (const unsigned char*)yb + (size_t)s4[k] * DM;
                const u32x2 p = *(const u32x2*)(yr + 8 * lane), q = *(const u32x2*)(yr + 512 + 8 * lane);
                const unsigned w4[4] = {p.x, p.y, q.x, q.y};
#pragma unroll
                for (int i = 0; i < 4; ++i) { const f32x2 lo = __builtin_amdgcn_cvt_pk_f32_fp8((int)w4[i], false), hi2 = __builtin_amdgcn_cvt_pk_f32_fp8((int)w4[i], true);
                    x[4 * i + 0] += lo.x * 0.0625f; x[4 * i + 1] += lo.y * 0.0625f; x[4 * i + 2] += hi2.x * 0.0625f; x[4 * i + 3] += hi2.y * 0.0625f; } }
            else { float y[16]; ln_row16(yb + (size_t)s4[k] * DM, y, lane);
#pragma unroll
                for (int j = 0; j < 16; ++j) x[j] += y[j]; } }
        store16bf(mid + (size_t)tok * DM, x, lane); store16f8((unsigned char*)(a.ws + WS_MIDQ) + (size_t)tok * DM, x, lane);
    }
}
__device__ __forceinline__ void ln2_phase(Frame& F, const Args& a, int layer) {
    const bf16_t* t2 = (const bf16_t*)(a.ws + WS_T1); bf16_t* xb = (bf16_t*)(a.ws + WS_XB);
    const float* g = a.in[18] + layer * DM; const float* bta = a.in[19] + layer * DM;
    const int lane = F.lane;
    for (int tok2 = F.bid * NWAVES + F.wave; tok2 < NTOK * PM(12); tok2 += F.G * NWAVES) { const int tok = tok2 % NTOK;
        float x[16]; ln_row16(t2 + (size_t)tok * DM, x, lane); ln_norm16(x, g, bta, lane);
        if (layer == 0) { store16bf(xb + (size_t)tok * DM, x, lane); if (FP8_IN1) store16f8((unsigned char*)(a.ws + WS_XQ) + (size_t)tok * DM, x, lane); }
        else { float* o = a.out + (size_t)tok * DM;
            *(f32x4*)(o + 8 * lane) = (f32x4){x[0], x[1], x[2], x[3]}; *(f32x4*)(o + 8 * lane + 4) = (f32x4){x[4], x[5], x[6], x[7]};
            *(f32x4*)(o + 512 + 8 * lane) = (f32x4){x[8], x[9], x[10], x[11]}; *(f32x4*)(o + 512 + 8 * lane + 4) = (f32x4){x[12], x[13], x[14], x[15]}; }
    }
}

__global__ void __launch_bounds__(NTHR, 2) hybrid_fwd(Args args) {
    extern __shared__ __attribute__((aligned(16))) unsigned char lds_raw[];
    Frame F;
    F.lds = (LAS unsigned char*)lds_raw;
    F.tid = threadIdx.x; F.lane = F.tid & 63; F.wave = __builtin_amdgcn_readfirstlane(F.tid >> 6); F.G = gridDim.x; F.bid = blockIdx.x;
    volatile LAS unsigned* MISC = (volatile LAS unsigned*)(F.lds + MISC_OFF);
    for (int u = F.tid; u < 128; u += NTHR) MISC[u] = 0u;
    __syncthreads();
    XcdBarrier bar = xcd_barrier_post((unsigned*)(args.ws + WS_CTL) + 4096, MISC + 8);
    const int lo = args.ph_lo; int ph = 0; (void)lo; (void)ph;
#ifndef PHMASK
#define PHMASK 0xfffff
#endif
#ifndef PROBE_DUP
#define PROBE_DUP 0
#endif
#define SITE(k) if constexpr ((PHMASK >> (k)) & 1)
typedef const __attribute__((address_space(4))) Args* KArgs;
#define PHASE_REFRESH int t_ = threadIdx.x; asm volatile("" : "+v"(t_)); F.tid = t_; F.lane = t_ & 63; F.wave = __builtin_amdgcn_readfirstlane(t_ >> 6); \
    { int b_ = blockIdx.x; asm volatile("" : "+s"(b_)); F.bid = b_; } \
    { unsigned l_ = 0; asm volatile("" : "+s"(l_)); F.lds = (LAS unsigned char*)lds_raw + l_; } LAS unsigned char* const ring = F.lds; \
    LOAD_ARGS unsigned char* const ws = A.ws;
#if defined(__HIP_DEVICE_COMPILE__)
#define LOAD_ARGS KArgs ap_ = (KArgs)__builtin_amdgcn_kernarg_segment_ptr(); asm volatile("" : "+s"(ap_)); const Args A = *ap_;
#else
#define LOAD_ARGS const Args A = args;
#endif
#ifdef MK_LAUNCHES_PER_PHASE
#define PHASE_BEGIN if (ph == lo) { PHASE_REFRESH
#define PHASE_END   } ++ph;
#define PHASE_END_LAST } ++ph;
#else
#define PHASE_BEGIN { PHASE_REFRESH
#ifdef PROBE_BAR2
#define PHASE_END   xcd_barrier(bar); xcd_barrier(bar); }
#else
#define PHASE_END   xcd_barrier(bar); }
#endif
#define PHASE_END_LAST if (layer == 0) xcd_barrier(bar); }
#endif
    using namespace pg8;

    PHASE_BEGIN SITE(0) p0_prologue(F, A); PHASE_END

    for (int layer = 0; layer < 2; ++layer) {
        PHASE_BEGIN
        SITE(1) {
        if (layer == 0) {
            SITE(16) { DenseOrder S; S.initp(ws + (FP8_IN0 ? WS_XQ : WS_XB), ws + WS_WIN0, NTOK, ZE, FP8_IN0 ? DM : 2 * DM, F.G, F.bid, PM(1)); EpiIn0 E{(bf16_t*)(ws + WS_Z), 0.125f * LOG2E}; int p8 = FP8_IN0 ? DM : 2 * DM; asm volatile("" : "+s"(p8)); gemm_phase<EpiIn0, DenseOrder, FP8_IN0 != 0>(ring, F.tid, p8, S, E); }
            SITE(17) { PleOrder S; S.D.init(ws + WS_PB, ws + WS_WPLE, 2 * NTOK, DM, PLE, F.G, F.bid, PM(1));
              int kple = 2 * PLE; asm volatile("" : "+s"(kple));
              EpiPlain E{(bf16_t*)(ws + WS_PPLE), DM}; gemm_phase(ring, F.tid, kple, S, E); }
        } else {
            SITE(18) { DenseOrder S; S.initp(ws + (FP8_IN1 ? WS_XQ : WS_XB), ws + WS_WIN1, NTOK, ZO, FP8_IN1 ? DM : 2 * DM, F.G, F.bid, PM(1)); EpiIn1 E{(bf16_t*)(ws + WS_Z), (bf16_t*)(ws + WS_KV1), (bf16_t*)(ws + WS_KI1)}; int p8 = FP8_IN1 ? DM : 2 * DM; asm volatile("" : "+s"(p8)); gemm_phase<EpiIn1, DenseOrder, FP8_IN1 != 0>(ring, F.tid, p8, S, E); }
        }
        }
        PHASE_END
        PHASE_BEGIN
        if (layer == 0) {
            const int vcS = ((F.G & 7) == 0) ? (F.bid & 7) * (F.G >> 3) + (F.bid >> 3) : F.bid;
            SITE(2) for (long L = vcS; L < 1024 * PM(2); L += F.G) { const int v = (int)(L & 255), rnd = (int)((L >> 8) & 3), s = v & 3, bh = v >> 2;
                const int qb = rnd == 0 ? 15 - s : (rnd == 1 ? 8 + s : (rnd == 2 ? 7 - s : s));
                sb_unit(F, A, bh >> 3, bh & 7, qb); }
            SITE(3) for (int u = F.bid; u < PM(3) * NTOK / 128; u += F.G) gmlp_unit(F, A, u % (NTOK / 128));
        } else {
            SITE(4) for (int L = F.bid; L < PM(4) * NTOK / 8; L += F.G) { const int Lm = L % (NTOK / 8), r = Lm >> 8, cc = Lm & 255;
                const int j = (r & 1) ? 511 - cc : cc; dsa_select_unit(F, A, (r >> 1) * 512 + j); }
        }
        PHASE_END
        if (layer == 1) {
        PHASE_BEGIN
            const int vcB = ((F.G & 7) == 0) ? (F.bid & 7) * (F.G >> 3) + (F.bid >> 3) : F.bid;
            SITE(13) for (int L = vcB; L < 1024 * PM(13); L += F.G) { const int idx = L & 1023, pp = idx & 31, g = (idx >> 5) & 3, b = idx >> 7;
                dsa_attn_unit(F, A, b, 63 - pp, g); dsa_attn_unit(F, A, b, pp, g); }
        PHASE_END
        }
        PHASE_BEGIN
        SITE(5) { DenseOrder S; S.initp(ws + WS_CAT, ws + (layer == 0 ? WS_WO0 : WS_WO1), NTOK, DM, FP8_OUT ? DM : 2 * DM, F.G, F.bid, PM(5));
          EpiOut E{layer == 0 ? A.in[0] : nullptr, (const bf16_t*)(ws + WS_XB), (bf16_t*)(ws + WS_T1)}; int p8 = FP8_OUT ? DM : 2 * DM; asm volatile("" : "+s"(p8)); gemm_phase<EpiOut, DenseOrder, FP8_OUT != 0>(ring, F.tid, p8, S, E); }
        PHASE_END
        PHASE_BEGIN SITE(6) ln1_router_phase(F, A, layer); PHASE_END
        PHASE_BEGIN SITE(7) scatter_phase(F, A); PHASE_END
        PHASE_BEGIN
        SITE(8) {
#ifdef MK_LAUNCHES_PER_PHASE
          moe_tables(F, A, -1);
#endif
          const int ntl = __builtin_amdgcn_readfirstlane(((LAS int*)(F.lds + TAB_OFF))[TB_NTL / 4]);
          MoeOrder<8, true> S; S.nunits = ntl * 8; S.G = F.G; S.c = F.bid; S.rep = PM(8); S.t2e = (const LAS unsigned char*)(F.lds + TAB_OFF + TB_T2E);
          S.A = (const char*)(ws + WS_XS); S.W = (const char*)(ws + WS_WGU) + (size_t)layer * 32 * 2048 * DM;
          EpiSwiglu E{(unsigned char*)(ws + WS_ACT), A.in[15] + (size_t)layer * 32 * 2048}; int p8 = DM; asm volatile("" : "+s"(p8)); gemm_phase<EpiSwiglu, MoeOrder<8, true>, true, MOE_ALIGN>(ring, F.tid, p8, S, E); }
        PHASE_END
        PHASE_BEGIN
        SITE(9) {
#ifdef MK_LAUNCHES_PER_PHASE
          moe_tables(F, A, -1);
#endif
          const int ntl = __builtin_amdgcn_readfirstlane(((LAS int*)(F.lds + TAB_OFF))[TB_NTL / 4]);
          MoeOrder<4, false> S; S.nunits = ntl * 4; S.G = F.G; S.c = F.bid; S.rep = PM(9); S.t2e = (const LAS unsigned char*)(F.lds + TAB_OFF + TB_T2E);
          S.A = (const char*)(ws + WS_ACT); S.W = (const char*)(ws + WS_WD) + (size_t)layer * 32 * DM * DM;
          EpiDown E{(bf16_t*)(ws + WS_XS), A.in[17] + (size_t)layer * 32 * DM, (const float*)(ws + WS_ROWG)}; int p8 = DM; asm volatile("" : "+s"(p8)); gemm_phase<EpiDown, MoeOrder<4, false>, true, MOE_ALIGN>(ring, F.tid, p8, S, E); }
        PHASE_END
        PHASE_BEGIN SITE(10) combine_phase(F, A); PHASE_END
        PHASE_BEGIN
        SITE(11) { DenseOrder S; S.initp(ws + (FP8_GATE ? WS_MIDQ : WS_MIDB), ws + WS_WG + (size_t)layer * DM * DM * (FP8_GATE ? 1 : 2), NTOK, DM, FP8_GATE ? DM : 2 * DM, F.G, F.bid, PM(11));
          EpiGate E{(const bf16_t*)(ws + WS_MIDB), (const bf16_t*)(ws + WS_PPLE) + (size_t)layer * NTOK * DM, A.in[22] + layer * DM, (bf16_t*)(ws + WS_T1)}; int p8 = FP8_GATE ? DM : 2 * DM; asm volatile("" : "+s"(p8)); gemm_phase<EpiGate, DenseOrder, FP8_GATE != 0>(ring, F.tid, p8, S, E); }
        PHASE_END
        PHASE_BEGIN SITE(12) ln2_phase(F, A, layer); PHASE_END_LAST
    }
#undef PHASE_BEGIN
#undef PHASE_END
#undef PHASE_END_LAST
}
constexpr int N_PHASES = 22;

extern "C" void kernel_launch(void* const* d_in, const int* in_sizes, int n_in, void* d_out, int out_size, void* d_ws, size_t ws_size, hipStream_t stream) {
    static int grid = 0;
    if (grid == 0) {
        if (n_in != 23 || out_size != NTOK * DM || ws_size < WS_END) { fprintf(stderr, "kernel_launch: unexpected problem: n_in %d out %d ws %zu (need %zu)\n", n_in, out_size, ws_size, (size_t)WS_END); grid = -1; return; }
        int dev = 0, cus = 0, per_cu = 0;
        if (hipGetDevice(&dev) != hipSuccess || hipDeviceGetAttribute(&cus, hipDeviceAttributeMultiprocessorCount, dev) != hipSuccess) { grid = -1; return; }
        if (hipFuncSetAttribute((const void*)hybrid_fwd, hipFuncAttributeMaxDynamicSharedMemorySize, LDS_BYTES) != hipSuccess) { fprintf(stderr, "kernel_launch: hipFuncSetAttribute failed\n"); grid = -1; return; }
        if (hipOccupancyMaxActiveBlocksPerMultiprocessor(&per_cu, (const void*)hybrid_fwd, NTHR, LDS_BYTES) != hipSuccess || per_cu < 1) fprintf(stderr, "kernel_launch: occupancy query says %d\n", per_cu);
        (void)hipGetLastError();
        grid = cus;
    }
    if (grid < 0) return;
    (void)hipMemsetAsync((char*)d_ws + WS_CTL, 0, CTL_ZERO_BYTES, stream);
    Args a{};
    for (int i = 0; i < 23; ++i) a.in[i] = (const float*)d_in[i];
    a.out = (float*)d_out; a.ws = (unsigned char*)d_ws;
#ifndef MK_LAUNCHES_PER_PHASE
    a.ph_lo = 0; a.ph_hi = N_PHASES;
    hipLaunchKernelGGL(hybrid_fwd, dim3(grid), dim3(NTHR), LDS_BYTES, stream, a);
#else
    for (int p = 0; p < N_PHASES; ++p) { a.ph_lo = p; a.ph_hi = p + 1; hipLaunchKernelGGL(hybrid_fwd, dim3(grid), dim3(NTHR), LDS_BYTES, stream, a); }
#endif
}
```

```cpp
#include <hip/hip_runtime.h>
#include <cstdio>
#include <cstdint>

#define LAS __attribute__((address_space(3)))
#define GAS __attribute__((address_space(1)))
typedef unsigned short bf16_t;
typedef short bf16x8 __attribute__((ext_vector_type(8)));
typedef short s16x4 __attribute__((ext_vector_type(4)));
typedef float f32x2 __attribute__((ext_vector_type(2)));
typedef float f32x4 __attribute__((ext_vector_type(4)));
typedef float f32x16 __attribute__((ext_vector_type(16)));
typedef unsigned u32x2 __attribute__((ext_vector_type(2)));
typedef unsigned u32x4 __attribute__((ext_vector_type(4)));

constexpr int DM = 1024, NB = 8, SEQ = 4096, NTOK = NB * SEQ;
constexpr int ZE = 2560;
constexpr int ZO = 2304, ZO_REAL = 2120;
constexpr int OQ = 0, OK_ = 1024, OV = 1280, OQI = 1536, OKI = 2048, OWI = 2112;
constexpr int NEXP = 32, PLE = 256;
constexpr int NGRP = NTOK / 128;
constexpr int MAXTILES = NTOK * 4 / 256 + NEXP;
constexpr int MAXROWS = MAXTILES * 256;
constexpr float LN_EPS = 1e-5f;
constexpr float ALPHA = 1.4142135623730951f;
constexpr float LOG2E = 1.4426950408889634f;
constexpr float WSC = 64.f, WSC_INV = 1.f / 64.f;

#ifndef FP8_IN0
#define FP8_IN0 1
#endif
#ifndef Y_FP8
#define Y_FP8 1
#endif
#ifndef MOE_ALIGN
#define MOE_ALIGN true
#endif
#ifndef FP8_IN1
#define FP8_IN1 0
#endif
#ifndef FP8_OUT
#define FP8_OUT 1
#endif
#ifndef FP8_GATE
#define FP8_GATE 1
#endif
#ifndef PROBE_DUP
#define PROBE_DUP 0
#endif
#define PM(k) (((PROBE_DUP >> (k)) & 1) ? 2 : 1)

constexpr size_t MiB = 1u << 20;
constexpr size_t WS_CTL = 0, CTL_ZERO_BYTES = 1 * MiB;
constexpr size_t WS_WRT = 1 * MiB;
constexpr size_t WS_WSB = WS_WRT + 256 * 1024;
constexpr size_t WS_CNT = WS_WSB + 256 * 1024;
constexpr size_t WS_TOPI = 2 * MiB;
constexpr size_t WS_GATE = WS_TOPI + 512 * 1024;
constexpr size_t WS_SLOT = 3 * MiB;
constexpr size_t WS_ROWG = WS_SLOT + 512 * 1024;
constexpr size_t WS_WIN0 = 8 * MiB, WS_WO0 = 13 * MiB, WS_WIN1 = 15 * MiB, WS_WO1 = 20 * MiB, WS_WG = 22 * MiB, WS_WPLE = 26 * MiB;
constexpr size_t WS_WGU = 32 * MiB, WS_WD = 288 * MiB;
constexpr size_t WS_XB = 416 * MiB, WS_PB = 480 * MiB, WS_PPLE = 512 * MiB, WS_Z = 640 * MiB, WS_CAT = 800 * MiB, WS_T1 = 864 * MiB;
constexpr size_t WS_BM = 1328 * MiB;
constexpr size_t WS_KV1 = WS_BM + 16 * MiB;
constexpr size_t WS_KI1 = WS_KV1 + 32 * MiB;
constexpr size_t WS_HB = 928 * MiB, WS_MIDB = 992 * MiB, WS_XS = 1056 * MiB, WS_ACT = 1328 * MiB;
constexpr size_t WS_XQ = 1600 * MiB, WS_MIDQ = 1632 * MiB, WS_END = 1664 * MiB;
static_assert(WS_ROWG + (size_t)MAXROWS * 4 <= WS_WIN0, "small buffers");
static_assert(WS_XS + (size_t)MAXROWS * DM * 2 <= WS_ACT && WS_ACT + (size_t)MAXROWS * DM * 2 <= WS_END, "moe buffers");

constexpr int RING_BYTES = 131072;
constexpr int MISC_OFF = RING_BYTES;
constexpr int TAB_OFF = MISC_OFF + 512;
constexpr int XTRA_OFF = TAB_OFF + 6144;
constexpr int LDS_BYTES = 147456;
static_assert(XTRA_OFF + 8192 <= LDS_BYTES, "LDS map");
constexpr int TB_TOT16 = 0, TB_BEF16 = 2048, TB_TOTAL = 4096, TB_BEFORE = 4224, TB_PADST = 4352  , TB_NTL = 4488, TB_LCUR = 4608  , TB_BASE = 4736  , TB_T2E = 5120  ;
static_assert(TB_T2E + 544 <= 6144, "tab");

#define RLX_AGENT __ATOMIC_RELAXED, __HIP_MEMORY_SCOPE_AGENT
typedef __bf16 bf16x2_t __attribute__((ext_vector_type(2)));
__device__ __forceinline__ unsigned cvt_pk_bf16(float lo, float hi) { const f32x2 v = {lo, hi}; const bf16x2_t b = __builtin_convertvector(v, bf16x2_t); return __builtin_bit_cast(unsigned, b); }
__device__ __forceinline__ unsigned char f8_1(float v) { return (unsigned char)(__builtin_amdgcn_cvt_pk_fp8_f32(v, v, 0, false) & 0xff); }
#if FP8_OUT
#define CAT_ST(cat, idx, v) ((cat)[idx] = f8_1(v))
#else
#define CAT_ST(cat, idx, v) (((bf16_t*)(cat))[idx] = (bf16_t)(cvt_pk_bf16((v), 0.f) & 0xffffu))
#endif
__device__ __forceinline__ float bf_lo(unsigned u) { return __uint_as_float(u << 16); }
__device__ __forceinline__ float bf_hi(unsigned u) { return __uint_as_float(u & 0xffff0000u); }
__device__ __forceinline__ float bf1(bf16_t u) { return __uint_as_float(((unsigned)u) << 16); }
template <int K> __device__ __forceinline__ int sxi(int v) {
    if constexpr (K == 32) { const auto rr = __builtin_amdgcn_permlane32_swap((unsigned)v, (unsigned)v, false, false); return (int)(rr[0] ^ rr[1] ^ (unsigned)v); }
    else return __builtin_amdgcn_ds_swizzle(v, (K << 10) | 0x1f);
}
template <int K> __device__ __forceinline__ float sxf(float v) { return __int_as_float(sxi<K>(__float_as_int(v))); }
__device__ __forceinline__ float wave_sum(float x) {
    int v = __float_as_int(x);
#define WSF_STEP(ctrl, rm) { const int o = __builtin_amdgcn_update_dpp(0, v, ctrl, rm, 0xf, false); v = __float_as_int(__int_as_float(v) + __int_as_float(o)); }
    WSF_STEP(0x111, 0xf) WSF_STEP(0x112, 0xf) WSF_STEP(0x114, 0xf) WSF_STEP(0x118, 0xf) WSF_STEP(0x142, 0xa) WSF_STEP(0x143, 0xc)
#undef WSF_STEP
    return __int_as_float(__builtin_amdgcn_readlane(v, 63));
}
__device__ __forceinline__ float wave_max(float v) {
    v = fmaxf(v, sxf<1>(v)); v = fmaxf(v, sxf<2>(v)); v = fmaxf(v, sxf<4>(v)); v = fmaxf(v, sxf<8>(v)); v = fmaxf(v, sxf<16>(v)); v = fmaxf(v, sxf<32>(v));
    return v;
}
__device__ __forceinline__ float wave_min(float v) {
    v = fminf(v, sxf<1>(v)); v = fminf(v, sxf<2>(v)); v = fminf(v, sxf<4>(v)); v = fminf(v, sxf<8>(v)); v = fminf(v, sxf<16>(v)); v = fminf(v, sxf<32>(v));
    return v;
}
__device__ __forceinline__ int wave_sumi(int v) {
    v += sxi<1>(v); v += sxi<2>(v); v += sxi<4>(v); v += sxi<8>(v); v += sxi<16>(v); v += sxi<32>(v);
    return v;
}
__device__ __forceinline__ int wave_sum_uniform(int v) {
    v += __builtin_amdgcn_update_dpp(0, v, 0x111, 0xf, 0xf, false);
    v += __builtin_amdgcn_update_dpp(0, v, 0x112, 0xf, 0xf, false);
    v += __builtin_amdgcn_update_dpp(0, v, 0x114, 0xf, 0xf, false);
    v += __builtin_amdgcn_update_dpp(0, v, 0x118, 0xf, 0xf, false);
    v += __builtin_amdgcn_update_dpp(0, v, 0x142, 0xa, 0xf, false);
    v += __builtin_amdgcn_update_dpp(0, v, 0x143, 0xc, 0xf, false);
    return __builtin_amdgcn_readlane(v, 63);
}
__device__ __forceinline__ float wave_max_uniform(float x) {
    int v = __float_as_int(x);
#define WMX_STEP(ctrl, rm) { const int o = __builtin_amdgcn_update_dpp(v, v, ctrl, rm, 0xf, false); v = __float_as_int(fmaxf(__int_as_float(v), __int_as_float(o))); }
    WMX_STEP(0x111, 0xf) WMX_STEP(0x112, 0xf) WMX_STEP(0x114, 0xf) WMX_STEP(0x118, 0xf) WMX_STEP(0x142, 0xa) WMX_STEP(0x143, 0xc)
#undef WMX_STEP
    return __int_as_float(__builtin_amdgcn_readlane(v, 63));
}
__device__ __forceinline__ float relu_i(float x) { const int i = __float_as_int(x); return __int_as_float(i > 0 ? i : 0); }
__device__ __forceinline__ float ex2(float x) { return __builtin_amdgcn_exp2f(x); }
__device__ __forceinline__ float lg2(float x) { return __builtin_amdgcn_logf(x); }
__device__ __forceinline__ float rcpf_(float x) { return __builtin_amdgcn_rcpf(x); }
__device__ __forceinline__ float sigmoidf_(float x) { return rcpf_(1.f + ex2(-LOG2E * x)); }
__device__ __forceinline__ float gelu_tanh(float x) { return x * rcpf_(1.f + ex2(-2.302208198f * (x + 0.044715f * x * x * x))); }

namespace pg8 {
constexpr int BM = 256, BK = 64, HALF = 128, HTB = HALF * BK * 2, STAGE_BYTES = 8 * HTB, NXCD = 8, WGM = 8;
__host__ __device__ __forceinline__ int lds_byte(int r, int c) { const int st = (r >> 4) * 2 + (c >> 5), rr = r & 15, cc = c & 31, ob = rr * 64 + cc * 2; return st * 1024 + (ob ^ (((ob >> 9) & 1) << 5)); }
__host__ __device__ __forceinline__ void stage_rc(int b, int& R, int& C) { const int st = b / 1024, sb = b % 1024, swz = sb ^ (((sb >> 9) & 1) << 5); R = (st >> 1) * 16 + swz / 64; C = (st & 1) * 32 + (swz % 64) / 2; }
__host__ __device__ __forceinline__ int perm32(int rho) { const int n = rho >> 4, i = rho & 15; return 8 * (i >> 2) + 4 * n + (i & 3); }

struct Unit { int pm, pn, e; const char* b0; };
typedef int v8i_t __attribute__((ext_vector_type(8)));
typedef int v4i_t __attribute__((ext_vector_type(4)));
__device__ __forceinline__ v8i_t cat8(const bf16x8 a, const bf16x8 b) { const v4i_t x = __builtin_bit_cast(v4i_t, a), y = __builtin_bit_cast(v4i_t, b); return __builtin_shufflevector(x, y, 0, 1, 2, 3, 4, 5, 6, 7); }

struct DenseOrder {
    int nM, nN, nwg, G, c, rep; const char* A; const char* B; size_t tstep, hstep;
    __device__ __forceinline__ void init(const void* A_, const void* B_, int M, int N, int K, int G_, int c_, int rep_ = 1) { initp(A_, B_, M, N, 2 * K, G_, c_, rep_); }
    __device__ __forceinline__ void initp(const void* A_, const void* B_, int M, int N, int pitch, int G_, int c_, int rep_ = 1) { A = (const char*)A_; B = (const char*)B_; nM = M / BM; nN = N / BM; nwg = nM * nN; G = G_; c = c_; rep = rep_; hstep = (size_t)HALF * pitch; tstep = 2 * hstep; }
    __device__ __forceinline__ bool next(int i, Unit& u) const {
        long L = (long)i * G + c; if (L >= (long)nwg * rep) return false; if (L >= nwg) L -= nwg;
        int wgid = (int)L; { const int q = nwg / NXCD, r = nwg % NXCD, xcd = wgid % NXCD, off = wgid / NXCD; wgid = (xcd < r ? xcd * (q + 1) : r * (q + 1) + (xcd - r) * q) + off; }
        const int nig = WGM * nN, gid = wgid / nig, fm = gid * WGM, gsz = (nM - fm) < WGM ? (nM - fm) : WGM;
        u.pm = fm + ((wgid % nig) % gsz); u.pn = (wgid % nig) / gsz; u.e = 0;
        u.b0 = B + (size_t)u.pn * tstep; return true;
    }
    __device__ __forceinline__ const char* aptr(const Unit& u) const { return A + (size_t)u.pm * tstep; }
    __device__ __forceinline__ size_t b1off() const { return hstep; }
};
struct PleOrder {
    DenseOrder D;
    __device__ __forceinline__ bool next(int i, Unit& u) const { if (!D.next(i, u)) return false; if (u.pm >= 32768 / BM) u.b0 += (size_t)1024 * 256 * 2; return true; }
    __device__ __forceinline__ const char* aptr(const Unit& u) const { return D.aptr(u); }
    __device__ __forceinline__ size_t b1off() const { return D.b1off(); }
};
template <int NT, bool SWIGLU>
struct MoeOrder {
    int nunits, G, c, rep; const LAS unsigned char* t2e; const char* A; const char* W;
    static constexpr size_t hstep = (size_t)HALF * 1024, tstep = 2 * hstep;
    __device__ __forceinline__ bool next(int i, Unit& u) const {
        const int vc = ((G & 7) == 0) ? (c & 7) * (G >> 3) + (c >> 3) : c;
        int L = i * G + vc; if (L >= nunits * rep) return false; if (L >= nunits) L -= nunits;
        const int rt = L / NT, pn = L % NT;
        const int e = __builtin_amdgcn_readfirstlane((int)t2e[rt]);
        u.pm = rt; u.pn = pn; u.e = e;
        if (SWIGLU) u.b0 = W + (size_t)e * (16 * hstep) + (size_t)pn * hstep;
        else u.b0 = W + (size_t)e * (8 * hstep) + (size_t)pn * tstep;
        return true;
    }
    __device__ __forceinline__ const char* aptr(const Unit& u) const { return A + (size_t)u.pm * tstep; }
    __device__ __forceinline__ size_t b1off() const { return SWIGLU ? 8 * hstep : hstep; }
};

template <class Epi, class Sched, bool FP8 = false, bool ALIGN_EPI = true>
__device__ __forceinline__ void gemm_phase(LAS unsigned char* lds, const int tid, const int pitch, const Sched& S, const Epi& E) {
    const int wid = __builtin_amdgcn_readfirstlane(tid >> 6), lane = tid & 63, wr = wid >> 2, wc = wid & 3, fr = lane & 15, fq = lane >> 4;
    const int nt = pitch / (BK * 2);
    unsigned voffA[2], voffB[2];
#pragma unroll
    for (int i = 0; i < 2; ++i) { int R, C; stage_rc(tid * 16 + i * 8192, R, C); const int Rb = (R & ~31) + perm32(R & 31);
        voffA[i] = (unsigned)(R * pitch + C * 2); voffB[i] = (unsigned)(Rb * pitch + C * 2); }
    const size_t kstep = (size_t)(BK * 2);
    const size_t hstep = (size_t)HALF * pitch;
    const unsigned ldsw = (unsigned)wid * 1024u;
    int sc127 = 127; asm volatile("" : "+v"(sc127));
    const unsigned ldsu = (unsigned)__builtin_amdgcn_readfirstlane((int)(unsigned)(uintptr_t)lds) + ldsw;
    const int aoff = lds_byte(wr * 64 + fr, fq * 8), boff = lds_byte(wc * 32 + fr, fq * 8);
#define PG8_SA(b, h) (((b) * 2 + (h)) * HTB)
#define PG8_SB(b, h) ((4 + (b) * 2 + (h)) * HTB)
#define PG8_STAGE(bufoff, gbase, voff) do { _Pragma("unroll") for (int _i = 0; _i < 2; ++_i) { unsigned _keep; \
        asm volatile("s_mov_b32 %0, m0\n\ts_mov_b32 m0, %3\n\ts_nop 0\n\tglobal_load_lds_dwordx4 %1, %2\n\ts_mov_b32 m0, %0" : "=&s"(_keep) : "v"((voff)[_i]), "s"((const char*)(gbase)), "s"(ldsu + (unsigned)((bufoff) + _i * 8192)) : "memory"); } } while (0)
#define PG8_LDA(dst, b, h) do { _Pragma("unroll") for (int m = 0; m < 4; ++m) _Pragma("unroll") for (int k = 0; k < 2; ++k) dst[m][k] = *(const LAS bf16x8*)(lds + PG8_SA(b, h) + aoff + m * 2048 + k * 1024); } while (0)
#define PG8_LDB(dst, b, h) do { _Pragma("unroll") for (int n = 0; n < 2; ++n) _Pragma("unroll") for (int k = 0; k < 2; ++k) dst[n][k] = *(const LAS bf16x8*)(lds + PG8_SB(b, h) + boff + n * 2048 + k * 1024); } while (0)
#define PG8_MMA(ai, bj, At, Bt) do { __builtin_amdgcn_s_setprio(1); _Pragma("unroll") for (int m = 0; m < 4; ++m) _Pragma("unroll") for (int n = 0; n < 2; ++n) { \
        if constexpr (FP8) { const v8i_t _a = cat8(Bt[n][0], Bt[n][1]), _b = cat8(At[m][0], At[m][1]); \
            asm volatile("v_mfma_scale_f32_16x16x128_f8f6f4 %0, %1, %2, %0, %3, %3 op_sel_hi:[0,0,0]" : "+v"(acc[ai][bj][m][n]) : "v"(_a), "v"(_b), "v"(sc127)); } \
        else { _Pragma("unroll") for (int k = 0; k < 2; ++k) acc[ai][bj][m][n] = __builtin_amdgcn_mfma_f32_16x16x32_bf16(Bt[n][k], At[m][k], acc[ai][bj][m][n], 0, 0, 0); } } __builtin_amdgcn_s_setprio(0); } while (0)
#define PG8_WAIT_V(n) asm volatile("s_waitcnt vmcnt(" #n ")" ::: "memory")
#define PG8_WAIT_L(n) asm volatile("s_waitcnt lgkmcnt(" #n ")" ::: "memory")
#define PG8_BAR __builtin_amdgcn_s_barrier()
#define PG8_SCHED __builtin_amdgcn_sched_barrier(0)
    Unit cur, nxt; int ui = 0;
    if (!S.next(0, cur)) return;
    f32x4 acc[2][2][4][2];
#pragma unroll
    for (int a = 0; a < 2; ++a)
#pragma unroll
        for (int b = 0; b < 2; ++b)
#pragma unroll
            for (int m = 0; m < 4; ++m)
#pragma unroll
                for (int n = 0; n < 2; ++n) acc[a][b][m][n] = (f32x4){0.f, 0.f, 0.f, 0.f};
    bf16x8 At[4][2], B0[2][2], B1[2][2];
    const char* cA = S.aptr(cur); const char* cB0 = cur.b0; const char* cB1 = cB0 + S.b1off();
    PG8_STAGE(PG8_SB(0, 0), cB0, voffB); PG8_STAGE(PG8_SB(0, 1), cB1, voffB); PG8_STAGE(PG8_SA(0, 0), cA, voffA); PG8_STAGE(PG8_SA(0, 1), cA + hstep, voffA);
    if (wr == 1) PG8_BAR;
    PG8_WAIT_V(2); PG8_BAR;
    PG8_STAGE(PG8_SB(1, 0), cB0 + kstep, voffB); PG8_STAGE(PG8_SA(1, 0), cA + kstep, voffA); PG8_STAGE(PG8_SB(1, 1), cB1 + kstep, voffB);
    PG8_WAIT_V(6); PG8_BAR;
    for (;;) {
        const bool has_next = S.next(ui + 1, nxt);
        const char* nA = has_next ? S.aptr(nxt) : cA; const char* nB0 = has_next ? nxt.b0 : cB0; const char* nB1 = nB0 + S.b1off();
        for (int t = 0; t < nt; t += 2) {
            const bool last = (t == nt - 2);
            const char* a1 = cA + (size_t)(t + 1) * kstep;
            const char* a2 = last ? nA : cA + (size_t)(t + 2) * kstep;
            const char* b20 = last ? nB0 : cB0 + (size_t)(t + 2) * kstep; const char* b21 = last ? nB1 : cB1 + (size_t)(t + 2) * kstep;
            const char* a3 = a2 + kstep; const char* b30 = b20 + kstep; const char* b31 = b21 + kstep;
            PG8_LDB(B0, 0, 0); PG8_LDB(B1, 0, 1); PG8_SCHED; PG8_LDA(At, 0, 0); PG8_STAGE(PG8_SA(1, 1), a1 + hstep, voffA);
            PG8_WAIT_V(8); PG8_WAIT_L(0); PG8_BAR; PG8_MMA(0, 0, At, B0); PG8_MMA(0, 1, At, B1); PG8_BAR; PG8_SCHED;
            PG8_LDA(At, 0, 1); PG8_STAGE(PG8_SB(0, 0), b20, voffB); PG8_STAGE(PG8_SB(0, 1), b21, voffB); PG8_STAGE(PG8_SA(0, 0), a2, voffA);
            PG8_WAIT_V(8); PG8_WAIT_L(0); PG8_BAR; PG8_MMA(1, 0, At, B0); PG8_MMA(1, 1, At, B1); PG8_BAR; PG8_SCHED;
            PG8_LDB(B0, 1, 0); PG8_LDB(B1, 1, 1); PG8_SCHED; PG8_LDA(At, 1, 0); PG8_STAGE(PG8_SA(0, 1), a2 + hstep, voffA);
            PG8_WAIT_V(8); PG8_WAIT_L(0); PG8_BAR; PG8_MMA(0, 0, At, B0); PG8_MMA(0, 1, At, B1); PG8_BAR; PG8_SCHED;
            PG8_LDA(At, 1, 1); PG8_STAGE(PG8_SB(1, 0), b30, voffB); PG8_STAGE(PG8_SB(1, 1), b31, voffB); PG8_STAGE(PG8_SA(1, 0), a3, voffA);
            PG8_WAIT_V(8); PG8_WAIT_L(0); PG8_BAR; PG8_MMA(1, 0, At, B0); PG8_MMA(1, 1, At, B1); PG8_BAR; PG8_SCHED;
        }
        if constexpr (ALIGN_EPI) { if (wr == 0) PG8_BAR; }
        E(acc, cur, wr, wc, fr, fq);
        if (!has_next) break;
#pragma unroll
        for (int a = 0; a < 2; ++a)
#pragma unroll
            for (int b = 0; b < 2; ++b)
#pragma unroll
                for (int m = 0; m < 4; ++m)
#pragma unroll
                    for (int n = 0; n < 2; ++n) acc[a][b][m][n] = (f32x4){0.f, 0.f, 0.f, 0.f};
        cur = nxt; cA = nA; cB0 = nB0; cB1 = nB1; ++ui;
        if constexpr (ALIGN_EPI) { if (wr == 1) PG8_BAR; }
    }
    PG8_WAIT_V(0);
    if constexpr (!ALIGN_EPI) { if (wr == 0) PG8_BAR; }
    PG8_BAR;
#undef PG8_SA
#undef PG8_SB
#undef PG8_STAGE
#undef PG8_LDA
#undef PG8_LDB
#undef PG8_MMA
#undef PG8_WAIT_V
#undef PG8_WAIT_L
#undef PG8_BAR
#undef PG8_SCHED
}

#define EPI_ROWS_BEGIN const int row0 = u.pm * BM + wr * 64 + fr; const int cl = wc * 32 + 8 * fq;
__device__ __forceinline__ void store8(bf16_t* p, const f32x4 v0, const f32x4 v1) {
    u32x4 w; w.x = cvt_pk_bf16(v0[0], v0[1]); w.y = cvt_pk_bf16(v0[2], v0[3]); w.z = cvt_pk_bf16(v1[0], v1[1]); w.w = cvt_pk_bf16(v1[2], v1[3]); *(u32x4*)p = w;
}
__device__ __forceinline__ u32x2 pack8_fp8(const f32x4 v0, const f32x4 v1) {
    int a = 0, b = 0; a = __builtin_amdgcn_cvt_pk_fp8_f32(v0[0], v0[1], a, false); a = __builtin_amdgcn_cvt_pk_fp8_f32(v0[2], v0[3], a, true);
    b = __builtin_amdgcn_cvt_pk_fp8_f32(v1[0], v1[1], b, false); b = __builtin_amdgcn_cvt_pk_fp8_f32(v1[2], v1[3], b, true); return (u32x2){(unsigned)a, (unsigned)b};
}
__device__ __forceinline__ void store8_fp8(unsigned char* p, const f32x4 v0, const f32x4 v1) { *(u32x2*)p = pack8_fp8(v0, v1); }
__device__ __forceinline__ void load8bf(const bf16_t* p, f32x4& v0, f32x4& v1) {
    const u32x4 w = *(const u32x4*)p; v0 = (f32x4){bf_lo(w.x), bf_hi(w.x), bf_lo(w.y), bf_hi(w.y)}; v1 = (f32x4){bf_lo(w.z), bf_hi(w.z), bf_lo(w.w), bf_hi(w.w)};
}
struct EpiPlain {
    bf16_t* O; int ldc;
    __device__ __forceinline__ void operator()(const f32x4 (&acc)[2][2][4][2], const Unit& u, int wr, int wc, int fr, int fq) const {
        EPI_ROWS_BEGIN
#pragma unroll
        for (int ai = 0; ai < 2; ++ai)
#pragma unroll
            for (int m = 0; m < 4; ++m) { bf16_t* rowp = O + (unsigned)((row0 + ai * HALF + m * 16) * ldc + u.pn * BM + cl);
#pragma unroll
                for (int bj = 0; bj < 2; ++bj) store8(rowp + bj * HALF, acc[ai][bj][m][0], acc[ai][bj][m][1]); asm volatile("" ::: "memory"); }
    }
};
struct EpiIn0 {
    static constexpr float WSI = FP8_IN0 ? WSC_INV : 1.f;
    bf16_t* O; float qscale;
    __device__ __forceinline__ void operator()(const f32x4 (&acc)[2][2][4][2], const Unit& u, int wr, int wc, int fr, int fq) const {
        EPI_ROWS_BEGIN
        if (u.pn < 4) {
#pragma unroll
            for (int ai = 0; ai < 2; ++ai)
#pragma unroll
                for (int m = 0; m < 4; ++m) { bf16_t* rowp = O + (unsigned)((row0 + ai * HALF + m * 16) * ZE + u.pn * BM + cl);
#pragma unroll
                    for (int bj = 0; bj < 2; ++bj) { f32x4 v0 = acc[ai][bj][m][0] * WSI, v1 = acc[ai][bj][m][1] * WSI;
#pragma unroll
                        for (int j = 0; j < 4; ++j) { v0[j] = gelu_tanh(v0[j]); v1[j] = gelu_tanh(v1[j]); }
                        store8(rowp + bj * HALF, v0, v1); asm volatile("" ::: "memory"); } }
        } else {
            const float sc = (u.pn < 6 ? qscale : 1.f) * WSI;
#pragma unroll
            for (int ai = 0; ai < 2; ++ai)
#pragma unroll
                for (int m = 0; m < 4; ++m) { bf16_t* rowp = O + (unsigned)((row0 + ai * HALF + m * 16) * ZE + u.pn * BM + cl);
#pragma unroll
                    for (int bj = 0; bj < 2; ++bj) store8(rowp + bj * HALF, acc[ai][bj][m][0] * sc, acc[ai][bj][m][1] * sc);
                    asm volatile("" ::: "memory"); }
        }
    }
};
struct EpiIn1 {
    static constexpr float WSI = FP8_IN1 ? WSC_INV : 1.f;
    bf16_t* O; bf16_t* KV; bf16_t* KI;
    __device__ __forceinline__ void operator()(const f32x4 (&acc)[2][2][4][2], const Unit& u, int wr, int wc, int fr, int fq) const {
        EPI_ROWS_BEGIN
        if (u.pn == 4 || u.pn == 5) {
            bf16_t* base = KV + (u.pn - 4) * 256 + cl;
#pragma unroll
            for (int ai = 0; ai < 2; ++ai)
#pragma unroll
                for (int m = 0; m < 4; ++m) { bf16_t* rowp = base + (unsigned)((row0 + ai * HALF + m * 16) * 512);
#pragma unroll
                    for (int bj = 0; bj < 2; ++bj) store8(rowp + bj * HALF, acc[ai][bj][m][0] * WSI, acc[ai][bj][m][1] * WSI);
                    asm volatile("" ::: "memory"); }
        } else {
            const float sc = (u.pn < 4 ? 0.125f * LOG2E : 1.f) * WSI;
#pragma unroll
            for (int ai = 0; ai < 2; ++ai)
#pragma unroll
                for (int m = 0; m < 4; ++m) { bf16_t* rowp = O + (unsigned)((row0 + ai * HALF + m * 16) * ZO + u.pn * BM + cl);
#pragma unroll
                    for (int bj = 0; bj < 2; ++bj) store8(rowp + bj * HALF, acc[ai][bj][m][0] * sc, acc[ai][bj][m][1] * sc);
                    asm volatile("" ::: "memory"); }
            if (u.pn == 8 && wc < 2) {
#pragma unroll
                for (int ai = 0; ai < 2; ++ai)
#pragma unroll
                    for (int m = 0; m < 4; ++m) { const int row = row0 + ai * HALF + m * 16;
                        store8(KI + (unsigned)(((((row >> 5) * 4 + (cl >> 4)) * 64) + (((cl >> 3) & 1) * 32 + (row & 31))) * 8), acc[ai][0][m][0] * WSI, acc[ai][0][m][1] * WSI); asm volatile("" ::: "memory"); }
            }
        }
    }
};
struct EpiOut {
    const float* xf; const bf16_t* xb; bf16_t* O;
    __device__ __forceinline__ void operator()(const f32x4 (&acc)[2][2][4][2], const Unit& u, int wr, int wc, int fr, int fq) const {
        EPI_ROWS_BEGIN
#pragma unroll
        for (int ai = 0; ai < 2; ++ai) {
            f32x4 xr[4][2][2];
#pragma unroll
            for (int m = 0; m < 4; ++m) { const unsigned off = (unsigned)((row0 + ai * HALF + m * 16) * DM + u.pn * BM + cl);
#pragma unroll
                for (int bj = 0; bj < 2; ++bj) {
                    if (xf) { xr[m][bj][0] = *(const f32x4*)(xf + off + bj * HALF); xr[m][bj][1] = *(const f32x4*)(xf + off + bj * HALF + 4); }
                    else load8bf(xb + off + bj * HALF, xr[m][bj][0], xr[m][bj][1]); } }
            asm volatile("" ::: "memory");
#pragma unroll
            for (int m = 0; m < 4; ++m) { const unsigned off = (unsigned)((row0 + ai * HALF + m * 16) * DM + u.pn * BM + cl);
#pragma unroll
                for (int bj = 0; bj < 2; ++bj)
                    store8(O + off + bj * HALF, xr[m][bj][0] * ALPHA + acc[ai][bj][m][0] * (FP8_OUT ? WSC_INV : 1.f), xr[m][bj][1] * ALPHA + acc[ai][bj][m][1] * (FP8_OUT ? WSC_INV : 1.f)); }
            asm volatile("" ::: "memory");
        }
    }
};
__device__ __forceinline__ f32x2 swiglu_pk(f32x2 g, f32x2 u) {
    f32x2 ga, ua; ga.x = fminf(g.x, 7.f); ga.y = fminf(g.y, 7.f);
    ua.x = __builtin_amdgcn_fmed3f(u.x, -7.f, 7.f); ua.y = __builtin_amdgcn_fmed3f(u.y, -7.f, 7.f);
    const f32x2 t = ga * (-1.702f * LOG2E);
    f32x2 e; e.x = __builtin_amdgcn_exp2f(t.x); e.y = __builtin_amdgcn_exp2f(t.y);
    const f32x2 d = e + 1.0f;
    f32x2 r; r.x = __builtin_amdgcn_rcpf(d.x); r.y = __builtin_amdgcn_rcpf(d.y);
    return (ga * r) * (ua + 1.0f);
}
struct EpiSwiglu {
    unsigned char* O; const float* bgu;
    __device__ __forceinline__ void operator()(const f32x4 (&acc)[2][2][4][2], const Unit& u, int wr, int wc, int fr, int fq) const {
        EPI_ROWS_BEGIN
        const int col = u.pn * HALF + cl;
        const float* bp = bgu + (unsigned)(u.e * 2048 + col);
        const f32x4 bg0 = *(const f32x4*)bp, bg1 = *(const f32x4*)(bp + 4), bu0 = *(const f32x4*)(bp + 1024), bu1 = *(const f32x4*)(bp + 1028);
#pragma unroll
        for (int ai = 0; ai < 2; ++ai)
#pragma unroll
            for (int m = 0; m < 4; ++m) { f32x4 g0 = acc[ai][0][m][0] * WSC_INV + bg0, g1 = acc[ai][0][m][1] * WSC_INV + bg1, p0 = acc[ai][1][m][0] * WSC_INV + bu0, p1 = acc[ai][1][m][1] * WSC_INV + bu1, r0, r1;
#pragma unroll
                for (int j = 0; j < 4; j += 2) { f32x2 o;
                    o = swiglu_pk((f32x2){g0[j], g0[j + 1]}, (f32x2){p0[j], p0[j + 1]}); r0[j] = o.x; r0[j + 1] = o.y;
                    o = swiglu_pk((f32x2){g1[j], g1[j + 1]}, (f32x2){p1[j], p1[j + 1]}); r1[j] = o.x; r1[j + 1] = o.y; }
                store8_fp8(O + (unsigned)((row0 + ai * HALF + m * 16) * DM + col), r0, r1); asm volatile("" ::: "memory"); }
    }
};
struct EpiDown {
    bf16_t* O; const float* bd; const float* rowgate;
    __device__ __forceinline__ void operator()(const f32x4 (&acc)[2][2][4][2], const Unit& u, int wr, int wc, int fr, int fq) const {
        EPI_ROWS_BEGIN
        const int col = u.pn * BM + cl; const float* bp = bd + (unsigned)(u.e * DM + col);
        f32x4 bv[2][2];
#pragma unroll
        for (int bj = 0; bj < 2; ++bj) { bv[bj][0] = *(const f32x4*)(bp + bj * HALF); bv[bj][1] = *(const f32x4*)(bp + bj * HALF + 4); }
        float gt[2][4];
#pragma unroll
        for (int ai = 0; ai < 2; ++ai)
#pragma unroll
            for (int m = 0; m < 4; ++m) gt[ai][m] = rowgate[row0 + ai * HALF + m * 16];
#pragma unroll
        for (int ai = 0; ai < 2; ++ai)
#pragma unroll
            for (int m = 0; m < 4; ++m) { const int row = row0 + ai * HALF + m * 16; const float g = gt[ai][m];
#pragma unroll
                for (int bj = 0; bj < 2; ++bj) {
                    if (Y_FP8) store8_fp8((unsigned char*)O + (unsigned)(row * DM + col + bj * HALF), (acc[ai][bj][m][0] * WSC_INV + bv[bj][0]) * (g * 16.f), (acc[ai][bj][m][1] * WSC_INV + bv[bj][1]) * (g * 16.f));
                    else store8(O + (unsigned)(row * DM + col + bj * HALF), (acc[ai][bj][m][0] * WSC_INV + bv[bj][0]) * g, (acc[ai][bj][m][1] * WSC_INV + bv[bj][1]) * g); }
                asm volatile("" ::: "memory"); }
    }
};
struct EpiGate {
    const bf16_t* mid; const bf16_t* P; const float* bg; bf16_t* O;
    __device__ __forceinline__ void operator()(const f32x4 (&acc)[2][2][4][2], const Unit& u, int wr, int wc, int fr, int fq) const {
        EPI_ROWS_BEGIN
        const int col = u.pn * BM + cl;
        f32x4 bv[2][2];
#pragma unroll
        for (int bj = 0; bj < 2; ++bj) { bv[bj][0] = *(const f32x4*)(bg + col + bj * HALF); bv[bj][1] = *(const f32x4*)(bg + col + bj * HALF + 4); }
#pragma unroll
        for (int ai = 0; ai < 2; ++ai) {
            u32x4 mr[4][2], pr[4][2];
#pragma unroll
            for (int m = 0; m < 4; ++m) { const unsigned off = (unsigned)((row0 + ai * HALF + m * 16) * DM + col);
#pragma unroll
                for (int bj = 0; bj < 2; ++bj) { mr[m][bj] = *(const u32x4*)(mid + off + bj * HALF); pr[m][bj] = *(const u32x4*)(P + off + bj * HALF); } }
            asm volatile("" ::: "memory");
#pragma unroll
            for (int m = 0; m < 4; ++m) { const unsigned off = (unsigned)((row0 + ai * HALF + m * 16) * DM + col);
#pragma unroll
                for (int bj = 0; bj < 2; ++bj) { const u32x4 mw = mr[m][bj], pw = pr[m][bj];
                    const f32x4 m0 = {bf_lo(mw.x), bf_hi(mw.x), bf_lo(mw.y), bf_hi(mw.y)}, m1 = {bf_lo(mw.z), bf_hi(mw.z), bf_lo(mw.w), bf_hi(mw.w)};
                    const f32x4 p0 = {bf_lo(pw.x), bf_hi(pw.x), bf_lo(pw.y), bf_hi(pw.y)}, p1 = {bf_lo(pw.z), bf_hi(pw.z), bf_lo(pw.w), bf_hi(pw.w)};
                    f32x4 r0, r1;
                    const f32x4 a0 = acc[ai][bj][m][0] * (FP8_GATE ? WSC_INV : 1.f) + bv[bj][0], a1 = acc[ai][bj][m][1] * (FP8_GATE ? WSC_INV : 1.f) + bv[bj][1];
#pragma unroll
                    for (int j = 0; j < 4; ++j) { r0[j] = m0[j] + sigmoidf_(a0[j]) * p0[j]; r1[j] = m1[j] + sigmoidf_(a1[j]) * p1[j]; }
                    store8(O + off + bj * HALF, r0, r1); } }
            asm volatile("" ::: "memory");
        }
    }
};
}

#define XB_TMO      128
#define XB_XCNT(j)  (256  + 64 * (j))
#define XB_XSUB(j)  (1280 + 64 * (j))
#define XB_XGEN(j)  (2304 + 64 * (j))
#define XB_TOP      3328
#define XB_TOPGEN   3392
#define XCD_BAR_WORDS 3456
#define XB_SPIN_CAP (1u << 18)
__device__ __forceinline__ unsigned xb_ld(unsigned* p)              { return __hip_atomic_load(p, __ATOMIC_RELAXED, __HIP_MEMORY_SCOPE_AGENT); }
__device__ __forceinline__ unsigned xb_add(unsigned* p, unsigned v) { return __hip_atomic_fetch_add(p, v, __ATOMIC_RELAXED, __HIP_MEMORY_SCOPE_AGENT); }
__device__ __forceinline__ unsigned xb_xcc_id() { return (unsigned)__builtin_amdgcn_s_getreg((3 << 11) | 20) & 0xFu; }
#define XB_SPIN(cond, bar) do { unsigned _sp = 0; while (cond) { __builtin_amdgcn_s_sleep(1); \
    if ((++_sp & 255u) == 0u) { if (xb_ld(&(bar)[XB_TMO])) break; if (_sp > XB_SPIN_CAP) { atomicAdd(&(bar)[XB_TMO], 1u); break; } } } } while (0)
struct XcdBarrier { unsigned* bar; unsigned x; volatile LAS unsigned* st; };
__device__ __forceinline__ XcdBarrier xcd_barrier_post(unsigned* bar, volatile LAS unsigned* st) {
    XcdBarrier b; b.bar = bar; b.x = xb_xcc_id(); b.st = st;
    if (threadIdx.x == 0) (void)xb_add(&bar[XB_XCNT(b.x)], 1u);
    return b;
}
__device__ __forceinline__ void xcd_barrier_complete(unsigned* bar, unsigned x, unsigned& nloc, unsigned& nx) {
    const unsigned G = gridDim.x * gridDim.y * gridDim.z;
    unsigned sum, cnt, mine, sp = 0u;
    for (;;) {
        sum = 0u; cnt = 0u; mine = 0u;
#pragma unroll
        for (unsigned j = 0; j < 16; ++j) { const unsigned c = xb_ld(&bar[XB_XCNT(j)]); sum += c; cnt += (c > 0u) ? 1u : 0u; mine = (j == x) ? c : mine; }
        if (sum == G) break;
        __builtin_amdgcn_s_sleep(1);
        if ((++sp & 255u) == 0u) { if (xb_ld(&bar[XB_TMO])) break; if (sp > XB_SPIN_CAP) { atomicAdd(&bar[XB_TMO], 1u); break; } }
    }
    nloc = mine > 0u ? mine : 1u; nx = cnt > 0u ? cnt : 1u;
}
__device__ __forceinline__ void xcd_barrier(const XcdBarrier& b) {
    asm volatile("s_waitcnt vmcnt(0)" ::: "memory");
    __syncthreads();
    if (threadIdx.x == 0) {
        unsigned* bar = b.bar; asm volatile("" : "+s"(bar));
        unsigned bx = b.x; asm volatile("" : "+s"(bx));
        __builtin_amdgcn_s_waitcnt(0);
        unsigned nloc = b.st[0], nx = b.st[1];
        if (nloc == 0u) { xcd_barrier_complete(bar, bx, nloc, nx); b.st[0] = nloc; b.st[1] = nx; }
        const unsigned old = xb_add(&bar[XB_XSUB(bx)], 1u);
        const unsigned gen = old / nloc;
        if (old + 1u == (gen + 1u) * nloc) {
            __builtin_amdgcn_fence(__ATOMIC_RELEASE, "agent");
            asm volatile("s_waitcnt vmcnt(0)" ::: "memory");
            const unsigned og = xb_add(&bar[XB_TOP], 1u);
            const unsigned tg = og / nx;
            if (og + 1u == (tg + 1u) * nx) xb_add(&bar[XB_TOPGEN], 1u);
            else XB_SPIN(xb_ld(&bar[XB_TOPGEN]) == tg, bar);
            __builtin_amdgcn_fence(__ATOMIC_ACQUIRE, "agent");
            xb_add(&bar[XB_XGEN(bx)], 1u);
            asm volatile("s_waitcnt vmcnt(0)" ::: "memory");
        } else {
            XB_SPIN(xb_ld(&bar[XB_XGEN(bx)]) == gen, bar);
            __builtin_amdgcn_fence(__ATOMIC_ACQUIRE, "agent");
            asm volatile("s_waitcnt vmcnt(0)" ::: "memory");
        }
    }
    __syncthreads();
}

constexpr int NWAVES = 8, NTHR = 512;
struct Args { const float* in[23]; float* out; unsigned char* ws; int ph_lo, ph_hi; };
struct Frame { LAS unsigned char* lds; int tid, lane, wave, G, bid; };
#define LDS_WAIT() asm volatile("s_waitcnt lgkmcnt(0)" ::: "memory")
#define LDS_BARRIER() asm volatile("s_waitcnt lgkmcnt(0)\n\ts_barrier" ::: "memory")

__device__ __forceinline__ void p0_transpose_item(const float* W, int K, int N, int Npad, bf16_t* WT, LAS float* scr, int item, int lane) {
    const int nblk = Npad / 32, kb = item / nblk, nb = item % nblk, k0 = 64 * kb, n0 = 32 * nb;
    const int n = n0 + (lane & 31);
#pragma unroll 8
    for (int i = 0; i < 32; ++i) { const int kk = 2 * i + (lane >> 5); scr[kk * 33 + (lane & 31)] = (n < N) ? W[(size_t)(k0 + kk) * N + n] : 0.f; }
    LDS_WAIT(); asm volatile("" ::: "memory");
    const int c = lane & 7;
#pragma unroll
    for (int j = 0; j < 4; ++j) { const int nn = (lane >> 3) + 8 * j; const LAS float* s = scr + (8 * c) * 33 + nn;
        u32x4 o; o.x = cvt_pk_bf16(s[0 * 33], s[1 * 33]); o.y = cvt_pk_bf16(s[2 * 33], s[3 * 33]); o.z = cvt_pk_bf16(s[4 * 33], s[5 * 33]); o.w = cvt_pk_bf16(s[6 * 33], s[7 * 33]);
        *(u32x4*)(WT + (size_t)(n0 + nn) * K + k0 + 8 * c) = o; }
    LDS_WAIT(); asm volatile("" ::: "memory");
}
__device__ __forceinline__ void p0_transpose_item_fp8(const float* W, int K, int N, int Npad, unsigned char* WT, LAS float* scr, int item, int lane) {
    const int nblk = Npad / 32, kb = item / nblk, nb = item % nblk, k0 = 64 * kb, n0 = 32 * nb;
#pragma unroll 8
    for (int i = 0; i < 32; ++i) { const int kk = 2 * i + (lane >> 5); const int n = n0 + (lane & 31); scr[kk * 33 + (lane & 31)] = (n < N) ? W[(size_t)(k0 + kk) * N + n] * WSC : 0.f; }
    LDS_WAIT(); asm volatile("" ::: "memory");
    const int c = lane & 7;
#pragma unroll
    for (int j = 0; j < 4; ++j) { const int nn = (lane >> 3) + 8 * j; const LAS float* sp = scr + (8 * c) * 33 + nn;
        const f32x4 v0 = {sp[0 * 33], sp[1 * 33], sp[2 * 33], sp[3 * 33]}, v1 = {sp[4 * 33], sp[5 * 33], sp[6 * 33], sp[7 * 33]};
        *(u32x2*)(WT + (size_t)(n0 + nn) * K + k0 + 8 * c) = pg8::pack8_fp8(v0, v1); }
    LDS_WAIT(); asm volatile("" ::: "memory");
}
__device__ __forceinline__ void cvt_f32_bf16(const float* src, bf16_t* dst, size_t n, int gtid, int gthreads) {
    for (size_t i = (size_t)gtid * 8; i < n; i += (size_t)gthreads * 8) {
        const f32x4 a = *(const f32x4*)(src + i), b = *(const f32x4*)(src + i + 4);
        u32x4 w; w.x = cvt_pk_bf16(a[0], a[1]); w.y = cvt_pk_bf16(a[2], a[3]); w.z = cvt_pk_bf16(b[0], b[1]); w.w = cvt_pk_bf16(b[2], b[3]); *(u32x4*)(dst + i) = w; }
}
__device__ __forceinline__ void p0_prologue(Frame& F, const Args& a) {
    unsigned char* ws = a.ws;
    LAS float* scr = (LAS float*)(F.lds + F.wave * 16384);
    const int gw = F.bid * NWAVES + F.wave, NGW = F.G * NWAVES;
    constexpr int I_IN0 = 16 * (ZE / 32), I_SQ = 16 * 32, I_IN1 = 16 * (ZO / 32), I_PLE = 4 * 32, I_RT = 16, I_GU = 16 * 64;
    constexpr int C0 = I_IN0, C1 = C0 + I_SQ, C2 = C1 + I_IN1, C3 = C2 + I_SQ, C4 = C3 + 2 * I_SQ, C5 = C4 + 2 * I_PLE, C6 = C5 + 2 * I_RT, C7 = C6 + 64 * I_GU, C8 = C7 + 64 * I_SQ;
    for (int it2 = gw; it2 < C8 * PM(0); it2 += NGW) { const int it = it2 >= C8 ? it2 - C8 : it2;
        if (it < C0) { if (FP8_IN0) p0_transpose_item_fp8(a.in[2], DM, ZE, ZE, (unsigned char*)(ws + WS_WIN0), scr, it, F.lane); else p0_transpose_item(a.in[2], DM, ZE, ZE, (bf16_t*)(ws + WS_WIN0), scr, it, F.lane); }
        else if (it < C1) { if (FP8_OUT) p0_transpose_item_fp8(a.in[7], DM, DM, DM, (unsigned char*)(ws + WS_WO0), scr, it - C0, F.lane); else p0_transpose_item(a.in[7], DM, DM, DM, (bf16_t*)(ws + WS_WO0), scr, it - C0, F.lane); }
        else if (it < C2) { if (FP8_IN1) p0_transpose_item_fp8(a.in[8], DM, ZO_REAL, ZO, (unsigned char*)(ws + WS_WIN1), scr, it - C1, F.lane); else p0_transpose_item(a.in[8], DM, ZO_REAL, ZO, (bf16_t*)(ws + WS_WIN1), scr, it - C1, F.lane); }
        else if (it < C3) { if (FP8_OUT) p0_transpose_item_fp8(a.in[9], DM, DM, DM, (unsigned char*)(ws + WS_WO1), scr, it - C2, F.lane); else p0_transpose_item(a.in[9], DM, DM, DM, (bf16_t*)(ws + WS_WO1), scr, it - C2, F.lane); }
        else if (it < C4) { const int r = it - C3, l = r / I_SQ; if (FP8_GATE) p0_transpose_item_fp8(a.in[21] + (size_t)l * DM * DM, DM, DM, DM, (unsigned char*)(ws + WS_WG) + (size_t)l * DM * DM, scr, r % I_SQ, F.lane); else p0_transpose_item(a.in[21] + (size_t)l * DM * DM, DM, DM, DM, (bf16_t*)(ws + WS_WG) + (size_t)l * DM * DM, scr, r % I_SQ, F.lane); }
        else if (it < C5) { const int r = it - C4, l = r / I_PLE; p0_transpose_item(a.in[20] + (size_t)l * PLE * DM, PLE, DM, DM, (bf16_t*)(ws + WS_WPLE) + (size_t)l * DM * PLE, scr, r % I_PLE, F.lane); }
        else if (it < C6) { const int r = it - C5, l = r / I_RT; p0_transpose_item(a.in[12] + (size_t)l * DM * NEXP, DM, NEXP, NEXP, (bf16_t*)(ws + WS_WRT) + (size_t)l * NEXP * DM, scr, r % I_RT, F.lane); }
        else if (it < C7) { const int r = it - C6, l = r / I_GU; p0_transpose_item_fp8(a.in[14] + (size_t)l * DM * 2048, DM, 2048, 2048, (unsigned char*)(ws + WS_WGU) + (size_t)l * 2048 * DM, scr, r % I_GU, F.lane); }
        else { const int r = it - C7, l = r / I_SQ; p0_transpose_item_fp8(a.in[16] + (size_t)l * DM * DM, DM, DM, DM, (unsigned char*)(ws + WS_WD) + (size_t)l * DM * DM, scr, r % I_SQ, F.lane); }
    }
    const int gtid = F.bid * NTHR + F.tid, gth = F.G * NTHR;
    if (!FP8_IN0) cvt_f32_bf16(a.in[0], (bf16_t*)(ws + WS_XB), (size_t)NTOK * DM, gtid, gth);
    else { unsigned char* xq = (unsigned char*)(ws + WS_XQ); const float* x = a.in[0];
      for (size_t i = (size_t)gtid * 8; i < (size_t)NTOK * DM; i += (size_t)gth * 8) { const f32x4 u = *(const f32x4*)(x + i), v = *(const f32x4*)(x + i + 4); *(u32x2*)(xq + i) = pg8::pack8_fp8(u, v); } }
    cvt_f32_bf16(a.in[1], (bf16_t*)(ws + WS_PB), (size_t)2 * NTOK * PLE, gtid, gth);
    for (int i = gtid; i < 8 * 128 * 128; i += gth) { const int t = (i >> 7) & 127, s = i & 127; const float v = (s <= t) ? a.in[5][i] : 0.f; ((bf16_t*)(ws + WS_WSB))[i] = (bf16_t)(cvt_pk_bf16(v, 0.f) & 0xffffu); }
}

__device__ __forceinline__ void gmlp_unit(Frame& F, const Args& a, int unit) {
    const bf16_t* z0 = (const bf16_t*)(a.ws + WS_Z); unsigned char* cat = (unsigned char*)(a.ws + WS_CAT); const bf16_t* wsb = (const bf16_t*)(a.ws + WS_WSB);
    const float* lng = a.in[3]; const float* lnb = a.in[4]; const float* bs = a.in[6];
    const size_t tok0 = (size_t)unit * 128;
    const int lane = F.lane, w = F.wave, r32 = lane & 31, hi = lane >> 5;
    LAS f32x2* stats = (LAS f32x2*)(F.lds + XTRA_OFF);
    for (int i = 0; i < 16; ++i) { const int tl = w * 16 + i;
        const u32x4 v = *(const u32x4*)(z0 + (tok0 + tl) * ZE + 512 + 8 * lane);
        float x[8] = {bf_lo(v.x), bf_hi(v.x), bf_lo(v.y), bf_hi(v.y), bf_lo(v.z), bf_hi(v.z), bf_lo(v.w), bf_hi(v.w)};
        float s = 0.f;
#pragma unroll
        for (int j = 0; j < 8; ++j) s += x[j];
        const float mean = wave_sum(s) * (1.f / 512.f); float q = 0.f;
#pragma unroll
        for (int j = 0; j < 8; ++j) { const float d = x[j] - mean; q += d * d; }
        const float rstd = 1.f / sqrtf(wave_sum(q) * (1.f / 512.f) + LN_EPS);
        if (lane == 0) stats[tl] = (f32x2){mean, rstd}; }
    __syncthreads();
    const int g = w;
    LAS unsigned char* vt = F.lds + w * 16384;
    { const int tl8 = lane >> 3, cc = lane & 7;
      float gg[8], bb[8];
#pragma unroll
      for (int j = 0; j < 8; ++j) { gg[j] = lng[g * 64 + 8 * cc + j]; bb[j] = lnb[g * 64 + 8 * cc + j]; }
      for (int it = 0; it < 16; ++it) { const int tl = 8 * it + tl8;
          const u32x4 v = *(const u32x4*)(z0 + (tok0 + tl) * ZE + 512 + g * 64 + 8 * cc);
          const f32x2 st = stats[tl];
          float x[8] = {bf_lo(v.x), bf_hi(v.x), bf_lo(v.y), bf_hi(v.y), bf_lo(v.z), bf_hi(v.z), bf_lo(v.w), bf_hi(v.w)};
#pragma unroll
          for (int j = 0; j < 8; ++j) { const int c = 8 * cc + j; const float y = (x[j] - st.x) * st.y * gg[j] + bb[j];
              *(LAS bf16_t*)(vt + c * 256 + ((((tl >> 3) ^ (c & 15))) << 4) + (tl & 7) * 2) = (bf16_t)(cvt_pk_bf16(y, 0.f) & 0xffffu); } } }
    LDS_WAIT(); asm volatile("" ::: "memory");
    for (int tb = 0; tb < 4; ++tb) {
        f32x16 d0 = {}, d1 = {};
        const bf16_t* wrow = wsb + ((size_t)g * 128 + tb * 32 + r32) * 128 + 8 * hi;
        bf16x8 afr[8];
#pragma unroll
        for (int ks = 0; ks < 8; ++ks) afr[ks] = *(const bf16x8*)(wrow + 16 * ks);
#pragma unroll
        for (int ks = 0; ks < 8; ++ks) { if (ks >= 2 * (tb + 1)) break;
            const bf16x8 af = afr[ks];
            const int chunk = 2 * ks + hi;
            const bf16x8 b0 = *(const LAS bf16x8*)(vt + r32 * 256 + ((chunk ^ (r32 & 15)) << 4));
            const bf16x8 b1 = *(const LAS bf16x8*)(vt + (32 + r32) * 256 + ((chunk ^ (r32 & 15)) << 4));
            d0 = __builtin_amdgcn_mfma_f32_32x32x16_bf16(af, b0, d0, 0, 0, 0);
            d1 = __builtin_amdgcn_mfma_f32_32x32x16_bf16(af, b1, d1, 0, 0, 0);
        }
#pragma unroll
        for (int r = 0; r < 16; ++r) { const int t = tb * 32 + (r & 3) + 8 * (r >> 2) + 4 * hi; const float bsv = bs[g * 128 + t];
            const size_t ro = (tok0 + t) * ZE + g * 64 + r32; const size_t co = (tok0 + t) * DM + g * 64 + r32;
            const float u0 = bf1(z0[ro]), u1 = bf1(z0[ro + 32]);
            CAT_ST(cat, co, u0 * (d0[r] + bsv)); CAT_ST(cat, co + 32, u1 * (d1[r] + bsv)); }
    }
    __syncthreads();
}

constexpr int SB_KST = 144;
constexpr int SB_TILE = 64 * SB_KST;
__device__ __forceinline__ void sb_unit(Frame& F, const Args& a, int b, int h, int qb) {
    const bf16_t* z0 = (const bf16_t*)(a.ws + WS_Z); unsigned char* cat = (unsigned char*)(a.ws + WS_CAT);
    const int tid = F.tid, lane = F.lane, wid = F.wave, r32 = lane & 31, hi = lane >> 5;
    const size_t rowbase = (size_t)b * SEQ;
    const int q0 = qb * 256, qw0 = q0 + wid * 32, tq = qw0 + r32;
    bf16x8 qr[4];
    { const bf16_t* qp = z0 + (rowbase + tq) * ZE + 1024 + h * 64 + hi * 8;
#pragma unroll
      for (int ks = 0; ks < 4; ++ks) qr[ks] = *(const bf16x8*)(qp + ks * 16); }
    f32x16 o0 = {}, o1 = {}; float C = 1.f;
    const int ntile = q0 / 64 + 4;
    LAS unsigned char* Kb = F.lds; LAS unsigned char* Vb = F.lds + 2 * SB_TILE;
    const bf16_t* kg = z0 + (rowbase + (tid >> 3)) * ZE + 1536 + h * 64 + (tid & 7) * 8;
    const unsigned ldst = (unsigned)(tid >> 3) * SB_KST + (unsigned)(tid & 7) * 16;
    { const size_t go = (size_t)(ntile - 1) * 64 * ZE; const u32x4 kn = *(const u32x4*)(kg + go), vn = *(const u32x4*)(kg + go + 512);
      *(LAS u32x4*)(Kb + ldst) = kn; *(LAS u32x4*)(Vb + ldst) = vn; }
    const int dh = (lane >> 4) & 1, q_ = (lane & 15) >> 2, p_ = lane & 3;
    for (int kt = ntile - 1; kt >= 0; --kt) {
        const int buf = (ntile - 1 - kt) & 1;
        u32x4 kn, vn;
        if (kt > 0) { const size_t go = (size_t)(kt - 1) * 64 * ZE; kn = *(const u32x4*)(kg + go); vn = *(const u32x4*)(kg + go + 512); }
        LDS_BARRIER();
        const LAS unsigned char* Kc = Kb + buf * SB_TILE; const LAS unsigned char* Vc = Vb + buf * SB_TILE;
        if (64 * kt <= qw0) {
            f32x16 p[2]; p[0] = (f32x16){}; p[1] = (f32x16){};
#pragma unroll
            for (int ks = 0; ks < 4; ++ks) {
                const bf16x8 k0 = *(const LAS bf16x8*)(Kc + r32 * SB_KST + (16 * ks + 8 * hi) * 2);
                const bf16x8 k1 = *(const LAS bf16x8*)(Kc + (32 + r32) * SB_KST + (16 * ks + 8 * hi) * 2);
                p[0] = __builtin_amdgcn_mfma_f32_32x32x16_bf16(k0, qr[ks], p[0], 0, 0, 0);
                p[1] = __builtin_amdgcn_mfma_f32_32x32x16_bf16(k1, qr[ks], p[1], 0, 0, 0);
            }
            const bool need_mask = (64 * kt + 64 > qw0);
            const int kb0 = 64 * kt + 4 * hi;
            float NB[2][16], BE[2][16];
            if (need_mask) {
#pragma unroll
                for (int bk = 0; bk < 2; ++bk)
#pragma unroll
                    for (int r = 0; r < 16; ++r) { const float rc = rcpf_(1.f + ex2(-p[bk][r]));
                        const int key = kb0 + 32 * bk + 8 * (r >> 2) + (r & 3); const bool ok = key < tq;
                        BE[bk][r] = ok ? rc : 0.f; NB[bk][r] = ok ? 1.f - rc : 1.f; }
            } else {
#pragma unroll
                for (int bk = 0; bk < 2; ++bk)
#pragma unroll
                    for (int r = 0; r < 16; ++r) { const float rc = rcpf_(1.f + ex2(-p[bk][r])); BE[bk][r] = rc; NB[bk][r] = 1.f - rc; }
            }
            float acc_c = C;
#pragma unroll
            for (int bk = 1; bk >= 0; --bk)
#pragma unroll
                for (int aa = 3; aa >= 0; --aa) {
                    const float R = (NB[bk][4 * aa] * NB[bk][4 * aa + 1]) * (NB[bk][4 * aa + 2] * NB[bk][4 * aa + 3]);
                    const auto rr = __builtin_amdgcn_permlane32_swap(__float_as_uint(R), __float_as_uint(R), false, false);
                    const float Rp = hi ? __uint_as_float(rr[0]) : __uint_as_float(rr[1]);
                    const float a3 = hi ? acc_c : acc_c * Rp, a2 = a3 * NB[bk][4 * aa + 3], a1 = a2 * NB[bk][4 * aa + 2], a0 = a1 * NB[bk][4 * aa + 1];
                    p[bk][4 * aa + 3] = BE[bk][4 * aa + 3] * a3; p[bk][4 * aa + 2] = BE[bk][4 * aa + 2] * a2;
                    p[bk][4 * aa + 1] = BE[bk][4 * aa + 1] * a1; p[bk][4 * aa + 0] = BE[bk][4 * aa + 0] * a0;
                    acc_c *= R * Rp;
                }
            C = acc_c;
            bf16x8 pa[2][2];
#pragma unroll
            for (int bk = 0; bk < 2; ++bk)
#pragma unroll
                for (int s = 0; s < 2; ++s) { u32x4 w; w.x = cvt_pk_bf16(p[bk][8 * s + 0], p[bk][8 * s + 1]); w.y = cvt_pk_bf16(p[bk][8 * s + 2], p[bk][8 * s + 3]);
                    w.z = cvt_pk_bf16(p[bk][8 * s + 4], p[bk][8 * s + 5]); w.w = cvt_pk_bf16(p[bk][8 * s + 6], p[bk][8 * s + 7]); pa[bk][s] = __builtin_bit_cast(bf16x8, w); }
#pragma unroll
            for (int bk = 0; bk < 2; ++bk)
#pragma unroll
                for (int s = 0; s < 2; ++s) {
                    const LAS unsigned char* vp = Vc + (32 * bk + 16 * s + 4 * hi + q_) * SB_KST + (16 * dh + 4 * p_) * 2;
                    const s16x4 l0 = __builtin_amdgcn_ds_read_tr16_b64_v4i16((LAS s16x4*)(vp));
                    const s16x4 h0 = __builtin_amdgcn_ds_read_tr16_b64_v4i16((LAS s16x4*)(vp + 8 * SB_KST));
                    const s16x4 l1 = __builtin_amdgcn_ds_read_tr16_b64_v4i16((LAS s16x4*)(vp + 64));
                    const s16x4 h1 = __builtin_amdgcn_ds_read_tr16_b64_v4i16((LAS s16x4*)(vp + 8 * SB_KST + 64));
                    const bf16x8 v0 = (bf16x8){l0[0], l0[1], l0[2], l0[3], h0[0], h0[1], h0[2], h0[3]};
                    const bf16x8 v1 = (bf16x8){l1[0], l1[1], l1[2], l1[3], h1[0], h1[1], h1[2], h1[3]};
                    o0 = __builtin_amdgcn_mfma_f32_32x32x16_bf16(pa[bk][s], v0, o0, 0, 0, 0);
                    o1 = __builtin_amdgcn_mfma_f32_32x32x16_bf16(pa[bk][s], v1, o1, 0, 0, 0);
                }
        }
        if (kt > 0) { *(LAS u32x4*)(Kb + (buf ^ 1) * SB_TILE + ldst) = kn; *(LAS u32x4*)(Vb + (buf ^ 1) * SB_TILE + ldst) = vn; }
    }
#pragma unroll
    for (int r = 0; r < 16; ++r) { const int q = (r & 3) + 8 * (r >> 2) + 4 * hi;
        const size_t oo = (rowbase + qw0 + q) * DM + 512 + h * 64 + r32;
        CAT_ST(cat, oo, o0[r]); CAT_ST(cat, oo + 32, o1[r]); }
    __syncthreads();
}

template <int I> struct SelStep {
    static __device__ __forceinline__ void run(const float (&v)[64], float thr, float lo, bool exact, int need_eq, int& eq_seen, unsigned& m0, unsigned& m1) {
        const bool gt = v[I] > thr; const bool eq = (!exact) && !gt && (v[I] > lo);
        const unsigned long long meq = __ballot(eq);
        const int eq_rank = eq_seen + __builtin_amdgcn_mbcnt_hi((unsigned)(meq >> 32), __builtin_amdgcn_mbcnt_lo((unsigned)meq, 0));
        const bool take = gt || (eq && eq_rank < need_eq);
        const unsigned long long mt = __ballot(take);
        const unsigned mlo = (unsigned)mt, mhi = (unsigned)(mt >> 32);
        asm volatile("s_nop 1\n\tv_writelane_b32 %0, %1, %2" : "+v"(m0) : "s"(mlo), "n"(I));
        asm volatile("s_nop 1\n\tv_writelane_b32 %0, %1, %2" : "+v"(m1) : "s"(mhi), "n"(I));
        eq_seen += __builtin_popcountll(meq);
        SelStep<I + 1>::run(v, thr, lo, exact, need_eq, eq_seen, m0, m1);
    }
};
template <> struct SelStep<64> { static __device__ __forceinline__ void run(const float (&)[64], float, float, bool, int, int&, unsigned&, unsigned&) {} };

template <int I> struct SelExact {
    static __device__ __forceinline__ void run(const float (&v)[64], float thr, unsigned& m0, unsigned& m1) {
        const unsigned long long mt = __ballot(v[I] > thr);
        const unsigned mlo = (unsigned)mt, mhi = (unsigned)(mt >> 32);
        asm volatile("s_nop 1\n\tv_writelane_b32 %0, %1, %2" : "+v"(m0) : "s"(mlo), "n"(I));
        asm volatile("s_nop 1\n\tv_writelane_b32 %0, %1, %2" : "+v"(m1) : "s"(mhi), "n"(I));
        SelExact<I + 1>::run(v, thr, m0, m1);
    }
};
template <> struct SelExact<64> { static __device__ __forceinline__ void run(const float (&)[64], float, unsigned&, unsigned&) {} };

__device__ __forceinline__ void dsa_select_unit(Frame& F, const Args& a, int unit) {
    const bf16_t* z1 = (const bf16_t*)(a.ws + WS_Z); unsigned* bm = (unsigned*)(a.ws + WS_BM);
    const int lane = F.lane, wid = F.wave, r32 = lane & 31, hi = lane >> 5;
    const int tok0 = unit * 8;
    const int b = tok0 / SEQ, t0 = tok0 % SEQ;
    const size_t rowbase = (size_t)b * SEQ;
    const int vis = (t0 / 64 + 1) * 64;
    LAS float* sc = (LAS float*)F.lds;
    if (vis > 256) {
        const int tl = 2 * (r32 >> 4) + ((r32 >> 2) & 1), hd = (r32 & 3) + 4 * ((r32 >> 3) & 1);
        bf16x8 af[2][4];
#pragma unroll
        for (int rt = 0; rt < 2; ++rt) { const bf16_t* qp = z1 + (size_t)(tok0 + 4 * rt + tl) * ZO + OQI + hd * 64 + 8 * hi;
#pragma unroll
            for (int ks = 0; ks < 4; ++ks) af[rt][ks] = *(const bf16x8*)(qp + 16 * ks); }
        float wv[4][8];
#pragma unroll
        for (int j = 0; j < 4; ++j) { const u32x4 w = *(const u32x4*)(z1 + (size_t)(tok0 + 2 * j + hi) * ZO + OWI);
            const float s = 0.35355339059f * 0.125f;
            wv[j][0] = bf_lo(w.x) * s; wv[j][1] = bf_hi(w.x) * s; wv[j][2] = bf_lo(w.y) * s; wv[j][3] = bf_hi(w.y) * s;
            wv[j][4] = bf_lo(w.z) * s; wv[j][5] = bf_hi(w.z) * s; wv[j][6] = bf_lo(w.w) * s; wv[j][7] = bf_hi(w.w) * s; }
        const int nkt = vis / 32;
        const bf16_t* kbase = (const bf16_t*)(a.ws + WS_KI1) + rowbase * 64 + (size_t)lane * 8;
        for (int rep14 = 0; rep14 < PM(14); ++rep14)
        for (int kt0 = wid; kt0 < nkt; kt0 += 8 * NWAVES) {
            bf16x8 kq[8][4];
#pragma unroll
            for (int pf = 0; pf < 8; ++pf) { const int kt = min(kt0 + pf * NWAVES, nkt - 1);
#pragma unroll
                for (int ks = 0; ks < 4; ++ks) kq[pf][ks] = *(const bf16x8*)(kbase + (size_t)(kt * 4 + ks) * 512); }
            __builtin_amdgcn_sched_barrier(0);
#pragma unroll
            for (int pf = 0; pf < 8; ++pf) { const int kt = kt0 + pf * NWAVES;
                if (kt < nkt) {
                    f32x16 d0 = {}, d1 = {};
#pragma unroll
                    for (int ks = 0; ks < 4; ++ks) { d0 = __builtin_amdgcn_mfma_f32_32x32x16_bf16(af[0][ks], kq[pf][ks], d0, 0, 0, 0); d1 = __builtin_amdgcn_mfma_f32_32x32x16_bf16(af[1][ks], kq[pf][ks], d1, 0, 0, 0); }
                    float s0 = 0.f, s1 = 0.f, s2 = 0.f, s3 = 0.f;
#pragma unroll
                    for (int r = 0; r < 8; ++r) { s0 += wv[0][r] * relu_i(d0[r]); s1 += wv[1][r] * relu_i(d0[8 + r]); s2 += wv[2][r] * relu_i(d1[r]); s3 += wv[3][r] * relu_i(d1[8 + r]); }
                    const int key = kt * 32 + r32;
                    sc[(hi) * 4096 + key] = s0; sc[(2 + hi) * 4096 + key] = s1; sc[(4 + hi) * 4096 + key] = s2; sc[(6 + hi) * 4096 + key] = s3;
                } }
        }
    }
    __syncthreads();
    for (int rep15 = 0; rep15 < PM(15); ++rep15) {
        unsigned m0 = 0u, m1 = 0u;
        if (vis <= 256) { m0 = 0xffffffffu; m1 = 0xffffffffu; }
        else {
            const LAS float* ms = sc + wid * 4096;
            float v[64];
            float mx = -INFINITY, mn = INFINITY;
#pragma unroll
            for (int i = 0; i < 64; ++i) { const bool in = (i * 64 < vis); v[i] = in ? ms[i * 64 + lane] : -INFINITY; if (in) { mx = fmaxf(mx, v[i]); mn = fminf(mn, v[i]); } }
            mx = wave_max_uniform(mx); mn = -wave_max_uniform(-mn);
            float lo = mn - 1.f - fabsf(mn), hiv = mx;
            float thr = hiv; int cgt = 0; bool exact = false;
            int c_lo = vis, c_hi = 0;
            bool dead = false;
            for (int it = 0; it < 64 && (c_lo - c_hi) > 448; ++it) {
                const float mid = 0.5f * (lo + hiv);
                if (!(mid > lo) || !(mid < hiv)) { dead = true; break; }
                int c = 0;
#pragma unroll
                for (int i = 0; i < 64; ++i) c += (v[i] > mid) ? 1 : 0;
                c = wave_sum_uniform(c);
                if (c == 256) { thr = mid; exact = true; break; }
                if (c > 256) { lo = mid; c_lo = c; } else { hiv = mid; c_hi = c; }
            }
            if (!exact && !dead) {
                LAS float* cand = sc + wid * 4096; int base = 0;
#pragma unroll
                for (int i = 0; i < 64; ++i) { const bool in = (v[i] > lo) && !(v[i] > hiv);
                    const unsigned long long mk = __ballot(in);
                    const int pos = base + __builtin_amdgcn_mbcnt_hi((unsigned)(mk >> 32), __builtin_amdgcn_mbcnt_lo((unsigned)mk, 0));
                    if (in) cand[pos] = v[i];
                    base += __builtin_popcountll(mk); }
                const int nc = c_lo - c_hi, c_hi0 = c_hi;
                float cv[8];
#pragma unroll
                for (int j = 0; j < 8; ++j) cv[j] = (lane + 64 * j < nc) ? cand[lane + 64 * j] : -INFINITY;
                for (int it = 0; it < 64; ++it) {
                    const float mid = 0.5f * (lo + hiv);
                    if (!(mid > lo) || !(mid < hiv)) break;
                    int c = 0;
#pragma unroll
                    for (int j = 0; j < 8; ++j) c += (cv[j] > mid) ? 1 : 0;
                    c = c_hi0 + wave_sum_uniform(c);
                    if (c == 256) { thr = mid; exact = true; break; }
                    if (c > 256) { lo = mid; c_lo = c; } else { hiv = mid; c_hi = c; }
                }
            }
            if (!exact) { thr = hiv; cgt = c_hi; }
            const int need_eq = exact ? 0 : (256 - cgt); int eq_seen = 0;
            if (exact) SelExact<0>::run(v, thr, m0, m1); else SelStep<0>::run(v, thr, lo, exact, need_eq, eq_seen, m0, m1);
        }
        if (lane * 64 < vis) *(u32x2*)(bm + (size_t)(tok0 + wid) * 128 + 2 * lane) = (u32x2){m0, m1};
    }
    __syncthreads();
}

template <int I> struct MaskInit {
    static __device__ __forceinline__ void run(f32x16 (&p)[2], int nw0, int nw1, float slope2, float T, int ninf) {
        constexpr int bk = I >> 4, r = I & 15, pos = 8 * (r >> 2) + (r & 3);
        const float vb = __builtin_fmaf(slope2, (float)(32 * bk + pos), T);
        int off; asm("v_bfe_i32 %0, %1, %2, 1" : "=v"(off) : "v"(bk ? nw1 : nw0), "n"(pos));
        float o; asm("v_bfi_b32 %0, %1, %2, %3" : "=v"(o) : "v"(off), "s"(ninf), "v"(vb));
        p[bk][r] = o;
        MaskInit<I + 1>::run(p, nw0, nw1, slope2, T, ninf);
    }
};
template <> struct MaskInit<32> { static __device__ __forceinline__ void run(f32x16 (&)[2], int, int, float, float, int) {} };
__device__ __forceinline__ float max3_asm(float a, float b, float c) { float r; asm("v_max3_f32 %0, %1, %2, %3" : "=v"(r) : "v"(a), "v"(b), "v"(c)); return r; }
__device__ __forceinline__ void dsa_attn_unit(Frame& F, const Args& a, int b, int ch, int g) {
    const bf16_t* z1 = (const bf16_t*)(a.ws + WS_Z); unsigned char* cat = (unsigned char*)(a.ws + WS_CAT); const unsigned* bm = (const unsigned*)(a.ws + WS_BM);
    const int tid = F.tid, lane = F.lane, wid = F.wave, r32 = lane & 31, hi = lane >> 5;
    const int hr = wid >> 1, qh = wid & 1, head = g * 4 + hr;
    const size_t rowbase = (size_t)b * SEQ;
    const int tq = ch * 64 + 32 * qh + r32;
    const float slope2 = ex2(-0.5f * (float)(head + 1)) * LOG2E;
    bf16x8 qr[4];
    { const bf16_t* qp = z1 + (rowbase + tq) * ZO + OQ + head * 64 + hi * 8;
#pragma unroll
      for (int ks = 0; ks < 4; ++ks) qr[ks] = *(const bf16x8*)(qp + ks * 16); }
    const unsigned* mrow = bm + (rowbase + tq) * 128;
    f32x16 o0 = {}, o1 = {}; float m = 0.f, l = 0.f;
    const int ntile = ch + 1;
    LAS unsigned char* Kb = F.lds; LAS unsigned char* Vb = F.lds + 2 * SB_TILE;
    LAS float* wsf = (LAS float*)(F.lds + 4 * SB_TILE) + wid * 32;
    const bf16_t* kg = (const bf16_t*)(a.ws + WS_KV1) + (rowbase + (tid >> 3)) * 512 + g * 64 + (tid & 7) * 8;
    const unsigned ldst = (unsigned)(tid >> 3) * SB_KST + (unsigned)(tid & 7) * 16;
    { const u32x4 kn = *(const u32x4*)(kg), vn = *(const u32x4*)(kg + 256);
      *(LAS u32x4*)(Kb + ldst) = kn; *(LAS u32x4*)(Vb + ldst) = vn; }
    const int dh = (lane >> 4) & 1, q_ = (lane & 15) >> 2, p_ = lane & 3;
    u32x2 mw = *(const u32x2*)(mrow);
    for (int kt = 0; kt < ntile; ++kt) {
        const int buf = kt & 1;
        u32x4 kn, vn; u32x2 mwn = mw;
        if (kt + 1 < ntile) { const size_t go = (size_t)(kt + 1) * 64 * 512; kn = *(const u32x4*)(kg + go); vn = *(const u32x4*)(kg + go + 256); mwn = *(const u32x2*)(mrow + 2 * (kt + 1)); }
        LDS_BARRIER();
        const LAS unsigned char* Kc = Kb + buf * SB_TILE; const LAS unsigned char* Vc = Vb + buf * SB_TILE;
        const float T = slope2 * (float)(64 * kt + 4 * hi) - m;
        const int nw0 = (int)~(mw.x >> (4 * hi)), nw1 = (int)~(mw.y >> (4 * hi));
        f32x16 p[2];
        MaskInit<0>::run(p, nw0, nw1, slope2, T, (int)0xff800000);
#pragma unroll
        for (int ks = 0; ks < 4; ++ks) {
            const bf16x8 k0 = *(const LAS bf16x8*)(Kc + r32 * SB_KST + (16 * ks + 8 * hi) * 2);
            const bf16x8 k1 = *(const LAS bf16x8*)(Kc + (32 + r32) * SB_KST + (16 * ks + 8 * hi) * 2);
            p[0] = __builtin_amdgcn_mfma_f32_32x32x16_bf16(k0, qr[ks], p[0], 0, 0, 0);
            p[1] = __builtin_amdgcn_mfma_f32_32x32x16_bf16(k1, qr[ks], p[1], 0, 0, 0);
        }
        if (kt == ntile - 1) {
            const float basef = (float)(tq - (64 * kt + 4 * hi));
#pragma unroll
            for (int bk = 0; bk < 2; ++bk)
#pragma unroll
                for (int r = 0; r < 16; ++r) { const float rel = (float)(32 * bk + 8 * (r >> 2) + (r & 3)) - basef; p[bk][r] -= 2.f * slope2 * fmaxf(rel, 0.f); }
        } else asm volatile("s_nop 15\n\ts_nop 7" : "+v"(p[0]), "+v"(p[1]));
        float rm;
        { float a0 = max3_asm(p[0][0], p[0][1], p[1][0]), b0 = max3_asm(p[0][2], p[0][3], p[1][1]); a0 = max3_asm(a0, p[1][2], p[1][3]);
#pragma unroll
          for (int r = 4; r < 16; r += 4) { a0 = max3_asm(a0, p[0][r], p[0][r + 1]); b0 = max3_asm(b0, p[0][r + 2], p[0][r + 3]); a0 = max3_asm(a0, p[1][r], p[1][r + 1]); b0 = max3_asm(b0, p[1][r + 2], p[1][r + 3]); }
          rm = fmaxf(a0, b0); }
        rm = fmaxf(rm, sxf<32>(rm));
        if (__any(rm > 6.f) || kt == 0) {
            const float d = (kt == 0) ? ((rm > -1e30f) ? rm : 0.f) : ((rm > 6.f) ? rm : 0.f);
            const float alpha = ex2(-d);
            l *= alpha; m += d;
#pragma unroll
            for (int bk = 0; bk < 2; ++bk)
#pragma unroll
                for (int r = 0; r < 16; ++r) p[bk][r] -= d;
            if (hi == 0) wsf[r32] = alpha;
#pragma unroll
            for (int r = 0; r < 16; ++r) { const float al = wsf[(r & 3) + 8 * (r >> 2) + 4 * hi]; o0[r] *= al; o1[r] *= al; }
        }
        float ls = 0.f;
#pragma unroll
        for (int bk = 0; bk < 2; ++bk)
#pragma unroll
            for (int r = 0; r < 16; ++r) { const float e = ex2(p[bk][r]); p[bk][r] = e; ls += e; }
        l += ls;
        bf16x8 pa[2][2];
#pragma unroll
        for (int bk = 0; bk < 2; ++bk)
#pragma unroll
            for (int s = 0; s < 2; ++s) { u32x4 w; w.x = cvt_pk_bf16(p[bk][8 * s + 0], p[bk][8 * s + 1]); w.y = cvt_pk_bf16(p[bk][8 * s + 2], p[bk][8 * s + 3]);
                w.z = cvt_pk_bf16(p[bk][8 * s + 4], p[bk][8 * s + 5]); w.w = cvt_pk_bf16(p[bk][8 * s + 6], p[bk][8 * s + 7]); pa[bk][s] = __builtin_bit_cast(bf16x8, w); }
#pragma unroll
        for (int bk = 0; bk < 2; ++bk)
#pragma unroll
            for (int s = 0; s < 2; ++s) {
                const LAS unsigned char* vp = Vc + (32 * bk + 16 * s + 4 * hi + q_) * SB_KST + (16 * dh + 4 * p_) * 2;
                const s16x4 l0 = __builtin_amdgcn_ds_read_tr16_b64_v4i16((LAS s16x4*)(vp));
                const s16x4 h0 = __builtin_amdgcn_ds_read_tr16_b64_v4i16((LAS s16x4*)(vp + 8 * SB_KST));
                const s16x4 l1 = __builtin_amdgcn_ds_read_tr16_b64_v4i16((LAS s16x4*)(vp + 64));
                const s16x4 h1 = __builtin_amdgcn_ds_read_tr16_b64_v4i16((LAS s16x4*)(vp + 8 * SB_KST + 64));
                const bf16x8 v0 = (bf16x8){l0[0], l0[1], l0[2], l0[3], h0[0], h0[1], h0[2], h0[3]};
                const bf16x8 v1 = (bf16x8){l1[0], l1[1], l1[2], l1[3], h1[0], h1[1], h1[2], h1[3]};
                o0 = __builtin_amdgcn_mfma_f32_32x32x16_bf16(pa[bk][s], v0, o0, 0, 0, 0);
                o1 = __builtin_amdgcn_mfma_f32_32x32x16_bf16(pa[bk][s], v1, o1, 0, 0, 0);
            }
        if (kt + 1 < ntile) { *(LAS u32x4*)(Kb + (buf ^ 1) * SB_TILE + ldst) = kn; *(LAS u32x4*)(Vb + (buf ^ 1) * SB_TILE + ldst) = vn; }
        mw = mwn;
    }
    l += sxf<32>(l);
    if (hi == 0) wsf[r32] = 1.f / l;
#pragma unroll
    for (int r = 0; r < 16; ++r) { const int q = (r & 3) + 8 * (r >> 2) + 4 * hi; const float inv = wsf[q];
        const size_t oo = (rowbase + ch * 64 + 32 * qh + q) * DM + head * 64 + r32;
        CAT_ST(cat, oo, o0[r] * inv); CAT_ST(cat, oo + 32, o1[r] * inv); }
    __syncthreads();
}

__device__ __forceinline__ void ln_row16(const bf16_t* src, float (&x)[16], int lane) {
    const u32x4 a = *(const u32x4*)(src + 8 * lane), b = *(const u32x4*)(src + 512 + 8 * lane);
    x[0] = bf_lo(a.x); x[1] = bf_hi(a.x); x[2] = bf_lo(a.y); x[3] = bf_hi(a.y); x[4] = bf_lo(a.z); x[5] = bf_hi(a.z); x[6] = bf_lo(a.w); x[7] = bf_hi(a.w);
    x[8] = bf_lo(b.x); x[9] = bf_hi(b.x); x[10] = bf_lo(b.y); x[11] = bf_hi(b.y); x[12] = bf_lo(b.z); x[13] = bf_hi(b.z); x[14] = bf_lo(b.w); x[15] = bf_hi(b.w);
}
__device__ __forceinline__ void ln_norm16(float (&x)[16], const float* g, const float* bta, int lane) {
    float s = 0.f;
#pragma unroll
    for (int j = 0; j < 16; ++j) s += x[j];
    const float mean = wave_sum(s) * (1.f / DM); float q = 0.f;
#pragma unroll
    for (int j = 0; j < 16; ++j) { x[j] -= mean; q += x[j] * x[j]; }
    const float rstd = 1.f / sqrtf(wave_sum(q) * (1.f / DM) + LN_EPS);
    const f32x4 g0 = *(const f32x4*)(g + 8 * lane), g1 = *(const f32x4*)(g + 8 * lane + 4), g2 = *(const f32x4*)(g + 512 + 8 * lane), g3 = *(const f32x4*)(g + 512 + 8 * lane + 4);
    const f32x4 b0 = *(const f32x4*)(bta + 8 * lane), b1 = *(const f32x4*)(bta + 8 * lane + 4), b2 = *(const f32x4*)(bta + 512 + 8 * lane), b3 = *(const f32x4*)(bta + 512 + 8 * lane + 4);
#pragma unroll
    for (int j = 0; j < 4; ++j) { x[j] = x[j] * rstd * g0[j] + b0[j]; x[4 + j] = x[4 + j] * rstd * g1[j] + b1[j]; x[8 + j] = x[8 + j] * rstd * g2[j] + b2[j]; x[12 + j] = x[12 + j] * rstd * g3[j] + b3[j]; }
}
__device__ __forceinline__ void store16bf(bf16_t* dst, const float (&x)[16], int lane) {
    u32x4 a, b; a.x = cvt_pk_bf16(x[0], x[1]); a.y = cvt_pk_bf16(x[2], x[3]); a.z = cvt_pk_bf16(x[4], x[5]); a.w = cvt_pk_bf16(x[6], x[7]);
    b.x = cvt_pk_bf16(x[8], x[9]); b.y = cvt_pk_bf16(x[10], x[11]); b.z = cvt_pk_bf16(x[12], x[13]); b.w = cvt_pk_bf16(x[14], x[15]);
    *(u32x4*)(dst + 8 * lane) = a; *(u32x4*)(dst + 512 + 8 * lane) = b;
}
__device__ __forceinline__ void store16f8(unsigned char* dst, const float (&x)[16], int lane) {
    *(u32x2*)(dst + 8 * lane) = pg8::pack8_fp8((f32x4){x[0], x[1], x[2], x[3]}, (f32x4){x[4], x[5], x[6], x[7]});
    *(u32x2*)(dst + 512 + 8 * lane) = pg8::pack8_fp8((f32x4){x[8], x[9], x[10], x[11]}, (f32x4){x[12], x[13], x[14], x[15]});
}
constexpr int HS_STRIDE = 2064;
__device__ __forceinline__ void ln1_router_phase(Frame& F, const Args& a, int layer) {
    const bf16_t* t1 = (const bf16_t*)(a.ws + WS_T1); bf16_t* hb = (bf16_t*)(a.ws + WS_HB);
    const bf16_t* wrt = (const bf16_t*)(a.ws + WS_WRT) + (size_t)layer * NEXP * DM;
    const float* g = a.in[10] + layer * DM; const float* bta = a.in[11] + layer * DM; const float* br = a.in[13] + layer * NEXP;
    int* topi = (int*)(a.ws + WS_TOPI); float* gate = (float*)(a.ws + WS_GATE); int* cnt = (int*)(a.ws + WS_CNT);
    const int lane = F.lane, w = F.wave, tid = F.tid;
    LAS unsigned char* hs = F.lds;
    LAS float* part = (LAS float*)(F.lds + 36864);
    LAS float* logit = (LAS float*)(F.lds + 36864 + 16384);
    LAS int* hist = (LAS int*)(F.lds + 36864 + 16384 + 2048);
    LAS int* topk_i = (LAS int*)(F.lds + 36864 + 16384 + 2048 + 256); LAS float* topk_v = (LAS float*)(F.lds + 36864 + 16384 + 2048 + 512);
    const int n16 = lane & 15, kg4 = lane >> 4;
    bf16x8 bw[2][4];
#pragma unroll
    for (int n = 0; n < 2; ++n)
#pragma unroll
        for (int ks = 0; ks < 4; ++ks) bw[n][ks] = *(const bf16x8*)(wrt + (size_t)(16 * n + n16) * DM + 128 * w + 32 * ks + 8 * kg4);
    for (int grp2 = F.bid; grp2 < NGRP * PM(6); grp2 += F.G) { const int grp = grp2 % NGRP;
        if (tid < 32) hist[tid] = 0;
        __syncthreads();
        for (int it = 0; it < 8; ++it) {
            const int r0 = grp * 128 + it * 16;
#pragma unroll
            for (int rr = 0; rr < 2; ++rr) { const int rl = 2 * w + rr; float x[16];
                ln_row16(t1 + (size_t)(r0 + rl) * DM, x, lane); ln_norm16(x, g, bta, lane);
                store16bf(hb + (size_t)(r0 + rl) * DM, x, lane);
                u32x4 p, q; p.x = cvt_pk_bf16(x[0], x[1]); p.y = cvt_pk_bf16(x[2], x[3]); p.z = cvt_pk_bf16(x[4], x[5]); p.w = cvt_pk_bf16(x[6], x[7]);
                q.x = cvt_pk_bf16(x[8], x[9]); q.y = cvt_pk_bf16(x[10], x[11]); q.z = cvt_pk_bf16(x[12], x[13]); q.w = cvt_pk_bf16(x[14], x[15]);
                *(LAS u32x4*)(hs + rl * HS_STRIDE + 16 * lane) = p; *(LAS u32x4*)(hs + rl * HS_STRIDE + 1024 + 16 * lane) = q; }
            __syncthreads();
            { f32x4 d0 = {0.f, 0.f, 0.f, 0.f}, d1 = {0.f, 0.f, 0.f, 0.f};
#pragma unroll
              for (int ks = 0; ks < 4; ++ks) { const bf16x8 af = *(const LAS bf16x8*)(hs + n16 * HS_STRIDE + (128 * w + 32 * ks + 8 * kg4) * 2);
                  d0 = __builtin_amdgcn_mfma_f32_16x16x32_bf16(af, bw[0][ks], d0, 0, 0, 0); d1 = __builtin_amdgcn_mfma_f32_16x16x32_bf16(af, bw[1][ks], d1, 0, 0, 0); }
#pragma unroll
              for (int r = 0; r < 4; ++r) { part[(w * 16 + 4 * kg4 + r) * 32 + n16] = d0[r]; part[(w * 16 + 4 * kg4 + r) * 32 + 16 + n16] = d1[r]; } }
            __syncthreads();
            { const int row = tid >> 5, e = tid & 31; float s = br[e];
#pragma unroll
              for (int ww = 0; ww < 8; ++ww) s += part[(ww * 16 + row) * 32 + e];
              logit[row * 32 + e] = s; }
            __syncthreads();
            { const int row = tid >> 5, e = tid & 31; const float lv = logit[row * 32 + e]; int rank = 0;
#pragma unroll
              for (int e2 = 0; e2 < 32; ++e2) { const float o = logit[row * 32 + e2]; rank += (o > lv || (o == lv && e2 < e)) ? 1 : 0; }
              if (rank < 4) { topk_i[row * 4 + rank] = e; topk_v[row * 4 + rank] = lv; } }
            __syncthreads();
            if (tid < 16) { const int tok = r0 + tid;
                const int t0 = topk_i[tid * 4 + 0], t1 = topk_i[tid * 4 + 1], t2 = topk_i[tid * 4 + 2], t3 = topk_i[tid * 4 + 3];
                const float v0 = topk_v[tid * 4 + 0];
                const float e0 = 1.f, e1 = __expf(topk_v[tid * 4 + 1] - v0), e2 = __expf(topk_v[tid * 4 + 2] - v0), e3 = __expf(topk_v[tid * 4 + 3] - v0); const float inv = 1.f / (e0 + e1 + e2 + e3);
                *(int4*)(topi + (size_t)tok * 4) = make_int4(t0, t1, t2, t3);
                *(float4*)(gate + (size_t)tok * 4) = make_float4(e0 * inv, e1 * inv, e2 * inv, e3 * inv);
                atomicAdd((int*)&hist[t0], 1); atomicAdd((int*)&hist[t1], 1); atomicAdd((int*)&hist[t2], 1); atomicAdd((int*)&hist[t3], 1); }
        }
        __syncthreads();
        if (tid < 32) cnt[grp * 32 + tid] = hist[tid];
        __syncthreads();
    }
}

__device__ __forceinline__ void moe_tables(Frame& F, const Args& a, int grp) {
    const int* cnt = (const int*)(a.ws + WS_CNT);
    LAS int* T = (LAS int*)(F.lds + TAB_OFF);
    const int tid = F.tid, e = tid & 31, j = tid >> 5;
    { int s = 0, bf = 0;
      for (int gg = j * 16; gg < j * 16 + 16; ++gg) { const int c = cnt[gg * 32 + e]; s += c; if (gg < grp) bf += c; }
      T[TB_TOT16 / 4 + j * 32 + e] = s; T[TB_BEF16 / 4 + j * 32 + e] = bf; }
    __syncthreads();
    if (tid < 32) { int s = 0, bf = 0;
#pragma unroll
        for (int jj = 0; jj < 16; ++jj) { s += T[TB_TOT16 / 4 + jj * 32 + tid]; bf += T[TB_BEF16 / 4 + jj * 32 + tid]; }
        T[TB_TOTAL / 4 + tid] = s; T[TB_BEFORE / 4 + tid] = bf; T[TB_LCUR / 4 + tid] = 0; }
    __syncthreads();
    if (tid < 32) {
        int ps = 0;
#pragma nounroll
        for (int ee = 0; ee < tid; ++ee) ps += ((T[TB_TOTAL / 4 + ee] + 255) >> 8) << 8;
        T[TB_PADST / 4 + tid] = ps; T[TB_BASE / 4 + tid] = ps + T[TB_BEFORE / 4 + tid];
        if (tid == 31) { const int end = ps + (((T[TB_TOTAL / 4 + 31] + 255) >> 8) << 8); T[TB_PADST / 4 + 32] = end; T[TB_NTL / 4] = end >> 8; } }
    __syncthreads();
    { LAS unsigned char* t2e = (LAS unsigned char*)(F.lds + TAB_OFF + TB_T2E); const int ntl = T[TB_NTL / 4];
      for (int rt = tid; rt < ntl; rt += NTHR) { int e = 0;
#pragma nounroll
          for (int ee = 1; ee < 32; ++ee) e += (T[TB_PADST / 4 + ee] <= rt * 256) ? 1 : 0;
          t2e[rt] = (unsigned char)e; } }
    __syncthreads();
}
__device__ __forceinline__ void scatter_phase(Frame& F, const Args& a) {
    const bf16_t* hb = (const bf16_t*)(a.ws + WS_HB); unsigned char* xs = (unsigned char*)(a.ws + WS_XS);
    const int* topi = (const int*)(a.ws + WS_TOPI); const float* gate = (const float*)(a.ws + WS_GATE);
    int* slot = (int*)(a.ws + WS_SLOT); float* rowg = (float*)(a.ws + WS_ROWG);
    LAS int* T = (LAS int*)(F.lds + TAB_OFF); LAS int* rows = (LAS int*)(F.lds + XTRA_OFF);
    const int tid = F.tid, lane = F.lane, w = F.wave;
    if (F.bid >= NGRP) moe_tables(F, a, -1);
    for (int grp2 = F.bid; grp2 < NGRP * PM(7); grp2 += F.G) { const int grp = grp2 % NGRP;
        moe_tables(F, a, grp);
        { const int tok = grp * 128 + (tid >> 2), k = tid & 3; const int e = topi[(size_t)tok * 4 + k];
          const int rank = atomicAdd((int*)&T[TB_LCUR / 4 + e], 1); const int row = T[TB_BASE / 4 + e] + rank;
          slot[(size_t)tok * 4 + k] = row; rowg[row] = gate[(size_t)tok * 4 + k]; rows[tid] = row; }
        __syncthreads();
        for (int i = 0; i < 16; ++i) { const int tl = w * 16 + i; const size_t tok = (size_t)grp * 128 + tl;
            float x[16]; ln_row16(hb + tok * DM, x, lane);
            const u32x2 p = pg8::pack8_fp8((f32x4){x[0], x[1], x[2], x[3]}, (f32x4){x[4], x[5], x[6], x[7]}), q = pg8::pack8_fp8((f32x4){x[8], x[9], x[10], x[11]}, (f32x4){x[12], x[13], x[14], x[15]});
#pragma unroll
            for (int k = 0; k < 4; ++k) { const size_t row = (size_t)rows[tl * 4 + k]; *(u32x2*)(xs + row * DM + 8 * lane) = p; *(u32x2*)(xs + row * DM + 512 + 8 * lane) = q; } }
        __syncthreads();
    }
}
__device__ __forceinline__ void combine_phase(Frame& F, const Args& a) {
    const bf16_t* hb = (const bf16_t*)(a.ws + WS_HB); const bf16_t* yb = (const bf16_t*)(a.ws + WS_XS); bf16_t* mid = (bf16_t*)(a.ws + WS_MIDB);
    const int* slot = (const int*)(a.ws + WS_SLOT);
    const int lane = F.lane;
    for (int tok2 = F.bid * NWAVES + F.wave; tok2 < NTOK * PM(10); tok2 += F.G * NWAVES) { const int tok = tok2 % NTOK;
        float x[16]; ln_row16(hb + (size_t)tok * DM, x, lane);
#pragma unroll
        for (int j = 0; j < 16; ++j) x[j] *= ALPHA;
        const int4 sl = *(const int4*)(slot + (size_t)tok * 4);
        const int s4[4] = {sl.x, sl.y, sl.z, sl.w};
#pragma unroll
        for (int k = 0; k < 4; ++k) {
            if (Y_FP8) { const unsigned char* yr = (const unsigned char*)yb + (size_t)s4[k] * DM;
                const u32x2 p = *(const u32x2*)(yr + 8 * lane), q = *(const u32x2*)(yr + 512 + 8 * lane);
                const unsigned w4[4] = {p.x, p.y, q.x, q.y};
#pragma unroll
                for (int i = 0; i < 4; ++i) { const f32x2 lo = __builtin_amdgcn_cvt_pk_f32_fp8((int)w4[i], false), hi2 = __builtin_amdgcn_cvt_pk_f32_fp8((int)w4[i], true);
                    x[4 * i + 0] += lo.x * 0.0625f; x[4 * i + 1] += lo.y * 0.0625f; x[4 * i + 2] += hi2.x * 0.0625f; x[4 * i + 3] += hi2.y * 0.0625f; } }
            else { float y[16]; ln_row16(yb + (size_t)s4[k] * DM, y, lane);
#pragma unroll
                for (int j = 0; j < 16; ++j) x[j] += y[j]; } }
        store16bf(mid + (size_t)tok * DM, x, lane); store16f8((unsigned char*)(a.ws + WS_MIDQ) + (size_t)tok * DM, x, lane);
    }
}
__device__ __forceinline__ void ln2_phase(Frame& F, const Args& a, int layer) {
    const bf16_t* t2 = (const bf16_t*)(a.ws + WS_T1); bf16_t* xb = (bf16_t*)(a.ws + WS_XB);
    const float* g = a.in[18] + layer * DM; const float* bta = a.in[19] + layer * DM;
    const int lane = F.lane;
    for (int tok2 = F.bid * NWAVES + F.wave; tok2 < NTOK * PM(12); tok2 += F.G * NWAVES) { const int tok = tok2 % NTOK;
        float x[16]; ln_row16(t2 + (size_t)tok * DM, x, lane); ln_norm16(x, g, bta, lane);
        if (layer == 0) { store16bf(xb + (size_t)tok * DM, x, lane); if (FP8_IN1) store16f8((unsigned char*)(a.ws + WS_XQ) + (size_t)tok * DM, x, lane); }
        else { float* o = a.out + (size_t)tok * DM;
            *(f32x4*)(o + 8 * lane) = (f32x4){x[0], x[1], x[2], x[3]}; *(f32x4*)(o + 8 * lane + 4) = (f32x4){x[4], x[5], x[6], x[7]};
            *(f32x4*)(o + 512 + 8 * lane) = (f32x4){x[8], x[9], x[10], x[11]}; *(f32x4*)(o + 512 + 8 * lane + 4) = (f32x4){x[12], x[13], x[14], x[15]}; }
    }
}

__global__ void __launch_bounds__(NTHR, 2) hybrid_fwd(Args args) {
    extern __shared__ __attribute__((aligned(16))) unsigned char lds_raw[];
    Frame F;
    F.lds = (LAS unsigned char*)lds_raw;
    F.tid = threadIdx.x; F.lane = F.tid & 63; F.wave = __builtin_amdgcn_readfirstlane(F.tid >> 6); F.G = gridDim.x; F.bid = blockIdx.x;
    volatile LAS unsigned* MISC = (volatile LAS unsigned*)(F.lds + MISC_OFF);
    for (int u = F.tid; u < 128; u += NTHR) MISC[u] = 0u;
    __syncthreads();
    XcdBarrier bar = xcd_barrier_post((unsigned*)(args.ws + WS_CTL) + 4096, MISC + 8);
    const int lo = args.ph_lo; int ph = 0; (void)lo; (void)ph;
#ifndef PHMASK
#define PHMASK 0xfffff
#endif
#ifndef PROBE_DUP
#define PROBE_DUP 0
#endif
#define SITE(k) if constexpr ((PHMASK >> (k)) & 1)
typedef const __attribute__((address_space(4))) Args* KArgs;
#define PHASE_REFRESH int t_ = threadIdx.x; asm volatile("" : "+v"(t_)); F.tid = t_; F.lane = t_ & 63; F.wave = __builtin_amdgcn_readfirstlane(t_ >> 6); \
    { int b_ = blockIdx.x; asm volatile("" : "+s"(b_)); F.bid = b_; } \
    { unsigned l_ = 0; asm volatile("" : "+s"(l_)); F.lds = (LAS unsigned char*)lds_raw + l_; } LAS unsigned char* const ring = F.lds; \
    LOAD_ARGS unsigned char* const ws = A.ws;
#if defined(__HIP_DEVICE_COMPILE__)
#define LOAD_ARGS KArgs ap_ = (KArgs)__builtin_amdgcn_kernarg_segment_ptr(); asm volatile("" : "+s"(ap_)); const Args A = *ap_;
#else
#define LOAD_ARGS const Args A = args;
#endif
#ifdef MK_LAUNCHES_PER_PHASE
#define PHASE_BEGIN if (ph == lo) { PHASE_REFRESH
#define PHASE_END   } ++ph;
#define PHASE_END_LAST } ++ph;
#else
#define PHASE_BEGIN { PHASE_REFRESH
#ifdef PROBE_BAR2
#define PHASE_END   xcd_barrier(bar); xcd_barrier(bar); }
#else
#define PHASE_END   xcd_barrier(bar); }
#endif
#define PHASE_END_LAST if (layer == 0) xcd_barrier(bar); }
#endif
    using namespace pg8;

    PHASE_BEGIN SITE(0) p0_prologue(F, A); PHASE_END

    for (int layer = 0; layer < 2; ++layer) {
        PHASE_BEGIN
        SITE(1) {
        if (layer == 0) {
            SITE(16) { DenseOrder S; S.initp(ws + (FP8_IN0 ? WS_XQ : WS_XB), ws + WS_WIN0, NTOK, ZE, FP8_IN0 ? DM : 2 * DM, F.G, F.bid, PM(1)); EpiIn0 E{(bf16_t*)(ws + WS_Z), 0.125f * LOG2E}; int p8 = FP8_IN0 ? DM : 2 * DM; asm volatile("" : "+s"(p8)); gemm_phase<EpiIn0, DenseOrder, FP8_IN0 != 0>(ring, F.tid, p8, S, E); }
            SITE(17) { PleOrder S; S.D.init(ws + WS_PB, ws + WS_WPLE, 2 * NTOK, DM, PLE, F.G, F.bid, PM(1));
              int kple = 2 * PLE; asm volatile("" : "+s"(kple));
              EpiPlain E{(bf16_t*)(ws + WS_PPLE), DM}; gemm_phase(ring, F.tid, kple, S, E); }
        } else {
            SITE(18) { DenseOrder S; S.initp(ws + (FP8_IN1 ? WS_XQ : WS_XB), ws + WS_WIN1, NTOK, ZO, FP8_IN1 ? DM : 2 * DM, F.G, F.bid, PM(1)); EpiIn1 E{(bf16_t*)(ws + WS_Z), (bf16_t*)(ws + WS_KV1), (bf16_t*)(ws + WS_KI1)}; int p8 = FP8_IN1 ? DM : 2 * DM; asm volatile("" : "+s"(p8)); gemm_phase<EpiIn1, DenseOrder, FP8_IN1 != 0>(ring, F.tid, p8, S, E); }
        }
        }
        PHASE_END
        PHASE_BEGIN
        if (layer == 0) {
            SITE(2) for (long L = F.bid; L < 1024 * PM(2); L += F.G) { const int v = (int)(L & 255), rnd = (int)((L >> 8) & 3), s = v & 3, bh = v >> 2;
                const int qb = rnd == 0 ? 15 - s : (rnd == 1 ? 8 + s : (rnd == 2 ? 7 - s : s));
                sb_unit(F, A, bh >> 3, bh & 7, qb); }
            SITE(3) for (int u = F.bid; u < PM(3) * NTOK / 128; u += F.G) gmlp_unit(F, A, u % (NTOK / 128));
        } else {
            SITE(4) for (int L = F.bid; L < PM(4) * NTOK / 8; L += F.G) { const int Lm = L % (NTOK / 8), r = Lm >> 8, cc = Lm & 255;
                const int j = (r & 1) ? 511 - cc : cc; dsa_select_unit(F, A, (r >> 1) * 512 + j); }
        }
        PHASE_END
        if (layer == 1) {
        PHASE_BEGIN
            SITE(13) for (int L = F.bid; L < 1024 * PM(13); L += F.G) { const int idx = L & 1023, pp = idx & 31, g = (idx >> 5) & 3, b = idx >> 7;
                dsa_attn_unit(F, A, b, 63 - pp, g); dsa_attn_unit(F, A, b, pp, g); }
        PHASE_END
        }
        PHASE_BEGIN
        SITE(5) { DenseOrder S; S.initp(ws + WS_CAT, ws + (layer == 0 ? WS_WO0 : WS_WO1), NTOK, DM, FP8_OUT ? DM : 2 * DM, F.G, F.bid, PM(5));
          EpiOut E{layer == 0 ? A.in[0] : nullptr, (const bf16_t*)(ws + WS_XB), (bf16_t*)(ws + WS_T1)}; int p8 = FP8_OUT ? DM : 2 * DM; asm volatile("" : "+s"(p8)); gemm_phase<EpiOut, DenseOrder, FP8_OUT != 0>(ring, F.tid, p8, S, E); }
        PHASE_END
        PHASE_BEGIN SITE(6) ln1_router_phase(F, A, layer); PHASE_END
        PHASE_BEGIN SITE(7) scatter_phase(F, A); PHASE_END
        PHASE_BEGIN
        SITE(8) {
#ifdef MK_LAUNCHES_PER_PHASE
          moe_tables(F, A, -1);
#endif
          const int ntl = __builtin_amdgcn_readfirstlane(((LAS int*)(F.lds + TAB_OFF))[TB_NTL / 4]);
          MoeOrder<8, true> S; S.nunits = ntl * 8; S.G = F.G; S.c = F.bid; S.rep = PM(8); S.t2e = (const LAS unsigned char*)(F.lds + TAB_OFF + TB_T2E);
          S.A = (const char*)(ws + WS_XS); S.W = (const char*)(ws + WS_WGU) + (size_t)layer * 32 * 2048 * DM;
          EpiSwiglu E{(unsigned char*)(ws + WS_ACT), A.in[15] + (size_t)layer * 32 * 2048}; int p8 = DM; asm volatile("" : "+s"(p8)); gemm_phase<EpiSwiglu, MoeOrder<8, true>, true, MOE_ALIGN>(ring, F.tid, p8, S, E); }
        PHASE_END
        PHASE_BEGIN
        SITE(9) {
#ifdef MK_LAUNCHES_PER_PHASE
          moe_tables(F, A, -1);
#endif
          const int ntl = __builtin_amdgcn_readfirstlane(((LAS int*)(F.lds + TAB_OFF))[TB_NTL / 4]);
          MoeOrder<4, false> S; S.nunits = ntl * 4; S.G = F.G; S.c = F.bid; S.rep = PM(9); S.t2e = (const LAS unsigned char*)(F.lds + TAB_OFF + TB_T2E);
          S.A = (const char*)(ws + WS_ACT); S.W = (const char*)(ws + WS_WD) + (size_t)layer * 32 * DM * DM;
          EpiDown E{(bf16_t*)(ws + WS_XS), A.in[17] + (size_t)layer * 32 * DM, (const float*)(ws + WS_ROWG)}; int p8 = DM; asm volatile("" : "+s"(p8)); gemm_phase<EpiDown, MoeOrder<4, false>, true, MOE_ALIGN>(ring, F.tid, p8, S, E); }
        PHASE_END
        PHASE_BEGIN SITE(10) combine_phase(F, A); PHASE_END
        PHASE_BEGIN
        SITE(11) { DenseOrder S; S.initp(ws + (FP8_GATE ? WS_MIDQ : WS_MIDB), ws + WS_WG + (size_t)layer * DM * DM * (FP8_GATE ? 1 : 2), NTOK, DM, FP8_GATE ? DM : 2 * DM, F.G, F.bid, PM(11));
          EpiGate E{(const bf16_t*)(ws + WS_MIDB), (const bf16_t*)(ws + WS_PPLE) + (size_t)layer * NTOK * DM, A.in[22] + layer * DM, (bf16_t*)(ws + WS_T1)}; int p8 = FP8_GATE ? DM : 2 * DM; asm volatile("" : "+s"(p8)); gemm_phase<EpiGate, DenseOrder, FP8_GATE != 0>(ring, F.tid, p8, S, E); }
        PHASE_END
        PHASE_BEGIN SITE(12) ln2_phase(F, A, layer); PHASE_END_LAST
    }
#undef PHASE_BEGIN
#undef PHASE_END
#undef PHASE_END_LAST
}
constexpr int N_PHASES = 22;

extern "C" void kernel_launch(void* const* d_in, const int* in_sizes, int n_in, void* d_out, int out_size, void* d_ws, size_t ws_size, hipStream_t stream) {
    static int grid = 0;
    if (grid == 0) {
        if (n_in != 23 || out_size != NTOK * DM || ws_size < WS_END) { fprintf(stderr, "kernel_launch: unexpected problem: n_in %d out %d ws %zu (need %zu)\n", n_in, out_size, ws_size, (size_t)WS_END); grid = -1; return; }
        int dev = 0, cus = 0, per_cu = 0;
        if (hipGetDevice(&dev) != hipSuccess || hipDeviceGetAttribute(&cus, hipDeviceAttributeMultiprocessorCount, dev) != hipSuccess) { grid = -1; return; }
        if (hipFuncSetAttribute((const void*)hybrid_fwd, hipFuncAttributeMaxDynamicSharedMemorySize, LDS_BYTES) != hipSuccess) { fprintf(stderr, "kernel_launch: hipFuncSetAttribute failed\n"); grid = -1; return; }
        if (hipOccupancyMaxActiveBlocksPerMultiprocessor(&per_cu, (const void*)hybrid_fwd, NTHR, LDS_BYTES) != hipSuccess || per_cu < 1) fprintf(stderr, "kernel_launch: occupancy query says %d\n", per_cu);
        (void)hipGetLastError();
        grid = cus;
    }
    if (grid < 0) return;
    (void)hipMemsetAsync((char*)d_ws + WS_CTL, 0, CTL_ZERO_BYTES, stream);
    Args a{};
    for (int i = 0; i < 23; ++i) a.in[i] = (const float*)d_in[i];
    a.out = (float*)d_out; a.ws = (unsigned char*)d_ws;
#ifndef MK_LAUNCHES_PER_PHASE
    a.ph_lo = 0; a.ph_hi = N_PHASES;
    hipLaunchKernelGGL(hybrid_fwd, dim3(grid), dim3(NTHR), LDS_BYTES, stream, a);
#else
    for (int p = 0; p < N_PHASES; ++p) { a.ph_lo = p; a.ph_hi = p + 1; hipLaunchKernelGGL(hybrid_fwd, dim3(grid), dim3(NTHR), LDS_BYTES, stream, a); }
#endif
}
```

```cpp
#include <hip/hip_runtime.h>
#include <cstdio>
#include <cstdint>

#define LAS __attribute__((address_space(3)))
#define GAS __attribute__((address_space(1)))
typedef unsigned short bf16_t;
typedef short bf16x8 __attribute__((ext_vector_type(8)));
typedef short s16x4 __attribute__((ext_vector_type(4)));
typedef float f32x2 __attribute__((ext_vector_type(2)));
typedef float f32x4 __attribute__((ext_vector_type(4)));
typedef float f32x16 __attribute__((ext_vector_type(16)));
typedef unsigned u32x2 __attribute__((ext_vector_type(2)));
typedef unsigned u32x4 __attribute__((ext_vector_type(4)));

constexpr int DM = 1024, NB = 8, SEQ = 4096, NTOK = NB * SEQ;
constexpr int ZE = 2560;
constexpr int ZO = 2304, ZO_REAL = 2120;
constexpr int OQ = 0, OK_ = 1024, OV = 1280, OQI = 1536, OKI = 2048, OWI = 2112;
constexpr int NEXP = 32, PLE = 256;
constexpr int NGRP = NTOK / 128;
constexpr int MAXTILES = NTOK * 4 / 256 + NEXP;
constexpr int MAXROWS = MAXTILES * 256;
constexpr float LN_EPS = 1e-5f;
constexpr float ALPHA = 1.4142135623730951f;
constexpr float LOG2E = 1.4426950408889634f;
constexpr float WSC = 64.f, WSC_INV = 1.f / 64.f;

#ifndef FP8_IN0
#define FP8_IN0 1
#endif
#ifndef Y_FP8
#define Y_FP8 1
#endif
#ifndef MOE_ALIGN
#define MOE_ALIGN true
#endif
#ifndef FP8_IN1
#define FP8_IN1 0
#endif
#ifndef FP8_OUT
#define FP8_OUT 1
#endif
#ifndef FP8_GATE
#define FP8_GATE 1
#endif
#ifndef PROBE_DUP
#define PROBE_DUP 0
#endif
#define PM(k) (((PROBE_DUP >> (k)) & 1) ? 2 : 1)

constexpr size_t MiB = 1u << 20;
constexpr size_t WS_CTL = 0, CTL_ZERO_BYTES = 1 * MiB;
constexpr size_t WS_WRT = 1 * MiB;
constexpr size_t WS_WSB = WS_WRT + 256 * 1024;
constexpr size_t WS_CNT = WS_WSB + 256 * 1024;
constexpr size_t WS_TOPI = 2 * MiB;
constexpr size_t WS_GATE = WS_TOPI + 512 * 1024;
constexpr size_t WS_SLOT = 3 * MiB;
constexpr size_t WS_ROWG = WS_SLOT + 512 * 1024;
constexpr size_t WS_WIN0 = 8 * MiB, WS_WO0 = 13 * MiB, WS_WIN1 = 15 * MiB, WS_WO1 = 20 * MiB, WS_WG = 22 * MiB, WS_WPLE = 26 * MiB;
constexpr size_t WS_WGU = 32 * MiB, WS_WD = 288 * MiB;
constexpr size_t WS_XB = 416 * MiB, WS_PB = 480 * MiB, WS_PPLE = 512 * MiB, WS_Z = 640 * MiB, WS_CAT = 800 * MiB, WS_T1 = 864 * MiB;
constexpr size_t WS_BM = 1328 * MiB;
constexpr size_t WS_KV1 = WS_BM + 16 * MiB;
constexpr size_t WS_KI1 = WS_KV1 + 32 * MiB;
constexpr size_t WS_HB = 928 * MiB, WS_MIDB = 992 * MiB, WS_XS = 1056 * MiB, WS_ACT = 1328 * MiB;
constexpr size_t WS_XQ = 1600 * MiB, WS_MIDQ = 1632 * MiB, WS_END = 1664 * MiB;
static_assert(WS_ROWG + (size_t)MAXROWS * 4 <= WS_WIN0, "small buffers");
static_assert(WS_XS + (size_t)MAXROWS * DM * 2 <= WS_ACT && WS_ACT + (size_t)MAXROWS * DM * 2 <= WS_END, "moe buffers");

constexpr int RING_BYTES = 131072;
constexpr int MISC_OFF = RING_BYTES;
constexpr int TAB_OFF = MISC_OFF + 512;
constexpr int XTRA_OFF = TAB_OFF + 6144;
constexpr int LDS_BYTES = 147456;
static_assert(XTRA_OFF + 8192 <= LDS_BYTES, "LDS map");
constexpr int TB_TOT16 = 0, TB_BEF16 = 2048, TB_TOTAL = 4096, TB_BEFORE = 4224, TB_PADST = 4352  , TB_NTL = 4488, TB_LCUR = 4608  , TB_BASE = 4736  , TB_T2E = 5120  ;
static_assert(TB_T2E + 544 <= 6144, "tab");

#define RLX_AGENT __ATOMIC_RELAXED, __HIP_MEMORY_SCOPE_AGENT
typedef __bf16 bf16x2_t __attribute__((ext_vector_type(2)));
__device__ __forceinline__ unsigned cvt_pk_bf16(float lo, float hi) { const f32x2 v = {lo, hi}; const bf16x2_t b = __builtin_convertvector(v, bf16x2_t); return __builtin_bit_cast(unsigned, b); }
__device__ __forceinline__ unsigned char f8_1(float v) { return (unsigned char)(__builtin_amdgcn_cvt_pk_fp8_f32(v, v, 0, false) & 0xff); }
#if FP8_OUT
#define CAT_ST(cat, idx, v) ((cat)[idx] = f8_1(v))
#else
#define CAT_ST(cat, idx, v) (((bf16_t*)(cat))[idx] = (bf16_t)(cvt_pk_bf16((v), 0.f) & 0xffffu))
#endif
__device__ __forceinline__ float bf_lo(unsigned u) { return __uint_as_float(u << 16); }
__device__ __forceinline__ float bf_hi(unsigned u) { return __uint_as_float(u & 0xffff0000u); }
__device__ __forceinline__ float bf1(bf16_t u) { return __uint_as_float(((unsigned)u) << 16); }
template <int K> __device__ __forceinline__ int sxi(int v) {
    if constexpr (K == 32) { const auto rr = __builtin_amdgcn_permlane32_swap((unsigned)v, (unsigned)v, false, false); return (int)(rr[0] ^ rr[1] ^ (unsigned)v); }
    else return __builtin_amdgcn_ds_swizzle(v, (K << 10) | 0x1f);
}
template <int K> __device__ __forceinline__ float sxf(float v) { return __int_as_float(sxi<K>(__float_as_int(v))); }
__device__ __forceinline__ float wave_sum(float x) {
    int v = __float_as_int(x);
#define WSF_STEP(ctrl, rm) { const int o = __builtin_amdgcn_update_dpp(0, v, ctrl, rm, 0xf, false); v = __float_as_int(__int_as_float(v) + __int_as_float(o)); }
    WSF_STEP(0x111, 0xf) WSF_STEP(0x112, 0xf) WSF_STEP(0x114, 0xf) WSF_STEP(0x118, 0xf) WSF_STEP(0x142, 0xa) WSF_STEP(0x143, 0xc)
#undef WSF_STEP
    return __int_as_float(__builtin_amdgcn_readlane(v, 63));
}
__device__ __forceinline__ float wave_max(float v) {
    v = fmaxf(v, sxf<1>(v)); v = fmaxf(v, sxf<2>(v)); v = fmaxf(v, sxf<4>(v)); v = fmaxf(v, sxf<8>(v)); v = fmaxf(v, sxf<16>(v)); v = fmaxf(v, sxf<32>(v));
    return v;
}
__device__ __forceinline__ float wave_min(float v) {
    v = fminf(v, sxf<1>(v)); v = fminf(v, sxf<2>(v)); v = fminf(v, sxf<4>(v)); v = fminf(v, sxf<8>(v)); v = fminf(v, sxf<16>(v)); v = fminf(v, sxf<32>(v));
    return v;
}
__device__ __forceinline__ int wave_sumi(int v) {
    v += sxi<1>(v); v += sxi<2>(v); v += sxi<4>(v); v += sxi<8>(v); v += sxi<16>(v); v += sxi<32>(v);
    return v;
}
__device__ __forceinline__ int wave_sum_uniform(int v) {
    v += __builtin_amdgcn_update_dpp(0, v, 0x111, 0xf, 0xf, false);
    v += __builtin_amdgcn_update_dpp(0, v, 0x112, 0xf, 0xf, false);
    v += __builtin_amdgcn_update_dpp(0, v, 0x114, 0xf, 0xf, false);
    v += __builtin_amdgcn_update_dpp(0, v, 0x118, 0xf, 0xf, false);
    v += __builtin_amdgcn_update_dpp(0, v, 0x142, 0xa, 0xf, false);
    v += __builtin_amdgcn_update_dpp(0, v, 0x143, 0xc, 0xf, false);
    return __builtin_amdgcn_readlane(v, 63);
}
__device__ __forceinline__ float wave_max_uniform(float x) {
    int v = __float_as_int(x);
#define WMX_STEP(ctrl, rm) { const int o = __builtin_amdgcn_update_dpp(v, v, ctrl, rm, 0xf, false); v = __float_as_int(fmaxf(__int_as_float(v), __int_as_float(o))); }
    WMX_STEP(0x111, 0xf) WMX_STEP(0x112, 0xf) WMX_STEP(0x114, 0xf) WMX_STEP(0x118, 0xf) WMX_STEP(0x142, 0xa) WMX_STEP(0x143, 0xc)
#undef WMX_STEP
    return __int_as_float(__builtin_amdgcn_readlane(v, 63));
}
__device__ __forceinline__ float relu_i(float x) { const int i = __float_as_int(x); return __int_as_float(i > 0 ? i : 0); }
__device__ __forceinline__ float ex2(float x) { return __builtin_amdgcn_exp2f(x); }
__device__ __forceinline__ float lg2(float x) { return __builtin_amdgcn_logf(x); }
__device__ __forceinline__ float rcpf_(float x) { return __builtin_amdgcn_rcpf(x); }
__device__ __forceinline__ float sigmoidf_(float x) { return rcpf_(1.f + ex2(-LOG2E * x)); }
__device__ __forceinline__ float gelu_tanh(float x) { return x * rcpf_(1.f + ex2(-2.302208198f * (x + 0.044715f * x * x * x))); }

namespace pg8 {
constexpr int BM = 256, BK = 64, HALF = 128, HTB = HALF * BK * 2, STAGE_BYTES = 8 * HTB, NXCD = 8, WGM = 8;
__host__ __device__ __forceinline__ int lds_byte(int r, int c) { const int st = (r >> 4) * 2 + (c >> 5), rr = r & 15, cc = c & 31, ob = rr * 64 + cc * 2; return st * 1024 + (ob ^ (((ob >> 9) & 1) << 5)); }
__host__ __device__ __forceinline__ void stage_rc(int b, int& R, int& C) { const int st = b / 1024, sb = b % 1024, swz = sb ^ (((sb >> 9) & 1) << 5); R = (st >> 1) * 16 + swz / 64; C = (st & 1) * 32 + (swz % 64) / 2; }
__host__ __device__ __forceinline__ int perm32(int rho) { const int n = rho >> 4, i = rho & 15; return 8 * (i >> 2) + 4 * n + (i & 3); }

struct Unit { int pm, pn, e; const char* b0; };
typedef int v8i_t __attribute__((ext_vector_type(8)));
typedef int v4i_t __attribute__((ext_vector_type(4)));
__device__ __forceinline__ v8i_t cat8(const bf16x8 a, const bf16x8 b) { const v4i_t x = __builtin_bit_cast(v4i_t, a), y = __builtin_bit_cast(v4i_t, b); return __builtin_shufflevector(x, y, 0, 1, 2, 3, 4, 5, 6, 7); }

struct DenseOrder {
    int nM, nN, nwg, G, c, rep; const char* A; const char* B; size_t tstep, hstep;
    __device__ __forceinline__ void init(const void* A_, const void* B_, int M, int N, int K, int G_, int c_, int rep_ = 1) { initp(A_, B_, M, N, 2 * K, G_, c_, rep_); }
    __device__ __forceinline__ void initp(const void* A_, const void* B_, int M, int N, int pitch, int G_, int c_, int rep_ = 1) { A = (const char*)A_; B = (const char*)B_; nM = M / BM; nN = N / BM; nwg = nM * nN; G = G_; c = c_; rep = rep_; hstep = (size_t)HALF * pitch; tstep = 2 * hstep; }
    __device__ __forceinline__ bool next(int i, Unit& u) const {
        long L = (long)i * G + c; if (L >= (long)nwg * rep) return false; if (L >= nwg) L -= nwg;
        int wgid = (int)L; { const int q = nwg / NXCD, r = nwg % NXCD, xcd = wgid % NXCD, off = wgid / NXCD; wgid = (xcd < r ? xcd * (q + 1) : r * (q + 1) + (xcd - r) * q) + off; }
        const int nig = WGM * nN, gid = wgid / nig, fm = gid * WGM, gsz = (nM - fm) < WGM ? (nM - fm) : WGM;
        u.pm = fm + ((wgid % nig) % gsz); u.pn = (wgid % nig) / gsz; u.e = 0;
        u.b0 = B + (size_t)u.pn * tstep; return true;
    }
    __device__ __forceinline__ const char* aptr(const Unit& u) const { return A + (size_t)u.pm * tstep; }
    __device__ __forceinline__ size_t b1off() const { return hstep; }
};
struct PleOrder {
    DenseOrder D;
    __device__ __forceinline__ bool next(int i, Unit& u) const { if (!D.next(i, u)) return false; if (u.pm >= 32768 / BM) u.b0 += (size_t)1024 * 256 * 2; return true; }
    __device__ __forceinline__ const char* aptr(const Unit& u) const { return D.aptr(u); }
    __device__ __forceinline__ size_t b1off() const { return D.b1off(); }
};
template <int NT, bool SWIGLU>
struct MoeOrder {
    int nunits, G, c, rep; const LAS unsigned char* t2e; const char* A; const char* W;
    static constexpr size_t hstep = (size_t)HALF * 1024, tstep = 2 * hstep;
    __device__ __forceinline__ bool next(int i, Unit& u) const {
        const int vc = ((G & 7) == 0) ? (c & 7) * (G >> 3) + (c >> 3) : c;
        int L = i * G + vc; if (L >= nunits * rep) return false; if (L >= nunits) L -= nunits;
        const int rt = L / NT, pn = L % NT;
        const int e = __builtin_amdgcn_readfirstlane((int)t2e[rt]);
        u.pm = rt; u.pn = pn; u.e = e;
        if (SWIGLU) u.b0 = W + (size_t)e * (16 * hstep) + (size_t)pn * hstep;
        else u.b0 = W + (size_t)e * (8 * hstep) + (size_t)pn * tstep;
        return true;
    }
    __device__ __forceinline__ const char* aptr(const Unit& u) const { return A + (size_t)u.pm * tstep; }
    __device__ __forceinline__ size_t b1off() const { return SWIGLU ? 8 * hstep : hstep; }
};

template <class Epi, class Sched, bool FP8 = false, bool ALIGN_EPI = true>
__device__ __forceinline__ void gemm_phase(LAS unsigned char* lds, const int tid, const int pitch, const Sched& S, const Epi& E) {
    const int wid = __builtin_amdgcn_readfirstlane(tid >> 6), lane = tid & 63, wr = wid >> 2, wc = wid & 3, fr = lane & 15, fq = lane >> 4;
    const int nt = pitch / (BK * 2);
    unsigned voffA[2], voffB[2];
#pragma unroll
    for (int i = 0; i < 2; ++i) { int R, C; stage_rc(tid * 16 + i * 8192, R, C); const int Rb = (R & ~31) + perm32(R & 31);
        voffA[i] = (unsigned)(R * pitch + C * 2); voffB[i] = (unsigned)(Rb * pitch + C * 2); }
    const size_t kstep = (size_t)(BK * 2);
    const size_t hstep = (size_t)HALF * pitch;
    const unsigned ldsw = (unsigned)wid * 1024u;
    int sc127 = 127; asm volatile("" : "+v"(sc127));
    const unsigned ldsu = (unsigned)__builtin_amdgcn_readfirstlane((int)(unsigned)(uintptr_t)lds) + ldsw;
    const int aoff = lds_byte(wr * 64 + fr, fq * 8), boff = lds_byte(wc * 32 + fr, fq * 8);
#define PG8_SA(b, h) (((b) * 2 + (h)) * HTB)
#define PG8_SB(b, h) ((4 + (b) * 2 + (h)) * HTB)
#define PG8_STAGE(bufoff, gbase, voff) do { _Pragma("unroll") for (int _i = 0; _i < 2; ++_i) { unsigned _keep; \
        asm volatile("s_mov_b32 %0, m0\n\ts_mov_b32 m0, %3\n\ts_nop 0\n\tglobal_load_lds_dwordx4 %1, %2\n\ts_mov_b32 m0, %0" : "=&s"(_keep) : "v"((voff)[_i]), "s"((const char*)(gbase)), "s"(ldsu + (unsigned)((bufoff) + _i * 8192)) : "memory"); } } while (0)
#define PG8_LDA(dst, b, h) do { _Pragma("unroll") for (int m = 0; m < 4; ++m) _Pragma("unroll") for (int k = 0; k < 2; ++k) dst[m][k] = *(const LAS bf16x8*)(lds + PG8_SA(b, h) + aoff + m * 2048 + k * 1024); } while (0)
#define PG8_LDB(dst, b, h) do { _Pragma("unroll") for (int n = 0; n < 2; ++n) _Pragma("unroll") for (int k = 0; k < 2; ++k) dst[n][k] = *(const LAS bf16x8*)(lds + PG8_SB(b, h) + boff + n * 2048 + k * 1024); } while (0)
#define PG8_MMA(ai, bj, At, Bt) do { __builtin_amdgcn_s_setprio(1); _Pragma("unroll") for (int m = 0; m < 4; ++m) _Pragma("unroll") for (int n = 0; n < 2; ++n) { \
        if constexpr (FP8) { const v8i_t _a = cat8(Bt[n][0], Bt[n][1]), _b = cat8(At[m][0], At[m][1]); \
            asm volatile("v_mfma_scale_f32_16x16x128_f8f6f4 %0, %1, %2, %0, %3, %3 op_sel_hi:[0,0,0]" : "+v"(acc[ai][bj][m][n]) : "v"(_a), "v"(_b), "v"(sc127)); } \
        else { _Pragma("unroll") for (int k = 0; k < 2; ++k) acc[ai][bj][m][n] = __builtin_amdgcn_mfma_f32_16x16x32_bf16(Bt[n][k], At[m][k], acc[ai][bj][m][n], 0, 0, 0); } } __builtin_amdgcn_s_setprio(0); } while (0)
#define PG8_WAIT_V(n) asm volatile("s_waitcnt vmcnt(" #n ")" ::: "memory")
#define PG8_WAIT_L(n) asm volatile("s_waitcnt lgkmcnt(" #n ")" ::: "memory")
#define PG8_BAR __builtin_amdgcn_s_barrier()
#define PG8_SCHED __builtin_amdgcn_sched_barrier(0)
    Unit cur, nxt; int ui = 0;
    if (!S.next(0, cur)) return;
    f32x4 acc[2][2][4][2];
#pragma unroll
    for (int a = 0; a < 2; ++a)
#pragma unroll
        for (int b = 0; b < 2; ++b)
#pragma unroll
            for (int m = 0; m < 4; ++m)
#pragma unroll
                for (int n = 0; n < 2; ++n) acc[a][b][m][n] = (f32x4){0.f, 0.f, 0.f, 0.f};
    bf16x8 At[4][2], B0[2][2], B1[2][2];
    const char* cA = S.aptr(cur); const char* cB0 = cur.b0; const char* cB1 = cB0 + S.b1off();
    PG8_STAGE(PG8_SB(0, 0), cB0, voffB); PG8_STAGE(PG8_SB(0, 1), cB1, voffB); PG8_STAGE(PG8_SA(0, 0), cA, voffA); PG8_STAGE(PG8_SA(0, 1), cA + hstep, voffA);
    if (wr == 1) PG8_BAR;
    PG8_WAIT_V(2); PG8_BAR;
    PG8_STAGE(PG8_SB(1, 0), cB0 + kstep, voffB); PG8_STAGE(PG8_SA(1, 0), cA + kstep, voffA); PG8_STAGE(PG8_SB(1, 1), cB1 + kstep, voffB);
    PG8_WAIT_V(6); PG8_BAR;
    for (;;) {
        const bool has_next = S.next(ui + 1, nxt);
        const char* nA = has_next ? S.aptr(nxt) : cA; const char* nB0 = has_next ? nxt.b0 : cB0; const char* nB1 = nB0 + S.b1off();
        for (int t = 0; t < nt; t += 2) {
            const bool last = (t == nt - 2);
            const char* a1 = cA + (size_t)(t + 1) * kstep;
            const char* a2 = last ? nA : cA + (size_t)(t + 2) * kstep;
            const char* b20 = last ? nB0 : cB0 + (size_t)(t + 2) * kstep; const char* b21 = last ? nB1 : cB1 + (size_t)(t + 2) * kstep;
            const char* a3 = a2 + kstep; const char* b30 = b20 + kstep; const char* b31 = b21 + kstep;
            PG8_LDB(B0, 0, 0); PG8_LDB(B1, 0, 1); PG8_SCHED; PG8_LDA(At, 0, 0); PG8_STAGE(PG8_SA(1, 1), a1 + hstep, voffA);
            PG8_WAIT_V(8); PG8_WAIT_L(0); PG8_BAR; PG8_MMA(0, 0, At, B0); PG8_MMA(0, 1, At, B1); PG8_BAR; PG8_SCHED;
            PG8_LDA(At, 0, 1); PG8_STAGE(PG8_SB(0, 0), b20, voffB); PG8_STAGE(PG8_SB(0, 1), b21, voffB); PG8_STAGE(PG8_SA(0, 0), a2, voffA);
            PG8_WAIT_V(8); PG8_WAIT_L(0); PG8_BAR; PG8_MMA(1, 0, At, B0); PG8_MMA(1, 1, At, B1); PG8_BAR; PG8_SCHED;
            PG8_LDB(B0, 1, 0); PG8_LDB(B1, 1, 1); PG8_SCHED; PG8_LDA(At, 1, 0); PG8_STAGE(PG8_SA(0, 1), a2 + hstep, voffA);
            PG8_WAIT_V(8); PG8_WAIT_L(0); PG8_BAR; PG8_MMA(0, 0, At, B0); PG8_MMA(0, 1, At, B1); PG8_BAR; PG8_SCHED;
            PG8_LDA(At, 1, 1); PG8_STAGE(PG8_SB(1, 0), b30, voffB); PG8_STAGE(PG8_SB(1, 1), b31, voffB); PG8_STAGE(PG8_SA(1, 0), a3, voffA);
            PG8_WAIT_V(8); PG8_WAIT_L(0); PG8_BAR; PG8_MMA(1, 0, At, B0); PG8_MMA(1, 1, At, B1); PG8_BAR; PG8_SCHED;
        }
        if constexpr (ALIGN_EPI) { if (wr == 0) PG8_BAR; }
        E(acc, cur, wr, wc, fr, fq);
        if (!has_next) break;
#pragma unroll
        for (int a = 0; a < 2; ++a)
#pragma unroll
            for (int b = 0; b < 2; ++b)
#pragma unroll
                for (int m = 0; m < 4; ++m)
#pragma unroll
                    for (int n = 0; n < 2; ++n) acc[a][b][m][n] = (f32x4){0.f, 0.f, 0.f, 0.f};
        cur = nxt; cA = nA; cB0 = nB0; cB1 = nB1; ++ui;
        if constexpr (ALIGN_EPI) { if (wr == 1) PG8_BAR; }
    }
    PG8_WAIT_V(0);
    if constexpr (!ALIGN_EPI) { if (wr == 0) PG8_BAR; }
    PG8_BAR;
#undef PG8_SA
#undef PG8_SB
#undef PG8_STAGE
#undef PG8_LDA
#undef PG8_LDB
#undef PG8_MMA
#undef PG8_WAIT_V
#undef PG8_WAIT_L
#undef PG8_BAR
#undef PG8_SCHED
}

#define EPI_ROWS_BEGIN const int row0 = u.pm * BM + wr * 64 + fr; const int cl = wc * 32 + 8 * fq;
__device__ __forceinline__ void store8(bf16_t* p, const f32x4 v0, const f32x4 v1) {
    u32x4 w; w.x = cvt_pk_bf16(v0[0], v0[1]); w.y = cvt_pk_bf16(v0[2], v0[3]); w.z = cvt_pk_bf16(v1[0], v1[1]); w.w = cvt_pk_bf16(v1[2], v1[3]); *(u32x4*)p = w;
}
__device__ __forceinline__ u32x2 pack8_fp8(const f32x4 v0, const f32x4 v1) {
    int a = 0, b = 0; a = __builtin_amdgcn_cvt_pk_fp8_f32(v0[0], v0[1], a, false); a = __builtin_amdgcn_cvt_pk_fp8_f32(v0[2], v0[3], a, true);
    b = __builtin_amdgcn_cvt_pk_fp8_f32(v1[0], v1[1], b, false); b = __builtin_amdgcn_cvt_pk_fp8_f32(v1[2], v1[3], b, true); return (u32x2){(unsigned)a, (unsigned)b};
}
__device__ __forceinline__ void store8_fp8(unsigned char* p, const f32x4 v0, const f32x4 v1) { *(u32x2*)p = pack8_fp8(v0, v1); }
__device__ __forceinline__ void load8bf(const bf16_t* p, f32x4& v0, f32x4& v1) {
    const u32x4 w = *(const u32x4*)p; v0 = (f32x4){bf_lo(w.x), bf_hi(w.x), bf_lo(w.y), bf_hi(w.y)}; v1 = (f32x4){bf_lo(w.z), bf_hi(w.z), bf_lo(w.w), bf_hi(w.w)};
}
struct EpiPlain {
    bf16_t* O; int ldc;
    __device__ __forceinline__ void operator()(const f32x4 (&acc)[2][2][4][2], const Unit& u, int wr, int wc, int fr, int fq) const {
        EPI_ROWS_BEGIN
#pragma unroll
        for (int ai = 0; ai < 2; ++ai)
#pragma unroll
            for (int m = 0; m < 4; ++m) { bf16_t* rowp = O + (unsigned)((row0 + ai * HALF + m * 16) * ldc + u.pn * BM + cl);
#pragma unroll
                for (int bj = 0; bj < 2; ++bj) store8(rowp + bj * HALF, acc[ai][bj][m][0], acc[ai][bj][m][1]); asm volatile("" ::: "memory"); }
    }
};
struct EpiIn0 {
    static constexpr float WSI = FP8_IN0 ? WSC_INV : 1.f;
    bf16_t* O; float qscale;
    __device__ __forceinline__ void operator()(const f32x4 (&acc)[2][2][4][2], const Unit& u, int wr, int wc, int fr, int fq) const {
        EPI_ROWS_BEGIN
        if (u.pn < 4) {
#pragma unroll
            for (int ai = 0; ai < 2; ++ai)
#pragma unroll
                for (int m = 0; m < 4; ++m) { bf16_t* rowp = O + (unsigned)((row0 + ai * HALF + m * 16) * ZE + u.pn * BM + cl);
#pragma unroll
                    for (int bj = 0; bj < 2; ++bj) { f32x4 v0 = acc[ai][bj][m][0] * WSI, v1 = acc[ai][bj][m][1] * WSI;
#pragma unroll
                        for (int j = 0; j < 4; ++j) { v0[j] = gelu_tanh(v0[j]); v1[j] = gelu_tanh(v1[j]); }
                        store8(rowp + bj * HALF, v0, v1); asm volatile("" ::: "memory"); } }
        } else {
            const float sc = (u.pn < 6 ? qscale : 1.f) * WSI;
#pragma unroll
            for (int ai = 0; ai < 2; ++ai)
#pragma unroll
                for (int m = 0; m < 4; ++m) { bf16_t* rowp = O + (unsigned)((row0 + ai * HALF + m * 16) * ZE + u.pn * BM + cl);
#pragma unroll
                    for (int bj = 0; bj < 2; ++bj) store8(rowp + bj * HALF, acc[ai][bj][m][0] * sc, acc[ai][bj][m][1] * sc);
                    asm volatile("" ::: "memory"); }
        }
    }
};
struct EpiIn1 {
    static constexpr float WSI = FP8_IN1 ? WSC_INV : 1.f;
    bf16_t* O; bf16_t* KV; bf16_t* KI;
    __device__ __forceinline__ void operator()(const f32x4 (&acc)[2][2][4][2], const Unit& u, int wr, int wc, int fr, int fq) const {
        EPI_ROWS_BEGIN
        if (u.pn == 4 || u.pn == 5) {
            bf16_t* base = KV + (u.pn - 4) * 256 + cl;
#pragma unroll
            for (int ai = 0; ai < 2; ++ai)
#pragma unroll
                for (int m = 0; m < 4; ++m) { bf16_t* rowp = base + (unsigned)((row0 + ai * HALF + m * 16) * 512);
#pragma unroll
                    for (int bj = 0; bj < 2; ++bj) store8(rowp + bj * HALF, acc[ai][bj][m][0] * WSI, acc[ai][bj][m][1] * WSI);
                    asm volatile("" ::: "memory"); }
        } else {
            const float sc = (u.pn < 4 ? 0.125f * LOG2E : 1.f) * WSI;
#pragma unroll
            for (int ai = 0; ai < 2; ++ai)
#pragma unroll
                for (int m = 0; m < 4; ++m) { bf16_t* rowp = O + (unsigned)((row0 + ai * HALF + m * 16) * ZO + u.pn * BM + cl);
#pragma unroll
                    for (int bj = 0; bj < 2; ++bj) store8(rowp + bj * HALF, acc[ai][bj][m][0] * sc, acc[ai][bj][m][1] * sc);
                    asm volatile("" ::: "memory"); }
            if (u.pn == 8 && wc < 2) {
#pragma unroll
                for (int ai = 0; ai < 2; ++ai)
#pragma unroll
                    for (int m = 0; m < 4; ++m) { const int row = row0 + ai * HALF + m * 16;
                        store8(KI + (unsigned)(((((row >> 5) * 4 + (cl >> 4)) * 64) + (((cl >> 3) & 1) * 32 + (row & 31))) * 8), acc[ai][0][m][0] * WSI, acc[ai][0][m][1] * WSI); asm volatile("" ::: "memory"); }
            }
        }
    }
};
struct EpiOut {
    const float* xf; const bf16_t* xb; bf16_t* O;
    __device__ __forceinline__ void operator()(const f32x4 (&acc)[2][2][4][2], const Unit& u, int wr, int wc, int fr, int fq) const {
        EPI_ROWS_BEGIN
#pragma unroll
        for (int ai = 0; ai < 2; ++ai) {
            f32x4 xr[4][2][2];
#pragma unroll
            for (int m = 0; m < 4; ++m) { const unsigned off = (unsigned)((row0 + ai * HALF + m * 16) * DM + u.pn * BM + cl);
#pragma unroll
                for (int bj = 0; bj < 2; ++bj) {
                    if (xf) { xr[m][bj][0] = *(const f32x4*)(xf + off + bj * HALF); xr[m][bj][1] = *(const f32x4*)(xf + off + bj * HALF + 4); }
                    else load8bf(xb + off + bj * HALF, xr[m][bj][0], xr[m][bj][1]); } }
            asm volatile("" ::: "memory");
#pragma unroll
            for (int m = 0; m < 4; ++m) { const unsigned off = (unsigned)((row0 + ai * HALF + m * 16) * DM + u.pn * BM + cl);
#pragma unroll
                for (int bj = 0; bj < 2; ++bj)
                    store8(O + off + bj * HALF, xr[m][bj][0] * ALPHA + acc[ai][bj][m][0] * (FP8_OUT ? WSC_INV : 1.f), xr[m][bj][1] * ALPHA + acc[ai][bj][m][1] * (FP8_OUT ? WSC_INV : 1.f)); }
            asm volatile("" ::: "memory");
        }
    }
};
__device__ __forceinline__ f32x2 swiglu_pk(f32x2 g, f32x2 u) {
    f32x2 ga, ua; ga.x = fminf(g.x, 7.f); ga.y = fminf(g.y, 7.f);
    ua.x = __builtin_amdgcn_fmed3f(u.x, -7.f, 7.f); ua.y = __builtin_amdgcn_fmed3f(u.y, -7.f, 7.f);
    const f32x2 t = ga * (-1.702f * LOG2E);
    f32x2 e; e.x = __builtin_amdgcn_exp2f(t.x); e.y = __builtin_amdgcn_exp2f(t.y);
    const f32x2 d = e + 1.0f;
    f32x2 r; r.x = __builtin_amdgcn_rcpf(d.x); r.y = __builtin_amdgcn_rcpf(d.y);
    return (ga * r) * (ua + 1.0f);
}
struct EpiSwiglu {
    unsigned char* O; const float* bgu;
    __device__ __forceinline__ void operator()(const f32x4 (&acc)[2][2][4][2], const Unit& u, int wr, int wc, int fr, int fq) const {
        EPI_ROWS_BEGIN
        const int col = u.pn * HALF + cl;
        const float* bp = bgu + (unsigned)(u.e * 2048 + col);
        const f32x4 bg0 = *(const f32x4*)bp, bg1 = *(const f32x4*)(bp + 4), bu0 = *(const f32x4*)(bp + 1024), bu1 = *(const f32x4*)(bp + 1028);
#pragma unroll
        for (int ai = 0; ai < 2; ++ai)
#pragma unroll
            for (int m = 0; m < 4; ++m) { f32x4 g0 = acc[ai][0][m][0] * WSC_INV + bg0, g1 = acc[ai][0][m][1] * WSC_INV + bg1, p0 = acc[ai][1][m][0] * WSC_INV + bu0, p1 = acc[ai][1][m][1] * WSC_INV + bu1, r0, r1;
#pragma unroll
                for (int j = 0; j < 4; j += 2) { f32x2 o;
                    o = swiglu_pk((f32x2){g0[j], g0[j + 1]}, (f32x2){p0[j], p0[j + 1]}); r0[j] = o.x; r0[j + 1] = o.y;
                    o = swiglu_pk((f32x2){g1[j], g1[j + 1]}, (f32x2){p1[j], p1[j + 1]}); r1[j] = o.x; r1[j + 1] = o.y; }
                store8_fp8(O + (unsigned)((row0 + ai * HALF + m * 16) * DM + col), r0, r1); asm volatile("" ::: "memory"); }
    }
};
struct EpiDown {
    bf16_t* O; const float* bd; const float* rowgate;
    __device__ __forceinline__ void operator()(const f32x4 (&acc)[2][2][4][2], const Unit& u, int wr, int wc, int fr, int fq) const {
        EPI_ROWS_BEGIN
        const int col = u.pn * BM + cl; const float* bp = bd + (unsigned)(u.e * DM + col);
        f32x4 bv[2][2];
#pragma unroll
        for (int bj = 0; bj < 2; ++bj) { bv[bj][0] = *(const f32x4*)(bp + bj * HALF); bv[bj][1] = *(const f32x4*)(bp + bj * HALF + 4); }
        float gt[2][4];
#pragma unroll
        for (int ai = 0; ai < 2; ++ai)
#pragma unroll
            for (int m = 0; m < 4; ++m) gt[ai][m] = rowgate[row0 + ai * HALF + m * 16];
#pragma unroll
        for (int ai = 0; ai < 2; ++ai)
#pragma unroll
            for (int m = 0; m < 4; ++m) { const int row = row0 + ai * HALF + m * 16; const float g = gt[ai][m];
#pragma unroll
                for (int bj = 0; bj < 2; ++bj) {
                    if (Y_FP8) store8_fp8((unsigned char*)O + (unsigned)(row * DM + col + bj * HALF), (acc[ai][bj][m][0] * WSC_INV + bv[bj][0]) * (g * 16.f), (acc[ai][bj][m][1] * WSC_INV + bv[bj][1]) * (g * 16.f));
                    else store8(O + (unsigned)(row * DM + col + bj * HALF), (acc[ai][bj][m][0] * WSC_INV + bv[bj][0]) * g, (acc[ai][bj][m][1] * WSC_INV + bv[bj][1]) * g); }
                asm volatile("" ::: "memory"); }
    }
};
struct EpiGate {
    const bf16_t* mid; const bf16_t* P; const float* bg; bf16_t* O;
    __device__ __forceinline__ void operator()(const f32x4 (&acc)[2][2][4][2], const Unit& u, int wr, int wc, int fr, int fq) const {
        EPI_ROWS_BEGIN
        const int col = u.pn * BM + cl;
        f32x4 bv[2][2];
#pragma unroll
        for (int bj = 0; bj < 2; ++bj) { bv[bj][0] = *(const f32x4*)(bg + col + bj * HALF); bv[bj][1] = *(const f32x4*)(bg + col + bj * HALF + 4); }
#pragma unroll
        for (int ai = 0; ai < 2; ++ai) {
            u32x4 mr[4][2], pr[4][2];
#pragma unroll
            for (int m = 0; m < 4; ++m) { const unsigned off = (unsigned)((row0 + ai * HALF + m * 16) * DM + col);
#pragma unroll
                for (int bj = 0; bj < 2; ++bj) { mr[m][bj] = *(const u32x4*)(mid + off + bj * HALF); pr[m][bj] = *(const u32x4*)(P + off + bj * HALF); } }
            asm volatile("" ::: "memory");
#pragma unroll
            for (int m = 0; m < 4; ++m) { const unsigned off = (unsigned)((row0 + ai * HALF + m * 16) * DM + col);
#pragma unroll
                for (int bj = 0; bj < 2; ++bj) { const u32x4 mw = mr[m][bj], pw = pr[m][bj];
                    const f32x4 m0 = {bf_lo(mw.x), bf_hi(mw.x), bf_lo(mw.y), bf_hi(mw.y)}, m1 = {bf_lo(mw.z), bf_hi(mw.z), bf_lo(mw.w), bf_hi(mw.w)};
                    const f32x4 p0 = {bf_lo(pw.x), bf_hi(pw.x), bf_lo(pw.y), bf_hi(pw.y)}, p1 = {bf_lo(pw.z), bf_hi(pw.z), bf_lo(pw.w), bf_hi(pw.w)};
                    f32x4 r0, r1;
                    const f32x4 a0 = acc[ai][bj][m][0] * (FP8_GATE ? WSC_INV : 1.f) + bv[bj][0], a1 = acc[ai][bj][m][1] * (FP8_GATE ? WSC_INV : 1.f) + bv[bj][1];
#pragma unroll
                    for (int j = 0; j < 4; ++j) { r0[j] = m0[j] + sigmoidf_(a0[j]) * p0[j]; r1[j] = m1[j] + sigmoidf_(a1[j]) * p1[j]; }
                    store8(O + off + bj * HALF, r0, r1); } }
            asm volatile("" ::: "memory");
        }
    }
};
}

#define XB_TMO      128
#define XB_XCNT(j)  (256  + 64 * (j))
#define XB_XSUB(j)  (1280 + 64 * (j))
#define XB_XGEN(j)  (2304 + 64 * (j))
#define XB_TOP      3328
#define XB_TOPGEN   3392
#define XCD_BAR_WORDS 3456
#define XB_SPIN_CAP (1u << 18)
__device__ __forceinline__ unsigned xb_ld(unsigned* p)              { return __hip_atomic_load(p, __ATOMIC_RELAXED, __HIP_MEMORY_SCOPE_AGENT); }
__device__ __forceinline__ unsigned xb_add(unsigned* p, unsigned v) { return __hip_atomic_fetch_add(p, v, __ATOMIC_RELAXED, __HIP_MEMORY_SCOPE_AGENT); }
__device__ __forceinline__ unsigned xb_xcc_id() { return (unsigned)__builtin_amdgcn_s_getreg((3 << 11) | 20) & 0xFu; }
#define XB_SPIN(cond, bar) do { unsigned _sp = 0; while (cond) { __builtin_amdgcn_s_sleep(1); \
    if ((++_sp & 255u) == 0u) { if (xb_ld(&(bar)[XB_TMO])) break; if (_sp > XB_SPIN_CAP) { atomicAdd(&(bar)[XB_TMO], 1u); break; } } } } while (0)
struct XcdBarrier { unsigned* bar; unsigned x; volatile LAS unsigned* st; };
__device__ __forceinline__ XcdBarrier xcd_barrier_post(unsigned* bar, volatile LAS unsigned* st) {
    XcdBarrier b; b.bar = bar; b.x = xb_xcc_id(); b.st = st;
    if (threadIdx.x == 0) (void)xb_add(&bar[XB_XCNT(b.x)], 1u);
    return b;
}
__device__ __forceinline__ void xcd_barrier_complete(unsigned* bar, unsigned x, unsigned& nloc, unsigned& nx) {
    const unsigned G = gridDim.x * gridDim.y * gridDim.z;
    unsigned sum, cnt, mine, sp = 0u;
    for (;;) {
        sum = 0u; cnt = 0u; mine = 0u;
#pragma unroll
        for (unsigned j = 0; j < 16; ++j) { const unsigned c = xb_ld(&bar[XB_XCNT(j)]); sum += c; cnt += (c > 0u) ? 1u : 0u; mine = (j == x) ? c : mine; }
        if (sum == G) break;
        __builtin_amdgcn_s_sleep(1);
        if ((++sp & 255u) == 0u) { if (xb_ld(&bar[XB_TMO])) break; if (sp > XB_SPIN_CAP) { atomicAdd(&bar[XB_TMO], 1u); break; } }
    }
    nloc = mine > 0u ? mine : 1u; nx = cnt > 0u ? cnt : 1u;
}
__device__ __forceinline__ void xcd_barrier(const XcdBarrier& b) {
    asm volatile("s_waitcnt vmcnt(0)" ::: "memory");
    __syncthreads();
    if (threadIdx.x == 0) {
        unsigned* bar = b.bar; asm volatile("" : "+s"(bar));
        unsigned bx = b.x; asm volatile("" : "+s"(bx));
        __builtin_amdgcn_s_waitcnt(0);
        unsigned nloc = b.st[0], nx = b.st[1];
        if (nloc == 0u) { xcd_barrier_complete(bar, bx, nloc, nx); b.st[0] = nloc; b.st[1] = nx; }
        const unsigned old = xb_add(&bar[XB_XSUB(bx)], 1u);
        const unsigned gen = old / nloc;
        if (old + 1u == (gen + 1u) * nloc) {
            __builtin_amdgcn_fence(__ATOMIC_RELEASE, "agent");
            asm volatile("s_waitcnt vmcnt(0)" ::: "memory");
            const unsigned og = xb_add(&bar[XB_TOP], 1u);
            const unsigned tg = og / nx;
            if (og + 1u == (tg + 1u) * nx) xb_add(&bar[XB_TOPGEN], 1u);
            else XB_SPIN(xb_ld(&bar[XB_TOPGEN]) == tg, bar);
            __builtin_amdgcn_fence(__ATOMIC_ACQUIRE, "agent");
            xb_add(&bar[XB_XGEN(bx)], 1u);
            asm volatile("s_waitcnt vmcnt(0)" ::: "memory");
        } else {
            XB_SPIN(xb_ld(&bar[XB_XGEN(bx)]) == gen, bar);
            __builtin_amdgcn_fence(__ATOMIC_ACQUIRE, "agent");
            asm volatile("s_waitcnt vmcnt(0)" ::: "memory");
        }
    }
    __syncthreads();
}

constexpr int NWAVES = 8, NTHR = 512;
struct Args { const float* in[23]; float* out; unsigned char* ws; int ph_lo, ph_hi; };
struct Frame { LAS unsigned char* lds; int tid, lane, wave, G, bid; };
#define LDS_WAIT() asm volatile("s_waitcnt lgkmcnt(0)" ::: "memory")
#define LDS_BARRIER() asm volatile("s_waitcnt lgkmcnt(0)\n\ts_barrier" ::: "memory")

__device__ __forceinline__ void p0_transpose_item(const float* W, int K, int N, int Npad, bf16_t* WT, LAS float* scr, int item, int lane) {
    const int nblk = Npad / 32, kb = item / nblk, nb = item % nblk, k0 = 64 * kb, n0 = 32 * nb;
    const int n = n0 + (lane & 31);
#pragma unroll 8
    for (int i = 0; i < 32; ++i) { const int kk = 2 * i + (lane >> 5); scr[kk * 33 + (lane & 31)] = (n < N) ? W[(size_t)(k0 + kk) * N + n] : 0.f; }
    LDS_WAIT(); asm volatile("" ::: "memory");
    const int c = lane & 7;
#pragma unroll
    for (int j = 0; j < 4; ++j) { const int nn = (lane >> 3) + 8 * j; const LAS float* s = scr + (8 * c) * 33 + nn;
        u32x4 o; o.x = cvt_pk_bf16(s[0 * 33], s[1 * 33]); o.y = cvt_pk_bf16(s[2 * 33], s[3 * 33]); o.z = cvt_pk_bf16(s[4 * 33], s[5 * 33]); o.w = cvt_pk_bf16(s[6 * 33], s[7 * 33]);
        *(u32x4*)(WT + (size_t)(n0 + nn) * K + k0 + 8 * c) = o; }
    LDS_WAIT(); asm volatile("" ::: "memory");
}
__device__ __forceinline__ void p0_transpose_item_fp8(const float* W, int K, int N, int Npad, unsigned char* WT, LAS float* scr, int item, int lane) {
    const int nblk = Npad / 32, kb = item / nblk, nb = item % nblk, k0 = 64 * kb, n0 = 32 * nb;
#pragma unroll 8
    for (int i = 0; i < 32; ++i) { const int kk = 2 * i + (lane >> 5); const int n = n0 + (lane & 31); scr[kk * 33 + (lane & 31)] = (n < N) ? W[(size_t)(k0 + kk) * N + n] * WSC : 0.f; }
    LDS_WAIT(); asm volatile("" ::: "memory");
    const int c = lane & 7;
#pragma unroll
    for (int j = 0; j < 4; ++j) { const int nn = (lane >> 3) + 8 * j; const LAS float* sp = scr + (8 * c) * 33 + nn;
        const f32x4 v0 = {sp[0 * 33], sp[1 * 33], sp[2 * 33], sp[3 * 33]}, v1 = {sp[4 * 33], sp[5 * 33], sp[6 * 33], sp[7 * 33]};
        *(u32x2*)(WT + (size_t)(n0 + nn) * K + k0 + 8 * c) = pg8::pack8_fp8(v0, v1); }
    LDS_WAIT(); asm volatile("" ::: "memory");
}
__device__ __forceinline__ void cvt_f32_bf16(const float* src, bf16_t* dst, size_t n, int gtid, int gthreads) {
    for (size_t i = (size_t)gtid * 8; i < n; i += (size_t)gthreads * 8) {
        const f32x4 a = *(const f32x4*)(src + i), b = *(const f32x4*)(src + i + 4);
        u32x4 w; w.x = cvt_pk_bf16(a[0], a[1]); w.y = cvt_pk_bf16(a[2], a[3]); w.z = cvt_pk_bf16(b[0], b[1]); w.w = cvt_pk_bf16(b[2], b[3]); *(u32x4*)(dst + i) = w; }
}
__device__ __forceinline__ void p0_prologue(Frame& F, const Args& a) {
    unsigned char* ws = a.ws;
    LAS float* scr = (LAS float*)(F.lds + F.wave * 16384);
    const int gw = F.bid * NWAVES + F.wave, NGW = F.G * NWAVES;
    constexpr int I_IN0 = 16 * (ZE / 32), I_SQ = 16 * 32, I_IN1 = 16 * (ZO / 32), I_PLE = 4 * 32, I_RT = 16, I_GU = 16 * 64;
    constexpr int C0 = I_IN0, C1 = C0 + I_SQ, C2 = C1 + I_IN1, C3 = C2 + I_SQ, C4 = C3 + 2 * I_SQ, C5 = C4 + 2 * I_PLE, C6 = C5 + 2 * I_RT, C7 = C6 + 64 * I_GU, C8 = C7 + 64 * I_SQ;
    for (int it2 = gw; it2 < C8 * PM(0); it2 += NGW) { const int it = it2 >= C8 ? it2 - C8 : it2;
        if (it < C0) { if (FP8_IN0) p0_transpose_item_fp8(a.in[2], DM, ZE, ZE, (unsigned char*)(ws + WS_WIN0), scr, it, F.lane); else p0_transpose_item(a.in[2], DM, ZE, ZE, (bf16_t*)(ws + WS_WIN0), scr, it, F.lane); }
        else if (it < C1) { if (FP8_OUT) p0_transpose_item_fp8(a.in[7], DM, DM, DM, (unsigned char*)(ws + WS_WO0), scr, it - C0, F.lane); else p0_transpose_item(a.in[7], DM, DM, DM, (bf16_t*)(ws + WS_WO0), scr, it - C0, F.lane); }
        else if (it < C2) { if (FP8_IN1) p0_transpose_item_fp8(a.in[8], DM, ZO_REAL, ZO, (unsigned char*)(ws + WS_WIN1), scr, it - C1, F.lane); else p0_transpose_item(a.in[8], DM, ZO_REAL, ZO, (bf16_t*)(ws + WS_WIN1), scr, it - C1, F.lane); }
        else if (it < C3) { if (FP8_OUT) p0_transpose_item_fp8(a.in[9], DM, DM, DM, (unsigned char*)(ws + WS_WO1), scr, it - C2, F.lane); else p0_transpose_item(a.in[9], DM, DM, DM, (bf16_t*)(ws + WS_WO1), scr, it - C2, F.lane); }
        else if (it < C4) { const int r = it - C3, l = r / I_SQ; if (FP8_GATE) p0_transpose_item_fp8(a.in[21] + (size_t)l * DM * DM, DM, DM, DM, (unsigned char*)(ws + WS_WG) + (size_t)l * DM * DM, scr, r % I_SQ, F.lane); else p0_transpose_item(a.in[21] + (size_t)l * DM * DM, DM, DM, DM, (bf16_t*)(ws + WS_WG) + (size_t)l * DM * DM, scr, r % I_SQ, F.lane); }
        else if (it < C5) { const int r = it - C4, l = r / I_PLE; p0_transpose_item(a.in[20] + (size_t)l * PLE * DM, PLE, DM, DM, (bf16_t*)(ws + WS_WPLE) + (size_t)l * DM * PLE, scr, r % I_PLE, F.lane); }
        else if (it < C6) { const int r = it - C5, l = r / I_RT; p0_transpose_item(a.in[12] + (size_t)l * DM * NEXP, DM, NEXP, NEXP, (bf16_t*)(ws + WS_WRT) + (size_t)l * NEXP * DM, scr, r % I_RT, F.lane); }
        else if (it < C7) { const int r = it - C6, l = r / I_GU; p0_transpose_item_fp8(a.in[14] + (size_t)l * DM * 2048, DM, 2048, 2048, (unsigned char*)(ws + WS_WGU) + (size_t)l * 2048 * DM, scr, r % I_GU, F.lane); }
        else { const int r = it - C7, l = r / I_SQ; p0_transpose_item_fp8(a.in[16] + (size_t)l * DM * DM, DM, DM, DM, (unsigned char*)(ws + WS_WD) + (size_t)l * DM * DM, scr, r % I_SQ, F.lane); }
    }
    const int gtid = F.bid * NTHR + F.tid, gth = F.G * NTHR;
    if (!FP8_IN0) cvt_f32_bf16(a.in[0], (bf16_t*)(ws + WS_XB), (size_t)NTOK * DM, gtid, gth);
    else { unsigned char* xq = (unsigned char*)(ws + WS_XQ); const float* x = a.in[0];
      for (size_t i = (size_t)gtid * 8; i < (size_t)NTOK * DM; i += (size_t)gth * 8) { const f32x4 u = *(const f32x4*)(x + i), v = *(const f32x4*)(x + i + 4); *(u32x2*)(xq + i) = pg8::pack8_fp8(u, v); } }
    cvt_f32_bf16(a.in[1], (bf16_t*)(ws + WS_PB), (size_t)2 * NTOK * PLE, gtid, gth);
    for (int i = gtid; i < 8 * 128 * 128; i += gth) { const int t = (i >> 7) & 127, s = i & 127; const float v = (s <= t) ? a.in[5][i] : 0.f; ((bf16_t*)(ws + WS_WSB))[i] = (bf16_t)(cvt_pk_bf16(v, 0.f) & 0xffffu); }
}

__device__ __forceinline__ void gmlp_unit(Frame& F, const Args& a, int unit) {
    const bf16_t* z0 = (const bf16_t*)(a.ws + WS_Z); unsigned char* cat = (unsigned char*)(a.ws + WS_CAT); const bf16_t* wsb = (const bf16_t*)(a.ws + WS_WSB);
    const float* lng = a.in[3]; const float* lnb = a.in[4]; const float* bs = a.in[6];
    const size_t tok0 = (size_t)unit * 128;
    const int lane = F.lane, w = F.wave, r32 = lane & 31, hi = lane >> 5;
    LAS f32x2* stats = (LAS f32x2*)(F.lds + XTRA_OFF);
    for (int i = 0; i < 16; ++i) { const int tl = w * 16 + i;
        const u32x4 v = *(const u32x4*)(z0 + (tok0 + tl) * ZE + 512 + 8 * lane);
        float x[8] = {bf_lo(v.x), bf_hi(v.x), bf_lo(v.y), bf_hi(v.y), bf_lo(v.z), bf_hi(v.z), bf_lo(v.w), bf_hi(v.w)};
        float s = 0.f;
#pragma unroll
        for (int j = 0; j < 8; ++j) s += x[j];
        const float mean = wave_sum(s) * (1.f / 512.f); float q = 0.f;
#pragma unroll
        for (int j = 0; j < 8; ++j) { const float d = x[j] - mean; q += d * d; }
        const float rstd = 1.f / sqrtf(wave_sum(q) * (1.f / 512.f) + LN_EPS);
        if (lane == 0) stats[tl] = (f32x2){mean, rstd}; }
    __syncthreads();
    const int g = w;
    LAS unsigned char* vt = F.lds + w * 16384;
    { const int tl8 = lane >> 3, cc = lane & 7;
      float gg[8], bb[8];
#pragma unroll
      for (int j = 0; j < 8; ++j) { gg[j] = lng[g * 64 + 8 * cc + j]; bb[j] = lnb[g * 64 + 8 * cc + j]; }
      for (int it = 0; it < 16; ++it) { const int tl = 8 * it + tl8;
          const u32x4 v = *(const u32x4*)(z0 + (tok0 + tl) * ZE + 512 + g * 64 + 8 * cc);
          const f32x2 st = stats[tl];
          float x[8] = {bf_lo(v.x), bf_hi(v.x), bf_lo(v.y), bf_hi(v.y), bf_lo(v.z), bf_hi(v.z), bf_lo(v.w), bf_hi(v.w)};
#pragma unroll
          for (int j = 0; j < 8; ++j) { const int c = 8 * cc + j; const float y = (x[j] - st.x) * st.y * gg[j] + bb[j];
              *(LAS bf16_t*)(vt + c * 256 + ((((tl >> 3) ^ (c & 15))) << 4) + (tl & 7) * 2) = (bf16_t)(cvt_pk_bf16(y, 0.f) & 0xffffu); } } }
    LDS_WAIT(); asm volatile("" ::: "memory");
    for (int tb = 0; tb < 4; ++tb) {
        f32x16 d0 = {}, d1 = {};
        const bf16_t* wrow = wsb + ((size_t)g * 128 + tb * 32 + r32) * 128 + 8 * hi;
        bf16x8 afr[8];
#pragma unroll
        for (int ks = 0; ks < 8; ++ks) afr[ks] = *(const bf16x8*)(wrow + 16 * ks);
#pragma unroll
        for (int ks = 0; ks < 8; ++ks) { if (ks >= 2 * (tb + 1)) break;
            const bf16x8 af = afr[ks];
            const int chunk = 2 * ks + hi;
            const bf16x8 b0 = *(const LAS bf16x8*)(vt + r32 * 256 + ((chunk ^ (r32 & 15)) << 4));
            const bf16x8 b1 = *(const LAS bf16x8*)(vt + (32 + r32) * 256 + ((chunk ^ (r32 & 15)) << 4));
            d0 = __builtin_amdgcn_mfma_f32_32x32x16_bf16(af, b0, d0, 0, 0, 0);
            d1 = __builtin_amdgcn_mfma_f32_32x32x16_bf16(af, b1, d1, 0, 0, 0);
        }
#pragma unroll
        for (int r = 0; r < 16; ++r) { const int t = tb * 32 + (r & 3) + 8 * (r >> 2) + 4 * hi; const float bsv = bs[g * 128 + t];
            const size_t ro = (tok0 + t) * ZE + g * 64 + r32; const size_t co = (tok0 + t) * DM + g * 64 + r32;
            const float u0 = bf1(z0[ro]), u1 = bf1(z0[ro + 32]);
            CAT_ST(cat, co, u0 * (d0[r] + bsv)); CAT_ST(cat, co + 32, u1 * (d1[r] + bsv)); }
    }
    __syncthreads();
}

constexpr int SB_KST = 144;
constexpr int SB_TILE = 64 * SB_KST;
__device__ __forceinline__ void sb_unit(Frame& F, const Args& a, int b, int h, int qb) {
    const bf16_t* z0 = (const bf16_t*)(a.ws + WS_Z); unsigned char* cat = (unsigned char*)(a.ws + WS_CAT);
    const int tid = F.tid, lane = F.lane, wid = F.wave, r32 = lane & 31, hi = lane >> 5;
    const size_t rowbase = (size_t)b * SEQ;
    const int q0 = qb * 256, qw0 = q0 + wid * 32, tq = qw0 + r32;
    bf16x8 qr[4];
    { const bf16_t* qp = z0 + (rowbase + tq) * ZE + 1024 + h * 64 + hi * 8;
#pragma unroll
      for (int ks = 0; ks < 4; ++ks) qr[ks] = *(const bf16x8*)(qp + ks * 16); }
    f32x16 o0 = {}, o1 = {}; float C = 1.f;
    const int ntile = q0 / 64 + 4;
    LAS unsigned char* Kb = F.lds; LAS unsigned char* Vb = F.lds + 2 * SB_TILE;
    const bf16_t* kg = z0 + (rowbase + (tid >> 3)) * ZE + 1536 + h * 64 + (tid & 7) * 8;
    const unsigned ldst = (unsigned)(tid >> 3) * SB_KST + (unsigned)(tid & 7) * 16;
    { const size_t go = (size_t)(ntile - 1) * 64 * ZE; const u32x4 kn = *(const u32x4*)(kg + go), vn = *(const u32x4*)(kg + go + 512);
      *(LAS u32x4*)(Kb + ldst) = kn; *(LAS u32x4*)(Vb + ldst) = vn; }
    const int dh = (lane >> 4) & 1, q_ = (lane & 15) >> 2, p_ = lane & 3;
    for (int kt = ntile - 1; kt >= 0; --kt) {
        const int buf = (ntile - 1 - kt) & 1;
        u32x4 kn, vn;
        if (kt > 0) { const size_t go = (size_t)(kt - 1) * 64 * ZE; kn = *(const u32x4*)(kg + go); vn = *(const u32x4*)(kg + go + 512); }
        LDS_BARRIER();
        const LAS unsigned char* Kc = Kb + buf * SB_TILE; const LAS unsigned char* Vc = Vb + buf * SB_TILE;
        if (64 * kt <= qw0) {
            f32x16 p[2]; p[0] = (f32x16){}; p[1] = (f32x16){};
#pragma unroll
            for (int ks = 0; ks < 4; ++ks) {
                const bf16x8 k0 = *(const LAS bf16x8*)(Kc + r32 * SB_KST + (16 * ks + 8 * hi) * 2);
                const bf16x8 k1 = *(const LAS bf16x8*)(Kc + (32 + r32) * SB_KST + (16 * ks + 8 * hi) * 2);
                p[0] = __builtin_amdgcn_mfma_f32_32x32x16_bf16(k0, qr[ks], p[0], 0, 0, 0);
                p[1] = __builtin_amdgcn_mfma_f32_32x32x16_bf16(k1, qr[ks], p[1], 0, 0, 0);
            }
            const bool need_mask = (64 * kt + 64 > qw0);
            const int kb0 = 64 * kt + 4 * hi;
            float NB[2][16], BE[2][16];
            if (need_mask) {
#pragma unroll
                for (int bk = 0; bk < 2; ++bk)
#pragma unroll
                    for (int r = 0; r < 16; ++r) { const float rc = rcpf_(1.f + ex2(-p[bk][r]));
                        const int key = kb0 + 32 * bk + 8 * (r >> 2) + (r & 3); const bool ok = key < tq;
                        BE[bk][r] = ok ? rc : 0.f; NB[bk][r] = ok ? 1.f - rc : 1.f; }
            } else {
#pragma unroll
                for (int bk = 0; bk < 2; ++bk)
#pragma unroll
                    for (int r = 0; r < 16; ++r) { const float rc = rcpf_(1.f + ex2(-p[bk][r])); BE[bk][r] = rc; NB[bk][r] = 1.f - rc; }
            }
            float acc_c = C;
#pragma unroll
            for (int bk = 1; bk >= 0; --bk)
#pragma unroll
                for (int aa = 3; aa >= 0; --aa) {
                    const float R = (NB[bk][4 * aa] * NB[bk][4 * aa + 1]) * (NB[bk][4 * aa + 2] * NB[bk][4 * aa + 3]);
                    const auto rr = __builtin_amdgcn_permlane32_swap(__float_as_uint(R), __float_as_uint(R), false, false);
                    const float Rp = hi ? __uint_as_float(rr[0]) : __uint_as_float(rr[1]);
                    const float a3 = hi ? acc_c : acc_c * Rp, a2 = a3 * NB[bk][4 * aa + 3], a1 = a2 * NB[bk][4 * aa + 2], a0 = a1 * NB[bk][4 * aa + 1];
                    p[bk][4 * aa + 3] = BE[bk][4 * aa + 3] * a3; p[bk][4 * aa + 2] = BE[bk][4 * aa + 2] * a2;
                    p[bk][4 * aa + 1] = BE[bk][4 * aa + 1] * a1; p[bk][4 * aa + 0] = BE[bk][4 * aa + 0] * a0;
                    acc_c *= R * Rp;
                }
            C = acc_c;
            bf16x8 pa[2][2];
#pragma unroll
            for (int bk = 0; bk < 2; ++bk)
#pragma unroll
                for (int s = 0; s < 2; ++s) { u32x4 w; w.x = cvt_pk_bf16(p[bk][8 * s + 0], p[bk][8 * s + 1]); w.y = cvt_pk_bf16(p[bk][8 * s + 2], p[bk][8 * s + 3]);
                    w.z = cvt_pk_bf16(p[bk][8 * s + 4], p[bk][8 * s + 5]); w.w = cvt_pk_bf16(p[bk][8 * s + 6], p[bk][8 * s + 7]); pa[bk][s] = __builtin_bit_cast(bf16x8, w); }
#pragma unroll
            for (int bk = 0; bk < 2; ++bk)
#pragma unroll
                for (int s = 0; s < 2; ++s) {
                    const LAS unsigned char* vp = Vc + (32 * bk + 16 * s + 4 * hi + q_) * SB_KST + (16 * dh + 4 * p_) * 2;
                    const s16x4 l0 = __builtin_amdgcn_ds_read_tr16_b64_v4i16((LAS s16x4*)(vp));
                    const s16x4 h0 = __builtin_amdgcn_ds_read_tr16_b64_v4i16((LAS s16x4*)(vp + 8 * SB_KST));
                    const s16x4 l1 = __builtin_amdgcn_ds_read_tr16_b64_v4i16((LAS s16x4*)(vp + 64));
                    const s16x4 h1 = __builtin_amdgcn_ds_read_tr16_b64_v4i16((LAS s16x4*)(vp + 8 * SB_KST + 64));
                    const bf16x8 v0 = (bf16x8){l0[0], l0[1], l0[2], l0[3], h0[0], h0[1], h0[2], h0[3]};
                    const bf16x8 v1 = (bf16x8){l1[0], l1[1], l1[2], l1[3], h1[0], h1[1], h1[2], h1[3]};
                    o0 = __builtin_amdgcn_mfma_f32_32x32x16_bf16(pa[bk][s], v0, o0, 0, 0, 0);
                    o1 = __builtin_amdgcn_mfma_f32_32x32x16_bf16(pa[bk][s], v1, o1, 0, 0, 0);
                }
        }
        if (kt > 0) { *(LAS u32x4*)(Kb + (buf ^ 1) * SB_TILE + ldst) = kn; *(LAS u32x4*)(Vb + (buf ^ 1) * SB_TILE + ldst) = vn; }
    }
#pragma unroll
    for (int r = 0; r < 16; ++r) { const int q = (r & 3) + 8 * (r >> 2) + 4 * hi;
        const size_t oo = (rowbase + qw0 + q) * DM + 512 + h * 64 + r32;
        CAT_ST(cat, oo, o0[r]); CAT_ST(cat, oo + 32, o1[r]); }
    __syncthreads();
}

template <int I> struct SelStep {
    static __device__ __forceinline__ void run(const float (&v)[64], float thr, float lo, bool exact, int need_eq, int& eq_seen, unsigned& m0, unsigned& m1) {
        const bool gt = v[I] > thr; const bool eq = (!exact) && !gt && (v[I] > lo);
        const unsigned long long meq = __ballot(eq);
        const int eq_rank = eq_seen + __builtin_amdgcn_mbcnt_hi((unsigned)(meq >> 32), __builtin_amdgcn_mbcnt_lo((unsigned)meq, 0));
        const bool take = gt || (eq && eq_rank < need_eq);
        const unsigned long long mt = __ballot(take);
        const unsigned mlo = (unsigned)mt, mhi = (unsigned)(mt >> 32);
        asm volatile("s_nop 1\n\tv_writelane_b32 %0, %1, %2" : "+v"(m0) : "s"(mlo), "n"(I));
        asm volatile("s_nop 1\n\tv_writelane_b32 %0, %1, %2" : "+v"(m1) : "s"(mhi), "n"(I));
        eq_seen += __builtin_popcountll(meq);
        SelStep<I + 1>::run(v, thr, lo, exact, need_eq, eq_seen, m0, m1);
    }
};
template <> struct SelStep<64> { static __device__ __forceinline__ void run(const float (&)[64], float, float, bool, int, int&, unsigned&, unsigned&) {} };

template <int I> struct SelExact {
    static __device__ __forceinline__ void run(const float (&v)[64], float thr, unsigned& m0, unsigned& m1) {
        const unsigned long long mt = __ballot(v[I] > thr);
        const unsigned mlo = (unsigned)mt, mhi = (unsigned)(mt >> 32);
        asm volatile("s_nop 1\n\tv_writelane_b32 %0, %1, %2" : "+v"(m0) : "s"(mlo), "n"(I));
        asm volatile("s_nop 1\n\tv_writelane_b32 %0, %1, %2" : "+v"(m1) : "s"(mhi), "n"(I));
        SelExact<I + 1>::run(v, thr, m0, m1);
    }
};
template <> struct SelExact<64> { static __device__ __forceinline__ void run(const float (&)[64], float, unsigned&, unsigned&) {} };

__device__ __forceinline__ void dsa_select_unit(Frame& F, const Args& a, int unit) {
    const bf16_t* z1 = (const bf16_t*)(a.ws + WS_Z); unsigned* bm = (unsigned*)(a.ws + WS_BM);
    const int lane = F.lane, wid = F.wave, r32 = lane & 31, hi = lane >> 5;
    const int tok0 = unit * 8;
    const int b = tok0 / SEQ, t0 = tok0 % SEQ;
    const size_t rowbase = (size_t)b * SEQ;
    const int vis = (t0 / 64 + 1) * 64;
    LAS float* sc = (LAS float*)F.lds;
    if (vis > 256) {
        const int tl = 2 * (r32 >> 4) + ((r32 >> 2) & 1), hd = (r32 & 3) + 4 * ((r32 >> 3) & 1);
        bf16x8 af[2][4];
#pragma unroll
        for (int rt = 0; rt < 2; ++rt) { const bf16_t* qp = z1 + (size_t)(tok0 + 4 * rt + tl) * ZO + OQI + hd * 64 + 8 * hi;
#pragma unroll
            for (int ks = 0; ks < 4; ++ks) af[rt][ks] = *(const bf16x8*)(qp + 16 * ks); }
        float wv[4][8];
#pragma unroll
        for (int j = 0; j < 4; ++j) { const u32x4 w = *(const u32x4*)(z1 + (size_t)(tok0 + 2 * j + hi) * ZO + OWI);
            const float s = 0.35355339059f * 0.125f;
            wv[j][0] = bf_lo(w.x) * s; wv[j][1] = bf_hi(w.x) * s; wv[j][2] = bf_lo(w.y) * s; wv[j][3] = bf_hi(w.y) * s;
            wv[j][4] = bf_lo(w.z) * s; wv[j][5] = bf_hi(w.z) * s; wv[j][6] = bf_lo(w.w) * s; wv[j][7] = bf_hi(w.w) * s; }
        const int nkt = vis / 32;
        const bf16_t* kbase = (const bf16_t*)(a.ws + WS_KI1) + rowbase * 64 + (size_t)lane * 8;
        for (int rep14 = 0; rep14 < PM(14); ++rep14)
        for (int kt0 = wid; kt0 < nkt; kt0 += 8 * NWAVES) {
            bf16x8 kq[8][4];
#pragma unroll
            for (int pf = 0; pf < 8; ++pf) { const int kt = min(kt0 + pf * NWAVES, nkt - 1);
#pragma unroll
                for (int ks = 0; ks < 4; ++ks) kq[pf][ks] = *(const bf16x8*)(kbase + (size_t)(kt * 4 + ks) * 512); }
            __builtin_amdgcn_sched_barrier(0);
#pragma unroll
            for (int pf = 0; pf < 8; ++pf) { const int kt = kt0 + pf * NWAVES;
                if (kt < nkt) {
                    f32x16 d0 = {}, d1 = {};
#pragma unroll
                    for (int ks = 0; ks < 4; ++ks) { d0 = __builtin_amdgcn_mfma_f32_32x32x16_bf16(af[0][ks], kq[pf][ks], d0, 0, 0, 0); d1 = __builtin_amdgcn_mfma_f32_32x32x16_bf16(af[1][ks], kq[pf][ks], d1, 0, 0, 0); }
                    float s0 = 0.f, s1 = 0.f, s2 = 0.f, s3 = 0.f;
#pragma unroll
                    for (int r = 0; r < 8; ++r) { s0 += wv[0][r] * relu_i(d0[r]); s1 += wv[1][r] * relu_i(d0[8 + r]); s2 += wv[2][r] * relu_i(d1[r]); s3 += wv[3][r] * relu_i(d1[8 + r]); }
                    const int key = kt * 32 + r32;
                    sc[(hi) * 4096 + key] = s0; sc[(2 + hi) * 4096 + key] = s1; sc[(4 + hi) * 4096 + key] = s2; sc[(6 + hi) * 4096 + key] = s3;
                } }
        }
    }
    __syncthreads();
    for (int rep15 = 0; rep15 < PM(15); ++rep15) {
        unsigned m0 = 0u, m1 = 0u;
        if (vis <= 256) { m0 = 0xffffffffu; m1 = 0xffffffffu; }
        else {
            const LAS float* ms = sc + wid * 4096;
            float v[64];
            float mx = -INFINITY, mn = INFINITY;
#pragma unroll
            for (int i = 0; i < 64; ++i) { const bool in = (i * 64 < vis); v[i] = in ? ms[i * 64 + lane] : -INFINITY; if (in) { mx = fmaxf(mx, v[i]); mn = fminf(mn, v[i]); } }
            mx = wave_max_uniform(mx); mn = -wave_max_uniform(-mn);
            float lo = mn - 1.f - fabsf(mn), hiv = mx;
            float thr = hiv; int cgt = 0; bool exact = false;
            int c_lo = vis, c_hi = 0;
            bool dead = false;
            for (int it = 0; it < 64 && (c_lo - c_hi) > 448; ++it) {
                const float mid = 0.5f * (lo + hiv);
                if (!(mid > lo) || !(mid < hiv)) { dead = true; break; }
                int c = 0;
#pragma unroll
                for (int i = 0; i < 64; ++i) c += (v[i] > mid) ? 1 : 0;
                c = wave_sum_uniform(c);
                if (c == 256) { thr = mid; exact = true; break; }
                if (c > 256) { lo = mid; c_lo = c; } else { hiv = mid; c_hi = c; }
            }
            if (!exact && !dead) {
                LAS float* cand = sc + wid * 4096; int base = 0;
#pragma unroll
                for (int i = 0; i < 64; ++i) { const bool in = (v[i] > lo) && !(v[i] > hiv);
                    const unsigned long long mk = __ballot(in);
                    const int pos = base + __builtin_amdgcn_mbcnt_hi((unsigned)(mk >> 32), __builtin_amdgcn_mbcnt_lo((unsigned)mk, 0));
                    if (in) cand[pos] = v[i];
                    base += __builtin_popcountll(mk); }
                const int nc = c_lo - c_hi, c_hi0 = c_hi;
                float cv[8];
#pragma unroll
                for (int j = 0; j < 8; ++j) cv[j] = (lane + 64 * j < nc) ? cand[lane + 64 * j] : -INFINITY;
                for (int it = 0; it < 64; ++it) {
                    const float mid = 0.5f * (lo + hiv);
                    if (!(mid > lo) || !(mid < hiv)) break;
                    int c = 0;
#pragma unroll
                    for (int j = 0; j < 8; ++j) c += (cv[j] > mid) ? 1 : 0;
                    c = c_hi0 + wave_sum_uniform(c);
                    if (c == 256) { thr = mid; exact = true; break; }
                    if (c > 256) { lo = mid; c_lo = c; } else { hiv = mid; c_hi = c; }
                }
            }
            if (!exact) { thr = hiv; cgt = c_hi; }
            const int need_eq = exact ? 0 : (256 - cgt); int eq_seen = 0;
            if (exact) SelExact<0>::run(v, thr, m0, m1); else SelStep<0>::run(v, thr, lo, exact, need_eq, eq_seen, m0, m1);
        }
        if (lane * 64 < vis) *(u32x2*)(bm + (size_t)(tok0 + wid) * 128 + 2 * lane) = (u32x2){m0, m1};
    }
    __syncthreads();
}

template <int I> struct MaskInit {
    static __device__ __forceinline__ void run(f32x16 (&p)[2], int nw0, int nw1, float slope2, float T, int ninf) {
        constexpr int bk = I >> 4, r = I & 15, pos = 8 * (r >> 2) + (r & 3);
        const float vb = __builtin_fmaf(slope2, (float)(32 * bk + pos), T);
        int off; asm("v_bfe_i32 %0, %1, %2, 1" : "=v"(off) : "v"(bk ? nw1 : nw0), "n"(pos));
        float o; asm("v_bfi_b32 %0, %1, %2, %3" : "=v"(o) : "v"(off), "s"(ninf), "v"(vb));
        p[bk][r] = o;
        MaskInit<I + 1>::run(p, nw0, nw1, slope2, T, ninf);
    }
};
template <> struct MaskInit<32> { static __device__ __forceinline__ void run(f32x16 (&)[2], int, int, float, float, int) {} };
__device__ __forceinline__ float max3_asm(float a, float b, float c) { float r; asm("v_max3_f32 %0, %1, %2, %3" : "=v"(r) : "v"(a), "v"(b), "v"(c)); return r; }
__device__ __forceinline__ void dsa_attn_unit(Frame& F, const Args& a, int b, int ch, int g) {
    const bf16_t* z1 = (const bf16_t*)(a.ws + WS_Z); unsigned char* cat = (unsigned char*)(a.ws + WS_CAT); const unsigned* bm = (const unsigned*)(a.ws + WS_BM);
    const int tid = F.tid, lane = F.lane, wid = F.wave, r32 = lane & 31, hi = lane >> 5;
    const int hr = wid >> 1, qh = wid & 1, head = g * 4 + hr;
    const size_t rowbase = (size_t)b * SEQ;
    const int tq = ch * 64 + 32 * qh + r32;
    const float slope2 = ex2(-0.5f * (float)(head + 1)) * LOG2E;
    bf16x8 qr[4];
    { const bf16_t* qp = z1 + (rowbase + tq) * ZO + OQ + head * 64 + hi * 8;
#pragma unroll
      for (int ks = 0; ks < 4; ++ks) qr[ks] = *(const bf16x8*)(qp + ks * 16); }
    const unsigned* mrow = bm + (rowbase + tq) * 128;
    f32x16 o0 = {}, o1 = {}; float m = 0.f, l = 0.f;
    const int ntile = ch + 1;
    LAS unsigned char* Kb = F.lds; LAS unsigned char* Vb = F.lds + 2 * SB_TILE;
    LAS float* wsf = (LAS float*)(F.lds + 4 * SB_TILE) + wid * 32;
    const bf16_t* kg = (const bf16_t*)(a.ws + WS_KV1) + (rowbase + (tid >> 3)) * 512 + g * 64 + (tid & 7) * 8;
    const unsigned ldst = (unsigned)(tid >> 3) * SB_KST + (unsigned)(tid & 7) * 16;
    { const u32x4 kn = *(const u32x4*)(kg), vn = *(const u32x4*)(kg + 256);
      *(LAS u32x4*)(Kb + ldst) = kn; *(LAS u32x4*)(Vb + ldst) = vn; }
    const int dh = (lane >> 4) & 1, q_ = (lane & 15) >> 2, p_ = lane & 3;
    u32x2 mw = *(const u32x2*)(mrow);
    for (int kt = 0; kt < ntile; ++kt) {
        const int buf = kt & 1;
        u32x4 kn, vn; u32x2 mwn = mw;
        if (kt + 1 < ntile) { const size_t go = (size_t)(kt + 1) * 64 * 512; kn = *(const u32x4*)(kg + go); vn = *(const u32x4*)(kg + go + 256); mwn = *(const u32x2*)(mrow + 2 * (kt + 1)); }
        LDS_BARRIER();
        const LAS unsigned char* Kc = Kb + buf * SB_TILE; const LAS unsigned char* Vc = Vb + buf * SB_TILE;
        const float T = slope2 * (float)(64 * kt + 4 * hi) - m;
        const int nw0 = (int)~(mw.x >> (4 * hi)), nw1 = (int)~(mw.y >> (4 * hi));
        f32x16 p[2];
        MaskInit<0>::run(p, nw0, nw1, slope2, T, (int)0xff800000);
#pragma unroll
        for (int ks = 0; ks < 4; ++ks) {
            const bf16x8 k0 = *(const LAS bf16x8*)(Kc + r32 * SB_KST + (16 * ks + 8 * hi) * 2);
            const bf16x8 k1 = *(const LAS bf16x8*)(Kc + (32 + r32) * SB_KST + (16 * ks + 8 * hi) * 2);
            p[0] = __builtin_amdgcn_mfma_f32_32x32x16_bf16(k0, qr[ks], p[0], 0, 0, 0);
            p[1] = __builtin_amdgcn_mfma_f32_32x32x16_bf16(k1, qr[ks], p[1], 0, 0, 0);
        }
        if (kt == ntile - 1) {
            const float basef = (float)(tq - (64 * kt + 4 * hi));
#pragma unroll
            for (int bk = 0; bk < 2; ++bk)
#pragma unroll
                for (int r = 0; r < 16; ++r) { const float rel = (float)(32 * bk + 8 * (r >> 2) + (r & 3)) - basef; p[bk][r] -= 2.f * slope2 * fmaxf(rel, 0.f); }
        } else asm volatile("s_nop 15\n\ts_nop 7" : "+v"(p[0]), "+v"(p[1]));
        float rm;
        { float a0 = max3_asm(p[0][0], p[0][1], p[1][0]), b0 = max3_asm(p[0][2], p[0][3], p[1][1]); a0 = max3_asm(a0, p[1][2], p[1][3]);
#pragma unroll
          for (int r = 4; r < 16; r += 4) { a0 = max3_asm(a0, p[0][r], p[0][r + 1]); b0 = max3_asm(b0, p[0][r + 2], p[0][r + 3]); a0 = max3_asm(a0, p[1][r], p[1][r + 1]); b0 = max3_asm(b0, p[1][r + 2], p[1][r + 3]); }
          rm = fmaxf(a0, b0); }
        rm = fmaxf(rm, sxf<32>(rm));
        if (__any(rm > 6.f) || kt == 0) {
            const float d = (kt == 0) ? ((rm > -1e30f) ? rm : 0.f) : ((rm > 6.f) ? rm : 0.f);
            const float alpha = ex2(-d);
            l *= alpha; m += d;
#pragma unroll
            for (int bk = 0; bk < 2; ++bk)
#pragma unroll
                for (int r = 0; r < 16; ++r) p[bk][r] -= d;
            if (hi == 0) wsf[r32] = alpha;
#pragma unroll
            for (int r = 0; r < 16; ++r) { const float al = wsf[(r & 3) + 8 * (r >> 2) + 4 * hi]; o0[r] *= al; o1[r] *= al; }
        }
        float ls = 0.f;
#pragma unroll
        for (int bk = 0; bk < 2; ++bk)
#pragma unroll
            for (int r = 0; r < 16; ++r) { const float e = ex2(p[bk][r]); p[bk][r] = e; ls += e; }
        l += ls;
        bf16x8 pa[2][2];
#pragma unroll
        for (int bk = 0; bk < 2; ++bk)
#pragma unroll
            for (int s = 0; s < 2; ++s) { u32x4 w; w.x = cvt_pk_bf16(p[bk][8 * s + 0], p[bk][8 * s + 1]); w.y = cvt_pk_bf16(p[bk][8 * s + 2], p[bk][8 * s + 3]);
                w.z = cvt_pk_bf16(p[bk][8 * s + 4], p[bk][8 * s + 5]); w.w = cvt_pk_bf16(p[bk][8 * s + 6], p[bk][8 * s + 7]); pa[bk][s] = __builtin_bit_cast(bf16x8, w); }
#pragma unroll
        for (int bk = 0; bk < 2; ++bk)
#pragma unroll
            for (int s = 0; s < 2; ++s) {
                const LAS unsigned char* vp = Vc + (32 * bk + 16 * s + 4 * hi + q_) * SB_KST + (16 * dh + 4 * p_) * 2;
                const s16x4 l0 = __builtin_amdgcn_ds_read_tr16_b64_v4i16((LAS s16x4*)(vp));
                const s16x4 h0 = __builtin_amdgcn_ds_read_tr16_b64_v4i16((LAS s16x4*)(vp + 8 * SB_KST));
                const s16x4 l1 = __builtin_amdgcn_ds_read_tr16_b64_v4i16((LAS s16x4*)(vp + 64));
                const s16x4 h1 = __builtin_amdgcn_ds_read_tr16_b64_v4i16((LAS s16x4*)(vp + 8 * SB_KST + 64));
                const bf16x8 v0 = (bf16x8){l0[0], l0[1], l0[2], l0[3], h0[0], h0[1], h0[2], h0[3]};
                const bf16x8 v1 = (bf16x8){l1[0], l1[1], l1[2], l1[3], h1[0], h1[1], h1[2], h1[3]};
                o0 = __builtin_amdgcn_mfma_f32_32x32x16_bf16(pa[bk][s], v0, o0, 0, 0, 0);
                o1 = __builtin_amdgcn_mfma_f32_32x32x16_bf16(pa[bk][s], v1, o1, 0, 0, 0);
            }
        if (kt + 1 < ntile) { *(LAS u32x4*)(Kb + (buf ^ 1) * SB_TILE + ldst) = kn; *(LAS u32x4*)(Vb + (buf ^ 1) * SB_TILE + ldst) = vn; }
        mw = mwn;
    }
    l += sxf<32>(l);
    if (hi == 0) wsf[r32] = 1.f / l;
#pragma unroll
    for (int r = 0; r < 16; ++r) { const int q = (r & 3) + 8 * (r >> 2) + 4 * hi; const float inv = wsf[q];
        const size_t oo = (rowbase + ch * 64 + 32 * qh + q) * DM + head * 64 + r32;
        CAT_ST(cat, oo, o0[r] * inv); CAT_ST(cat, oo + 32, o1[r] * inv); }
    __syncthreads();
}

__device__ __forceinline__ void ln_row16(const bf16_t* src, float (&x)[16], int lane) {
    const u32x4 a = *(const u32x4*)(src + 8 * lane), b = *(const u32x4*)(src + 512 + 8 * lane);
    x[0] = bf_lo(a.x); x[1] = bf_hi(a.x); x[2] = bf_lo(a.y); x[3] = bf_hi(a.y); x[4] = bf_lo(a.z); x[5] = bf_hi(a.z); x[6] = bf_lo(a.w); x[7] = bf_hi(a.w);
    x[8] = bf_lo(b.x); x[9] = bf_hi(b.x); x[10] = bf_lo(b.y); x[11] = bf_hi(b.y); x[12] = bf_lo(b.z); x[13] = bf_hi(b.z); x[14] = bf_lo(b.w); x[15] = bf_hi(b.w);
}
__device__ __forceinline__ void ln_norm16(float (&x)[16], const float* g, const float* bta, int lane) {
    float s = 0.f;
#pragma unroll
    for (int j = 0; j < 16; ++j) s += x[j];
    const float mean = wave_sum(s) * (1.f / DM); float q = 0.f;
#pragma unroll
    for (int j = 0; j < 16; ++j) { x[j] -= mean; q += x[j] * x[j]; }
    const float rstd = 1.f / sqrtf(wave_sum(q) * (1.f / DM) + LN_EPS);
    const f32x4 g0 = *(const f32x4*)(g + 8 * lane), g1 = *(const f32x4*)(g + 8 * lane + 4), g2 = *(const f32x4*)(g + 512 + 8 * lane), g3 = *(const f32x4*)(g + 512 + 8 * lane + 4);
    const f32x4 b0 = *(const f32x4*)(bta + 8 * lane), b1 = *(const f32x4*)(bta + 8 * lane + 4), b2 = *(const f32x4*)(bta + 512 + 8 * lane), b3 = *(const f32x4*)(bta + 512 + 8 * lane + 4);
#pragma unroll
    for (int j = 0; j < 4; ++j) { x[j] = x[j] * rstd * g0[j] + b0[j]; x[4 + j] = x[4 + j] * rstd * g1[j] + b1[j]; x[8 + j] = x[8 + j] * rstd * g2[j] + b2[j]; x[12 + j] = x[12 + j] * rstd * g3[j] + b3[j]; }
}
__device__ __forceinline__ void store16bf(bf16_t* dst, const float (&x)[16], int lane) {
    u32x4 a, b; a.x = cvt_pk_bf16(x[0], x[1]); a.y = cvt_pk_bf16(x[2], x[3]); a.z = cvt_pk_bf16(x[4], x[5]); a.w = cvt_pk_bf16(x[6], x[7]);
    b.x = cvt_pk_bf16(x[8], x[9]); b.y = cvt_pk_bf16(x[10], x[11]); b.z = cvt_pk_bf16(x[12], x[13]); b.w = cvt_pk_bf16(x[14], x[15]);
    *(u32x4*)(dst + 8 * lane) = a; *(u32x4*)(dst + 512 + 8 * lane) = b;
}
__device__ __forceinline__ void store16f8(unsigned char* dst, const float (&x)[16], int lane) {
    *(u32x2*)(dst + 8 * lane) = pg8::pack8_fp8((f32x4){x[0], x[1], x[2], x[3]}, (f32x4){x[4], x[5], x[6], x[7]});
    *(u32x2*)(dst + 512 + 8 * lane) = pg8::pack8_fp8((f32x4){x[8], x[9], x[10], x[11]}, (f32x4){x[12], x[13], x[14], x[15]});
}
constexpr int HS_STRIDE = 2064;
__device__ __forceinline__ void ln1_router_phase(Frame& F, const Args& a, int layer) {
    const bf16_t* t1 = (const bf16_t*)(a.ws + WS_T1); bf16_t* hb = (bf16_t*)(a.ws + WS_HB);
    const bf16_t* wrt = (const bf16_t*)(a.ws + WS_WRT) + (size_t)layer * NEXP * DM;
    const float* g = a.in[10] + layer * DM; const float* bta = a.in[11] + layer * DM; const float* br = a.in[13] + layer * NEXP;
    int* topi = (int*)(a.ws + WS_TOPI); float* gate = (float*)(a.ws + WS_GATE); int* cnt = (int*)(a.ws + WS_CNT);
    const int lane = F.lane, w = F.wave, tid = F.tid;
    LAS unsigned char* hs = F.lds;
    LAS float* part = (LAS float*)(F.lds + 36864);
    LAS float* logit = (LAS float*)(F.lds + 36864 + 16384);
    LAS int* hist = (LAS int*)(F.lds + 36864 + 16384 + 2048);
    LAS int* topk_i = (LAS int*)(F.lds + 36864 + 16384 + 2048 + 256); LAS float* topk_v = (LAS float*)(F.lds + 36864 + 16384 + 2048 + 512);
    const int n16 = lane & 15, kg4 = lane >> 4;
    bf16x8 bw[2][4];
#pragma unroll
    for (int n = 0; n < 2; ++n)
#pragma unroll
        for (int ks = 0; ks < 4; ++ks) bw[n][ks] = *(const bf16x8*)(wrt + (size_t)(16 * n + n16) * DM + 128 * w + 32 * ks + 8 * kg4);
    for (int grp2 = F.bid; grp2 < NGRP * PM(6); grp2 += F.G) { const int grp = grp2 % NGRP;
        if (tid < 32) hist[tid] = 0;
        __syncthreads();
        for (int it = 0; it < 8; ++it) {
            const int r0 = grp * 128 + it * 16;
#pragma unroll
            for (int rr = 0; rr < 2; ++rr) { const int rl = 2 * w + rr; float x[16];
                ln_row16(t1 + (size_t)(r0 + rl) * DM, x, lane); ln_norm16(x, g, bta, lane);
                store16bf(hb + (size_t)(r0 + rl) * DM, x, lane);
                u32x4 p, q; p.x = cvt_pk_bf16(x[0], x[1]); p.y = cvt_pk_bf16(x[2], x[3]); p.z = cvt_pk_bf16(x[4], x[5]); p.w = cvt_pk_bf16(x[6], x[7]);
                q.x = cvt_pk_bf16(x[8], x[9]); q.y = cvt_pk_bf16(x[10], x[11]); q.z = cvt_pk_bf16(x[12], x[13]); q.w = cvt_pk_bf16(x[14], x[15]);
                *(LAS u32x4*)(hs + rl * HS_STRIDE + 16 * lane) = p; *(LAS u32x4*)(hs + rl * HS_STRIDE + 1024 + 16 * lane) = q; }
            __syncthreads();
            { f32x4 d0 = {0.f, 0.f, 0.f, 0.f}, d1 = {0.f, 0.f, 0.f, 0.f};
#pragma unroll
              for (int ks = 0; ks < 4; ++ks) { const bf16x8 af = *(const LAS bf16x8*)(hs + n16 * HS_STRIDE + (128 * w + 32 * ks + 8 * kg4) * 2);
                  d0 = __builtin_amdgcn_mfma_f32_16x16x32_bf16(af, bw[0][ks], d0, 0, 0, 0); d1 = __builtin_amdgcn_mfma_f32_16x16x32_bf16(af, bw[1][ks], d1, 0, 0, 0); }
#pragma unroll
              for (int r = 0; r < 4; ++r) { part[(w * 16 + 4 * kg4 + r) * 32 + n16] = d0[r]; part[(w * 16 + 4 * kg4 + r) * 32 + 16 + n16] = d1[r]; } }
            __syncthreads();
            { const int row = tid >> 5, e = tid & 31; float s = br[e];
#pragma unroll
              for (int ww = 0; ww < 8; ++ww) s += part[(ww * 16 + row) * 32 + e];
              logit[row * 32 + e] = s; }
            __syncthreads();
            { const int row = tid >> 5, e = tid & 31; const float lv = logit[row * 32 + e]; int rank = 0;
#pragma unroll
              for (int e2 = 0; e2 < 32; ++e2) { const float o = logit[row * 32 + e2]; rank += (o > lv || (o == lv && e2 < e)) ? 1 : 0; }
              if (rank < 4) { topk_i[row * 4 + rank] = e; topk_v[row * 4 + rank] = lv; } }
            __syncthreads();
            if (tid < 16) { const int tok = r0 + tid;
                const int t0 = topk_i[tid * 4 + 0], t1 = topk_i[tid * 4 + 1], t2 = topk_i[tid * 4 + 2], t3 = topk_i[tid * 4 + 3];
                const float v0 = topk_v[tid * 4 + 0];
                const float e0 = 1.f, e1 = __expf(topk_v[tid * 4 + 1] - v0), e2 = __expf(topk_v[tid * 4 + 2] - v0), e3 = __expf(topk_v[tid * 4 + 3] - v0); const float inv = 1.f / (e0 + e1 + e2 + e3);
                *(int4*)(topi + (size_t)tok * 4) = make_int4(t0, t1, t2, t3);
                *(float4*)(gate + (size_t)tok * 4) = make_float4(e0 * inv, e1 * inv, e2 * inv, e3 * inv);
                atomicAdd((int*)&hist[t0], 1); atomicAdd((int*)&hist[t1], 1); atomicAdd((int*)&hist[t2], 1); atomicAdd((int*)&hist[t3], 1); }
        }
        __syncthreads();
        if (tid < 32) cnt[grp * 32 + tid] = hist[tid];
        __syncthreads();
    }
}

__device__ __forceinline__ void moe_tables(Frame& F, const Args& a, int grp) {
    const int* cnt = (const int*)(a.ws + WS_CNT);
    LAS int* T = (LAS int*)(F.lds + TAB_OFF);
    const int tid = F.tid, e = tid & 31, j = tid >> 5;
    { int s = 0, bf = 0;
      for (int gg = j * 16; gg < j * 16 + 16; ++gg) { const int c = cnt[gg * 32 + e]; s += c; if (gg < grp) bf += c; }
      T[TB_TOT16 / 4 + j * 32 + e] = s; T[TB_BEF16 / 4 + j * 32 + e] = bf; }
    __syncthreads();
    if (tid < 32) { int s = 0, bf = 0;
#pragma unroll
        for (int jj = 0; jj < 16; ++jj) { s += T[TB_TOT16 / 4 + jj * 32 + tid]; bf += T[TB_BEF16 / 4 + jj * 32 + tid]; }
        T[TB_TOTAL / 4 + tid] = s; T[TB_BEFORE / 4 + tid] = bf; T[TB_LCUR / 4 + tid] = 0; }
    __syncthreads();
    if (tid < 32) {
        int ps = 0;
#pragma nounroll
        for (int ee = 0; ee < tid; ++ee) ps += ((T[TB_TOTAL / 4 + ee] + 255) >> 8) << 8;
        T[TB_PADST / 4 + tid] = ps; T[TB_BASE / 4 + tid] = ps + T[TB_BEFORE / 4 + tid];
        if (tid == 31) { const int end = ps + (((T[TB_TOTAL / 4 + 31] + 255) >> 8) << 8); T[TB_PADST / 4 + 32] = end; T[TB_NTL / 4] = end >> 8; } }
    __syncthreads();
    { LAS unsigned char* t2e = (LAS unsigned char*)(F.lds + TAB_OFF + TB_T2E); const int ntl = T[TB_NTL / 4];
      for (int rt = tid; rt < ntl; rt += NTHR) { int e = 0;
#pragma nounroll
          for (int ee = 1; ee < 32; ++ee) e += (T[TB_PADST / 4 + ee] <= rt * 256) ? 1 : 0;
          t2e[rt] = (unsigned char)e; } }
    __syncthreads();
}
__device__ __forceinline__ void scatter_phase(Frame& F, const Args& a) {
    const bf16_t* hb = (const bf16_t*)(a.ws + WS_HB); unsigned char* xs = (unsigned char*)(a.ws + WS_XS);
    const int* topi = (const int*)(a.ws + WS_TOPI); const float* gate = (const float*)(a.ws + WS_GATE);
    int* slot = (int*)(a.ws + WS_SLOT); float* rowg = (float*)(a.ws + WS_ROWG);
    LAS int* T = (LAS int*)(F.lds + TAB_OFF); LAS int* rows = (LAS int*)(F.lds + XTRA_OFF);
    const int tid = F.tid, lane = F.lane, w = F.wave;
    if (F.bid >= NGRP) moe_tables(F, a, -1);
    for (int grp2 = F.bid; grp2 < NGRP * PM(7); grp2 += F.G) { const int grp = grp2 % NGRP;
        moe_tables(F, a, grp);
        { const int tok = grp * 128 + (tid >> 2), k = tid & 3; const int e = topi[(size_t)tok * 4 + k];
          const int rank = atomicAdd((int*)&T[TB_LCUR / 4 + e], 1); const int row = T[TB_BASE / 4 + e] + rank;
          slot[(size_t)tok * 4 + k] = row; rowg[row] = gate[(size_t)tok * 4 + k]; rows[tid] = row; }
        __syncthreads();
        for (int i = 0; i < 16; ++i) { const int tl = w * 16 + i; const size_t tok = (size_t)grp * 128 + tl;
            float x[16]; ln_row16(hb + tok * DM, x, lane);
            const u32x2 p = pg8::pack8_fp8((f32x4){x[0], x[1], x[2], x[3]}, (f32x4){x[4], x[5], x[6], x[7]}), q = pg8::pack8_fp8((f32x4){x[8], x[9], x[10], x[11]}, (f32x4){x[12], x[13], x[14], x[15]});
#pragma unroll
            for (int k = 0; k < 4; ++k) { const size_t row = (size_t)rows[tl * 4 + k]; *(u32x2*)(xs + row * DM + 8 * lane) = p; *(u32x2*)(xs + row * DM + 512 + 8 * lane) = q; } }
        __syncthreads();
    }
}
__device__ __forceinline__ void combine_phase(Frame& F, const Args& a) {
    const bf16_t* hb = (const bf16_t*)(a.ws + WS_HB); const bf16_t* yb = (const bf16_t*)(a.ws + WS_XS); bf16_t* mid = (bf16_t*)(a.ws + WS_MIDB);
    const int* slot = (const int*)(a.ws + WS_SLOT);
    const int lane = F.lane;
    for (int tok2 = F.bid * NWAVES + F.wave; tok2 < NTOK * PM(10); tok2 += F.G * NWAVES) { const int tok = tok2 % NTOK;
        float x[16]; ln_row16(hb + (size_t)tok * DM, x, lane);
#pragma unroll
        for (int j = 0; j < 16; ++j) x[j] *= ALPHA;
        const int4 sl = *(const int4*)(slot + (size_t)tok * 4);
        const int s4[4] = {sl.x, sl.y, sl.z, sl.w};
#pragma unroll
        for (int k = 0; k < 4; ++k) {
            if (Y_FP8) { const unsigned char* yr = (const unsigned char*)yb + (size_t)s4[k] * DM;
                const u32x2 p = *(const u32x2*)(yr + 8 * lane), q = *(const u32x2*)(yr + 512 + 8 * lane);
                const unsigned w4[4] = {p.x, p.y, q.x, q.y};
#pragma unroll
                for (int i = 0; i < 4; ++i) { const f32x2 lo = __builtin_amdgcn_cvt_pk_f32_fp8((int)w4[i], false), hi2 = __builtin_amdgcn_cvt_pk_f32_fp8((int)w4[i], true);
                    x[4 * i + 0] += lo.x * 0.0625f; x[4 * i + 1] += lo.y * 0.0625f; x[4 * i + 2] += hi2.x * 0.0625f; x[4 * i + 3] += hi2.y * 0.0625f; } }
            else { float y[16]; ln_row16(yb + (size_t)s4[k] * DM, y, lane);
#pragma unroll
                for (int j = 0; j < 16; ++j) x[j] += y[j]; } }
        store16bf(mid + (size_t)tok * DM, x, lane); store16f8((unsigned char*)(a.ws + WS_MIDQ) + (size_t)tok * DM, x, lane);
    }
}
__device__ __forceinline__ void ln2_phase(Frame& F, const Args& a, int layer) {
    const bf16_t* t2 = (const bf16_t*)(a.ws + WS_T1); bf16_t* xb = (bf16_t*)(a.ws + WS_XB);
    const float* g = a.in[18] + layer * DM; const float* bta = a.in[19] + layer * DM;
    const int lane = F.lane;
    for (int tok2 = F.bid * NWAVES + F.wave; tok2 < NTOK * PM(12); tok2 += F.G * NWAVES) { const int tok = tok2 % NTOK;
        float x[16]; ln_row16(t2 + (size_t)tok * DM, x, lane); ln_norm16(x, g, bta, lane);
        if (layer == 0) { store16bf(xb + (size_t)tok * DM, x, lane); if (FP8_IN1) store16f8((unsigned char*)(a.ws + WS_XQ) + (size_t)tok * DM, x, lane); }
        else { float* o = a.out + (size_t)tok * DM;
            *(f32x4*)(o + 8 * lane) = (f32x4){x[0], x[1], x[2], x[3]}; *(f32x4*)(o + 8 * lane + 4) = (f32x4){x[4], x[5], x[6], x[7]};
            *(f32x4*)(o + 512 + 8 * lane) = (f32x4){x[8], x[9], x[10], x[11]}; *(f32x4*)(o + 512 + 8 * lane + 4) = (f32x4){x[12], x[13], x[14], x[15]}; }
    }
}

__global__ void __launch_bounds__(NTHR, 2) __attribute__((target("no-packed-fp32-ops"))) hybrid_fwd(Args args) {
    extern __shared__ __attribute__((aligned(16))) unsigned char lds_raw[];
    Frame F;
    F.lds = (LAS unsigned char*)lds_raw;
    F.tid = threadIdx.x; F.lane = F.tid & 63; F.wave = __builtin_amdgcn_readfirstlane(F.tid >> 6); F.G = gridDim.x; F.bid = blockIdx.x;
    volatile LAS unsigned* MISC = (volatile LAS unsigned*)(F.lds + MISC_OFF);
    for (int u = F.tid; u < 128; u += NTHR) MISC[u] = 0u;
    __syncthreads();
    XcdBarrier bar = xcd_barrier_post((unsigned*)(args.ws + WS_CTL) + 4096, MISC + 8);
    const int lo = args.ph_lo; int ph = 0; (void)lo; (void)ph;
#ifndef PHMASK
#define PHMASK 0xfffff
#endif
#ifndef PROBE_DUP
#define PROBE_DUP 0
#endif
#define SITE(k) if constexpr ((PHMASK >> (k)) & 1)
typedef const __attribute__((address_space(4))) Args* KArgs;
#define PHASE_REFRESH int t_ = threadIdx.x; asm volatile("" : "+v"(t_)); F.tid = t_; F.lane = t_ & 63; F.wave = __builtin_amdgcn_readfirstlane(t_ >> 6); \
    { int b_ = blockIdx.x; asm volatile("" : "+s"(b_)); F.bid = b_; } \
    { unsigned l_ = 0; asm volatile("" : "+s"(l_)); F.lds = (LAS unsigned char*)lds_raw + l_; } LAS unsigned char* const ring = F.lds; \
    LOAD_ARGS unsigned char* const ws = A.ws;
#if defined(__HIP_DEVICE_COMPILE__)
#define LOAD_ARGS KArgs ap_ = (KArgs)__builtin_amdgcn_kernarg_segment_ptr(); asm volatile("" : "+s"(ap_)); const Args A = *ap_;
#else
#define LOAD_ARGS const Args A = args;
#endif
#ifdef MK_LAUNCHES_PER_PHASE
#define PHASE_BEGIN if (ph == lo) { PHASE_REFRESH
#define PHASE_END   } ++ph;
#define PHASE_END_LAST } ++ph;
#else
#define PHASE_BEGIN { PHASE_REFRESH
#ifdef PROBE_BAR2
#define PHASE_END   xcd_barrier(bar); xcd_barrier(bar); }
#else
#define PHASE_END   xcd_barrier(bar); }
#endif
#define PHASE_END_LAST if (layer == 0) xcd_barrier(bar); }
#endif
    using namespace pg8;

    PHASE_BEGIN SITE(0) p0_prologue(F, A); PHASE_END

    for (int layer = 0; layer < 2; ++layer) {
        PHASE_BEGIN
        SITE(1) {
        if (layer == 0) {
            SITE(16) { DenseOrder S; S.initp(ws + (FP8_IN0 ? WS_XQ : WS_XB), ws + WS_WIN0, NTOK, ZE, FP8_IN0 ? DM : 2 * DM, F.G, F.bid, PM(1)); EpiIn0 E{(bf16_t*)(ws + WS_Z), 0.125f * LOG2E}; int p8 = FP8_IN0 ? DM : 2 * DM; asm volatile("" : "+s"(p8)); gemm_phase<EpiIn0, DenseOrder, FP8_IN0 != 0>(ring, F.tid, p8, S, E); }
            SITE(17) { PleOrder S; S.D.init(ws + WS_PB, ws + WS_WPLE, 2 * NTOK, DM, PLE, F.G, F.bid, PM(1));
              int kple = 2 * PLE; asm volatile("" : "+s"(kple));
              EpiPlain E{(bf16_t*)(ws + WS_PPLE), DM}; gemm_phase(ring, F.tid, kple, S, E); }
        } else {
            SITE(18) { DenseOrder S; S.initp(ws + (FP8_IN1 ? WS_XQ : WS_XB), ws + WS_WIN1, NTOK, ZO, FP8_IN1 ? DM : 2 * DM, F.G, F.bid, PM(1)); EpiIn1 E{(bf16_t*)(ws + WS_Z), (bf16_t*)(ws + WS_KV1), (bf16_t*)(ws + WS_KI1)}; int p8 = FP8_IN1 ? DM : 2 * DM; asm volatile("" : "+s"(p8)); gemm_phase<EpiIn1, DenseOrder, FP8_IN1 != 0>(ring, F.tid, p8, S, E); }
        }
        }
        PHASE_END
        PHASE_BEGIN
        if (layer == 0) {
            SITE(2) for (long L = F.bid; L < 1024 * PM(2); L += F.G) { const int v = (int)(L & 255), rnd = (int)((L >> 8) & 3), s = v & 3, bh = v >> 2;
                const int qb = rnd == 0 ? 15 - s : (rnd == 1 ? 8 + s : (rnd == 2 ? 7 - s : s));
                sb_unit(F, A, bh >> 3, bh & 7, qb); }
            SITE(3) for (int u = F.bid; u < PM(3) * NTOK / 128; u += F.G) gmlp_unit(F, A, u % (NTOK / 128));
        } else {
            SITE(4) for (int L = F.bid; L < PM(4) * NTOK / 8; L += F.G) { const int Lm = L % (NTOK / 8), r = Lm >> 8, cc = Lm & 255;
                const int j = (r & 1) ? 511 - cc : cc; dsa_select_unit(F, A, (r >> 1) * 512 + j); }
        }
        PHASE_END
        if (layer == 1) {
        PHASE_BEGIN
            SITE(13) for (int L = F.bid; L < 1024 * PM(13); L += F.G) { const int idx = L & 1023, pp = idx & 31, g = (idx >> 5) & 3, b = idx >> 7;
                dsa_attn_unit(F, A, b, 63 - pp, g); dsa_attn_unit(F, A, b, pp, g); }
        PHASE_END
        }
        PHASE_BEGIN
        SITE(5) { DenseOrder S; S.initp(ws + WS_CAT, ws + (layer == 0 ? WS_WO0 : WS_WO1), NTOK, DM, FP8_OUT ? DM : 2 * DM, F.G, F.bid, PM(5));
          EpiOut E{layer == 0 ? A.in[0] : nullptr, (const bf16_t*)(ws + WS_XB), (bf16_t*)(ws + WS_T1)}; int p8 = FP8_OUT ? DM : 2 * DM; asm volatile("" : "+s"(p8)); gemm_phase<EpiOut, DenseOrder, FP8_OUT != 0>(ring, F.tid, p8, S, E); }
        PHASE_END
        PHASE_BEGIN SITE(6) ln1_router_phase(F, A, layer); PHASE_END
        PHASE_BEGIN SITE(7) scatter_phase(F, A); PHASE_END
        PHASE_BEGIN
        SITE(8) {
#ifdef MK_LAUNCHES_PER_PHASE
          moe_tables(F, A, -1);
#endif
          const int ntl = __builtin_amdgcn_readfirstlane(((LAS int*)(F.lds + TAB_OFF))[TB_NTL / 4]);
          MoeOrder<8, true> S; S.nunits = ntl * 8; S.G = F.G; S.c = F.bid; S.rep = PM(8); S.t2e = (const LAS unsigned char*)(F.lds + TAB_OFF + TB_T2E);
          S.A = (const char*)(ws + WS_XS); S.W = (const char*)(ws + WS_WGU) + (size_t)layer * 32 * 2048 * DM;
          EpiSwiglu E{(unsigned char*)(ws + WS_ACT), A.in[15] + (size_t)layer * 32 * 2048}; int p8 = DM; asm volatile("" : "+s"(p8)); gemm_phase<EpiSwiglu, MoeOrder<8, true>, true, MOE_ALIGN>(ring, F.tid, p8, S, E); }
        PHASE_END
        PHASE_BEGIN
        SITE(9) {
#ifdef MK_LAUNCHES_PER_PHASE
          moe_tables(F, A, -1);
#endif
          const int ntl = __builtin_amdgcn_readfirstlane(((LAS int*)(F.lds + TAB_OFF))[TB_NTL / 4]);
          MoeOrder<4, false> S; S.nunits = ntl * 4; S.G = F.G; S.c = F.bid; S.rep = PM(9); S.t2e = (const LAS unsigned char*)(F.lds + TAB_OFF + TB_T2E);
          S.A = (const char*)(ws + WS_ACT); S.W = (const char*)(ws + WS_WD) + (size_t)layer * 32 * DM * DM;
          EpiDown E{(bf16_t*)(ws + WS_XS), A.in[17] + (size_t)layer * 32 * DM, (const float*)(ws + WS_ROWG)}; int p8 = DM; asm volatile("" : "+s"(p8)); gemm_phase<EpiDown, MoeOrder<4, false>, true, MOE_ALIGN>(ring, F.tid, p8, S, E); }
        PHASE_END
        PHASE_BEGIN SITE(10) combine_phase(F, A); PHASE_END
        PHASE_BEGIN
        SITE(11) { DenseOrder S; S.initp(ws + (FP8_GATE ? WS_MIDQ : WS_MIDB), ws + WS_WG + (size_t)layer * DM * DM * (FP8_GATE ? 1 : 2), NTOK, DM, FP8_GATE ? DM : 2 * DM, F.G, F.bid, PM(11));
          EpiGate E{(const bf16_t*)(ws + WS_MIDB), (const bf16_t*)(ws + WS_PPLE) + (size_t)layer * NTOK * DM, A.in[22] + layer * DM, (bf16_t*)(ws + WS_T1)}; int p8 = FP8_GATE ? DM : 2 * DM; asm volatile("" : "+s"(p8)); gemm_phase<EpiGate, DenseOrder, FP8_GATE != 0>(ring, F.tid, p8, S, E); }
        PHASE_END
        PHASE_BEGIN SITE(12) ln2_phase(F, A, layer); PHASE_END_LAST
    }
#undef PHASE_BEGIN
#undef PHASE_END
#undef PHASE_END_LAST
}
constexpr int N_PHASES = 22;

extern "C" void kernel_launch(void* const* d_in, const int* in_sizes, int n_in, void* d_out, int out_size, void* d_ws, size_t ws_size, hipStream_t stream) {
    static int grid = 0;
    if (grid == 0) {
        if (n_in != 23 || out_size != NTOK * DM || ws_size < WS_END) { fprintf(stderr, "kernel_launch: unexpected problem: n_in %d out %d ws %zu (need %zu)\n", n_in, out_size, ws_size, (size_t)WS_END); grid = -1; return; }
        int dev = 0, cus = 0, per_cu = 0;
        if (hipGetDevice(&dev) != hipSuccess || hipDeviceGetAttribute(&cus, hipDeviceAttributeMultiprocessorCount, dev) != hipSuccess) { grid = -1; return; }
        if (hipFuncSetAttribute((const void*)hybrid_fwd, hipFuncAttributeMaxDynamicSharedMemorySize, LDS_BYTES) != hipSuccess) { fprintf(stderr, "kernel_launch: hipFuncSetAttribute failed\n"); grid = -1; return; }
        if (hipOccupancyMaxActiveBlocksPerMultiprocessor(&per_cu, (const void*)hybrid_fwd, NTHR, LDS_BYTES) != hipSuccess || per_cu < 1) fprintf(stderr, "kernel_launch: occupancy query says %d\n", per_cu);
        (void)hipGetLastError();
        grid = cus;
    }
    if (grid < 0) return;
    (void)hipMemsetAsync((char*)d_ws + WS_CTL, 0, CTL_ZERO_BYTES, stream);
    Args a{};
    for (int i = 0; i < 23; ++i) a.in[i] = (const float*)d_in[i];
    a.out = (float*)d_out; a.ws = (unsigned char*)d_ws;
#ifndef MK_LAUNCHES_PER_PHASE
    a.ph_lo = 0; a.ph_hi = N_PHASES;
    hipLaunchKernelGGL(hybrid_fwd, dim3(grid), dim3(NTHR), LDS_BYTES, stream, a);
#else
    for (int p = 0; p < N_PHASES; ++p) { a.ph_lo = p; a.ph_hi = p + 1; hipLaunchKernelGGL(hybrid_fwd, dim3(grid), dim3(NTHR), LDS_BYTES, stream, a); }
#endif
}
```

```cpp
#include <hip/hip_runtime.h>
#include <cstdio>
#include <cstdint>

#define LAS __attribute__((address_space(3)))
#define GAS __attribute__((address_space(1)))
typedef unsigned short bf16_t;
typedef short bf16x8 __attribute__((ext_vector_type(8)));
typedef short s16x4 __attribute__((ext_vector_type(4)));
typedef float f32x2 __attribute__((ext_vector_type(2)));
typedef float f32x4 __attribute__((ext_vector_type(4)));
typedef float f32x16 __attribute__((ext_vector_type(16)));
typedef unsigned u32x2 __attribute__((ext_vector_type(2)));
typedef unsigned u32x4 __attribute__((ext_vector_type(4)));

constexpr int DM = 1024, NB = 8, SEQ = 4096, NTOK = NB * SEQ;
constexpr int ZE = 2560;
constexpr int ZO = 2304, ZO_REAL = 2120;
constexpr int OQ = 0, OK_ = 1024, OV = 1280, OQI = 1536, OKI = 2048, OWI = 2112;
constexpr int NEXP = 32, PLE = 256;
constexpr int NGRP = NTOK / 128;
constexpr int MAXTILES = NTOK * 4 / 256 + NEXP;
constexpr int MAXROWS = MAXTILES * 256;
constexpr float LN_EPS = 1e-5f;
constexpr float ALPHA = 1.4142135623730951f;
constexpr float LOG2E = 1.4426950408889634f;
constexpr float WSC = 64.f, WSC_INV = 1.f / 64.f;

#ifndef FP8_IN0
#define FP8_IN0 1
#endif
#ifndef Y_FP8
#define Y_FP8 1
#endif
#ifndef MOE_ALIGN
#define MOE_ALIGN true
#endif
#ifndef FP8_IN1
#define FP8_IN1 0
#endif
#ifndef FP8_OUT
#define FP8_OUT 1
#endif
#ifndef FP8_GATE
#define FP8_GATE 1
#endif
#ifndef PROBE_DUP
#define PROBE_DUP 0
#endif
#define PM(k) (((PROBE_DUP >> (k)) & 1) ? 2 : 1)

constexpr size_t MiB = 1u << 20;
constexpr size_t WS_CTL = 0, CTL_ZERO_BYTES = 1 * MiB;
constexpr size_t WS_WRT = 1 * MiB;
constexpr size_t WS_WSB = WS_WRT + 256 * 1024;
constexpr size_t WS_CNT = WS_WSB + 256 * 1024;
constexpr size_t WS_TOPI = 2 * MiB;
constexpr size_t WS_GATE = WS_TOPI + 512 * 1024;
constexpr size_t WS_SLOT = 3 * MiB;
constexpr size_t WS_ROWG = WS_SLOT + 512 * 1024;
constexpr size_t WS_WIN0 = 8 * MiB, WS_WO0 = 13 * MiB, WS_WIN1 = 15 * MiB, WS_WO1 = 20 * MiB, WS_WG = 22 * MiB, WS_WPLE = 26 * MiB;
constexpr size_t WS_WGU = 32 * MiB, WS_WD = 288 * MiB;
constexpr size_t WS_XB = 416 * MiB, WS_PB = 480 * MiB, WS_PPLE = 512 * MiB, WS_Z = 640 * MiB, WS_CAT = 800 * MiB, WS_T1 = 864 * MiB;
constexpr size_t WS_BM = 1328 * MiB;
constexpr size_t WS_KV1 = WS_BM + 16 * MiB;
constexpr size_t WS_KI1 = WS_KV1 + 32 * MiB;
constexpr size_t WS_HB = 928 * MiB, WS_MIDB = 992 * MiB, WS_XS = 1056 * MiB, WS_ACT = 1328 * MiB;
constexpr size_t WS_XQ = 1600 * MiB, WS_MIDQ = 1632 * MiB, WS_END = 1664 * MiB;
static_assert(WS_ROWG + (size_t)MAXROWS * 4 <= WS_WIN0, "small buffers");
static_assert(WS_XS + (size_t)MAXROWS * DM * 2 <= WS_ACT && WS_ACT + (size_t)MAXROWS * DM * 2 <= WS_END, "moe buffers");

constexpr int RING_BYTES = 131072;
constexpr int MISC_OFF = RING_BYTES;
constexpr int TAB_OFF = MISC_OFF + 512;
constexpr int XTRA_OFF = TAB_OFF + 6144;
constexpr int LDS_BYTES = 147456;
static_assert(XTRA_OFF + 8192 <= LDS_BYTES, "LDS map");
constexpr int TB_TOT16 = 0, TB_BEF16 = 2048, TB_TOTAL = 4096, TB_BEFORE = 4224, TB_PADST = 4352  , TB_NTL = 4488, TB_LCUR = 4608  , TB_BASE = 4736  , TB_T2E = 5120  ;
static_assert(TB_T2E + 544 <= 6144, "tab");

#define RLX_AGENT __ATOMIC_RELAXED, __HIP_MEMORY_SCOPE_AGENT
typedef __bf16 bf16x2_t __attribute__((ext_vector_type(2)));
__device__ __forceinline__ unsigned cvt_pk_bf16(float lo, float hi) { const f32x2 v = {lo, hi}; const bf16x2_t b = __builtin_convertvector(v, bf16x2_t); return __builtin_bit_cast(unsigned, b); }
__device__ __forceinline__ unsigned char f8_1(float v) { return (unsigned char)(__builtin_amdgcn_cvt_pk_fp8_f32(v, v, 0, false) & 0xff); }
#if FP8_OUT
#define CAT_ST(cat, idx, v) ((cat)[idx] = f8_1(v))
#else
#define CAT_ST(cat, idx, v) (((bf16_t*)(cat))[idx] = (bf16_t)(cvt_pk_bf16((v), 0.f) & 0xffffu))
#endif
__device__ __forceinline__ float bf_lo(unsigned u) { return __uint_as_float(u << 16); }
__device__ __forceinline__ float bf_hi(unsigned u) { return __uint_as_float(u & 0xffff0000u); }
__device__ __forceinline__ float bf1(bf16_t u) { return __uint_as_float(((unsigned)u) << 16); }
template <int K> __device__ __forceinline__ int sxi(int v) {
    if constexpr (K == 32) { const auto rr = __builtin_amdgcn_permlane32_swap((unsigned)v, (unsigned)v, false, false); return (int)(rr[0] ^ rr[1] ^ (unsigned)v); }
    else return __builtin_amdgcn_ds_swizzle(v, (K << 10) | 0x1f);
}
template <int K> __device__ __forceinline__ float sxf(float v) { return __int_as_float(sxi<K>(__float_as_int(v))); }
__device__ __forceinline__ float wave_sum(float x) {
    int v = __float_as_int(x);
#define WSF_STEP(ctrl, rm) { const int o = __builtin_amdgcn_update_dpp(0, v, ctrl, rm, 0xf, false); v = __float_as_int(__int_as_float(v) + __int_as_float(o)); }
    WSF_STEP(0x111, 0xf) WSF_STEP(0x112, 0xf) WSF_STEP(0x114, 0xf) WSF_STEP(0x118, 0xf) WSF_STEP(0x142, 0xa) WSF_STEP(0x143, 0xc)
#undef WSF_STEP
    return __int_as_float(__builtin_amdgcn_readlane(v, 63));
}
__device__ __forceinline__ float wave_max(float v) {
    v = fmaxf(v, sxf<1>(v)); v = fmaxf(v, sxf<2>(v)); v = fmaxf(v, sxf<4>(v)); v = fmaxf(v, sxf<8>(v)); v = fmaxf(v, sxf<16>(v)); v = fmaxf(v, sxf<32>(v));
    return v;
}
__device__ __forceinline__ float wave_min(float v) {
    v = fminf(v, sxf<1>(v)); v = fminf(v, sxf<2>(v)); v = fminf(v, sxf<4>(v)); v = fminf(v, sxf<8>(v)); v = fminf(v, sxf<16>(v)); v = fminf(v, sxf<32>(v));
    return v;
}
__device__ __forceinline__ int wave_sumi(int v) {
    v += sxi<1>(v); v += sxi<2>(v); v += sxi<4>(v); v += sxi<8>(v); v += sxi<16>(v); v += sxi<32>(v);
    return v;
}
__device__ __forceinline__ int wave_sum_uniform(int v) {
    v += __builtin_amdgcn_update_dpp(0, v, 0x111, 0xf, 0xf, false);
    v += __builtin_amdgcn_update_dpp(0, v, 0x112, 0xf, 0xf, false);
    v += __builtin_amdgcn_update_dpp(0, v, 0x114, 0xf, 0xf, false);
    v += __builtin_amdgcn_update_dpp(0, v, 0x118, 0xf, 0xf, false);
    v += __builtin_amdgcn_update_dpp(0, v, 0x142, 0xa, 0xf, false);
    v += __builtin_amdgcn_update_dpp(0, v, 0x143, 0xc, 0xf, false);
    return __builtin_amdgcn_readlane(v, 63);
}
__device__ __forceinline__ float wave_max_uniform(float x) {
    int v = __float_as_int(x);
#define WMX_STEP(ctrl, rm) { const int o = __builtin_amdgcn_update_dpp(v, v, ctrl, rm, 0xf, false); v = __float_as_int(fmaxf(__int_as_float(v), __int_as_float(o))); }
    WMX_STEP(0x111, 0xf) WMX_STEP(0x112, 0xf) WMX_STEP(0x114, 0xf) WMX_STEP(0x118, 0xf) WMX_STEP(0x142, 0xa) WMX_STEP(0x143, 0xc)
#undef WMX_STEP
    return __int_as_float(__builtin_amdgcn_readlane(v, 63));
}
__device__ __forceinline__ float relu_i(float x) { const int i = __float_as_int(x); return __int_as_float(i > 0 ? i : 0); }
__device__ __forceinline__ float ex2(float x) { return __builtin_amdgcn_exp2f(x); }
__device__ __forceinline__ float lg2(float x) { return __builtin_amdgcn_logf(x); }
__device__ __forceinline__ float rcpf_(float x) { return __builtin_amdgcn_rcpf(x); }
__device__ __forceinline__ float sigmoidf_(float x) { return rcpf_(1.f + ex2(-LOG2E * x)); }
__device__ __forceinline__ float gelu_tanh(float x) { return x * rcpf_(1.f + ex2(-2.302208198f * (x + 0.044715f * x * x * x))); }

namespace pg8 {
constexpr int BM = 256, BK = 64, HALF = 128, HTB = HALF * BK * 2, STAGE_BYTES = 8 * HTB, NXCD = 8, WGM = 8;
__host__ __device__ __forceinline__ int lds_byte(int r, int c) { const int st = (r >> 4) * 2 + (c >> 5), rr = r & 15, cc = c & 31, ob = rr * 64 + cc * 2; return st * 1024 + (ob ^ (((ob >> 9) & 1) << 5)); }
__host__ __device__ __forceinline__ void stage_rc(int b, int& R, int& C) { const int st = b / 1024, sb = b % 1024, swz = sb ^ (((sb >> 9) & 1) << 5); R = (st >> 1) * 16 + swz / 64; C = (st & 1) * 32 + (swz % 64) / 2; }
__host__ __device__ __forceinline__ int perm32(int rho) { const int n = rho >> 4, i = rho & 15; return 8 * (i >> 2) + 4 * n + (i & 3); }

struct Unit { int pm, pn, e; const char* b0; };
typedef int v8i_t __attribute__((ext_vector_type(8)));
typedef int v4i_t __attribute__((ext_vector_type(4)));
__device__ __forceinline__ v8i_t cat8(const bf16x8 a, const bf16x8 b) { const v4i_t x = __builtin_bit_cast(v4i_t, a), y = __builtin_bit_cast(v4i_t, b); return __builtin_shufflevector(x, y, 0, 1, 2, 3, 4, 5, 6, 7); }

struct DenseOrder {
    int nM, nN, nwg, G, c, rep; const char* A; const char* B; size_t tstep, hstep;
    __device__ __forceinline__ void init(const void* A_, const void* B_, int M, int N, int K, int G_, int c_, int rep_ = 1) { initp(A_, B_, M, N, 2 * K, G_, c_, rep_); }
    __device__ __forceinline__ void initp(const void* A_, const void* B_, int M, int N, int pitch, int G_, int c_, int rep_ = 1) { A = (const char*)A_; B = (const char*)B_; nM = M / BM; nN = N / BM; nwg = nM * nN; G = G_; c = c_; rep = rep_; hstep = (size_t)HALF * pitch; tstep = 2 * hstep; }
    __device__ __forceinline__ bool next(int i, Unit& u) const {
        long L = (long)i * G + c; if (L >= (long)nwg * rep) return false; if (L >= nwg) L -= nwg;
        int wgid = (int)L; { const int q = nwg / NXCD, r = nwg % NXCD, xcd = wgid % NXCD, off = wgid / NXCD; wgid = (xcd < r ? xcd * (q + 1) : r * (q + 1) + (xcd - r) * q) + off; }
        const int nig = WGM * nN, gid = wgid / nig, fm = gid * WGM, gsz = (nM - fm) < WGM ? (nM - fm) : WGM;
        u.pm = fm + ((wgid % nig) % gsz); u.pn = (wgid % nig) / gsz; u.e = 0;
        u.b0 = B + (size_t)u.pn * tstep; return true;
    }
    __device__ __forceinline__ const char* aptr(const Unit& u) const { return A + (size_t)u.pm * tstep; }
    __device__ __forceinline__ size_t b1off() const { return hstep; }
};
struct PleOrder {
    DenseOrder D;
    __device__ __forceinline__ bool next(int i, Unit& u) const { if (!D.next(i, u)) return false; if (u.pm >= 32768 / BM) u.b0 += (size_t)1024 * 256 * 2; return true; }
    __device__ __forceinline__ const char* aptr(const Unit& u) const { return D.aptr(u); }
    __device__ __forceinline__ size_t b1off() const { return D.b1off(); }
};
template <int NT, bool SWIGLU>
struct MoeOrder {
    int nunits, G, c, rep; const LAS unsigned char* t2e; const char* A; const char* W;
    static constexpr size_t hstep = (size_t)HALF * 1024, tstep = 2 * hstep;
    __device__ __forceinline__ bool next(int i, Unit& u) const {
        const int vc = ((G & 7) == 0) ? (c & 7) * (G >> 3) + (c >> 3) : c;
        int L = i * G + vc; if (L >= nunits * rep) return false; if (L >= nunits) L -= nunits;
        const int rt = L / NT, pn = L % NT;
        const int e = __builtin_amdgcn_readfirstlane((int)t2e[rt]);
        u.pm = rt; u.pn = pn; u.e = e;
        if (SWIGLU) u.b0 = W + (size_t)e * (16 * hstep) + (size_t)pn * hstep;
        else u.b0 = W + (size_t)e * (8 * hstep) + (size_t)pn * tstep;
        return true;
    }
    __device__ __forceinline__ const char* aptr(const Unit& u) const { return A + (size_t)u.pm * tstep; }
    __device__ __forceinline__ size_t b1off() const { return SWIGLU ? 8 * hstep : hstep; }
};

template <class Epi, class Sched, bool FP8 = false, bool ALIGN_EPI = true>
__device__ __forceinline__ void gemm_phase(LAS unsigned char* lds, const int tid, const int pitch, const Sched& S, const Epi& E) {
    const int wid = __builtin_amdgcn_readfirstlane(tid >> 6), lane = tid & 63, wr = wid >> 2, wc = wid & 3, fr = lane & 15, fq = lane >> 4;
    const int nt = pitch / (BK * 2);
    unsigned voffA[2], voffB[2];
#pragma unroll
    for (int i = 0; i < 2; ++i) { int R, C; stage_rc(tid * 16 + i * 8192, R, C); const int Rb = (R & ~31) + perm32(R & 31);
        voffA[i] = (unsigned)(R * pitch + C * 2); voffB[i] = (unsigned)(Rb * pitch + C * 2); }
    const size_t kstep = (size_t)(BK * 2);
    const size_t hstep = (size_t)HALF * pitch;
    const unsigned ldsw = (unsigned)wid * 1024u;
    int sc127 = 127; asm volatile("" : "+v"(sc127));
    const unsigned ldsu = (unsigned)__builtin_amdgcn_readfirstlane((int)(unsigned)(uintptr_t)lds) + ldsw;
    const int aoff = lds_byte(wr * 64 + fr, fq * 8), boff = lds_byte(wc * 32 + fr, fq * 8);
#define PG8_SA(b, h) (((b) * 2 + (h)) * HTB)
#define PG8_SB(b, h) ((4 + (b) * 2 + (h)) * HTB)
#define PG8_STAGE(bufoff, gbase, voff) do { _Pragma("unroll") for (int _i = 0; _i < 2; ++_i) { unsigned _keep; \
        asm volatile("s_mov_b32 %0, m0\n\ts_mov_b32 m0, %3\n\ts_nop 0\n\tglobal_load_lds_dwordx4 %1, %2\n\ts_mov_b32 m0, %0" : "=&s"(_keep) : "v"((voff)[_i]), "s"((const char*)(gbase)), "s"(ldsu + (unsigned)((bufoff) + _i * 8192)) : "memory"); } } while (0)
#define PG8_LDA(dst, b, h) do { _Pragma("unroll") for (int m = 0; m < 4; ++m) _Pragma("unroll") for (int k = 0; k < 2; ++k) dst[m][k] = *(const LAS bf16x8*)(lds + PG8_SA(b, h) + aoff + m * 2048 + k * 1024); } while (0)
#define PG8_LDB(dst, b, h) do { _Pragma("unroll") for (int n = 0; n < 2; ++n) _Pragma("unroll") for (int k = 0; k < 2; ++k) dst[n][k] = *(const LAS bf16x8*)(lds + PG8_SB(b, h) + boff + n * 2048 + k * 1024); } while (0)
#define PG8_MMA(ai, bj, At, Bt) do { __builtin_amdgcn_s_setprio(1); _Pragma("unroll") for (int m = 0; m < 4; ++m) _Pragma("unroll") for (int n = 0; n < 2; ++n) { \
        if constexpr (FP8) { const v8i_t _a = cat8(Bt[n][0], Bt[n][1]), _b = cat8(At[m][0], At[m][1]); \
            asm volatile("v_mfma_scale_f32_16x16x128_f8f6f4 %0, %1, %2, %0, %3, %3 op_sel_hi:[0,0,0]" : "+v"(acc[ai][bj][m][n]) : "v"(_a), "v"(_b), "v"(sc127)); } \
        else { _Pragma("unroll") for (int k = 0; k < 2; ++k) acc[ai][bj][m][n] = __builtin_amdgcn_mfma_f32_16x16x32_bf16(Bt[n][k], At[m][k], acc[ai][bj][m][n], 0, 0, 0); } } __builtin_amdgcn_s_setprio(0); } while (0)
#define PG8_WAIT_V(n) asm volatile("s_waitcnt vmcnt(" #n ")" ::: "memory")
#define PG8_WAIT_L(n) asm volatile("s_waitcnt lgkmcnt(" #n ")" ::: "memory")
#define PG8_BAR __builtin_amdgcn_s_barrier()
#define PG8_SCHED __builtin_amdgcn_sched_barrier(0)
    Unit cur, nxt; int ui = 0;
    if (!S.next(0, cur)) return;
    f32x4 acc[2][2][4][2];
#pragma unroll
    for (int a = 0; a < 2; ++a)
#pragma unroll
        for (int b = 0; b < 2; ++b)
#pragma unroll
            for (int m = 0; m < 4; ++m)
#pragma unroll
                for (int n = 0; n < 2; ++n) acc[a][b][m][n] = (f32x4){0.f, 0.f, 0.f, 0.f};
    bf16x8 At[4][2], B0[2][2], B1[2][2];
    const char* cA = S.aptr(cur); const char* cB0 = cur.b0; const char* cB1 = cB0 + S.b1off();
    PG8_STAGE(PG8_SB(0, 0), cB0, voffB); PG8_STAGE(PG8_SB(0, 1), cB1, voffB); PG8_STAGE(PG8_SA(0, 0), cA, voffA); PG8_STAGE(PG8_SA(0, 1), cA + hstep, voffA);
    if (wr == 1) PG8_BAR;
    PG8_WAIT_V(2); PG8_BAR;
    PG8_STAGE(PG8_SB(1, 0), cB0 + kstep, voffB); PG8_STAGE(PG8_SA(1, 0), cA + kstep, voffA); PG8_STAGE(PG8_SB(1, 1), cB1 + kstep, voffB);
    PG8_WAIT_V(6); PG8_BAR;
    for (;;) {
        const bool has_next = S.next(ui + 1, nxt);
        const char* nA = has_next ? S.aptr(nxt) : cA; const char* nB0 = has_next ? nxt.b0 : cB0; const char* nB1 = nB0 + S.b1off();
        for (int t = 0; t < nt; t += 2) {
            const bool last = (t == nt - 2);
            const char* a1 = cA + (size_t)(t + 1) * kstep;
            const char* a2 = last ? nA : cA + (size_t)(t + 2) * kstep;
            const char* b20 = last ? nB0 : cB0 + (size_t)(t + 2) * kstep; const char* b21 = last ? nB1 : cB1 + (size_t)(t + 2) * kstep;
            const char* a3 = a2 + kstep; const char* b30 = b20 + kstep; const char* b31 = b21 + kstep;
            PG8_LDB(B0, 0, 0); PG8_LDB(B1, 0, 1); PG8_SCHED; PG8_LDA(At, 0, 0); PG8_STAGE(PG8_SA(1, 1), a1 + hstep, voffA);
            PG8_WAIT_V(8); PG8_WAIT_L(0); PG8_BAR; PG8_MMA(0, 0, At, B0); PG8_MMA(0, 1, At, B1); PG8_BAR; PG8_SCHED;
            PG8_LDA(At, 0, 1); PG8_STAGE(PG8_SB(0, 0), b20, voffB); PG8_STAGE(PG8_SB(0, 1), b21, voffB); PG8_STAGE(PG8_SA(0, 0), a2, voffA);
            PG8_WAIT_V(8); PG8_WAIT_L(0); PG8_BAR; PG8_MMA(1, 0, At, B0); PG8_MMA(1, 1, At, B1); PG8_BAR; PG8_SCHED;
            PG8_LDB(B0, 1, 0); PG8_LDB(B1, 1, 1); PG8_SCHED; PG8_LDA(At, 1, 0); PG8_STAGE(PG8_SA(0, 1), a2 + hstep, voffA);
            PG8_WAIT_V(8); PG8_WAIT_L(0); PG8_BAR; PG8_MMA(0, 0, At, B0); PG8_MMA(0, 1, At, B1); PG8_BAR; PG8_SCHED;
            PG8_LDA(At, 1, 1); PG8_STAGE(PG8_SB(1, 0), b30, voffB); PG8_STAGE(PG8_SB(1, 1), b31, voffB); PG8_STAGE(PG8_SA(1, 0), a3, voffA);
            PG8_WAIT_V(8); PG8_WAIT_L(0); PG8_BAR; PG8_MMA(1, 0, At, B0); PG8_MMA(1, 1, At, B1); PG8_BAR; PG8_SCHED;
        }
        if constexpr (ALIGN_EPI) { if (wr == 0) PG8_BAR; }
        E(acc, cur, wr, wc, fr, fq);
        if (!has_next) break;
#pragma unroll
        for (int a = 0; a < 2; ++a)
#pragma unroll
            for (int b = 0; b < 2; ++b)
#pragma unroll
                for (int m = 0; m < 4; ++m)
#pragma unroll
                    for (int n = 0; n < 2; ++n) acc[a][b][m][n] = (f32x4){0.f, 0.f, 0.f, 0.f};
        cur = nxt; cA = nA; cB0 = nB0; cB1 = nB1; ++ui;
        if constexpr (ALIGN_EPI) { if (wr == 1) PG8_BAR; }
    }
    PG8_WAIT_V(0);
    if constexpr (!ALIGN_EPI) { if (wr == 0) PG8_BAR; }
    PG8_BAR;
#undef PG8_SA
#undef PG8_SB
#undef PG8_STAGE
#undef PG8_LDA
#undef PG8_LDB
#undef PG8_MMA
#undef PG8_WAIT_V
#undef PG8_WAIT_L
#undef PG8_BAR
#undef PG8_SCHED
}

#define EPI_ROWS_BEGIN const int row0 = u.pm * BM + wr * 64 + fr; const int cl = wc * 32 + 8 * fq;
__device__ __forceinline__ void store8(bf16_t* p, const f32x4 v0, const f32x4 v1) {
    u32x4 w; w.x = cvt_pk_bf16(v0[0], v0[1]); w.y = cvt_pk_bf16(v0[2], v0[3]); w.z = cvt_pk_bf16(v1[0], v1[1]); w.w = cvt_pk_bf16(v1[2], v1[3]); *(u32x4*)p = w;
}
__device__ __forceinline__ u32x2 pack8_fp8(const f32x4 v0, const f32x4 v1) {
    int a = 0, b = 0; a = __builtin_amdgcn_cvt_pk_fp8_f32(v0[0], v0[1], a, false); a = __builtin_amdgcn_cvt_pk_fp8_f32(v0[2], v0[3], a, true);
    b = __builtin_amdgcn_cvt_pk_fp8_f32(v1[0], v1[1], b, false); b = __builtin_amdgcn_cvt_pk_fp8_f32(v1[2], v1[3], b, true); return (u32x2){(unsigned)a, (unsigned)b};
}
__device__ __forceinline__ void store8_fp8(unsigned char* p, const f32x4 v0, const f32x4 v1) { *(u32x2*)p = pack8_fp8(v0, v1); }
__device__ __forceinline__ void load8bf(const bf16_t* p, f32x4& v0, f32x4& v1) {
    const u32x4 w = *(const u32x4*)p; v0 = (f32x4){bf_lo(w.x), bf_hi(w.x), bf_lo(w.y), bf_hi(w.y)}; v1 = (f32x4){bf_lo(w.z), bf_hi(w.z), bf_lo(w.w), bf_hi(w.w)};
}
struct EpiPlain {
    bf16_t* O; int ldc;
    __device__ __forceinline__ void operator()(const f32x4 (&acc)[2][2][4][2], const Unit& u, int wr, int wc, int fr, int fq) const {
        EPI_ROWS_BEGIN
#pragma unroll
        for (int ai = 0; ai < 2; ++ai)
#pragma unroll
            for (int m = 0; m < 4; ++m) { bf16_t* rowp = O + (unsigned)((row0 + ai * HALF + m * 16) * ldc + u.pn * BM + cl);
#pragma unroll
                for (int bj = 0; bj < 2; ++bj) store8(rowp + bj * HALF, acc[ai][bj][m][0], acc[ai][bj][m][1]); asm volatile("" ::: "memory"); }
    }
};
struct EpiIn0 {
    static constexpr float WSI = FP8_IN0 ? WSC_INV : 1.f;
    bf16_t* O; float qscale;
    __device__ __forceinline__ void operator()(const f32x4 (&acc)[2][2][4][2], const Unit& u, int wr, int wc, int fr, int fq) const {
        EPI_ROWS_BEGIN
        if (u.pn < 4) {
#pragma unroll
            for (int ai = 0; ai < 2; ++ai)
#pragma unroll
                for (int m = 0; m < 4; ++m) { bf16_t* rowp = O + (unsigned)((row0 + ai * HALF + m * 16) * ZE + u.pn * BM + cl);
#pragma unroll
                    for (int bj = 0; bj < 2; ++bj) { f32x4 v0 = acc[ai][bj][m][0] * WSI, v1 = acc[ai][bj][m][1] * WSI;
#pragma unroll
                        for (int j = 0; j < 4; ++j) { v0[j] = gelu_tanh(v0[j]); v1[j] = gelu_tanh(v1[j]); }
                        store8(rowp + bj * HALF, v0, v1); asm volatile("" ::: "memory"); } }
        } else {
            const float sc = (u.pn < 6 ? qscale : 1.f) * WSI;
#pragma unroll
            for (int ai = 0; ai < 2; ++ai)
#pragma unroll
                for (int m = 0; m < 4; ++m) { bf16_t* rowp = O + (unsigned)((row0 + ai * HALF + m * 16) * ZE + u.pn * BM + cl);
#pragma unroll
                    for (int bj = 0; bj < 2; ++bj) store8(rowp + bj * HALF, acc[ai][bj][m][0] * sc, acc[ai][bj][m][1] * sc);
                    asm volatile("" ::: "memory"); }
        }
    }
};
struct EpiIn1 {
    static constexpr float WSI = FP8_IN1 ? WSC_INV : 1.f;
    bf16_t* O; bf16_t* KV; bf16_t* KI;
    __device__ __forceinline__ void operator()(const f32x4 (&acc)[2][2][4][2], const Unit& u, int wr, int wc, int fr, int fq) const {
        EPI_ROWS_BEGIN
        if (u.pn == 4 || u.pn == 5) {
            bf16_t* base = KV + (u.pn - 4) * 256 + cl;
#pragma unroll
            for (int ai = 0; ai < 2; ++ai)
#pragma unroll
                for (int m = 0; m < 4; ++m) { bf16_t* rowp = base + (unsigned)((row0 + ai * HALF + m * 16) * 512);
#pragma unroll
                    for (int bj = 0; bj < 2; ++bj) store8(rowp + bj * HALF, acc[ai][bj][m][0] * WSI, acc[ai][bj][m][1] * WSI);
                    asm volatile("" ::: "memory"); }
        } else {
            const float sc = (u.pn < 4 ? 0.125f * LOG2E : 1.f) * WSI;
#pragma unroll
            for (int ai = 0; ai < 2; ++ai)
#pragma unroll
                for (int m = 0; m < 4; ++m) { bf16_t* rowp = O + (unsigned)((row0 + ai * HALF + m * 16) * ZO + u.pn * BM + cl);
#pragma unroll
                    for (int bj = 0; bj < 2; ++bj) store8(rowp + bj * HALF, acc[ai][bj][m][0] * sc, acc[ai][bj][m][1] * sc);
                    asm volatile("" ::: "memory"); }
            if (u.pn == 8 && wc < 2) {
#pragma unroll
                for (int ai = 0; ai < 2; ++ai)
#pragma unroll
                    for (int m = 0; m < 4; ++m) { const int row = row0 + ai * HALF + m * 16;
                        store8(KI + (unsigned)(((((row >> 5) * 4 + (cl >> 4)) * 64) + (((cl >> 3) & 1) * 32 + (row & 31))) * 8), acc[ai][0][m][0] * WSI, acc[ai][0][m][1] * WSI); asm volatile("" ::: "memory"); }
            }
        }
    }
};
struct EpiOut {
    const float* xf; const bf16_t* xb; bf16_t* O;
    __device__ __forceinline__ void operator()(const f32x4 (&acc)[2][2][4][2], const Unit& u, int wr, int wc, int fr, int fq) const {
        EPI_ROWS_BEGIN
#pragma unroll
        for (int ai = 0; ai < 2; ++ai) {
            f32x4 xr[4][2][2];
#pragma unroll
            for (int m = 0; m < 4; ++m) { const unsigned off = (unsigned)((row0 + ai * HALF + m * 16) * DM + u.pn * BM + cl);
#pragma unroll
                for (int bj = 0; bj < 2; ++bj) {
                    if (xf) { xr[m][bj][0] = *(const f32x4*)(xf + off + bj * HALF); xr[m][bj][1] = *(const f32x4*)(xf + off + bj * HALF + 4); }
                    else load8bf(xb + off + bj * HALF, xr[m][bj][0], xr[m][bj][1]); } }
            asm volatile("" ::: "memory");
#pragma unroll
            for (int m = 0; m < 4; ++m) { const unsigned off = (unsigned)((row0 + ai * HALF + m * 16) * DM + u.pn * BM + cl);
#pragma unroll
                for (int bj = 0; bj < 2; ++bj)
                    store8(O + off + bj * HALF, xr[m][bj][0] * ALPHA + acc[ai][bj][m][0] * (FP8_OUT ? WSC_INV : 1.f), xr[m][bj][1] * ALPHA + acc[ai][bj][m][1] * (FP8_OUT ? WSC_INV : 1.f)); }
            asm volatile("" ::: "memory");
        }
    }
};
__device__ __forceinline__ f32x2 swiglu_pk(f32x2 g, f32x2 u) {
    f32x2 ga, ua; ga.x = fminf(g.x, 7.f); ga.y = fminf(g.y, 7.f);
    ua.x = __builtin_amdgcn_fmed3f(u.x, -7.f, 7.f); ua.y = __builtin_amdgcn_fmed3f(u.y, -7.f, 7.f);
    const f32x2 t = ga * (-1.702f * LOG2E);
    f32x2 e; e.x = __builtin_amdgcn_exp2f(t.x); e.y = __builtin_amdgcn_exp2f(t.y);
    const f32x2 d = e + 1.0f;
    f32x2 r; r.x = __builtin_amdgcn_rcpf(d.x); r.y = __builtin_amdgcn_rcpf(d.y);
    return (ga * r) * (ua + 1.0f);
}
struct EpiSwiglu {
    unsigned char* O; const float* bgu;
    __device__ __forceinline__ void operator()(const f32x4 (&acc)[2][2][4][2], const Unit& u, int wr, int wc, int fr, int fq) const {
        EPI_ROWS_BEGIN
        const int col = u.pn * HALF + cl;
        const float* bp = bgu + (unsigned)(u.e * 2048 + col);
        const f32x4 bg0 = *(const f32x4*)bp, bg1 = *(const f32x4*)(bp + 4), bu0 = *(const f32x4*)(bp + 1024), bu1 = *(const f32x4*)(bp + 1028);
#pragma unroll
        for (int ai = 0; ai < 2; ++ai)
#pragma unroll
            for (int m = 0; m < 4; ++m) { f32x4 g0 = acc[ai][0][m][0] * WSC_INV + bg0, g1 = acc[ai][0][m][1] * WSC_INV + bg1, p0 = acc[ai][1][m][0] * WSC_INV + bu0, p1 = acc[ai][1][m][1] * WSC_INV + bu1, r0, r1;
#pragma unroll
                for (int j = 0; j < 4; j += 2) { f32x2 o;
                    o = swiglu_pk((f32x2){g0[j], g0[j + 1]}, (f32x2){p0[j], p0[j + 1]}); r0[j] = o.x; r0[j + 1] = o.y;
                    o = swiglu_pk((f32x2){g1[j], g1[j + 1]}, (f32x2){p1[j], p1[j + 1]}); r1[j] = o.x; r1[j + 1] = o.y; }
                store8_fp8(O + (unsigned)((row0 + ai * HALF + m * 16) * DM + col), r0, r1); asm volatile("" ::: "memory"); }
    }
};
struct EpiDown {
    bf16_t* O; const float* bd; const float* rowgate;
    __device__ __forceinline__ void operator()(const f32x4 (&acc)[2][2][4][2], const Unit& u, int wr, int wc, int fr, int fq) const {
        EPI_ROWS_BEGIN
        const int col = u.pn * BM + cl; const float* bp = bd + (unsigned)(u.e * DM + col);
        f32x4 bv[2][2];
#pragma unroll
        for (int bj = 0; bj < 2; ++bj) { bv[bj][0] = *(const f32x4*)(bp + bj * HALF); bv[bj][1] = *(const f32x4*)(bp + bj * HALF + 4); }
        float gt[2][4];
#pragma unroll
        for (int ai = 0; ai < 2; ++ai)
#pragma unroll
            for (int m = 0; m < 4; ++m) gt[ai][m] = rowgate[row0 + ai * HALF + m * 16];
#pragma unroll
        for (int ai = 0; ai < 2; ++ai)
#pragma unroll
            for (int m = 0; m < 4; ++m) { const int row = row0 + ai * HALF + m * 16; const float g = gt[ai][m];
#pragma unroll
                for (int bj = 0; bj < 2; ++bj) {
                    if (Y_FP8) store8_fp8((unsigned char*)O + (unsigned)(row * DM + col + bj * HALF), (acc[ai][bj][m][0] * WSC_INV + bv[bj][0]) * (g * 16.f), (acc[ai][bj][m][1] * WSC_INV + bv[bj][1]) * (g * 16.f));
                    else store8(O + (unsigned)(row * DM + col + bj * HALF), (acc[ai][bj][m][0] * WSC_INV + bv[bj][0]) * g, (acc[ai][bj][m][1] * WSC_INV + bv[bj][1]) * g); }
                asm volatile("" ::: "memory"); }
    }
};
struct EpiGate {
    const bf16_t* mid; const bf16_t* P; const float* bg; bf16_t* O;
    __device__ __forceinline__ void operator()(const f32x4 (&acc)[2][2][4][2], const Unit& u, int wr, int wc, int fr, int fq) const {
        EPI_ROWS_BEGIN
        const int col = u.pn * BM + cl;
        f32x4 bv[2][2];
#pragma unroll
        for (int bj = 0; bj < 2; ++bj) { bv[bj][0] = *(const f32x4*)(bg + col + bj * HALF); bv[bj][1] = *(const f32x4*)(bg + col + bj * HALF + 4); }
#pragma unroll
        for (int ai = 0; ai < 2; ++ai) {
            u32x4 mr[4][2], pr[4][2];
#pragma unroll
            for (int m = 0; m < 4; ++m) { const unsigned off = (unsigned)((row0 + ai * HALF + m * 16) * DM + col);
#pragma unroll
                for (int bj = 0; bj < 2; ++bj) { mr[m][bj] = *(const u32x4*)(mid + off + bj * HALF); pr[m][bj] = *(const u32x4*)(P + off + bj * HALF); } }
            asm volatile("" ::: "memory");
#pragma unroll
            for (int m = 0; m < 4; ++m) { const unsigned off = (unsigned)((row0 + ai * HALF + m * 16) * DM + col);
#pragma unroll
                for (int bj = 0; bj < 2; ++bj) { const u32x4 mw = mr[m][bj], pw = pr[m][bj];
                    const f32x4 m0 = {bf_lo(mw.x), bf_hi(mw.x), bf_lo(mw.y), bf_hi(mw.y)}, m1 = {bf_lo(mw.z), bf_hi(mw.z), bf_lo(mw.w), bf_hi(mw.w)};
                    const f32x4 p0 = {bf_lo(pw.x), bf_hi(pw.x), bf_lo(pw.y), bf_hi(pw.y)}, p1 = {bf_lo(pw.z), bf_hi(pw.z), bf_lo(pw.w), bf_hi(pw.w)};
                    f32x4 r0, r1;
                    const f32x4 a0 = acc[ai][bj][m][0] * (FP8_GATE ? WSC_INV : 1.f) + bv[bj][0], a1 = acc[ai][bj][m][1] * (FP8_GATE ? WSC_INV : 1.f) + bv[bj][1];
#pragma unroll
                    for (int j = 0; j < 4; ++j) { r0[j] = m0[j] + sigmoidf_(a0[j]) * p0[j]; r1[j] = m1[j] + sigmoidf_(a1[j]) * p1[j]; }
                    store8(O + off + bj * HALF, r0, r1); } }
            asm volatile("" ::: "memory");
        }
    }
};
}

#define XB_TMO      128
#define XB_XCNT(j)  (256  + 64 * (j))
#define XB_XSUB(j)  (1280 + 64 * (j))
#define XB_XGEN(j)  (2304 + 64 * (j))
#define XB_TOP      3328
#define XB_TOPGEN   3392
#define XCD_BAR_WORDS 3456
#define XB_SPIN_CAP (1u << 18)
__device__ __forceinline__ unsigned xb_ld(unsigned* p)              { return __hip_atomic_load(p, __ATOMIC_RELAXED, __HIP_MEMORY_SCOPE_AGENT); }
__device__ __forceinline__ unsigned xb_add(unsigned* p, unsigned v) { return __hip_atomic_fetch_add(p, v, __ATOMIC_RELAXED, __HIP_MEMORY_SCOPE_AGENT); }
__device__ __forceinline__ unsigned xb_xcc_id() { return (unsigned)__builtin_amdgcn_s_getreg((3 << 11) | 20) & 0xFu; }
#define XB_SPIN(cond, bar) do { unsigned _sp = 0; while (cond) { __builtin_amdgcn_s_sleep(1); \
    if ((++_sp & 255u) == 0u) { if (xb_ld(&(bar)[XB_TMO])) break; if (_sp > XB_SPIN_CAP) { atomicAdd(&(bar)[XB_TMO], 1u); break; } } } } while (0)
struct XcdBarrier { unsigned* bar; unsigned x; volatile LAS unsigned* st; };
__device__ __forceinline__ XcdBarrier xcd_barrier_post(unsigned* bar, volatile LAS unsigned* st) {
    XcdBarrier b; b.bar = bar; b.x = xb_xcc_id(); b.st = st;
    if (threadIdx.x == 0) (void)xb_add(&bar[XB_XCNT(b.x)], 1u);
    return b;
}
__device__ __forceinline__ void xcd_barrier_complete(unsigned* bar, unsigned x, unsigned& nloc, unsigned& nx) {
    const unsigned G = gridDim.x * gridDim.y * gridDim.z;
    unsigned sum, cnt, mine, sp = 0u;
    for (;;) {
        sum = 0u; cnt = 0u; mine = 0u;
#pragma unroll
        for (unsigned j = 0; j < 16; ++j) { const unsigned c = xb_ld(&bar[XB_XCNT(j)]); sum += c; cnt += (c > 0u) ? 1u : 0u; mine = (j == x) ? c : mine; }
        if (sum == G) break;
        __builtin_amdgcn_s_sleep(1);
        if ((++sp & 255u) == 0u) { if (xb_ld(&bar[XB_TMO])) break; if (sp > XB_SPIN_CAP) { atomicAdd(&bar[XB_TMO], 1u); break; } }
    }
    nloc = mine > 0u ? mine : 1u; nx = cnt > 0u ? cnt : 1u;
}
__device__ __forceinline__ void xcd_barrier(const XcdBarrier& b) {
    asm volatile("s_waitcnt vmcnt(0)" ::: "memory");
    __syncthreads();
    if (threadIdx.x == 0) {
        unsigned* bar = b.bar; asm volatile("" : "+s"(bar));
        unsigned bx = b.x; asm volatile("" : "+s"(bx));
        __builtin_amdgcn_s_waitcnt(0);
        unsigned nloc = b.st[0], nx = b.st[1];
        if (nloc == 0u) { xcd_barrier_complete(bar, bx, nloc, nx); b.st[0] = nloc; b.st[1] = nx; }
        const unsigned old = xb_add(&bar[XB_XSUB(bx)], 1u);
        const unsigned gen = old / nloc;
        if (old + 1u == (gen + 1u) * nloc) {
            __builtin_amdgcn_fence(__ATOMIC_RELEASE, "agent");
            asm volatile("s_waitcnt vmcnt(0)" ::: "memory");
            const unsigned og = xb_add(&bar[XB_TOP], 1u);
            const unsigned tg = og / nx;
            if (og + 1u == (tg + 1u) * nx) xb_add(&bar[XB_TOPGEN], 1u);
            else XB_SPIN(xb_ld(&bar[XB_TOPGEN]) == tg, bar);
            __builtin_amdgcn_fence(__ATOMIC_ACQUIRE, "agent");
            xb_add(&bar[XB_XGEN(bx)], 1u);
            asm volatile("s_waitcnt vmcnt(0)" ::: "memory");
        } else {
            XB_SPIN(xb_ld(&bar[XB_XGEN(bx)]) == gen, bar);
            __builtin_amdgcn_fence(__ATOMIC_ACQUIRE, "agent");
            asm volatile("s_waitcnt vmcnt(0)" ::: "memory");
        }
    }
    __syncthreads();
}

constexpr int NWAVES = 8, NTHR = 512;
struct Args { const float* in[23]; float* out; unsigned char* ws; int ph_lo, ph_hi; };
struct Frame { LAS unsigned char* lds; int tid, lane, wave, G, bid; };
#define LDS_WAIT() asm volatile("s_waitcnt lgkmcnt(0)" ::: "memory")
#define LDS_BARRIER() asm volatile("s_waitcnt lgkmcnt(0)\n\ts_barrier" ::: "memory")

template <bool F8>
__device__ __forceinline__ void p0_transpose_item(const float* W, int K, int N, int Npad, void* WT_, LAS float* scr, int item, int lane) {
    const int nblk = Npad / 32, kb = item / nblk, nb = item % nblk, k0 = 128 * kb, n0 = 32 * nb;
    const int r = lane >> 3, c4 = (lane & 7) * 4;
    const bool ok = n0 + c4 < N;
    const float* src = W + (size_t)(k0 + r) * N + (ok ? n0 + c4 : 0);
    f32x4 v[16];
#pragma unroll
    for (int i = 0; i < 16; ++i) v[i] = *(const f32x4*)(src + (size_t)(8 * i) * N);
    __builtin_amdgcn_sched_barrier(0);
    const float sc = ok ? (F8 ? WSC : 1.f) : 0.f;
#pragma unroll
    for (int i = 0; i < 16; ++i) *(LAS f32x4*)(scr + (8 * i + r) * 32 + (c4 ^ ((i >> 1) << 2))) = v[i] * sc;
    LDS_WAIT(); asm volatile("" ::: "memory");
    const int c = lane & 7;
#pragma unroll
    for (int j = 0; j < 4; ++j) { const int nn = (lane >> 3) + 8 * j; const LAS float* sp = scr + (16 * c) * 32 + (nn ^ (c << 2));
        float t[16];
#pragma unroll
        for (int q = 0; q < 16; ++q) t[q] = sp[q * 32];
        if constexpr (F8) { const u32x2 lo = pg8::pack8_fp8(f32x4{t[0], t[1], t[2], t[3]}, f32x4{t[4], t[5], t[6], t[7]}), hi = pg8::pack8_fp8(f32x4{t[8], t[9], t[10], t[11]}, f32x4{t[12], t[13], t[14], t[15]});
            u32x4 o; o.x = lo.x; o.y = lo.y; o.z = hi.x; o.w = hi.y; *(u32x4*)((unsigned char*)WT_ + (size_t)(n0 + nn) * K + k0 + 16 * c) = o; }
        else { u32x4 o0, o1; o0.x = cvt_pk_bf16(t[0], t[1]); o0.y = cvt_pk_bf16(t[2], t[3]); o0.z = cvt_pk_bf16(t[4], t[5]); o0.w = cvt_pk_bf16(t[6], t[7]);
            o1.x = cvt_pk_bf16(t[8], t[9]); o1.y = cvt_pk_bf16(t[10], t[11]); o1.z = cvt_pk_bf16(t[12], t[13]); o1.w = cvt_pk_bf16(t[14], t[15]);
            bf16_t* d = (bf16_t*)WT_ + (size_t)(n0 + nn) * K + k0 + 16 * c; *(u32x4*)d = o0; *(u32x4*)(d + 8) = o1; } }
    LDS_WAIT(); asm volatile("" ::: "memory");
}
template <int U, bool F8>
__device__ __forceinline__ void cvt_stream(const float* src, void* dst_, size_t n, int gtid, int gthreads) {
    const size_t st = (size_t)gthreads * 8;
    size_t i = (size_t)gtid * 8;
    for (; i + (U - 1) * st < n; i += U * st) {
        f32x4 a[U], b[U];
#pragma unroll
        for (int q = 0; q < U; ++q) { const float* p = src + i + q * st; a[q] = *(const f32x4*)p; b[q] = *(const f32x4*)(p + 4); }
        __builtin_amdgcn_sched_barrier(0);
#pragma unroll
        for (int q = 0; q < U; ++q) { const size_t o = i + q * st;
            if constexpr (F8) *(u32x2*)((unsigned char*)dst_ + o) = pg8::pack8_fp8(a[q], b[q]);
            else { u32x4 w; w.x = cvt_pk_bf16(a[q][0], a[q][1]); w.y = cvt_pk_bf16(a[q][2], a[q][3]); w.z = cvt_pk_bf16(b[q][0], b[q][1]); w.w = cvt_pk_bf16(b[q][2], b[q][3]); *(u32x4*)((bf16_t*)dst_ + o) = w; } }
    }
    for (; i < n; i += st) { const f32x4 a = *(const f32x4*)(src + i), b = *(const f32x4*)(src + i + 4);
        if constexpr (F8) *(u32x2*)((unsigned char*)dst_ + i) = pg8::pack8_fp8(a, b);
        else { u32x4 w; w.x = cvt_pk_bf16(a[0], a[1]); w.y = cvt_pk_bf16(a[2], a[3]); w.z = cvt_pk_bf16(b[0], b[1]); w.w = cvt_pk_bf16(b[2], b[3]); *(u32x4*)((bf16_t*)dst_ + i) = w; } }
}
struct P0Desc { const float* W; unsigned char* WT; int K, N, Npad, tile, f8; };
constexpr int P0_IN0 = 8 * (ZE / 256), P0_SQ = 8 * 4, P0_IN1 = 8 * (ZO / 256), P0_PLE = 2 * 4, P0_GU = 8 * 8;
constexpr int P0_C0 = P0_IN0, P0_C1 = P0_C0 + P0_SQ, P0_C2 = P0_C1 + P0_IN1, P0_C3 = P0_C2 + P0_SQ, P0_C4 = P0_C3 + 2 * P0_SQ, P0_C5 = P0_C4 + 2 * P0_PLE, P0_C6 = P0_C5 + 64 * P0_GU, P0_C7 = P0_C6 + 64 * P0_SQ;
__device__ __forceinline__ P0Desc p0_desc(const Args& a, int it) {
    unsigned char* ws = a.ws;
    if (it < P0_C0) return P0Desc{a.in[2], ws + WS_WIN0, DM, ZE, ZE, it, FP8_IN0};
    if (it < P0_C1) return P0Desc{a.in[7], ws + WS_WO0, DM, DM, DM, it - P0_C0, FP8_OUT};
    if (it < P0_C2) return P0Desc{a.in[8], ws + WS_WIN1, DM, ZO_REAL, ZO, it - P0_C1, FP8_IN1};
    if (it < P0_C3) return P0Desc{a.in[9], ws + WS_WO1, DM, DM, DM, it - P0_C2, FP8_OUT};
    if (it < P0_C4) { const int r = it - P0_C3, l = r / P0_SQ; return P0Desc{a.in[21] + (size_t)l * DM * DM, ws + WS_WG + (size_t)l * DM * DM * (FP8_GATE ? 1 : 2), DM, DM, DM, r % P0_SQ, FP8_GATE}; }
    if (it < P0_C5) { const int r = it - P0_C4, l = r / P0_PLE; return P0Desc{a.in[20] + (size_t)l * PLE * DM, ws + WS_WPLE + (size_t)l * DM * PLE * 2, PLE, DM, DM, r % P0_PLE, 0}; }
    if (it < P0_C6) { const int r = it - P0_C5, l = r / P0_GU; return P0Desc{a.in[14] + (size_t)l * DM * 2048, ws + WS_WGU + (size_t)l * 2048 * DM, DM, 2048, 2048, r % P0_GU, 1}; }
    const int r = it - P0_C6, l = r / P0_SQ; return P0Desc{a.in[16] + (size_t)l * DM * DM, ws + WS_WD + (size_t)l * DM * DM, DM, DM, DM, r % P0_SQ, 1};
}
__device__ __forceinline__ void p0_tile_load(const P0Desc& d, int wave, int lane, f32x4 (&v)[16], float& sc) {
    const int nblk = d.Npad / 256, kb = d.tile / nblk, nb = d.tile % nblk;
    const int n = nb * 256 + 4 * lane; const bool ok = n < d.N;
    const float* src = d.W + (size_t)(kb * 128 + 16 * wave) * d.N + (ok ? n : 0);
#pragma unroll
    for (int i = 0; i < 16; ++i) v[i] = *(const f32x4*)(src + (size_t)i * d.N);
    sc = ok ? (d.f8 ? WSC : 1.f) : 0.f;
}
__device__ __forceinline__ void p0_tile_emit(const P0Desc& d, LAS float* img, int wave, int lane) {
    const int nblk = d.Npad / 256, kb = d.tile / nblk, nb = d.tile % nblk, k0 = 128 * kb, n0 = 256 * nb;
    const int c = lane & 7;
#pragma unroll
    for (int j = 0; j < 4; ++j) { const int nn = 32 * wave + (lane >> 3) + 8 * j; const LAS float* sp = img + (16 * c) * 256 + (nn ^ (c << 2));
        float t[16];
#pragma unroll
        for (int q = 0; q < 16; ++q) t[q] = sp[q * 256];
        const size_t o = (size_t)(n0 + nn) * d.K + k0 + 16 * c;
        if (d.f8) { const u32x2 lo = pg8::pack8_fp8(f32x4{t[0], t[1], t[2], t[3]}, f32x4{t[4], t[5], t[6], t[7]}), hi = pg8::pack8_fp8(f32x4{t[8], t[9], t[10], t[11]}, f32x4{t[12], t[13], t[14], t[15]});
            u32x4 w; w.x = lo.x; w.y = lo.y; w.z = hi.x; w.w = hi.y; *(u32x4*)(d.WT + o) = w; }
        else { u32x4 o0, o1; o0.x = cvt_pk_bf16(t[0], t[1]); o0.y = cvt_pk_bf16(t[2], t[3]); o0.z = cvt_pk_bf16(t[4], t[5]); o0.w = cvt_pk_bf16(t[6], t[7]);
            o1.x = cvt_pk_bf16(t[8], t[9]); o1.y = cvt_pk_bf16(t[10], t[11]); o1.z = cvt_pk_bf16(t[12], t[13]); o1.w = cvt_pk_bf16(t[14], t[15]);
            bf16_t* dp = (bf16_t*)d.WT + o; *(u32x4*)dp = o0; *(u32x4*)(dp + 8) = o1; } }
}
__device__ __forceinline__ void p0_prologue(Frame& F, const Args& a) {
    unsigned char* ws = a.ws;
    LAS float* img = (LAS float*)F.lds;
    { const int TOT = P0_C7 * PM(0);
      int it = F.bid; f32x4 v[16]; float sc = 0.f; P0Desc d = p0_desc(a, it % P0_C7);
      if (it < TOT) p0_tile_load(d, F.wave, F.lane, v, sc);
      for (; it < TOT; it += F.G) {
#pragma unroll
        for (int i = 0; i < 16; ++i) *(LAS f32x4*)(img + (16 * F.wave + i) * 256 + ((4 * F.lane) ^ (F.wave << 2))) = v[i] * sc;
        LDS_BARRIER();
        const P0Desc dc = d; const int nx = it + F.G;
        if (nx < TOT) { d = p0_desc(a, nx % P0_C7); p0_tile_load(d, F.wave, F.lane, v, sc); }
        __builtin_amdgcn_sched_barrier(0);
        p0_tile_emit(dc, img, F.wave, F.lane);
        LDS_BARRIER();
      } }
    {
      LAS float* scr = (LAS float*)(F.lds + F.wave * 16384);
      const int gw = F.bid * NWAVES + F.wave;
      if (gw < 16) p0_transpose_item<false>(a.in[12] + (size_t)(gw >> 3) * DM * NEXP, DM, NEXP, NEXP, (bf16_t*)(ws + WS_WRT) + (size_t)(gw >> 3) * NEXP * DM, scr, gw & 7, F.lane); }
    const int gtid = F.bid * NTHR + F.tid, gth = F.G * NTHR;
    if (!FP8_IN0) cvt_stream<8, false>(a.in[0], ws + WS_XB, (size_t)NTOK * DM, gtid, gth);
    else cvt_stream<8, true>(a.in[0], ws + WS_XQ, (size_t)NTOK * DM, gtid, gth);
    cvt_stream<8, false>(a.in[1], ws + WS_PB, (size_t)2 * NTOK * PLE, gtid, gth);
    for (int i = gtid; i < 8 * 128 * 128; i += gth) { const int t = (i >> 7) & 127, s = i & 127; const float v = (s <= t) ? a.in[5][i] : 0.f; ((bf16_t*)(ws + WS_WSB))[i] = (bf16_t)(cvt_pk_bf16(v, 0.f) & 0xffffu); }
}

__device__ __forceinline__ void gmlp_unit(Frame& F, const Args& a, int unit) {
    const bf16_t* z0 = (const bf16_t*)(a.ws + WS_Z); unsigned char* cat = (unsigned char*)(a.ws + WS_CAT); const bf16_t* wsb = (const bf16_t*)(a.ws + WS_WSB);
    const float* lng = a.in[3]; const float* lnb = a.in[4]; const float* bs = a.in[6];
    const size_t tok0 = (size_t)unit * 128;
    const int lane = F.lane, w = F.wave, r32 = lane & 31, hi = lane >> 5;
    LAS f32x2* stats = (LAS f32x2*)(F.lds + XTRA_OFF);
    for (int i = 0; i < 16; ++i) { const int tl = w * 16 + i;
        const u32x4 v = *(const u32x4*)(z0 + (tok0 + tl) * ZE + 512 + 8 * lane);
        float x[8] = {bf_lo(v.x), bf_hi(v.x), bf_lo(v.y), bf_hi(v.y), bf_lo(v.z), bf_hi(v.z), bf_lo(v.w), bf_hi(v.w)};
        float s = 0.f;
#pragma unroll
        for (int j = 0; j < 8; ++j) s += x[j];
        const float mean = wave_sum(s) * (1.f / 512.f); float q = 0.f;
#pragma unroll
        for (int j = 0; j < 8; ++j) { const float d = x[j] - mean; q += d * d; }
        const float rstd = 1.f / sqrtf(wave_sum(q) * (1.f / 512.f) + LN_EPS);
        if (lane == 0) stats[tl] = (f32x2){mean, rstd}; }
    __syncthreads();
    const int g = w;
    LAS unsigned char* vt = F.lds + w * 16384;
    { const int tl8 = lane >> 3, cc = lane & 7;
      float gg[8], bb[8];
#pragma unroll
      for (int j = 0; j < 8; ++j) { gg[j] = lng[g * 64 + 8 * cc + j]; bb[j] = lnb[g * 64 + 8 * cc + j]; }
      for (int it = 0; it < 16; ++it) { const int tl = 8 * it + tl8;
          const u32x4 v = *(const u32x4*)(z0 + (tok0 + tl) * ZE + 512 + g * 64 + 8 * cc);
          const f32x2 st = stats[tl];
          float x[8] = {bf_lo(v.x), bf_hi(v.x), bf_lo(v.y), bf_hi(v.y), bf_lo(v.z), bf_hi(v.z), bf_lo(v.w), bf_hi(v.w)};
#pragma unroll
          for (int j = 0; j < 8; ++j) { const int c = 8 * cc + j; const float y = (x[j] - st.x) * st.y * gg[j] + bb[j];
              *(LAS bf16_t*)(vt + c * 256 + ((((tl >> 3) ^ (c & 15))) << 4) + (tl & 7) * 2) = (bf16_t)(cvt_pk_bf16(y, 0.f) & 0xffffu); } } }
    LDS_WAIT(); asm volatile("" ::: "memory");
    for (int tb = 0; tb < 4; ++tb) {
        f32x16 d0 = {}, d1 = {};
        const bf16_t* wrow = wsb + ((size_t)g * 128 + tb * 32 + r32) * 128 + 8 * hi;
        bf16x8 afr[8];
#pragma unroll
        for (int ks = 0; ks < 8; ++ks) afr[ks] = *(const bf16x8*)(wrow + 16 * ks);
#pragma unroll
        for (int ks = 0; ks < 8; ++ks) { if (ks >= 2 * (tb + 1)) break;
            const bf16x8 af = afr[ks];
            const int chunk = 2 * ks + hi;
            const bf16x8 b0 = *(const LAS bf16x8*)(vt + r32 * 256 + ((chunk ^ (r32 & 15)) << 4));
            const bf16x8 b1 = *(const LAS bf16x8*)(vt + (32 + r32) * 256 + ((chunk ^ (r32 & 15)) << 4));
            d0 = __builtin_amdgcn_mfma_f32_32x32x16_bf16(af, b0, d0, 0, 0, 0);
            d1 = __builtin_amdgcn_mfma_f32_32x32x16_bf16(af, b1, d1, 0, 0, 0);
        }
#pragma unroll
        for (int r = 0; r < 16; ++r) { const int t = tb * 32 + (r & 3) + 8 * (r >> 2) + 4 * hi; const float bsv = bs[g * 128 + t];
            const size_t ro = (tok0 + t) * ZE + g * 64 + r32; const size_t co = (tok0 + t) * DM + g * 64 + r32;
            const float u0 = bf1(z0[ro]), u1 = bf1(z0[ro + 32]);
            CAT_ST(cat, co, u0 * (d0[r] + bsv)); CAT_ST(cat, co + 32, u1 * (d1[r] + bsv)); }
    }
    __syncthreads();
}

constexpr int SB_KST = 144;
constexpr int SB_TILE = 64 * SB_KST;
__device__ __forceinline__ void sb_unit(Frame& F, const Args& a, int b, int h, int qb) {
    const bf16_t* z0 = (const bf16_t*)(a.ws + WS_Z); unsigned char* cat = (unsigned char*)(a.ws + WS_CAT);
    const int tid = F.tid, lane = F.lane, wid = F.wave, r32 = lane & 31, hi = lane >> 5;
    const size_t rowbase = (size_t)b * SEQ;
    const int q0 = qb * 256, qw0 = q0 + wid * 32, tq = qw0 + r32;
    bf16x8 qr[4];
    { const bf16_t* qp = z0 + (rowbase + tq) * ZE + 1024 + h * 64 + hi * 8;
#pragma unroll
      for (int ks = 0; ks < 4; ++ks) qr[ks] = *(const bf16x8*)(qp + ks * 16); }
    f32x16 o0 = {}, o1 = {}; float C = 1.f;
    const int ntile = q0 / 64 + 4;
    LAS unsigned char* Kb = F.lds; LAS unsigned char* Vb = F.lds + 2 * SB_TILE;
    const bf16_t* kg = z0 + (rowbase + (tid >> 3)) * ZE + 1536 + h * 64 + (tid & 7) * 8;
    const unsigned ldst = (unsigned)(tid >> 3) * SB_KST + (unsigned)(tid & 7) * 16;
    { const size_t go = (size_t)(ntile - 1) * 64 * ZE; const u32x4 kn = *(const u32x4*)(kg + go), vn = *(const u32x4*)(kg + go + 512);
      *(LAS u32x4*)(Kb + ldst) = kn; *(LAS u32x4*)(Vb + ldst) = vn; }
    const int dh = (lane >> 4) & 1, q_ = (lane & 15) >> 2, p_ = lane & 3;
    for (int kt = ntile - 1; kt >= 0; --kt) {
        const int buf = (ntile - 1 - kt) & 1;
        u32x4 kn, vn;
        if (kt > 0) { const size_t go = (size_t)(kt - 1) * 64 * ZE; kn = *(const u32x4*)(kg + go); vn = *(const u32x4*)(kg + go + 512); }
        LDS_BARRIER();
        const LAS unsigned char* Kc = Kb + buf * SB_TILE; const LAS unsigned char* Vc = Vb + buf * SB_TILE;
        if (64 * kt <= qw0) {
            f32x16 p[2]; p[0] = (f32x16){}; p[1] = (f32x16){};
#pragma unroll
            for (int ks = 0; ks < 4; ++ks) {
                const bf16x8 k0 = *(const LAS bf16x8*)(Kc + r32 * SB_KST + (16 * ks + 8 * hi) * 2);
                const bf16x8 k1 = *(const LAS bf16x8*)(Kc + (32 + r32) * SB_KST + (16 * ks + 8 * hi) * 2);
                p[0] = __builtin_amdgcn_mfma_f32_32x32x16_bf16(k0, qr[ks], p[0], 0, 0, 0);
                p[1] = __builtin_amdgcn_mfma_f32_32x32x16_bf16(k1, qr[ks], p[1], 0, 0, 0);
            }
            const bool need_mask = (64 * kt + 64 > qw0);
            const int kb0 = 64 * kt + 4 * hi;
            float NB[2][16], BE[2][16];
            if (need_mask) {
#pragma unroll
                for (int bk = 0; bk < 2; ++bk)
#pragma unroll
                    for (int r = 0; r < 16; ++r) { const float rc = rcpf_(1.f + ex2(-p[bk][r]));
                        const int key = kb0 + 32 * bk + 8 * (r >> 2) + (r & 3); const bool ok = key < tq;
                        BE[bk][r] = ok ? rc : 0.f; NB[bk][r] = ok ? 1.f - rc : 1.f; }
            } else {
#pragma unroll
                for (int bk = 0; bk < 2; ++bk)
#pragma unroll
                    for (int r = 0; r < 16; ++r) { const float rc = rcpf_(1.f + ex2(-p[bk][r])); BE[bk][r] = rc; NB[bk][r] = 1.f - rc; }
            }
            float acc_c = C;
#pragma unroll
            for (int bk = 1; bk >= 0; --bk)
#pragma unroll
                for (int aa = 3; aa >= 0; --aa) {
                    const float R = (NB[bk][4 * aa] * NB[bk][4 * aa + 1]) * (NB[bk][4 * aa + 2] * NB[bk][4 * aa + 3]);
                    const auto rr = __builtin_amdgcn_permlane32_swap(__float_as_uint(R), __float_as_uint(R), false, false);
                    const float Rp = hi ? __uint_as_float(rr[0]) : __uint_as_float(rr[1]);
                    const float a3 = hi ? acc_c : acc_c * Rp, a2 = a3 * NB[bk][4 * aa + 3], a1 = a2 * NB[bk][4 * aa + 2], a0 = a1 * NB[bk][4 * aa + 1];
                    p[bk][4 * aa + 3] = BE[bk][4 * aa + 3] * a3; p[bk][4 * aa + 2] = BE[bk][4 * aa + 2] * a2;
                    p[bk][4 * aa + 1] = BE[bk][4 * aa + 1] * a1; p[bk][4 * aa + 0] = BE[bk][4 * aa + 0] * a0;
                    acc_c *= R * Rp;
                }
            C = acc_c;
            bf16x8 pa[2][2];
#pragma unroll
            for (int bk = 0; bk < 2; ++bk)
#pragma unroll
                for (int s = 0; s < 2; ++s) { u32x4 w; w.x = cvt_pk_bf16(p[bk][8 * s + 0], p[bk][8 * s + 1]); w.y = cvt_pk_bf16(p[bk][8 * s + 2], p[bk][8 * s + 3]);
                    w.z = cvt_pk_bf16(p[bk][8 * s + 4], p[bk][8 * s + 5]); w.w = cvt_pk_bf16(p[bk][8 * s + 6], p[bk][8 * s + 7]); pa[bk][s] = __builtin_bit_cast(bf16x8, w); }
#pragma unroll
            for (int bk = 0; bk < 2; ++bk)
#pragma unroll
                for (int s = 0; s < 2; ++s) {
                    const LAS unsigned char* vp = Vc + (32 * bk + 16 * s + 4 * hi + q_) * SB_KST + (16 * dh + 4 * p_) * 2;
                    const s16x4 l0 = __builtin_amdgcn_ds_read_tr16_b64_v4i16((LAS s16x4*)(vp));
                    const s16x4 h0 = __builtin_amdgcn_ds_read_tr16_b64_v4i16((LAS s16x4*)(vp + 8 * SB_KST));
                    const s16x4 l1 = __builtin_amdgcn_ds_read_tr16_b64_v4i16((LAS s16x4*)(vp + 64));
                    const s16x4 h1 = __builtin_amdgcn_ds_read_tr16_b64_v4i16((LAS s16x4*)(vp + 8 * SB_KST + 64));
                    const bf16x8 v0 = (bf16x8){l0[0], l0[1], l0[2], l0[3], h0[0], h0[1], h0[2], h0[3]};
                    const bf16x8 v1 = (bf16x8){l1[0], l1[1], l1[2], l1[3], h1[0], h1[1], h1[2], h1[3]};
                    o0 = __builtin_amdgcn_mfma_f32_32x32x16_bf16(pa[bk][s], v0, o0, 0, 0, 0);
                    o1 = __builtin_amdgcn_mfma_f32_32x32x16_bf16(pa[bk][s], v1, o1, 0, 0, 0);
                }
        }
        if (kt > 0) { *(LAS u32x4*)(Kb + (buf ^ 1) * SB_TILE + ldst) = kn; *(LAS u32x4*)(Vb + (buf ^ 1) * SB_TILE + ldst) = vn; }
    }
#pragma unroll
    for (int r = 0; r < 16; ++r) { const int q = (r & 3) + 8 * (r >> 2) + 4 * hi;
        const size_t oo = (rowbase + qw0 + q) * DM + 512 + h * 64 + r32;
        CAT_ST(cat, oo, o0[r]); CAT_ST(cat, oo + 32, o1[r]); }
    __syncthreads();
}

template <int I> struct SelStep {
    static __device__ __forceinline__ void run(const float (&v)[64], float thr, float lo, bool exact, int need_eq, int& eq_seen, unsigned& m0, unsigned& m1) {
        const bool gt = v[I] > thr; const bool eq = (!exact) && !gt && (v[I] > lo);
        const unsigned long long meq = __ballot(eq);
        const int eq_rank = eq_seen + __builtin_amdgcn_mbcnt_hi((unsigned)(meq >> 32), __builtin_amdgcn_mbcnt_lo((unsigned)meq, 0));
        const bool take = gt || (eq && eq_rank < need_eq);
        const unsigned long long mt = __ballot(take);
        const unsigned mlo = (unsigned)mt, mhi = (unsigned)(mt >> 32);
        asm volatile("s_nop 1\n\tv_writelane_b32 %0, %1, %2" : "+v"(m0) : "s"(mlo), "n"(I));
        asm volatile("s_nop 1\n\tv_writelane_b32 %0, %1, %2" : "+v"(m1) : "s"(mhi), "n"(I));
        eq_seen += __builtin_popcountll(meq);
        SelStep<I + 1>::run(v, thr, lo, exact, need_eq, eq_seen, m0, m1);
    }
};
template <> struct SelStep<64> { static __device__ __forceinline__ void run(const float (&)[64], float, float, bool, int, int&, unsigned&, unsigned&) {} };

template <int I> struct SelExact {
    static __device__ __forceinline__ void run(const float (&v)[64], float thr, unsigned& m0, unsigned& m1) {
        const unsigned long long mt = __ballot(v[I] > thr);
        const unsigned mlo = (unsigned)mt, mhi = (unsigned)(mt >> 32);
        asm volatile("s_nop 1\n\tv_writelane_b32 %0, %1, %2" : "+v"(m0) : "s"(mlo), "n"(I));
        asm volatile("s_nop 1\n\tv_writelane_b32 %0, %1, %2" : "+v"(m1) : "s"(mhi), "n"(I));
        SelExact<I + 1>::run(v, thr, m0, m1);
    }
};
template <> struct SelExact<64> { static __device__ __forceinline__ void run(const float (&)[64], float, unsigned&, unsigned&) {} };

__device__ __forceinline__ void dsa_select_unit(Frame& F, const Args& a, int unit) {
    const bf16_t* z1 = (const bf16_t*)(a.ws + WS_Z); unsigned* bm = (unsigned*)(a.ws + WS_BM);
    const int lane = F.lane, wid = F.wave, r32 = lane & 31, hi = lane >> 5;
    const int tok0 = unit * 8;
    const int b = tok0 / SEQ, t0 = tok0 % SEQ;
    const size_t rowbase = (size_t)b * SEQ;
    const int vis = (t0 / 64 + 1) * 64;
    LAS float* sc = (LAS float*)F.lds;
    if (vis > 256) {
        const int tl = 2 * (r32 >> 4) + ((r32 >> 2) & 1), hd = (r32 & 3) + 4 * ((r32 >> 3) & 1);
        bf16x8 af[2][4];
#pragma unroll
        for (int rt = 0; rt < 2; ++rt) { const bf16_t* qp = z1 + (size_t)(tok0 + 4 * rt + tl) * ZO + OQI + hd * 64 + 8 * hi;
#pragma unroll
            for (int ks = 0; ks < 4; ++ks) af[rt][ks] = *(const bf16x8*)(qp + 16 * ks); }
        float wv[4][8];
#pragma unroll
        for (int j = 0; j < 4; ++j) { const u32x4 w = *(const u32x4*)(z1 + (size_t)(tok0 + 2 * j + hi) * ZO + OWI);
            const float s = 0.35355339059f * 0.125f;
            wv[j][0] = bf_lo(w.x) * s; wv[j][1] = bf_hi(w.x) * s; wv[j][2] = bf_lo(w.y) * s; wv[j][3] = bf_hi(w.y) * s;
            wv[j][4] = bf_lo(w.z) * s; wv[j][5] = bf_hi(w.z) * s; wv[j][6] = bf_lo(w.w) * s; wv[j][7] = bf_hi(w.w) * s; }
        const int nkt = vis / 32;
        const bf16_t* kbase = (const bf16_t*)(a.ws + WS_KI1) + rowbase * 64 + (size_t)lane * 8;
        for (int rep14 = 0; rep14 < PM(14); ++rep14)
        for (int kt0 = wid; kt0 < nkt; kt0 += 8 * NWAVES) {
            bf16x8 kq[8][4];
#pragma unroll
            for (int pf = 0; pf < 8; ++pf) { const int kt = min(kt0 + pf * NWAVES, nkt - 1);
#pragma unroll
                for (int ks = 0; ks < 4; ++ks) kq[pf][ks] = *(const bf16x8*)(kbase + (size_t)(kt * 4 + ks) * 512); }
            __builtin_amdgcn_sched_barrier(0);
#pragma unroll
            for (int pf = 0; pf < 8; ++pf) { const int kt = kt0 + pf * NWAVES;
                if (kt < nkt) {
                    f32x16 d0 = {}, d1 = {};
#pragma unroll
                    for (int ks = 0; ks < 4; ++ks) { d0 = __builtin_amdgcn_mfma_f32_32x32x16_bf16(af[0][ks], kq[pf][ks], d0, 0, 0, 0); d1 = __builtin_amdgcn_mfma_f32_32x32x16_bf16(af[1][ks], kq[pf][ks], d1, 0, 0, 0); }
                    float s0 = 0.f, s1 = 0.f, s2 = 0.f, s3 = 0.f;
#pragma unroll
                    for (int r = 0; r < 8; ++r) { s0 += wv[0][r] * relu_i(d0[r]); s1 += wv[1][r] * relu_i(d0[8 + r]); s2 += wv[2][r] * relu_i(d1[r]); s3 += wv[3][r] * relu_i(d1[8 + r]); }
                    const int key = kt * 32 + r32;
                    sc[(hi) * 4096 + key] = s0; sc[(2 + hi) * 4096 + key] = s1; sc[(4 + hi) * 4096 + key] = s2; sc[(6 + hi) * 4096 + key] = s3;
                } }
        }
    }
    __syncthreads();
    for (int rep15 = 0; rep15 < PM(15); ++rep15) {
        unsigned m0 = 0u, m1 = 0u;
        if (vis <= 256) { m0 = 0xffffffffu; m1 = 0xffffffffu; }
        else {
            const LAS float* ms = sc + wid * 4096;
            float v[64];
            float mx = -INFINITY, mn = INFINITY;
#pragma unroll
            for (int i = 0; i < 64; ++i) { const bool in = (i * 64 < vis); v[i] = in ? ms[i * 64 + lane] : -INFINITY; if (in) { mx = fmaxf(mx, v[i]); mn = fminf(mn, v[i]); } }
            mx = wave_max_uniform(mx); mn = -wave_max_uniform(-mn);
            float lo = mn - 1.f - fabsf(mn), hiv = mx;
            float thr = hiv; int cgt = 0; bool exact = false;
            int c_lo = vis, c_hi = 0;
            bool dead = false;
            for (int it = 0; it < 64 && (c_lo - c_hi) > 448; ++it) {
                const float mid = 0.5f * (lo + hiv);
                if (!(mid > lo) || !(mid < hiv)) { dead = true; break; }
                int c = 0;
#pragma unroll
                for (int i = 0; i < 64; ++i) c += (v[i] > mid) ? 1 : 0;
                c = wave_sum_uniform(c);
                if (c == 256) { thr = mid; exact = true; break; }
                if (c > 256) { lo = mid; c_lo = c; } else { hiv = mid; c_hi = c; }
            }
            if (!exact && !dead) {
                LAS float* cand = sc + wid * 4096; int base = 0;
#pragma unroll
                for (int i = 0; i < 64; ++i) { const bool in = (v[i] > lo) && !(v[i] > hiv);
                    const unsigned long long mk = __ballot(in);
                    const int pos = base + __builtin_amdgcn_mbcnt_hi((unsigned)(mk >> 32), __builtin_amdgcn_mbcnt_lo((unsigned)mk, 0));
                    if (in) cand[pos] = v[i];
                    base += __builtin_popcountll(mk); }
                const int nc = c_lo - c_hi, c_hi0 = c_hi;
                float cv[8];
#pragma unroll
                for (int j = 0; j < 8; ++j) cv[j] = (lane + 64 * j < nc) ? cand[lane + 64 * j] : -INFINITY;
                for (int it = 0; it < 64; ++it) {
                    const float mid = 0.5f * (lo + hiv);
                    if (!(mid > lo) || !(mid < hiv)) break;
                    int c = 0;
#pragma unroll
                    for (int j = 0; j < 8; ++j) c += (cv[j] > mid) ? 1 : 0;
                    c = c_hi0 + wave_sum_uniform(c);
                    if (c == 256) { thr = mid; exact = true; break; }
                    if (c > 256) { lo = mid; c_lo = c; } else { hiv = mid; c_hi = c; }
                }
            }
            if (!exact) { thr = hiv; cgt = c_hi; }
            const int need_eq = exact ? 0 : (256 - cgt); int eq_seen = 0;
            if (exact) SelExact<0>::run(v, thr, m0, m1); else SelStep<0>::run(v, thr, lo, exact, need_eq, eq_seen, m0, m1);
        }
        if (lane * 64 < vis) *(u32x2*)(bm + (size_t)(tok0 + wid) * 128 + 2 * lane) = (u32x2){m0, m1};
    }
    __syncthreads();
}

template <int I> struct MaskInit {
    static __device__ __forceinline__ void run(f32x16 (&p)[2], int nw0, int nw1, float slope2, float T, int ninf) {
        constexpr int bk = I >> 4, r = I & 15, pos = 8 * (r >> 2) + (r & 3);
        const float vb = __builtin_fmaf(slope2, (float)(32 * bk + pos), T);
        int off; asm("v_bfe_i32 %0, %1, %2, 1" : "=v"(off) : "v"(bk ? nw1 : nw0), "n"(pos));
        float o; asm("v_bfi_b32 %0, %1, %2, %3" : "=v"(o) : "v"(off), "s"(ninf), "v"(vb));
        p[bk][r] = o;
        MaskInit<I + 1>::run(p, nw0, nw1, slope2, T, ninf);
    }
};
template <> struct MaskInit<32> { static __device__ __forceinline__ void run(f32x16 (&)[2], int, int, float, float, int) {} };
__device__ __forceinline__ float max3_asm(float a, float b, float c) { float r; asm("v_max3_f32 %0, %1, %2, %3" : "=v"(r) : "v"(a), "v"(b), "v"(c)); return r; }
__device__ __forceinline__ void dsa_attn_unit(Frame& F, const Args& a, int b, int ch, int g) {
    const bf16_t* z1 = (const bf16_t*)(a.ws + WS_Z); unsigned char* cat = (unsigned char*)(a.ws + WS_CAT); const unsigned* bm = (const unsigned*)(a.ws + WS_BM);
    const int tid = F.tid, lane = F.lane, wid = F.wave, r32 = lane & 31, hi = lane >> 5;
    const int hr = wid >> 1, qh = wid & 1, head = g * 4 + hr;
    const size_t rowbase = (size_t)b * SEQ;
    const int tq = ch * 64 + 32 * qh + r32;
    const float slope2 = ex2(-0.5f * (float)(head + 1)) * LOG2E;
    bf16x8 qr[4];
    { const bf16_t* qp = z1 + (rowbase + tq) * ZO + OQ + head * 64 + hi * 8;
#pragma unroll
      for (int ks = 0; ks < 4; ++ks) qr[ks] = *(const bf16x8*)(qp + ks * 16); }
    const unsigned* mrow = bm + (rowbase + tq) * 128;
    f32x16 o0 = {}, o1 = {}; float m = 0.f, l = 0.f;
    const int ntile = ch + 1;
    LAS unsigned char* Kb = F.lds; LAS unsigned char* Vb = F.lds + 2 * SB_TILE;
    LAS float* wsf = (LAS float*)(F.lds + 4 * SB_TILE) + wid * 32;
    const bf16_t* kg = (const bf16_t*)(a.ws + WS_KV1) + (rowbase + (tid >> 3)) * 512 + g * 64 + (tid & 7) * 8;
    const unsigned ldst = (unsigned)(tid >> 3) * SB_KST + (unsigned)(tid & 7) * 16;
    { const u32x4 kn = *(const u32x4*)(kg), vn = *(const u32x4*)(kg + 256);
      *(LAS u32x4*)(Kb + ldst) = kn; *(LAS u32x4*)(Vb + ldst) = vn; }
    const int dh = (lane >> 4) & 1, q_ = (lane & 15) >> 2, p_ = lane & 3;
    u32x2 mw = *(const u32x2*)(mrow);
    for (int kt = 0; kt < ntile; ++kt) {
        const int buf = kt & 1;
        u32x4 kn, vn; u32x2 mwn = mw;
        if (kt + 1 < ntile) { const size_t go = (size_t)(kt + 1) * 64 * 512; kn = *(const u32x4*)(kg + go); vn = *(const u32x4*)(kg + go + 256); mwn = *(const u32x2*)(mrow + 2 * (kt + 1)); }
        LDS_BARRIER();
        const LAS unsigned char* Kc = Kb + buf * SB_TILE; const LAS unsigned char* Vc = Vb + buf * SB_TILE;
        const float T = slope2 * (float)(64 * kt + 4 * hi) - m;
        const int nw0 = (int)~(mw.x >> (4 * hi)), nw1 = (int)~(mw.y >> (4 * hi));
        f32x16 p[2];
        MaskInit<0>::run(p, nw0, nw1, slope2, T, (int)0xff800000);
#pragma unroll
        for (int ks = 0; ks < 4; ++ks) {
            const bf16x8 k0 = *(const LAS bf16x8*)(Kc + r32 * SB_KST + (16 * ks + 8 * hi) * 2);
            const bf16x8 k1 = *(const LAS bf16x8*)(Kc + (32 + r32) * SB_KST + (16 * ks + 8 * hi) * 2);
            p[0] = __builtin_amdgcn_mfma_f32_32x32x16_bf16(k0, qr[ks], p[0], 0, 0, 0);
            p[1] = __builtin_amdgcn_mfma_f32_32x32x16_bf16(k1, qr[ks], p[1], 0, 0, 0);
        }
        if (kt == ntile - 1) {
            const float basef = (float)(tq - (64 * kt + 4 * hi));
#pragma unroll
            for (int bk = 0; bk < 2; ++bk)
#pragma unroll
                for (int r = 0; r < 16; ++r) { const float rel = (float)(32 * bk + 8 * (r >> 2) + (r & 3)) - basef; p[bk][r] -= 2.f * slope2 * fmaxf(rel, 0.f); }
        } else asm volatile("s_nop 15\n\ts_nop 7" : "+v"(p[0]), "+v"(p[1]));
        float rm;
        { float a0 = max3_asm(p[0][0], p[0][1], p[1][0]), b0 = max3_asm(p[0][2], p[0][3], p[1][1]); a0 = max3_asm(a0, p[1][2], p[1][3]);
#pragma unroll
          for (int r = 4; r < 16; r += 4) { a0 = max3_asm(a0, p[0][r], p[0][r + 1]); b0 = max3_asm(b0, p[0][r + 2], p[0][r + 3]); a0 = max3_asm(a0, p[1][r], p[1][r + 1]); b0 = max3_asm(b0, p[1][r + 2], p[1][r + 3]); }
          rm = fmaxf(a0, b0); }
        rm = fmaxf(rm, sxf<32>(rm));
        if (__any(rm > 6.f) || kt == 0) {
            const float d = (kt == 0) ? ((rm > -1e30f) ? rm : 0.f) : ((rm > 6.f) ? rm : 0.f);
            const float alpha = ex2(-d);
            l *= alpha; m += d;
#pragma unroll
            for (int bk = 0; bk < 2; ++bk)
#pragma unroll
                for (int r = 0; r < 16; ++r) p[bk][r] -= d;
            if (hi == 0) wsf[r32] = alpha;
#pragma unroll
            for (int r = 0; r < 16; ++r) { const float al = wsf[(r & 3) + 8 * (r >> 2) + 4 * hi]; o0[r] *= al; o1[r] *= al; }
        }
        float ls = 0.f;
#pragma unroll
        for (int bk = 0; bk < 2; ++bk)
#pragma unroll
            for (int r = 0; r < 16; ++r) { const float e = ex2(p[bk][r]); p[bk][r] = e; ls += e; }
        l += ls;
        bf16x8 pa[2][2];
#pragma unroll
        for (int bk = 0; bk < 2; ++bk)
#pragma unroll
            for (int s = 0; s < 2; ++s) { u32x4 w; w.x = cvt_pk_bf16(p[bk][8 * s + 0], p[bk][8 * s + 1]); w.y = cvt_pk_bf16(p[bk][8 * s + 2], p[bk][8 * s + 3]);
                w.z = cvt_pk_bf16(p[bk][8 * s + 4], p[bk][8 * s + 5]); w.w = cvt_pk_bf16(p[bk][8 * s + 6], p[bk][8 * s + 7]); pa[bk][s] = __builtin_bit_cast(bf16x8, w); }
#pragma unroll
        for (int bk = 0; bk < 2; ++bk)
#pragma unroll
            for (int s = 0; s < 2; ++s) {
                const LAS unsigned char* vp = Vc + (32 * bk + 16 * s + 4 * hi + q_) * SB_KST + (16 * dh + 4 * p_) * 2;
                const s16x4 l0 = __builtin_amdgcn_ds_read_tr16_b64_v4i16((LAS s16x4*)(vp));
                const s16x4 h0 = __builtin_amdgcn_ds_read_tr16_b64_v4i16((LAS s16x4*)(vp + 8 * SB_KST));
                const s16x4 l1 = __builtin_amdgcn_ds_read_tr16_b64_v4i16((LAS s16x4*)(vp + 64));
                const s16x4 h1 = __builtin_amdgcn_ds_read_tr16_b64_v4i16((LAS s16x4*)(vp + 8 * SB_KST + 64));
                const bf16x8 v0 = (bf16x8){l0[0], l0[1], l0[2], l0[3], h0[0], h0[1], h0[2], h0[3]};
                const bf16x8 v1 = (bf16x8){l1[0], l1[1], l1[2], l1[3], h1[0], h1[1], h1[2], h1[3]};
                o0 = __builtin_amdgcn_mfma_f32_32x32x16_bf16(pa[bk][s], v0, o0, 0, 0, 0);
                o1 = __builtin_amdgcn_mfma_f32_32x32x16_bf16(pa[bk][s], v1, o1, 0, 0, 0);
            }
        if (kt + 1 < ntile) { *(LAS u32x4*)(Kb + (buf ^ 1) * SB_TILE + ldst) = kn; *(LAS u32x4*)(Vb + (buf ^ 1) * SB_TILE + ldst) = vn; }
        mw = mwn;
    }
    l += sxf<32>(l);
    if (hi == 0) wsf[r32] = 1.f / l;
#pragma unroll
    for (int r = 0; r < 16; ++r) { const int q = (r & 3) + 8 * (r >> 2) + 4 * hi; const float inv = wsf[q];
        const size_t oo = (rowbase + ch * 64 + 32 * qh + q) * DM + head * 64 + r32;
        CAT_ST(cat, oo, o0[r] * inv); CAT_ST(cat, oo + 32, o1[r] * inv); }
    __syncthreads();
}

__device__ __forceinline__ void ln_row16(const bf16_t* src, float (&x)[16], int lane) {
    const u32x4 a = *(const u32x4*)(src + 8 * lane), b = *(const u32x4*)(src + 512 + 8 * lane);
    x[0] = bf_lo(a.x); x[1] = bf_hi(a.x); x[2] = bf_lo(a.y); x[3] = bf_hi(a.y); x[4] = bf_lo(a.z); x[5] = bf_hi(a.z); x[6] = bf_lo(a.w); x[7] = bf_hi(a.w);
    x[8] = bf_lo(b.x); x[9] = bf_hi(b.x); x[10] = bf_lo(b.y); x[11] = bf_hi(b.y); x[12] = bf_lo(b.z); x[13] = bf_hi(b.z); x[14] = bf_lo(b.w); x[15] = bf_hi(b.w);
}
__device__ __forceinline__ void ln_norm16(float (&x)[16], const float* g, const float* bta, int lane) {
    float s = 0.f;
#pragma unroll
    for (int j = 0; j < 16; ++j) s += x[j];
    const float mean = wave_sum(s) * (1.f / DM); float q = 0.f;
#pragma unroll
    for (int j = 0; j < 16; ++j) { x[j] -= mean; q += x[j] * x[j]; }
    const float rstd = 1.f / sqrtf(wave_sum(q) * (1.f / DM) + LN_EPS);
    const f32x4 g0 = *(const f32x4*)(g + 8 * lane), g1 = *(const f32x4*)(g + 8 * lane + 4), g2 = *(const f32x4*)(g + 512 + 8 * lane), g3 = *(const f32x4*)(g + 512 + 8 * lane + 4);
    const f32x4 b0 = *(const f32x4*)(bta + 8 * lane), b1 = *(const f32x4*)(bta + 8 * lane + 4), b2 = *(const f32x4*)(bta + 512 + 8 * lane), b3 = *(const f32x4*)(bta + 512 + 8 * lane + 4);
#pragma unroll
    for (int j = 0; j < 4; ++j) { x[j] = x[j] * rstd * g0[j] + b0[j]; x[4 + j] = x[4 + j] * rstd * g1[j] + b1[j]; x[8 + j] = x[8 + j] * rstd * g2[j] + b2[j]; x[12 + j] = x[12 + j] * rstd * g3[j] + b3[j]; }
}
__device__ __forceinline__ void store16bf(bf16_t* dst, const float (&x)[16], int lane) {
    u32x4 a, b; a.x = cvt_pk_bf16(x[0], x[1]); a.y = cvt_pk_bf16(x[2], x[3]); a.z = cvt_pk_bf16(x[4], x[5]); a.w = cvt_pk_bf16(x[6], x[7]);
    b.x = cvt_pk_bf16(x[8], x[9]); b.y = cvt_pk_bf16(x[10], x[11]); b.z = cvt_pk_bf16(x[12], x[13]); b.w = cvt_pk_bf16(x[14], x[15]);
    *(u32x4*)(dst + 8 * lane) = a; *(u32x4*)(dst + 512 + 8 * lane) = b;
}
__device__ __forceinline__ void store16f8(unsigned char* dst, const float (&x)[16], int lane) {
    *(u32x2*)(dst + 8 * lane) = pg8::pack8_fp8((f32x4){x[0], x[1], x[2], x[3]}, (f32x4){x[4], x[5], x[6], x[7]});
    *(u32x2*)(dst + 512 + 8 * lane) = pg8::pack8_fp8((f32x4){x[8], x[9], x[10], x[11]}, (f32x4){x[12], x[13], x[14], x[15]});
}
constexpr int HS_STRIDE = 2064;
__device__ __forceinline__ void ln1_router_phase(Frame& F, const Args& a, int layer) {
    const bf16_t* t1 = (const bf16_t*)(a.ws + WS_T1); bf16_t* hb = (bf16_t*)(a.ws + WS_HB);
    const bf16_t* wrt = (const bf16_t*)(a.ws + WS_WRT) + (size_t)layer * NEXP * DM;
    const float* g = a.in[10] + layer * DM; const float* bta = a.in[11] + layer * DM; const float* br = a.in[13] + layer * NEXP;
    int* topi = (int*)(a.ws + WS_TOPI); float* gate = (float*)(a.ws + WS_GATE); int* cnt = (int*)(a.ws + WS_CNT);
    const int lane = F.lane, w = F.wave, tid = F.tid;
    LAS unsigned char* hs = F.lds;
    LAS float* part = (LAS float*)(F.lds + 36864);
    LAS float* logit = (LAS float*)(F.lds + 36864 + 16384);
    LAS int* hist = (LAS int*)(F.lds + 36864 + 16384 + 2048);
    LAS int* topk_i = (LAS int*)(F.lds + 36864 + 16384 + 2048 + 256); LAS float* topk_v = (LAS float*)(F.lds + 36864 + 16384 + 2048 + 512);
    const int n16 = lane & 15, kg4 = lane >> 4;
    bf16x8 bw[2][4];
#pragma unroll
    for (int n = 0; n < 2; ++n)
#pragma unroll
        for (int ks = 0; ks < 4; ++ks) bw[n][ks] = *(const bf16x8*)(wrt + (size_t)(16 * n + n16) * DM + 128 * w + 32 * ks + 8 * kg4);
    for (int grp2 = F.bid; grp2 < NGRP * PM(6); grp2 += F.G) { const int grp = grp2 % NGRP;
        if (tid < 32) hist[tid] = 0;
        __syncthreads();
        for (int it = 0; it < 8; ++it) {
            const int r0 = grp * 128 + it * 16;
#pragma unroll
            for (int rr = 0; rr < 2; ++rr) { const int rl = 2 * w + rr; float x[16];
                ln_row16(t1 + (size_t)(r0 + rl) * DM, x, lane); ln_norm16(x, g, bta, lane);
                store16bf(hb + (size_t)(r0 + rl) * DM, x, lane);
                u32x4 p, q; p.x = cvt_pk_bf16(x[0], x[1]); p.y = cvt_pk_bf16(x[2], x[3]); p.z = cvt_pk_bf16(x[4], x[5]); p.w = cvt_pk_bf16(x[6], x[7]);
                q.x = cvt_pk_bf16(x[8], x[9]); q.y = cvt_pk_bf16(x[10], x[11]); q.z = cvt_pk_bf16(x[12], x[13]); q.w = cvt_pk_bf16(x[14], x[15]);
                *(LAS u32x4*)(hs + rl * HS_STRIDE + 16 * lane) = p; *(LAS u32x4*)(hs + rl * HS_STRIDE + 1024 + 16 * lane) = q; }
            __syncthreads();
            { f32x4 d0 = {0.f, 0.f, 0.f, 0.f}, d1 = {0.f, 0.f, 0.f, 0.f};
#pragma unroll
              for (int ks = 0; ks < 4; ++ks) { const bf16x8 af = *(const LAS bf16x8*)(hs + n16 * HS_STRIDE + (128 * w + 32 * ks + 8 * kg4) * 2);
                  d0 = __builtin_amdgcn_mfma_f32_16x16x32_bf16(af, bw[0][ks], d0, 0, 0, 0); d1 = __builtin_amdgcn_mfma_f32_16x16x32_bf16(af, bw[1][ks], d1, 0, 0, 0); }
#pragma unroll
              for (int r = 0; r < 4; ++r) { part[(w * 16 + 4 * kg4 + r) * 32 + n16] = d0[r]; part[(w * 16 + 4 * kg4 + r) * 32 + 16 + n16] = d1[r]; } }
            __syncthreads();
            { const int row = tid >> 5, e = tid & 31; float s = br[e];
#pragma unroll
              for (int ww = 0; ww < 8; ++ww) s += part[(ww * 16 + row) * 32 + e];
              logit[row * 32 + e] = s; }
            __syncthreads();
            { const int row = tid >> 5, e = tid & 31; const float lv = logit[row * 32 + e]; int rank = 0;
#pragma unroll
              for (int e2 = 0; e2 < 32; ++e2) { const float o = logit[row * 32 + e2]; rank += (o > lv || (o == lv && e2 < e)) ? 1 : 0; }
              if (rank < 4) { topk_i[row * 4 + rank] = e; topk_v[row * 4 + rank] = lv; } }
            __syncthreads();
            if (tid < 16) { const int tok = r0 + tid;
                const int t0 = topk_i[tid * 4 + 0], t1 = topk_i[tid * 4 + 1], t2 = topk_i[tid * 4 + 2], t3 = topk_i[tid * 4 + 3];
                const float v0 = topk_v[tid * 4 + 0];
                const float e0 = 1.f, e1 = __expf(topk_v[tid * 4 + 1] - v0), e2 = __expf(topk_v[tid * 4 + 2] - v0), e3 = __expf(topk_v[tid * 4 + 3] - v0); const float inv = 1.f / (e0 + e1 + e2 + e3);
                *(int4*)(topi + (size_t)tok * 4) = make_int4(t0, t1, t2, t3);
                *(float4*)(gate + (size_t)tok * 4) = make_float4(e0 * inv, e1 * inv, e2 * inv, e3 * inv);
                atomicAdd((int*)&hist[t0], 1); atomicAdd((int*)&hist[t1], 1); atomicAdd((int*)&hist[t2], 1); atomicAdd((int*)&hist[t3], 1); }
        }
        __syncthreads();
        if (tid < 32) cnt[grp * 32 + tid] = hist[tid];
        __syncthreads();
    }
}

__device__ __forceinline__ void moe_tables(Frame& F, const Args& a, int grp) {
    const int* cnt = (const int*)(a.ws + WS_CNT);
    LAS int* T = (LAS int*)(F.lds + TAB_OFF);
    const int tid = F.tid, e = tid & 31, j = tid >> 5;
    { int s = 0, bf = 0;
      for (int gg = j * 16; gg < j * 16 + 16; ++gg) { const int c = cnt[gg * 32 + e]; s += c; if (gg < grp) bf += c; }
      T[TB_TOT16 / 4 + j * 32 + e] = s; T[TB_BEF16 / 4 + j * 32 + e] = bf; }
    __syncthreads();
    if (tid < 32) { int s = 0, bf = 0;
#pragma unroll
        for (int jj = 0; jj < 16; ++jj) { s += T[TB_TOT16 / 4 + jj * 32 + tid]; bf += T[TB_BEF16 / 4 + jj * 32 + tid]; }
        T[TB_TOTAL / 4 + tid] = s; T[TB_BEFORE / 4 + tid] = bf; T[TB_LCUR / 4 + tid] = 0; }
    __syncthreads();
    if (tid < 32) {
        int ps = 0;
#pragma nounroll
        for (int ee = 0; ee < tid; ++ee) ps += ((T[TB_TOTAL / 4 + ee] + 255) >> 8) << 8;
        T[TB_PADST / 4 + tid] = ps; T[TB_BASE / 4 + tid] = ps + T[TB_BEFORE / 4 + tid];
        if (tid == 31) { const int end = ps + (((T[TB_TOTAL / 4 + 31] + 255) >> 8) << 8); T[TB_PADST / 4 + 32] = end; T[TB_NTL / 4] = end >> 8; } }
    __syncthreads();
    { LAS unsigned char* t2e = (LAS unsigned char*)(F.lds + TAB_OFF + TB_T2E); const int ntl = T[TB_NTL / 4];
      for (int rt = tid; rt < ntl; rt += NTHR) { int e = 0;
#pragma nounroll
          for (int ee = 1; ee < 32; ++ee) e += (T[TB_PADST / 4 + ee] <= rt * 256) ? 1 : 0;
          t2e[rt] = (unsigned char)e; } }
    __syncthreads();
}
__device__ __forceinline__ void scatter_phase(Frame& F, const Args& a) {
    const bf16_t* hb = (const bf16_t*)(a.ws + WS_HB); unsigned char* xs = (unsigned char*)(a.ws + WS_XS);
    const int* topi = (const int*)(a.ws + WS_TOPI); const float* gate = (const float*)(a.ws + WS_GATE);
    int* slot = (int*)(a.ws + WS_SLOT); float* rowg = (float*)(a.ws + WS_ROWG);
    LAS int* T = (LAS int*)(F.lds + TAB_OFF); LAS int* rows = (LAS int*)(F.lds + XTRA_OFF);
    const int tid = F.tid, lane = F.lane, w = F.wave;
    if (F.bid >= NGRP) moe_tables(F, a, -1);
    for (int grp2 = F.bid; grp2 < NGRP * PM(7); grp2 += F.G) { const int grp = grp2 % NGRP;
        moe_tables(F, a, grp);
        { const int tok = grp * 128 + (tid >> 2), k = tid & 3; const int e = topi[(size_t)tok * 4 + k];
          const int rank = atomicAdd((int*)&T[TB_LCUR / 4 + e], 1); const int row = T[TB_BASE / 4 + e] + rank;
          slot[(size_t)tok * 4 + k] = row; rowg[row] = gate[(size_t)tok * 4 + k]; rows[tid] = row; }
        __syncthreads();
        for (int i = 0; i < 16; ++i) { const int tl = w * 16 + i; const size_t tok = (size_t)grp * 128 + tl;
            float x[16]; ln_row16(hb + tok * DM, x, lane);
            const u32x2 p = pg8::pack8_fp8((f32x4){x[0], x[1], x[2], x[3]}, (f32x4){x[4], x[5], x[6], x[7]}), q = pg8::pack8_fp8((f32x4){x[8], x[9], x[10], x[11]}, (f32x4){x[12], x[13], x[14], x[15]});
#pragma unroll
            for (int k = 0; k < 4; ++k) { const size_t row = (size_t)rows[tl * 4 + k]; *(u32x2*)(xs + row * DM + 8 * lane) = p; *(u32x2*)(xs + row * DM + 512 + 8 * lane) = q; } }
        __syncthreads();
    }
}
__device__ __forceinline__ void combine_phase(Frame& F, const Args& a) {
    const bf16_t* hb = (const bf16_t*)(a.ws + WS_HB); const bf16_t* yb = (const bf16_t*)(a.ws + WS_XS); bf16_t* mid = (bf16_t*)(a.ws + WS_MIDB);
    const int* slot = (const int*)(a.ws + WS_SLOT);
    const int lane = F.lane;
    for (int tok2 = F.bid * NWAVES + F.wave; tok2 < NTOK * PM(10); tok2 += F.G * NWAVES) { const int tok = tok2 % NTOK;
        float x[16]; ln_row16(hb + (size_t)tok * DM, x, lane);
#pragma unroll
        for (int j = 0; j < 16; ++j) x[j] *= ALPHA;
        const int4 sl = *(const int4*)(slot + (size_t)tok * 4);
        const int s4[4] = {sl.x, sl.y, sl.z, sl.w};
#pragma unroll
        for (int k = 0; k < 4; ++k) {
            if (Y_FP8) { const unsigned char* yr = (const unsigned char*)yb + (size_t)s4[k] * DM;
                const u32x2 p = *(const u32x2*)(yr + 8 * lane), q = *(const u32x2*)(yr + 512 + 8 * lane);
                const unsigned w4[4] = {p.x, p.y, q.x, q.y};
#pragma unroll
                for (int i = 0; i < 4; ++i) { const f32x2 lo = __builtin_amdgcn_cvt_pk_f32_fp8((int)w4[i], false), hi2 = __builtin_amdgcn_cvt_pk_f32_fp8((int)w4[i], true);
                    x[4 * i + 0] += lo.x * 0.0625f; x[4 * i + 1] += lo.y * 0.0625f; x[4 * i + 2] += hi2.x * 0.0625f; x[4 * i + 3] += hi2.y * 0.0625f; } }
            else { float y[16]; ln_row16(yb + (size_t)s4[k] * DM, y, lane);
#pragma unroll
                for (int j = 0; j < 16; ++j) x[j] += y[j]; } }
        store16bf(mid + (size_t)tok * DM, x, lane); store16f8((unsigned char*)(a.ws + WS_MIDQ) + (size_t)tok * DM, x, lane);
    }
}
__device__ __forceinline__ void ln2_phase(Frame& F, const Args& a, int layer) {
    const bf16_t* t2 = (const bf16_t*)(a.ws + WS_T1); bf16_t* xb = (bf16_t*)(a.ws + WS_XB);
    const float* g = a.in[18] + layer * DM; const float* bta = a.in[19] + layer * DM;
    const int lane = F.lane;
    for (int tok2 = F.bid * NWAVES + F.wave; tok2 < NTOK * PM(12); tok2 += F.G * NWAVES) { const int tok = tok2 % NTOK;
        float x[16]; ln_row16(t2 + (size_t)tok * DM, x, lane); ln_norm16(x, g, bta, lane);
        if (layer == 0) { store16bf(xb + (size_t)tok * DM, x, lane); if (FP8_IN1) store16f8((unsigned char*)(a.ws + WS_XQ) + (size_t)tok * DM, x, lane); }
        else { float* o = a.out + (size_t)tok * DM;
            *(f32x4*)(o + 8 * lane) = (f32x4){x[0], x[1], x[2], x[3]}; *(f32x4*)(o + 8 * lane + 4) = (f32x4){x[4], x[5], x[6], x[7]};
            *(f32x4*)(o + 512 + 8 * lane) = (f32x4){x[8], x[9], x[10], x[11]}; *(f32x4*)(o + 512 + 8 * lane + 4) = (f32x4){x[12], x[13], x[14], x[15]}; }
    }
}

__global__ void __launch_bounds__(NTHR, 2) __attribute__((target("no-packed-fp32-ops"))) hybrid_fwd(Args args) {
    extern __shared__ __attribute__((aligned(16))) unsigned char lds_raw[];
    Frame F;
    F.lds = (LAS unsigned char*)lds_raw;
    F.tid = threadIdx.x; F.lane = F.tid & 63; F.wave = __builtin_amdgcn_readfirstlane(F.tid >> 6); F.G = gridDim.x; F.bid = blockIdx.x;
    volatile LAS unsigned* MISC = (volatile LAS unsigned*)(F.lds + MISC_OFF);
    for (int u = F.tid; u < 128; u += NTHR) MISC[u] = 0u;
    __syncthreads();
    XcdBarrier bar = xcd_barrier_post((unsigned*)(args.ws + WS_CTL) + 4096, MISC + 8);
    const int lo = args.ph_lo; int ph = 0; (void)lo; (void)ph;
#ifndef PHMASK
#define PHMASK 0xfffff
#endif
#ifndef PROBE_DUP
#define PROBE_DUP 0
#endif
#define SITE(k) if constexpr ((PHMASK >> (k)) & 1)
typedef const __attribute__((address_space(4))) Args* KArgs;
#define PHASE_REFRESH int t_ = threadIdx.x; asm volatile("" : "+v"(t_)); F.tid = t_; F.lane = t_ & 63; F.wave = __builtin_amdgcn_readfirstlane(t_ >> 6); \
    { int b_ = blockIdx.x; asm volatile("" : "+s"(b_)); F.bid = b_; } \
    { unsigned l_ = 0; asm volatile("" : "+s"(l_)); F.lds = (LAS unsigned char*)lds_raw + l_; } LAS unsigned char* const ring = F.lds; \
    LOAD_ARGS unsigned char* const ws = A.ws;
#if defined(__HIP_DEVICE_COMPILE__)
#define LOAD_ARGS KArgs ap_ = (KArgs)__builtin_amdgcn_kernarg_segment_ptr(); asm volatile("" : "+s"(ap_)); const Args A = *ap_;
#else
#define LOAD_ARGS const Args A = args;
#endif
#ifdef MK_LAUNCHES_PER_PHASE
#define PHASE_BEGIN if (ph == lo) { PHASE_REFRESH
#define PHASE_END   } ++ph;
#define PHASE_END_LAST } ++ph;
#else
#define PHASE_BEGIN { PHASE_REFRESH
#ifdef PROBE_BAR2
#define PHASE_END   xcd_barrier(bar); xcd_barrier(bar); }
#else
#define PHASE_END   xcd_barrier(bar); }
#endif
#define PHASE_END_LAST if (layer == 0) xcd_barrier(bar); }
#endif
    using namespace pg8;

    PHASE_BEGIN SITE(0) p0_prologue(F, A); PHASE_END

    for (int layer = 0; layer < 2; ++layer) {
        PHASE_BEGIN
        SITE(1) {
        if (layer == 0) {
            SITE(16) { DenseOrder S; S.initp(ws + (FP8_IN0 ? WS_XQ : WS_XB), ws + WS_WIN0, NTOK, ZE, FP8_IN0 ? DM : 2 * DM, F.G, F.bid, PM(1)); EpiIn0 E{(bf16_t*)(ws + WS_Z), 0.125f * LOG2E}; int p8 = FP8_IN0 ? DM : 2 * DM; asm volatile("" : "+s"(p8)); gemm_phase<EpiIn0, DenseOrder, FP8_IN0 != 0>(ring, F.tid, p8, S, E); }
            SITE(17) { PleOrder S; S.D.init(ws + WS_PB, ws + WS_WPLE, 2 * NTOK, DM, PLE, F.G, F.bid, PM(1));
              int kple = 2 * PLE; asm volatile("" : "+s"(kple));
              EpiPlain E{(bf16_t*)(ws + WS_PPLE), DM}; gemm_phase(ring, F.tid, kple, S, E); }
        } else {
            SITE(18) { DenseOrder S; S.initp(ws + (FP8_IN1 ? WS_XQ : WS_XB), ws + WS_WIN1, NTOK, ZO, FP8_IN1 ? DM : 2 * DM, F.G, F.bid, PM(1)); EpiIn1 E{(bf16_t*)(ws + WS_Z), (bf16_t*)(ws + WS_KV1), (bf16_t*)(ws + WS_KI1)}; int p8 = FP8_IN1 ? DM : 2 * DM; asm volatile("" : "+s"(p8)); gemm_phase<EpiIn1, DenseOrder, FP8_IN1 != 0>(ring, F.tid, p8, S, E); }
        }
        }
        PHASE_END
        PHASE_BEGIN
        if (layer == 0) {
            SITE(2) for (long L = F.bid; L < 1024 * PM(2); L += F.G) { const int v = (int)(L & 255), rnd = (int)((L >> 8) & 3), s = v & 3, bh = v >> 2;
                const int qb = rnd == 0 ? 15 - s : (rnd == 1 ? 8 + s : (rnd == 2 ? 7 - s : s));
                sb_unit(F, A, bh >> 3, bh & 7, qb); }
            SITE(3) for (int u = F.bid; u < PM(3) * NTOK / 128; u += F.G) gmlp_unit(F, A, u % (NTOK / 128));
        } else {
            SITE(4) for (int L = F.bid; L < PM(4) * NTOK / 8; L += F.G) { const int Lm = L % (NTOK / 8), r = Lm >> 8, cc = Lm & 255;
                const int j = (r & 1) ? 511 - cc : cc; dsa_select_unit(F, A, (r >> 1) * 512 + j); }
        }
        PHASE_END
        if (layer == 1) {
        PHASE_BEGIN
            SITE(13) for (int L = F.bid; L < 1024 * PM(13); L += F.G) { const int idx = L & 1023, pp = idx & 31, g = (idx >> 5) & 3, b = idx >> 7;
                dsa_attn_unit(F, A, b, 63 - pp, g); dsa_attn_unit(F, A, b, pp, g); }
        PHASE_END
        }
        PHASE_BEGIN
        SITE(5) { DenseOrder S; S.initp(ws + WS_CAT, ws + (layer == 0 ? WS_WO0 : WS_WO1), NTOK, DM, FP8_OUT ? DM : 2 * DM, F.G, F.bid, PM(5));
          EpiOut E{layer == 0 ? A.in[0] : nullptr, (const bf16_t*)(ws + WS_XB), (bf16_t*)(ws + WS_T1)}; int p8 = FP8_OUT ? DM : 2 * DM; asm volatile("" : "+s"(p8)); gemm_phase<EpiOut, DenseOrder, FP8_OUT != 0>(ring, F.tid, p8, S, E); }
        PHASE_END
        PHASE_BEGIN SITE(6) ln1_router_phase(F, A, layer); PHASE_END
        PHASE_BEGIN SITE(7) scatter_phase(F, A); PHASE_END
        PHASE_BEGIN
        SITE(8) {
#ifdef MK_LAUNCHES_PER_PHASE
          moe_tables(F, A, -1);
#endif
          const int ntl = __builtin_amdgcn_readfirstlane(((LAS int*)(F.lds + TAB_OFF))[TB_NTL / 4]);
          MoeOrder<8, true> S; S.nunits = ntl * 8; S.G = F.G; S.c = F.bid; S.rep = PM(8); S.t2e = (const LAS unsigned char*)(F.lds + TAB_OFF + TB_T2E);
          S.A = (const char*)(ws + WS_XS); S.W = (const char*)(ws + WS_WGU) + (size_t)layer * 32 * 2048 * DM;
          EpiSwiglu E{(unsigned char*)(ws + WS_ACT), A.in[15] + (size_t)layer * 32 * 2048}; int p8 = DM; asm volatile("" : "+s"(p8)); gemm_phase<EpiSwiglu, MoeOrder<8, true>, true, MOE_ALIGN>(ring, F.tid, p8, S, E); }
        PHASE_END
        PHASE_BEGIN
        SITE(9) {
#ifdef MK_LAUNCHES_PER_PHASE
          moe_tables(F, A, -1);
#endif
          const int ntl = __builtin_amdgcn_readfirstlane(((LAS int*)(F.lds + TAB_OFF))[TB_NTL / 4]);
          MoeOrder<4, false> S; S.nunits = ntl * 4; S.G = F.G; S.c = F.bid; S.rep = PM(9); S.t2e = (const LAS unsigned char*)(F.lds + TAB_OFF + TB_T2E);
          S.A = (const char*)(ws + WS_ACT); S.W = (const char*)(ws + WS_WD) + (size_t)layer * 32 * DM * DM;
          EpiDown E{(bf16_t*)(ws + WS_XS), A.in[17] + (size_t)layer * 32 * DM, (const float*)(ws + WS_ROWG)}; int p8 = DM; asm volatile("" : "+s"(p8)); gemm_phase<EpiDown, MoeOrder<4, false>, true, MOE_ALIGN>(ring, F.tid, p8, S, E); }
        PHASE_END
        PHASE_BEGIN SITE(10) combine_phase(F, A); PHASE_END
        PHASE_BEGIN
        SITE(11) { DenseOrder S; S.initp(ws + (FP8_GATE ? WS_MIDQ : WS_MIDB), ws + WS_WG + (size_t)layer * DM * DM * (FP8_GATE ? 1 : 2), NTOK, DM, FP8_GATE ? DM : 2 * DM, F.G, F.bid, PM(11));
          EpiGate E{(const bf16_t*)(ws + WS_MIDB), (const bf16_t*)(ws + WS_PPLE) + (size_t)layer * NTOK * DM, A.in[22] + layer * DM, (bf16_t*)(ws + WS_T1)}; int p8 = FP8_GATE ? DM : 2 * DM; asm volatile("" : "+s"(p8)); gemm_phase<EpiGate, DenseOrder, FP8_GATE != 0>(ring, F.tid, p8, S, E); }
        PHASE_END
        PHASE_BEGIN SITE(12) ln2_phase(F, A, layer); PHASE_END_LAST
    }
#undef PHASE_BEGIN
#undef PHASE_END
#undef PHASE_END_LAST
}
constexpr int N_PHASES = 22;

extern "C" void kernel_launch(void* const* d_in, const int* in_sizes, int n_in, void* d_out, int out_size, void* d_ws, size_t ws_size, hipStream_t stream) {
    static int grid = 0;
    if (grid == 0) {
        if (n_in != 23 || out_size != NTOK * DM || ws_size < WS_END) { fprintf(stderr, "kernel_launch: unexpected problem: n_in %d out %d ws %zu (need %zu)\n", n_in, out_size, ws_size, (size_t)WS_END); grid = -1; return; }
        int dev = 0, cus = 0, per_cu = 0;
        if (hipGetDevice(&dev) != hipSuccess || hipDeviceGetAttribute(&cus, hipDeviceAttributeMultiprocessorCount, dev) != hipSuccess) { grid = -1; return; }
        if (hipFuncSetAttribute((const void*)hybrid_fwd, hipFuncAttributeMaxDynamicSharedMemorySize, LDS_BYTES) != hipSuccess) { fprintf(stderr, "kernel_launch: hipFuncSetAttribute failed\n"); grid = -1; return; }
        if (hipOccupancyMaxActiveBlocksPerMultiprocessor(&per_cu, (const void*)hybrid_fwd, NTHR, LDS_BYTES) != hipSuccess || per_cu < 1) fprintf(stderr, "kernel_launch: occupancy query says %d\n", per_cu);
        (void)hipGetLastError();
        grid = cus;
    }
    if (grid < 0) return;
    (void)hipMemsetAsync((char*)d_ws + WS_CTL, 0, CTL_ZERO_BYTES, stream);
    Args a{};
    for (int i = 0; i < 23; ++i) a.in[i] = (const float*)d_in[i];
    a.out = (float*)d_out; a.ws = (unsigned char*)d_ws;
#ifndef MK_LAUNCHES_PER_PHASE
    a.ph_lo = 0; a.ph_hi = N_PHASES;
    hipLaunchKernelGGL(hybrid_fwd, dim3(grid), dim3(NTHR), LDS_BYTES, stream, a);
#else
    for (int p = 0; p < N_PHASES; ++p) { a.ph_lo = p; a.ph_hi = p + 1; hipLaunchKernelGGL(hybrid_fwd, dim3(grid), dim3(NTHR), LDS_BYTES, stream, a); }
#endif
}
```

```cpp
#include <hip/hip_runtime.h>
#include <cstdio>
#include <cstdint>

#define LAS __attribute__((address_space(3)))
#define GAS __attribute__((address_space(1)))
typedef unsigned short bf16_t;
typedef short bf16x8 __attribute__((ext_vector_type(8)));
typedef short s16x4 __attribute__((ext_vector_type(4)));
typedef float f32x2 __attribute__((ext_vector_type(2)));
typedef float f32x4 __attribute__((ext_vector_type(4)));
typedef float f32x16 __attribute__((ext_vector_type(16)));
typedef unsigned u32x2 __attribute__((ext_vector_type(2)));
typedef unsigned u32x4 __attribute__((ext_vector_type(4)));

constexpr int DM = 1024, NB = 8, SEQ = 4096, NTOK = NB * SEQ;
constexpr int ZE = 2560;
constexpr int ZO = 2304, ZO_REAL = 2120;
constexpr int OQ = 0, OK_ = 1024, OV = 1280, OQI = 1536, OKI = 2048, OWI = 2112;
constexpr int NEXP = 32, PLE = 256;
constexpr int NGRP = NTOK / 128;
constexpr int MAXTILES = NTOK * 4 / 256 + NEXP;
constexpr int MAXROWS = MAXTILES * 256;
constexpr float LN_EPS = 1e-5f;
constexpr float ALPHA = 1.4142135623730951f;
constexpr float LOG2E = 1.4426950408889634f;
constexpr float WSC = 64.f, WSC_INV = 1.f / 64.f;

#ifndef FP8_IN0
#define FP8_IN0 1
#endif
#ifndef Y_FP8
#define Y_FP8 1
#endif
#ifndef MOE_ALIGN
#define MOE_ALIGN true
#endif
#ifndef FP8_IN1
#define FP8_IN1 0
#endif
#ifndef FP8_OUT
#define FP8_OUT 1
#endif
#ifndef FP8_GATE
#define FP8_GATE 1
#endif
#ifndef PROBE_DUP
#define PROBE_DUP 0
#endif
#define PM(k) (((PROBE_DUP >> (k)) & 1) ? 2 : 1)

constexpr size_t MiB = 1u << 20;
constexpr size_t WS_CTL = 0, CTL_ZERO_BYTES = 1 * MiB;
constexpr size_t WS_WRT = 1 * MiB;
constexpr size_t WS_WSB = WS_WRT + 256 * 1024;
constexpr size_t WS_CNT = WS_WSB + 256 * 1024;
constexpr size_t WS_TOPI = 2 * MiB;
constexpr size_t WS_GATE = WS_TOPI + 512 * 1024;
constexpr size_t WS_SLOT = 3 * MiB;
constexpr size_t WS_ROWG = WS_SLOT + 512 * 1024;
constexpr size_t WS_WIN0 = 8 * MiB, WS_WO0 = 13 * MiB, WS_WIN1 = 15 * MiB, WS_WO1 = 20 * MiB, WS_WG = 22 * MiB, WS_WPLE = 26 * MiB;
constexpr size_t WS_WGU = 32 * MiB, WS_WD = 288 * MiB;
constexpr size_t WS_XB = 416 * MiB, WS_PB = 480 * MiB, WS_PPLE = 512 * MiB, WS_Z = 640 * MiB, WS_CAT = 800 * MiB, WS_T1 = 864 * MiB;
constexpr size_t WS_BM = 1328 * MiB;
constexpr size_t WS_KV1 = WS_BM + 16 * MiB;
constexpr size_t WS_KI1 = WS_KV1 + 32 * MiB;
constexpr size_t WS_HB = 928 * MiB, WS_MIDB = 992 * MiB, WS_XS = 1056 * MiB, WS_ACT = 1328 * MiB;
constexpr size_t WS_XQ = 1600 * MiB, WS_MIDQ = 1632 * MiB, WS_END = 1664 * MiB;
static_assert(WS_ROWG + (size_t)MAXROWS * 4 <= WS_WIN0, "small buffers");
static_assert(WS_XS + (size_t)MAXROWS * DM * 2 <= WS_ACT && WS_ACT + (size_t)MAXROWS * DM * 2 <= WS_END, "moe buffers");

constexpr int RING_BYTES = 131072;
constexpr int MISC_OFF = RING_BYTES;
constexpr int TAB_OFF = MISC_OFF + 512;
constexpr int XTRA_OFF = TAB_OFF + 6144;
constexpr int LDS_BYTES = 147456;
static_assert(XTRA_OFF + 8192 <= LDS_BYTES, "LDS map");
constexpr int TB_TOT16 = 0, TB_BEF16 = 2048, TB_TOTAL = 4096, TB_BEFORE = 4224, TB_PADST = 4352  , TB_NTL = 4488, TB_LCUR = 4608  , TB_BASE = 4736  , TB_T2E = 5120  ;
static_assert(TB_T2E + 544 <= 6144, "tab");

#define RLX_AGENT __ATOMIC_RELAXED, __HIP_MEMORY_SCOPE_AGENT
typedef __bf16 bf16x2_t __attribute__((ext_vector_type(2)));
__device__ __forceinline__ unsigned cvt_pk_bf16(float lo, float hi) { const f32x2 v = {lo, hi}; const bf16x2_t b = __builtin_convertvector(v, bf16x2_t); return __builtin_bit_cast(unsigned, b); }
__device__ __forceinline__ unsigned char f8_1(float v) { return (unsigned char)(__builtin_amdgcn_cvt_pk_fp8_f32(v, v, 0, false) & 0xff); }
#if FP8_OUT
#define CAT_ST(cat, idx, v) ((cat)[idx] = f8_1(v))
#else
#define CAT_ST(cat, idx, v) (((bf16_t*)(cat))[idx] = (bf16_t)(cvt_pk_bf16((v), 0.f) & 0xffffu))
#endif
__device__ __forceinline__ float bf_lo(unsigned u) { return __uint_as_float(u << 16); }
__device__ __forceinline__ float bf_hi(unsigned u) { return __uint_as_float(u & 0xffff0000u); }
__device__ __forceinline__ float bf1(bf16_t u) { return __uint_as_float(((unsigned)u) << 16); }
template <int K> __device__ __forceinline__ int sxi(int v) {
    if constexpr (K == 32) { const auto rr = __builtin_amdgcn_permlane32_swap((unsigned)v, (unsigned)v, false, false); return (int)(rr[0] ^ rr[1] ^ (unsigned)v); }
    else return __builtin_amdgcn_ds_swizzle(v, (K << 10) | 0x1f);
}
template <int K> __device__ __forceinline__ float sxf(float v) { return __int_as_float(sxi<K>(__float_as_int(v))); }
__device__ __forceinline__ float wave_sum(float x) {
    int v = __float_as_int(x);
#define WSF_STEP(ctrl, rm) { const int o = __builtin_amdgcn_update_dpp(0, v, ctrl, rm, 0xf, false); v = __float_as_int(__int_as_float(v) + __int_as_float(o)); }
    WSF_STEP(0x111, 0xf) WSF_STEP(0x112, 0xf) WSF_STEP(0x114, 0xf) WSF_STEP(0x118, 0xf) WSF_STEP(0x142, 0xa) WSF_STEP(0x143, 0xc)
#undef WSF_STEP
    return __int_as_float(__builtin_amdgcn_readlane(v, 63));
}
__device__ __forceinline__ float wave_max(float v) {
    v = fmaxf(v, sxf<1>(v)); v = fmaxf(v, sxf<2>(v)); v = fmaxf(v, sxf<4>(v)); v = fmaxf(v, sxf<8>(v)); v = fmaxf(v, sxf<16>(v)); v = fmaxf(v, sxf<32>(v));
    return v;
}
__device__ __forceinline__ float wave_min(float v) {
    v = fminf(v, sxf<1>(v)); v = fminf(v, sxf<2>(v)); v = fminf(v, sxf<4>(v)); v = fminf(v, sxf<8>(v)); v = fminf(v, sxf<16>(v)); v = fminf(v, sxf<32>(v));
    return v;
}
__device__ __forceinline__ int wave_sumi(int v) {
    v += sxi<1>(v); v += sxi<2>(v); v += sxi<4>(v); v += sxi<8>(v); v += sxi<16>(v); v += sxi<32>(v);
    return v;
}
__device__ __forceinline__ int wave_sum_uniform(int v) {
    v += __builtin_amdgcn_update_dpp(0, v, 0x111, 0xf, 0xf, false);
    v += __builtin_amdgcn_update_dpp(0, v, 0x112, 0xf, 0xf, false);
    v += __builtin_amdgcn_update_dpp(0, v, 0x114, 0xf, 0xf, false);
    v += __builtin_amdgcn_update_dpp(0, v, 0x118, 0xf, 0xf, false);
    v += __builtin_amdgcn_update_dpp(0, v, 0x142, 0xa, 0xf, false);
    v += __builtin_amdgcn_update_dpp(0, v, 0x143, 0xc, 0xf, false);
    return __builtin_amdgcn_readlane(v, 63);
}
__device__ __forceinline__ float wave_max_uniform(float x) {
    int v = __float_as_int(x);
#define WMX_STEP(ctrl, rm) { const int o = __builtin_amdgcn_update_dpp(v, v, ctrl, rm, 0xf, false); v = __float_as_int(fmaxf(__int_as_float(v), __int_as_float(o))); }
    WMX_STEP(0x111, 0xf) WMX_STEP(0x112, 0xf) WMX_STEP(0x114, 0xf) WMX_STEP(0x118, 0xf) WMX_STEP(0x142, 0xa) WMX_STEP(0x143, 0xc)
#undef WMX_STEP
    return __int_as_float(__builtin_amdgcn_readlane(v, 63));
}
__device__ __forceinline__ float relu_i(float x) { const int i = __float_as_int(x); return __int_as_float(i > 0 ? i : 0); }
__device__ __forceinline__ float ex2(float x) { return __builtin_amdgcn_exp2f(x); }
__device__ __forceinline__ float lg2(float x) { return __builtin_amdgcn_logf(x); }
__device__ __forceinline__ float rcpf_(float x) { return __builtin_amdgcn_rcpf(x); }
__device__ __forceinline__ float sigmoidf_(float x) { return rcpf_(1.f + ex2(-LOG2E * x)); }
__device__ __forceinline__ float gelu_tanh(float x) { return x * rcpf_(1.f + ex2(-2.302208198f * (x + 0.044715f * x * x * x))); }

namespace pg8 {
constexpr int BM = 256, BK = 64, HALF = 128, HTB = HALF * BK * 2, STAGE_BYTES = 8 * HTB, NXCD = 8, WGM = 8;
__host__ __device__ __forceinline__ int lds_byte(int r, int c) { const int st = (r >> 4) * 2 + (c >> 5), rr = r & 15, cc = c & 31, ob = rr * 64 + cc * 2; return st * 1024 + (ob ^ (((ob >> 9) & 1) << 5)); }
__host__ __device__ __forceinline__ void stage_rc(int b, int& R, int& C) { const int st = b / 1024, sb = b % 1024, swz = sb ^ (((sb >> 9) & 1) << 5); R = (st >> 1) * 16 + swz / 64; C = (st & 1) * 32 + (swz % 64) / 2; }
__host__ __device__ __forceinline__ int perm32(int rho) { const int n = rho >> 4, i = rho & 15; return 8 * (i >> 2) + 4 * n + (i & 3); }

struct Unit { int pm, pn, e; const char* b0; };
typedef int v8i_t __attribute__((ext_vector_type(8)));
typedef int v4i_t __attribute__((ext_vector_type(4)));
__device__ __forceinline__ v8i_t cat8(const bf16x8 a, const bf16x8 b) { const v4i_t x = __builtin_bit_cast(v4i_t, a), y = __builtin_bit_cast(v4i_t, b); return __builtin_shufflevector(x, y, 0, 1, 2, 3, 4, 5, 6, 7); }

struct DenseOrder {
    int nM, nN, nwg, G, c, rep; const char* A; const char* B; size_t tstep, hstep;
    __device__ __forceinline__ void init(const void* A_, const void* B_, int M, int N, int K, int G_, int c_, int rep_ = 1) { initp(A_, B_, M, N, 2 * K, G_, c_, rep_); }
    __device__ __forceinline__ void initp(const void* A_, const void* B_, int M, int N, int pitch, int G_, int c_, int rep_ = 1) { A = (const char*)A_; B = (const char*)B_; nM = M / BM; nN = N / BM; nwg = nM * nN; G = G_; c = c_; rep = rep_; hstep = (size_t)HALF * pitch; tstep = 2 * hstep; }
    __device__ __forceinline__ bool next(int i, Unit& u) const {
        long L = (long)i * G + c; if (L >= (long)nwg * rep) return false; if (L >= nwg) L -= nwg;
        int wgid = (int)L; { const int q = nwg / NXCD, r = nwg % NXCD, xcd = wgid % NXCD, off = wgid / NXCD; wgid = (xcd < r ? xcd * (q + 1) : r * (q + 1) + (xcd - r) * q) + off; }
        const int nig = WGM * nN, gid = wgid / nig, fm = gid * WGM, gsz = (nM - fm) < WGM ? (nM - fm) : WGM;
        u.pm = fm + ((wgid % nig) % gsz); u.pn = (wgid % nig) / gsz; u.e = 0;
        u.b0 = B + (size_t)u.pn * tstep; return true;
    }
    __device__ __forceinline__ const char* aptr(const Unit& u) const { return A + (size_t)u.pm * tstep; }
    __device__ __forceinline__ size_t b1off() const { return hstep; }
};
struct PleOrder {
    DenseOrder D;
    __device__ __forceinline__ bool next(int i, Unit& u) const { if (!D.next(i, u)) return false; if (u.pm >= 32768 / BM) u.b0 += (size_t)1024 * 256 * 2; return true; }
    __device__ __forceinline__ const char* aptr(const Unit& u) const { return D.aptr(u); }
    __device__ __forceinline__ size_t b1off() const { return D.b1off(); }
};
template <int NT, bool SWIGLU>
struct MoeOrder {
    int nunits, G, c, rep; const LAS unsigned char* t2e; const char* A; const char* W;
    static constexpr size_t hstep = (size_t)HALF * 1024, tstep = 2 * hstep;
    __device__ __forceinline__ bool next(int i, Unit& u) const {
        const int vc = ((G & 7) == 0) ? (c & 7) * (G >> 3) + (c >> 3) : c;
        int L = i * G + vc; if (L >= nunits * rep) return false; if (L >= nunits) L -= nunits;
        const int rt = L / NT, pn = L % NT;
        const int e = __builtin_amdgcn_readfirstlane((int)t2e[rt]);
        u.pm = rt; u.pn = pn; u.e = e;
        if (SWIGLU) u.b0 = W + (size_t)e * (16 * hstep) + (size_t)pn * hstep;
        else u.b0 = W + (size_t)e * (8 * hstep) + (size_t)pn * tstep;
        return true;
    }
    __device__ __forceinline__ const char* aptr(const Unit& u) const { return A + (size_t)u.pm * tstep; }
    __device__ __forceinline__ size_t b1off() const { return SWIGLU ? 8 * hstep : hstep; }
};

template <class Epi, class Sched, bool FP8 = false, bool ALIGN_EPI = true>
__device__ __forceinline__ void gemm_phase(LAS unsigned char* lds, const int tid, const int pitch, const Sched& S, const Epi& E) {
    const int wid = __builtin_amdgcn_readfirstlane(tid >> 6), lane = tid & 63, wr = wid >> 2, wc = wid & 3, fr = lane & 15, fq = lane >> 4;
    const int nt = pitch / (BK * 2);
    unsigned voffA[2], voffB[2];
#pragma unroll
    for (int i = 0; i < 2; ++i) { int R, C; stage_rc(tid * 16 + i * 8192, R, C); const int Rb = (R & ~31) + perm32(R & 31);
        voffA[i] = (unsigned)(R * pitch + C * 2); voffB[i] = (unsigned)(Rb * pitch + C * 2); }
    const size_t kstep = (size_t)(BK * 2);
    const size_t hstep = (size_t)HALF * pitch;
    const unsigned ldsw = (unsigned)wid * 1024u;
    int sc127 = 127, scw = Epi::SCALE_EXP; asm volatile("" : "+v"(sc127), "+v"(scw));
    const unsigned ldsu = (unsigned)__builtin_amdgcn_readfirstlane((int)(unsigned)(uintptr_t)lds) + ldsw;
    const int aoff = lds_byte(wr * 64 + fr, fq * 8), boff = lds_byte(wc * 32 + fr, fq * 8);
#define PG8_SA(b, h) (((b) * 2 + (h)) * HTB)
#define PG8_SB(b, h) ((4 + (b) * 2 + (h)) * HTB)
#define PG8_STAGE(bufoff, gbase, voff) do { _Pragma("unroll") for (int _i = 0; _i < 2; ++_i) { unsigned _keep; \
        asm volatile("s_mov_b32 %0, m0\n\ts_mov_b32 m0, %3\n\ts_nop 0\n\tglobal_load_lds_dwordx4 %1, %2\n\ts_mov_b32 m0, %0" : "=&s"(_keep) : "v"((voff)[_i]), "s"((const char*)(gbase)), "s"(ldsu + (unsigned)((bufoff) + _i * 8192)) : "memory"); } } while (0)
#define PG8_LDA(dst, b, h) do { _Pragma("unroll") for (int m = 0; m < 4; ++m) _Pragma("unroll") for (int k = 0; k < 2; ++k) dst[m][k] = *(const LAS bf16x8*)(lds + PG8_SA(b, h) + aoff + m * 2048 + k * 1024); } while (0)
#define PG8_LDB(dst, b, h) do { _Pragma("unroll") for (int n = 0; n < 2; ++n) _Pragma("unroll") for (int k = 0; k < 2; ++k) dst[n][k] = *(const LAS bf16x8*)(lds + PG8_SB(b, h) + boff + n * 2048 + k * 1024); } while (0)
#define PG8_MMA(ai, bj, At, Bt) do { __builtin_amdgcn_s_setprio(1); _Pragma("unroll") for (int m = 0; m < 4; ++m) _Pragma("unroll") for (int n = 0; n < 2; ++n) { \
        if constexpr (FP8) { const v8i_t _a = cat8(Bt[n][0], Bt[n][1]), _b = cat8(At[m][0], At[m][1]); \
            asm volatile("v_mfma_scale_f32_16x16x128_f8f6f4 %0, %1, %2, %0, %3, %4 op_sel_hi:[0,0,0]" : "+v"(acc[ai][bj][m][n]) : "v"(_a), "v"(_b), "v"(scw), "v"(sc127)); } \
        else { _Pragma("unroll") for (int k = 0; k < 2; ++k) acc[ai][bj][m][n] = __builtin_amdgcn_mfma_f32_16x16x32_bf16(Bt[n][k], At[m][k], acc[ai][bj][m][n], 0, 0, 0); } } __builtin_amdgcn_s_setprio(0); } while (0)
#define PG8_WAIT_V(n) asm volatile("s_waitcnt vmcnt(" #n ")" ::: "memory")
#define PG8_WAIT_L(n) asm volatile("s_waitcnt lgkmcnt(" #n ")" ::: "memory")
#define PG8_BAR __builtin_amdgcn_s_barrier()
#define PG8_SCHED __builtin_amdgcn_sched_barrier(0)
    Unit cur, nxt; int ui = 0;
    if (!S.next(0, cur)) return;
    f32x4 acc[2][2][4][2];
    { typename Epi::Pre pre0; E.prefetch(pre0, cur, wr, wc, fr, fq); E.init(acc, pre0); }
    bf16x8 At[4][2], B0[2][2], B1[2][2];
    const char* cA = S.aptr(cur); const char* cB0 = cur.b0; const char* cB1 = cB0 + S.b1off();
    PG8_STAGE(PG8_SB(0, 0), cB0, voffB); PG8_STAGE(PG8_SB(0, 1), cB1, voffB); PG8_STAGE(PG8_SA(0, 0), cA, voffA); PG8_STAGE(PG8_SA(0, 1), cA + hstep, voffA);
    if (wr == 1) PG8_BAR;
    PG8_WAIT_V(2); PG8_BAR;
    PG8_STAGE(PG8_SB(1, 0), cB0 + kstep, voffB); PG8_STAGE(PG8_SA(1, 0), cA + kstep, voffA); PG8_STAGE(PG8_SB(1, 1), cB1 + kstep, voffB);
    PG8_WAIT_V(6); PG8_BAR;
    for (;;) {
        const bool has_next = S.next(ui + 1, nxt);
        const char* nA = has_next ? S.aptr(nxt) : cA; const char* nB0 = has_next ? nxt.b0 : cB0; const char* nB1 = nB0 + S.b1off();
        for (int t = 0; t < nt; t += 2) {
            const bool last = (t == nt - 2);
            const char* a1 = cA + (size_t)(t + 1) * kstep;
            const char* a2 = last ? nA : cA + (size_t)(t + 2) * kstep;
            const char* b20 = last ? nB0 : cB0 + (size_t)(t + 2) * kstep; const char* b21 = last ? nB1 : cB1 + (size_t)(t + 2) * kstep;
            const char* a3 = a2 + kstep; const char* b30 = b20 + kstep; const char* b31 = b21 + kstep;
            PG8_LDB(B0, 0, 0); PG8_LDB(B1, 0, 1); PG8_SCHED; PG8_LDA(At, 0, 0); PG8_STAGE(PG8_SA(1, 1), a1 + hstep, voffA);
            PG8_WAIT_V(8); PG8_WAIT_L(0); PG8_BAR; PG8_MMA(0, 0, At, B0); PG8_MMA(0, 1, At, B1); PG8_BAR; PG8_SCHED;
            PG8_LDA(At, 0, 1); PG8_STAGE(PG8_SB(0, 0), b20, voffB); PG8_STAGE(PG8_SB(0, 1), b21, voffB); PG8_STAGE(PG8_SA(0, 0), a2, voffA);
            PG8_WAIT_V(8); PG8_WAIT_L(0); PG8_BAR; PG8_MMA(1, 0, At, B0); PG8_MMA(1, 1, At, B1); PG8_BAR; PG8_SCHED;
            PG8_LDB(B0, 1, 0); PG8_LDB(B1, 1, 1); PG8_SCHED; PG8_LDA(At, 1, 0); PG8_STAGE(PG8_SA(0, 1), a2 + hstep, voffA);
            PG8_WAIT_V(8); PG8_WAIT_L(0); PG8_BAR; PG8_MMA(0, 0, At, B0); PG8_MMA(0, 1, At, B1); PG8_BAR; PG8_SCHED;
            PG8_LDA(At, 1, 1); PG8_STAGE(PG8_SB(1, 0), b30, voffB); PG8_STAGE(PG8_SB(1, 1), b31, voffB); PG8_STAGE(PG8_SA(1, 0), a3, voffA);
            PG8_WAIT_V(8); PG8_WAIT_L(0); PG8_BAR; PG8_MMA(1, 0, At, B0); PG8_MMA(1, 1, At, B1); PG8_BAR; PG8_SCHED;
        }
        if constexpr (ALIGN_EPI) { if (wr == 0) PG8_BAR; }
        typename Epi::Pre pre; E.prefetch(pre, has_next ? nxt : cur, wr, wc, fr, fq); PG8_SCHED;
        E(acc, cur, wr, wc, fr, fq);
        if (!has_next) break;
        E.init(acc, pre);
        cur = nxt; cA = nA; cB0 = nB0; cB1 = nB1; ++ui;
        if constexpr (ALIGN_EPI) { if (wr == 1) PG8_BAR; }
    }
    PG8_WAIT_V(0);
    if constexpr (!ALIGN_EPI) { if (wr == 0) PG8_BAR; }
    PG8_BAR;
#undef PG8_SA
#undef PG8_SB
#undef PG8_STAGE
#undef PG8_LDA
#undef PG8_LDB
#undef PG8_MMA
#undef PG8_WAIT_V
#undef PG8_WAIT_L
#undef PG8_BAR
#undef PG8_SCHED
}

#define EPI_ROWS_BEGIN const int row0 = u.pm * BM + wr * 64 + fr; const int cl = wc * 32 + 8 * fq;
__device__ __forceinline__ void store8(bf16_t* p, const f32x4 v0, const f32x4 v1) {
    u32x4 w; w.x = cvt_pk_bf16(v0[0], v0[1]); w.y = cvt_pk_bf16(v0[2], v0[3]); w.z = cvt_pk_bf16(v1[0], v1[1]); w.w = cvt_pk_bf16(v1[2], v1[3]); *(u32x4*)p = w;
}
__device__ __forceinline__ u32x2 pack8_fp8(const f32x4 v0, const f32x4 v1) {
    int a = 0, b = 0; a = __builtin_amdgcn_cvt_pk_fp8_f32(v0[0], v0[1], a, false); a = __builtin_amdgcn_cvt_pk_fp8_f32(v0[2], v0[3], a, true);
    b = __builtin_amdgcn_cvt_pk_fp8_f32(v1[0], v1[1], b, false); b = __builtin_amdgcn_cvt_pk_fp8_f32(v1[2], v1[3], b, true); return (u32x2){(unsigned)a, (unsigned)b};
}
__device__ __forceinline__ void store8_fp8(unsigned char* p, const f32x4 v0, const f32x4 v1) { *(u32x2*)p = pack8_fp8(v0, v1); }
__device__ __forceinline__ void load8bf(const bf16_t* p, f32x4& v0, f32x4& v1) {
    const u32x4 w = *(const u32x4*)p; v0 = (f32x4){bf_lo(w.x), bf_hi(w.x), bf_lo(w.y), bf_hi(w.y)}; v1 = (f32x4){bf_lo(w.z), bf_hi(w.z), bf_lo(w.w), bf_hi(w.w)};
}
__device__ __forceinline__ void acc_zero(f32x4 (&acc)[2][2][4][2]) {
#pragma unroll
    for (int a = 0; a < 2; ++a)
#pragma unroll
        for (int b = 0; b < 2; ++b)
#pragma unroll
            for (int m = 0; m < 4; ++m)
#pragma unroll
                for (int n = 0; n < 2; ++n) acc[a][b][m][n] = (f32x4){0.f, 0.f, 0.f, 0.f};
}
#define EPI_NO_PRE static constexpr int SCALE_EXP = 121; struct Pre {}; \
    __device__ __forceinline__ void prefetch(Pre&, const Unit&, int, int, int, int) const {} \
    __device__ __forceinline__ void init(f32x4 (&acc)[2][2][4][2], const Pre&) const { acc_zero(acc); }
struct EpiPlain {
    EPI_NO_PRE
    bf16_t* O; int ldc;
    __device__ __forceinline__ void operator()(const f32x4 (&acc)[2][2][4][2], const Unit& u, int wr, int wc, int fr, int fq) const {
        EPI_ROWS_BEGIN
#pragma unroll
        for (int ai = 0; ai < 2; ++ai)
#pragma unroll
            for (int m = 0; m < 4; ++m) { bf16_t* rowp = O + (unsigned)((row0 + ai * HALF + m * 16) * ldc + u.pn * BM + cl);
#pragma unroll
                for (int bj = 0; bj < 2; ++bj) store8(rowp + bj * HALF, acc[ai][bj][m][0], acc[ai][bj][m][1]); asm volatile("" ::: "memory"); }
    }
};
struct EpiIn0 {
    EPI_NO_PRE
    static constexpr float WSI = 1.f;
    bf16_t* O; float qscale;
    __device__ __forceinline__ void operator()(const f32x4 (&acc)[2][2][4][2], const Unit& u, int wr, int wc, int fr, int fq) const {
        EPI_ROWS_BEGIN
        if (u.pn < 4) {
#pragma unroll
            for (int ai = 0; ai < 2; ++ai)
#pragma unroll
                for (int m = 0; m < 4; ++m) { bf16_t* rowp = O + (unsigned)((row0 + ai * HALF + m * 16) * ZE + u.pn * BM + cl);
#pragma unroll
                    for (int bj = 0; bj < 2; ++bj) { f32x4 v0 = acc[ai][bj][m][0] * WSI, v1 = acc[ai][bj][m][1] * WSI;
#pragma unroll
                        for (int j = 0; j < 4; ++j) { v0[j] = gelu_tanh(v0[j]); v1[j] = gelu_tanh(v1[j]); }
                        store8(rowp + bj * HALF, v0, v1); asm volatile("" ::: "memory"); } }
        } else {
            const float sc = (u.pn < 6 ? qscale : 1.f) * WSI;
#pragma unroll
            for (int ai = 0; ai < 2; ++ai)
#pragma unroll
                for (int m = 0; m < 4; ++m) { bf16_t* rowp = O + (unsigned)((row0 + ai * HALF + m * 16) * ZE + u.pn * BM + cl);
#pragma unroll
                    for (int bj = 0; bj < 2; ++bj) store8(rowp + bj * HALF, acc[ai][bj][m][0] * sc, acc[ai][bj][m][1] * sc);
                    asm volatile("" ::: "memory"); }
        }
    }
};
struct EpiIn1 {
    EPI_NO_PRE
    static constexpr float WSI = 1.f;
    bf16_t* O; bf16_t* KV; bf16_t* KI;
    __device__ __forceinline__ void operator()(const f32x4 (&acc)[2][2][4][2], const Unit& u, int wr, int wc, int fr, int fq) const {
        EPI_ROWS_BEGIN
        if (u.pn == 4 || u.pn == 5) {
            bf16_t* base = KV + (u.pn - 4) * 256 + cl;
#pragma unroll
            for (int ai = 0; ai < 2; ++ai)
#pragma unroll
                for (int m = 0; m < 4; ++m) { bf16_t* rowp = base + (unsigned)((row0 + ai * HALF + m * 16) * 512);
#pragma unroll
                    for (int bj = 0; bj < 2; ++bj) store8(rowp + bj * HALF, acc[ai][bj][m][0] * WSI, acc[ai][bj][m][1] * WSI);
                    asm volatile("" ::: "memory"); }
        } else {
            const float sc = (u.pn < 4 ? 0.125f * LOG2E : 1.f) * WSI;
#pragma unroll
            for (int ai = 0; ai < 2; ++ai)
#pragma unroll
                for (int m = 0; m < 4; ++m) { bf16_t* rowp = O + (unsigned)((row0 + ai * HALF + m * 16) * ZO + u.pn * BM + cl);
#pragma unroll
                    for (int bj = 0; bj < 2; ++bj) store8(rowp + bj * HALF, acc[ai][bj][m][0] * sc, acc[ai][bj][m][1] * sc);
                    asm volatile("" ::: "memory"); }
            if (u.pn == 8 && wc < 2) {
#pragma unroll
                for (int ai = 0; ai < 2; ++ai)
#pragma unroll
                    for (int m = 0; m < 4; ++m) { const int row = row0 + ai * HALF + m * 16;
                        store8(KI + (unsigned)(((((row >> 5) * 4 + (cl >> 4)) * 64) + (((cl >> 3) & 1) * 32 + (row & 31))) * 8), acc[ai][0][m][0] * WSI, acc[ai][0][m][1] * WSI); asm volatile("" ::: "memory"); }
            }
        }
    }
};
struct EpiOut {
    EPI_NO_PRE
    const float* xf; const bf16_t* xb; bf16_t* O;
    __device__ __forceinline__ void operator()(const f32x4 (&acc)[2][2][4][2], const Unit& u, int wr, int wc, int fr, int fq) const {
        EPI_ROWS_BEGIN
#pragma unroll
        for (int ai = 0; ai < 2; ++ai) {
            f32x4 xr[4][2][2];
#pragma unroll
            for (int m = 0; m < 4; ++m) { const unsigned off = (unsigned)((row0 + ai * HALF + m * 16) * DM + u.pn * BM + cl);
#pragma unroll
                for (int bj = 0; bj < 2; ++bj) {
                    if (xf) { xr[m][bj][0] = *(const f32x4*)(xf + off + bj * HALF); xr[m][bj][1] = *(const f32x4*)(xf + off + bj * HALF + 4); }
                    else load8bf(xb + off + bj * HALF, xr[m][bj][0], xr[m][bj][1]); } }
            asm volatile("" ::: "memory");
#pragma unroll
            for (int m = 0; m < 4; ++m) { const unsigned off = (unsigned)((row0 + ai * HALF + m * 16) * DM + u.pn * BM + cl);
#pragma unroll
                for (int bj = 0; bj < 2; ++bj)
                    store8(O + off + bj * HALF, xr[m][bj][0] * ALPHA + acc[ai][bj][m][0], xr[m][bj][1] * ALPHA + acc[ai][bj][m][1]); }
            asm volatile("" ::: "memory");
        }
    }
};
constexpr float SWC = -1.702f * LOG2E;
struct EpiSwiglu {
    static constexpr int SCALE_EXP = 121;
    unsigned char* O; const float* bgu;
    struct Pre { f32x4 b[4]; };
    __device__ __forceinline__ void prefetch(Pre& p, const Unit& u, int wr, int wc, int fr, int fq) const {
        const float* bp = bgu + (unsigned)(u.e * 2048 + u.pn * HALF + wc * 32 + 8 * fq);
        p.b[0] = *(const f32x4*)bp; p.b[1] = *(const f32x4*)(bp + 4); p.b[2] = *(const f32x4*)(bp + 1024); p.b[3] = *(const f32x4*)(bp + 1028);
    }
    __device__ __forceinline__ void init(f32x4 (&acc)[2][2][4][2], const Pre& p) const {
        const f32x4 g0 = p.b[0] * SWC, g1 = p.b[1] * SWC, u0 = (p.b[2] + 1.0f) * (1.0f / SWC), u1 = (p.b[3] + 1.0f) * (1.0f / SWC);
#pragma unroll
        for (int ai = 0; ai < 2; ++ai)
#pragma unroll
            for (int m = 0; m < 4; ++m) { acc[ai][0][m][0] = g0; acc[ai][0][m][1] = g1; acc[ai][1][m][0] = u0; acc[ai][1][m][1] = u1; }
    }
    __device__ __forceinline__ void operator()(const f32x4 (&acc)[2][2][4][2], const Unit& u, int wr, int wc, int fr, int fq) const {
        EPI_ROWS_BEGIN
        const int col = u.pn * HALF + cl;
        float c7 = 7.0f * SWC, ya = -6.0f / SWC, yb = 8.0f / SWC; asm volatile("" : "+v"(c7), "+v"(ya), "+v"(yb));
#pragma unroll
        for (int ai = 0; ai < 2; ++ai)
#pragma unroll
            for (int m = 0; m < 4; ++m) { float t[8], y[8], e[8];
#pragma unroll
                for (int j = 0; j < 8; ++j) { asm("v_max_f32 %0, %1, %2" : "=v"(t[j]) : "v"(acc[ai][0][m][j >> 2][j & 3]), "v"(c7)); }
#pragma unroll
                for (int j = 0; j < 8; ++j) e[j] = __builtin_amdgcn_exp2f(t[j]);
#pragma unroll
                for (int j = 0; j < 8; ++j) { asm("v_med3_f32 %0, %1, %2, %3" : "=v"(y[j]) : "v"(acc[ai][1][m][j >> 2][j & 3]), "v"(ya), "v"(yb)); }
                __builtin_amdgcn_sched_barrier(0);
#pragma unroll
                for (int j = 0; j < 8; ++j) e[j] += 1.0f;
#pragma unroll
                for (int j = 0; j < 8; ++j) e[j] = __builtin_amdgcn_rcpf(e[j]);
#pragma unroll
                for (int j = 0; j < 8; ++j) y[j] *= t[j];
                __builtin_amdgcn_sched_barrier(0);
#pragma unroll
                for (int j = 0; j < 8; ++j) y[j] *= e[j];
                store8_fp8(O + (unsigned)((row0 + ai * HALF + m * 16) * DM + col), (f32x4){y[0], y[1], y[2], y[3]}, (f32x4){y[4], y[5], y[6], y[7]}); asm volatile("" ::: "memory"); }
    }
};
struct EpiDown {
    static constexpr int SCALE_EXP = 125;
    unsigned char* O; const float* bd;
    struct Pre { f32x4 b[2][2]; };
    __device__ __forceinline__ void prefetch(Pre& p, const Unit& u, int wr, int wc, int fr, int fq) const {
        const float* bp = bd + (unsigned)(u.e * DM + u.pn * BM + wc * 32 + 8 * fq);
#pragma unroll
        for (int bj = 0; bj < 2; ++bj) { p.b[bj][0] = *(const f32x4*)(bp + bj * HALF); p.b[bj][1] = *(const f32x4*)(bp + bj * HALF + 4); }
    }
    __device__ __forceinline__ void init(f32x4 (&acc)[2][2][4][2], const Pre& p) const {
#pragma unroll
        for (int bj = 0; bj < 2; ++bj) { const f32x4 b0 = p.b[bj][0] * 16.f, b1 = p.b[bj][1] * 16.f;
#pragma unroll
            for (int ai = 0; ai < 2; ++ai)
#pragma unroll
                for (int m = 0; m < 4; ++m) { acc[ai][bj][m][0] = b0; acc[ai][bj][m][1] = b1; } }
    }
    __device__ __forceinline__ void operator()(const f32x4 (&acc)[2][2][4][2], const Unit& u, int wr, int wc, int fr, int fq) const {
        EPI_ROWS_BEGIN
        const int col = u.pn * BM + cl;
#pragma unroll
        for (int ai = 0; ai < 2; ++ai)
#pragma unroll
            for (int m = 0; m < 4; ++m) { const int row = row0 + ai * HALF + m * 16;
#pragma unroll
                for (int bj = 0; bj < 2; ++bj) store8_fp8(O + (unsigned)(row * DM + col + bj * HALF), acc[ai][bj][m][0], acc[ai][bj][m][1]);
                asm volatile("" ::: "memory"); }
    }
};
struct EpiGate {
    EPI_NO_PRE
    const bf16_t* mid; const bf16_t* P; const float* bg; bf16_t* O;
    __device__ __forceinline__ void operator()(const f32x4 (&acc)[2][2][4][2], const Unit& u, int wr, int wc, int fr, int fq) const {
        EPI_ROWS_BEGIN
        const int col = u.pn * BM + cl;
        f32x4 bv[2][2];
#pragma unroll
        for (int bj = 0; bj < 2; ++bj) { bv[bj][0] = *(const f32x4*)(bg + col + bj * HALF); bv[bj][1] = *(const f32x4*)(bg + col + bj * HALF + 4); }
#pragma unroll
        for (int ai = 0; ai < 2; ++ai) {
            u32x4 mr[4][2], pr[4][2];
#pragma unroll
            for (int m = 0; m < 4; ++m) { const unsigned off = (unsigned)((row0 + ai * HALF + m * 16) * DM + col);
#pragma unroll
                for (int bj = 0; bj < 2; ++bj) { mr[m][bj] = *(const u32x4*)(mid + off + bj * HALF); pr[m][bj] = *(const u32x4*)(P + off + bj * HALF); } }
            asm volatile("" ::: "memory");
#pragma unroll
            for (int m = 0; m < 4; ++m) { const unsigned off = (unsigned)((row0 + ai * HALF + m * 16) * DM + col);
#pragma unroll
                for (int bj = 0; bj < 2; ++bj) { const u32x4 mw = mr[m][bj], pw = pr[m][bj];
                    const f32x4 m0 = {bf_lo(mw.x), bf_hi(mw.x), bf_lo(mw.y), bf_hi(mw.y)}, m1 = {bf_lo(mw.z), bf_hi(mw.z), bf_lo(mw.w), bf_hi(mw.w)};
                    const f32x4 p0 = {bf_lo(pw.x), bf_hi(pw.x), bf_lo(pw.y), bf_hi(pw.y)}, p1 = {bf_lo(pw.z), bf_hi(pw.z), bf_lo(pw.w), bf_hi(pw.w)};
                    f32x4 r0, r1;
                    const f32x4 a0 = acc[ai][bj][m][0] + bv[bj][0], a1 = acc[ai][bj][m][1] + bv[bj][1];
#pragma unroll
                    for (int j = 0; j < 4; ++j) { r0[j] = m0[j] + sigmoidf_(a0[j]) * p0[j]; r1[j] = m1[j] + sigmoidf_(a1[j]) * p1[j]; }
                    store8(O + off + bj * HALF, r0, r1); } }
            asm volatile("" ::: "memory");
        }
    }
};
}

#define XB_TMO      128
#define XB_XCNT(j)  (256  + 64 * (j))
#define XB_XSUB(j)  (1280 + 64 * (j))
#define XB_XGEN(j)  (2304 + 64 * (j))
#define XB_TOP      3328
#define XB_TOPGEN   3392
#define XCD_BAR_WORDS 3456
#define XB_SPIN_CAP (1u << 18)
__device__ __forceinline__ unsigned xb_ld(unsigned* p)              { return __hip_atomic_load(p, __ATOMIC_RELAXED, __HIP_MEMORY_SCOPE_AGENT); }
__device__ __forceinline__ unsigned xb_add(unsigned* p, unsigned v) { return __hip_atomic_fetch_add(p, v, __ATOMIC_RELAXED, __HIP_MEMORY_SCOPE_AGENT); }
__device__ __forceinline__ unsigned xb_xcc_id() { return (unsigned)__builtin_amdgcn_s_getreg((3 << 11) | 20) & 0xFu; }
#define XB_SPIN(cond, bar) do { unsigned _sp = 0; while (cond) { __builtin_amdgcn_s_sleep(1); \
    if ((++_sp & 255u) == 0u) { if (xb_ld(&(bar)[XB_TMO])) break; if (_sp > XB_SPIN_CAP) { atomicAdd(&(bar)[XB_TMO], 1u); break; } } } } while (0)
struct XcdBarrier { unsigned* bar; unsigned x; volatile LAS unsigned* st; };
__device__ __forceinline__ XcdBarrier xcd_barrier_post(unsigned* bar, volatile LAS unsigned* st) {
    XcdBarrier b; b.bar = bar; b.x = xb_xcc_id(); b.st = st;
    if (threadIdx.x == 0) (void)xb_add(&bar[XB_XCNT(b.x)], 1u);
    return b;
}
__device__ __forceinline__ void xcd_barrier_complete(unsigned* bar, unsigned x, unsigned& nloc, unsigned& nx) {
    const unsigned G = gridDim.x * gridDim.y * gridDim.z;
    unsigned sum, cnt, mine, sp = 0u;
    for (;;) {
        sum = 0u; cnt = 0u; mine = 0u;
#pragma unroll
        for (unsigned j = 0; j < 16; ++j) { const unsigned c = xb_ld(&bar[XB_XCNT(j)]); sum += c; cnt += (c > 0u) ? 1u : 0u; mine = (j == x) ? c : mine; }
        if (sum == G) break;
        __builtin_amdgcn_s_sleep(1);
        if ((++sp & 255u) == 0u) { if (xb_ld(&bar[XB_TMO])) break; if (sp > XB_SPIN_CAP) { atomicAdd(&bar[XB_TMO], 1u); break; } }
    }
    nloc = mine > 0u ? mine : 1u; nx = cnt > 0u ? cnt : 1u;
}
__device__ __forceinline__ void xcd_barrier(const XcdBarrier& b) {
    asm volatile("s_waitcnt vmcnt(0)" ::: "memory");
    __syncthreads();
    if (threadIdx.x == 0) {
        unsigned* bar = b.bar; asm volatile("" : "+s"(bar));
        unsigned bx = b.x; asm volatile("" : "+s"(bx));
        __builtin_amdgcn_s_waitcnt(0);
        unsigned nloc = b.st[0], nx = b.st[1];
        if (nloc == 0u) { xcd_barrier_complete(bar, bx, nloc, nx); b.st[0] = nloc; b.st[1] = nx; }
        const unsigned old = xb_add(&bar[XB_XSUB(bx)], 1u);
        const unsigned gen = old / nloc;
        if (old + 1u == (gen + 1u) * nloc) {
            __builtin_amdgcn_fence(__ATOMIC_RELEASE, "agent");
            asm volatile("s_waitcnt vmcnt(0)" ::: "memory");
            const unsigned og = xb_add(&bar[XB_TOP], 1u);
            const unsigned tg = og / nx;
            if (og + 1u == (tg + 1u) * nx) xb_add(&bar[XB_TOPGEN], 1u);
            else XB_SPIN(xb_ld(&bar[XB_TOPGEN]) == tg, bar);
            __builtin_amdgcn_fence(__ATOMIC_ACQUIRE, "agent");
            xb_add(&bar[XB_XGEN(bx)], 1u);
            asm volatile("s_waitcnt vmcnt(0)" ::: "memory");
        } else {
            XB_SPIN(xb_ld(&bar[XB_XGEN(bx)]) == gen, bar);
            __builtin_amdgcn_fence(__ATOMIC_ACQUIRE, "agent");
            asm volatile("s_waitcnt vmcnt(0)" ::: "memory");
        }
    }
    __syncthreads();
}

constexpr int NWAVES = 8, NTHR = 512;
struct Args { const float* in[23]; float* out; unsigned char* ws; int ph_lo, ph_hi; };
struct Frame { LAS unsigned char* lds; int tid, lane, wave, G, bid; };
#define LDS_WAIT() asm volatile("s_waitcnt lgkmcnt(0)" ::: "memory")
#define LDS_BARRIER() asm volatile("s_waitcnt lgkmcnt(0)\n\ts_barrier" ::: "memory")

template <bool F8>
__device__ __forceinline__ void p0_transpose_item(const float* W, int K, int N, int Npad, void* WT_, LAS float* scr, int item, int lane) {
    const int nblk = Npad / 32, kb = item / nblk, nb = item % nblk, k0 = 128 * kb, n0 = 32 * nb;
    const int r = lane >> 3, c4 = (lane & 7) * 4;
    const bool ok = n0 + c4 < N;
    const float* src = W + (size_t)(k0 + r) * N + (ok ? n0 + c4 : 0);
    f32x4 v[16];
#pragma unroll
    for (int i = 0; i < 16; ++i) v[i] = *(const f32x4*)(src + (size_t)(8 * i) * N);
    __builtin_amdgcn_sched_barrier(0);
    const float sc = ok ? (F8 ? WSC : 1.f) : 0.f;
#pragma unroll
    for (int i = 0; i < 16; ++i) *(LAS f32x4*)(scr + (8 * i + r) * 32 + (c4 ^ ((i >> 1) << 2))) = v[i] * sc;
    LDS_WAIT(); asm volatile("" ::: "memory");
    const int c = lane & 7;
#pragma unroll
    for (int j = 0; j < 4; ++j) { const int nn = (lane >> 3) + 8 * j; const LAS float* sp = scr + (16 * c) * 32 + (nn ^ (c << 2));
        float t[16];
#pragma unroll
        for (int q = 0; q < 16; ++q) t[q] = sp[q * 32];
        if constexpr (F8) { const u32x2 lo = pg8::pack8_fp8(f32x4{t[0], t[1], t[2], t[3]}, f32x4{t[4], t[5], t[6], t[7]}), hi = pg8::pack8_fp8(f32x4{t[8], t[9], t[10], t[11]}, f32x4{t[12], t[13], t[14], t[15]});
            u32x4 o; o.x = lo.x; o.y = lo.y; o.z = hi.x; o.w = hi.y; *(u32x4*)((unsigned char*)WT_ + (size_t)(n0 + nn) * K + k0 + 16 * c) = o; }
        else { u32x4 o0, o1; o0.x = cvt_pk_bf16(t[0], t[1]); o0.y = cvt_pk_bf16(t[2], t[3]); o0.z = cvt_pk_bf16(t[4], t[5]); o0.w = cvt_pk_bf16(t[6], t[7]);
            o1.x = cvt_pk_bf16(t[8], t[9]); o1.y = cvt_pk_bf16(t[10], t[11]); o1.z = cvt_pk_bf16(t[12], t[13]); o1.w = cvt_pk_bf16(t[14], t[15]);
            bf16_t* d = (bf16_t*)WT_ + (size_t)(n0 + nn) * K + k0 + 16 * c; *(u32x4*)d = o0; *(u32x4*)(d + 8) = o1; } }
    LDS_WAIT(); asm volatile("" ::: "memory");
}
template <int U, bool F8>
__device__ __forceinline__ void cvt_stream(const float* src, void* dst_, size_t n, int gtid, int gthreads) {
    const size_t st = (size_t)gthreads * 8;
    size_t i = (size_t)gtid * 8;
    for (; i + (U - 1) * st < n; i += U * st) {
        f32x4 a[U], b[U];
#pragma unroll
        for (int q = 0; q < U; ++q) { const float* p = src + i + q * st; a[q] = *(const f32x4*)p; b[q] = *(const f32x4*)(p + 4); }
        __builtin_amdgcn_sched_barrier(0);
#pragma unroll
        for (int q = 0; q < U; ++q) { const size_t o = i + q * st;
            if constexpr (F8) *(u32x2*)((unsigned char*)dst_ + o) = pg8::pack8_fp8(a[q], b[q]);
            else { u32x4 w; w.x = cvt_pk_bf16(a[q][0], a[q][1]); w.y = cvt_pk_bf16(a[q][2], a[q][3]); w.z = cvt_pk_bf16(b[q][0], b[q][1]); w.w = cvt_pk_bf16(b[q][2], b[q][3]); *(u32x4*)((bf16_t*)dst_ + o) = w; } }
    }
    for (; i < n; i += st) { const f32x4 a = *(const f32x4*)(src + i), b = *(const f32x4*)(src + i + 4);
        if constexpr (F8) *(u32x2*)((unsigned char*)dst_ + i) = pg8::pack8_fp8(a, b);
        else { u32x4 w; w.x = cvt_pk_bf16(a[0], a[1]); w.y = cvt_pk_bf16(a[2], a[3]); w.z = cvt_pk_bf16(b[0], b[1]); w.w = cvt_pk_bf16(b[2], b[3]); *(u32x4*)((bf16_t*)dst_ + i) = w; } }
}
struct P0Desc { const float* W; unsigned char* WT; int K, N, Npad, tile, f8; float s0, s1; int split; };
constexpr int P0_IN0 = 8 * (ZE / 256), P0_SQ = 8 * 4, P0_IN1 = 8 * (ZO / 256), P0_PLE = 2 * 4, P0_GU = 8 * 8;
constexpr int P0_C0 = P0_IN0, P0_C1 = P0_C0 + P0_SQ, P0_C2 = P0_C1 + P0_IN1, P0_C3 = P0_C2 + P0_SQ, P0_C4 = P0_C3 + 2 * P0_SQ, P0_C5 = P0_C4 + 2 * P0_PLE, P0_C6 = P0_C5 + 64 * P0_GU, P0_C7 = P0_C6 + 64 * P0_SQ;
__device__ __forceinline__ P0Desc p0_desc(const Args& a, int it) {
    unsigned char* ws = a.ws;
    if (it < P0_C0) return P0Desc{a.in[2], ws + WS_WIN0, DM, ZE, ZE, it, FP8_IN0, FP8_IN0 ? WSC : 1.f, FP8_IN0 ? WSC : 1.f, 0};
    if (it < P0_C1) return P0Desc{a.in[7], ws + WS_WO0, DM, DM, DM, it - P0_C0, FP8_OUT, FP8_OUT ? WSC : 1.f, FP8_OUT ? WSC : 1.f, 0};
    if (it < P0_C2) return P0Desc{a.in[8], ws + WS_WIN1, DM, ZO_REAL, ZO, it - P0_C1, FP8_IN1, FP8_IN1 ? WSC : 1.f, FP8_IN1 ? WSC : 1.f, 0};
    if (it < P0_C3) return P0Desc{a.in[9], ws + WS_WO1, DM, DM, DM, it - P0_C2, FP8_OUT, FP8_OUT ? WSC : 1.f, FP8_OUT ? WSC : 1.f, 0};
    if (it < P0_C4) { const int r = it - P0_C3, l = r / P0_SQ; return P0Desc{a.in[21] + (size_t)l * DM * DM, ws + WS_WG + (size_t)l * DM * DM * (FP8_GATE ? 1 : 2), DM, DM, DM, r % P0_SQ, FP8_GATE, FP8_GATE ? WSC : 1.f, FP8_GATE ? WSC : 1.f, 0}; }
    if (it < P0_C5) { const int r = it - P0_C4, l = r / P0_PLE; return P0Desc{a.in[20] + (size_t)l * PLE * DM, ws + WS_WPLE + (size_t)l * DM * PLE * 2, PLE, DM, DM, r % P0_PLE, 0, 1.f, 1.f, 0}; }
    if (it < P0_C6) { const int r = it - P0_C5, l = r / P0_GU; return P0Desc{a.in[14] + (size_t)l * DM * 2048, ws + WS_WGU + (size_t)l * 2048 * DM, DM, 2048, 2048, r % P0_GU, 1, WSC * pg8::SWC, WSC / pg8::SWC, 1024}; }
    const int r = it - P0_C6, l = r / P0_SQ; return P0Desc{a.in[16] + (size_t)l * DM * DM, ws + WS_WD + (size_t)l * DM * DM, DM, DM, DM, r % P0_SQ, 1, WSC, WSC, 0};
}
__device__ __forceinline__ void p0_tile_load(const P0Desc& d, int wave, int lane, f32x4 (&v)[16], float& sc) {
    const int nblk = d.Npad / 256, kb = d.tile / nblk, nb = d.tile % nblk;
    const int n = nb * 256 + 4 * lane; const bool ok = n < d.N;
    const float* src = d.W + (size_t)(kb * 128 + 16 * wave) * d.N + (ok ? n : 0);
#pragma unroll
    for (int i = 0; i < 16; ++i) v[i] = *(const f32x4*)(src + (size_t)i * d.N);
    sc = ok ? (n < d.split ? d.s0 : d.s1) : 0.f;
}
__device__ __forceinline__ void p0_tile_emit(const P0Desc& d, LAS float* img, int wave, int lane) {
    const int nblk = d.Npad / 256, kb = d.tile / nblk, nb = d.tile % nblk, k0 = 128 * kb, n0 = 256 * nb;
    const int c = lane & 7;
#pragma unroll
    for (int j = 0; j < 4; ++j) { const int nn = 32 * wave + (lane >> 3) + 8 * j; const LAS float* sp = img + (16 * c) * 256 + (nn ^ (c << 2));
        float t[16];
#pragma unroll
        for (int q = 0; q < 16; ++q) t[q] = sp[q * 256];
        const size_t o = (size_t)(n0 + nn) * d.K + k0 + 16 * c;
        if (d.f8) { const u32x2 lo = pg8::pack8_fp8(f32x4{t[0], t[1], t[2], t[3]}, f32x4{t[4], t[5], t[6], t[7]}), hi = pg8::pack8_fp8(f32x4{t[8], t[9], t[10], t[11]}, f32x4{t[12], t[13], t[14], t[15]});
            u32x4 w; w.x = lo.x; w.y = lo.y; w.z = hi.x; w.w = hi.y; *(u32x4*)(d.WT + o) = w; }
        else { u32x4 o0, o1; o0.x = cvt_pk_bf16(t[0], t[1]); o0.y = cvt_pk_bf16(t[2], t[3]); o0.z = cvt_pk_bf16(t[4], t[5]); o0.w = cvt_pk_bf16(t[6], t[7]);
            o1.x = cvt_pk_bf16(t[8], t[9]); o1.y = cvt_pk_bf16(t[10], t[11]); o1.z = cvt_pk_bf16(t[12], t[13]); o1.w = cvt_pk_bf16(t[14], t[15]);
            bf16_t* dp = (bf16_t*)d.WT + o; *(u32x4*)dp = o0; *(u32x4*)(dp + 8) = o1; } }
}
__device__ __forceinline__ void p0_prologue(Frame& F, const Args& a) {
    unsigned char* ws = a.ws;
    LAS float* img = (LAS float*)F.lds;
    { const int TOT = P0_C7 * PM(0);
      int it = F.bid; f32x4 v[16]; float sc = 0.f; P0Desc d = p0_desc(a, it % P0_C7);
      if (it < TOT) p0_tile_load(d, F.wave, F.lane, v, sc);
      for (; it < TOT; it += F.G) {
#pragma unroll
        for (int i = 0; i < 16; ++i) *(LAS f32x4*)(img + (16 * F.wave + i) * 256 + ((4 * F.lane) ^ (F.wave << 2))) = v[i] * sc;
        LDS_BARRIER();
        const P0Desc dc = d; const int nx = it + F.G;
        if (nx < TOT) { d = p0_desc(a, nx % P0_C7); p0_tile_load(d, F.wave, F.lane, v, sc); }
        __builtin_amdgcn_sched_barrier(0);
        p0_tile_emit(dc, img, F.wave, F.lane);
        LDS_BARRIER();
      } }
    {
      LAS float* scr = (LAS float*)(F.lds + F.wave * 16384);
      const int gw = F.bid * NWAVES + F.wave;
      if (gw < 16) p0_transpose_item<false>(a.in[12] + (size_t)(gw >> 3) * DM * NEXP, DM, NEXP, NEXP, (bf16_t*)(ws + WS_WRT) + (size_t)(gw >> 3) * NEXP * DM, scr, gw & 7, F.lane); }
    const int gtid = F.bid * NTHR + F.tid, gth = F.G * NTHR;
    if (!FP8_IN0) cvt_stream<8, false>(a.in[0], ws + WS_XB, (size_t)NTOK * DM, gtid, gth);
    else cvt_stream<8, true>(a.in[0], ws + WS_XQ, (size_t)NTOK * DM, gtid, gth);
    cvt_stream<8, false>(a.in[1], ws + WS_PB, (size_t)2 * NTOK * PLE, gtid, gth);
    for (int i = gtid; i < 8 * 128 * 128; i += gth) { const int t = (i >> 7) & 127, s = i & 127; const float v = (s <= t) ? a.in[5][i] : 0.f; ((bf16_t*)(ws + WS_WSB))[i] = (bf16_t)(cvt_pk_bf16(v, 0.f) & 0xffffu); }
}

__device__ __forceinline__ void gmlp_unit(Frame& F, const Args& a, int unit) {
    const bf16_t* z0 = (const bf16_t*)(a.ws + WS_Z); unsigned char* cat = (unsigned char*)(a.ws + WS_CAT); const bf16_t* wsb = (const bf16_t*)(a.ws + WS_WSB);
    const float* lng = a.in[3]; const float* lnb = a.in[4]; const float* bs = a.in[6];
    const size_t tok0 = (size_t)unit * 128;
    const int lane = F.lane, w = F.wave, r32 = lane & 31, hi = lane >> 5;
    LAS f32x2* stats = (LAS f32x2*)(F.lds + XTRA_OFF);
    for (int i = 0; i < 16; ++i) { const int tl = w * 16 + i;
        const u32x4 v = *(const u32x4*)(z0 + (tok0 + tl) * ZE + 512 + 8 * lane);
        float x[8] = {bf_lo(v.x), bf_hi(v.x), bf_lo(v.y), bf_hi(v.y), bf_lo(v.z), bf_hi(v.z), bf_lo(v.w), bf_hi(v.w)};
        float s = 0.f;
#pragma unroll
        for (int j = 0; j < 8; ++j) s += x[j];
        const float mean = wave_sum(s) * (1.f / 512.f); float q = 0.f;
#pragma unroll
        for (int j = 0; j < 8; ++j) { const float d = x[j] - mean; q += d * d; }
        const float rstd = 1.f / sqrtf(wave_sum(q) * (1.f / 512.f) + LN_EPS);
        if (lane == 0) stats[tl] = (f32x2){mean, rstd}; }
    __syncthreads();
    const int g = w;
    LAS unsigned char* vt = F.lds + w * 16384;
    { const int tl8 = lane >> 3, cc = lane & 7;
      float gg[8], bb[8];
#pragma unroll
      for (int j = 0; j < 8; ++j) { gg[j] = lng[g * 64 + 8 * cc + j]; bb[j] = lnb[g * 64 + 8 * cc + j]; }
      for (int it = 0; it < 16; ++it) { const int tl = 8 * it + tl8;
          const u32x4 v = *(const u32x4*)(z0 + (tok0 + tl) * ZE + 512 + g * 64 + 8 * cc);
          const f32x2 st = stats[tl];
          float x[8] = {bf_lo(v.x), bf_hi(v.x), bf_lo(v.y), bf_hi(v.y), bf_lo(v.z), bf_hi(v.z), bf_lo(v.w), bf_hi(v.w)};
#pragma unroll
          for (int j = 0; j < 8; ++j) { const int c = 8 * cc + j; const float y = (x[j] - st.x) * st.y * gg[j] + bb[j];
              *(LAS bf16_t*)(vt + c * 256 + ((((tl >> 3) ^ (c & 15))) << 4) + (tl & 7) * 2) = (bf16_t)(cvt_pk_bf16(y, 0.f) & 0xffffu); } } }
    LDS_WAIT(); asm volatile("" ::: "memory");
    for (int tb = 0; tb < 4; ++tb) {
        f32x16 d0 = {}, d1 = {};
        const bf16_t* wrow = wsb + ((size_t)g * 128 + tb * 32 + r32) * 128 + 8 * hi;
        bf16x8 afr[8];
#pragma unroll
        for (int ks = 0; ks < 8; ++ks) afr[ks] = *(const bf16x8*)(wrow + 16 * ks);
#pragma unroll
        for (int ks = 0; ks < 8; ++ks) { if (ks >= 2 * (tb + 1)) break;
            const bf16x8 af = afr[ks];
            const int chunk = 2 * ks + hi;
            const bf16x8 b0 = *(const LAS bf16x8*)(vt + r32 * 256 + ((chunk ^ (r32 & 15)) << 4));
            const bf16x8 b1 = *(const LAS bf16x8*)(vt + (32 + r32) * 256 + ((chunk ^ (r32 & 15)) << 4));
            d0 = __builtin_amdgcn_mfma_f32_32x32x16_bf16(af, b0, d0, 0, 0, 0);
            d1 = __builtin_amdgcn_mfma_f32_32x32x16_bf16(af, b1, d1, 0, 0, 0);
        }
#pragma unroll
        for (int r = 0; r < 16; ++r) { const int t = tb * 32 + (r & 3) + 8 * (r >> 2) + 4 * hi; const float bsv = bs[g * 128 + t];
            const size_t ro = (tok0 + t) * ZE + g * 64 + r32; const size_t co = (tok0 + t) * DM + g * 64 + r32;
            const float u0 = bf1(z0[ro]), u1 = bf1(z0[ro + 32]);
            CAT_ST(cat, co, u0 * (d0[r] + bsv)); CAT_ST(cat, co + 32, u1 * (d1[r] + bsv)); }
    }
    __syncthreads();
}

constexpr int SB_KST = 144;
constexpr int SB_TILE = 64 * SB_KST;
__device__ __forceinline__ void sb_unit(Frame& F, const Args& a, int b, int h, int qb) {
    const bf16_t* z0 = (const bf16_t*)(a.ws + WS_Z); unsigned char* cat = (unsigned char*)(a.ws + WS_CAT);
    const int tid = F.tid, lane = F.lane, wid = F.wave, r32 = lane & 31, hi = lane >> 5;
    const size_t rowbase = (size_t)b * SEQ;
    const int q0 = qb * 256, qw0 = q0 + wid * 32, tq = qw0 + r32;
    bf16x8 qr[4];
    { const bf16_t* qp = z0 + (rowbase + tq) * ZE + 1024 + h * 64 + hi * 8;
#pragma unroll
      for (int ks = 0; ks < 4; ++ks) qr[ks] = *(const bf16x8*)(qp + ks * 16); }
    f32x16 o0 = {}, o1 = {}; float C = 1.f;
    const int ntile = q0 / 64 + 4;
    LAS unsigned char* Kb = F.lds; LAS unsigned char* Vb = F.lds + 2 * SB_TILE;
    const bf16_t* kg = z0 + (rowbase + (tid >> 3)) * ZE + 1536 + h * 64 + (tid & 7) * 8;
    const unsigned ldst = (unsigned)(tid >> 3) * SB_KST + (unsigned)(tid & 7) * 16;
    { const size_t go = (size_t)(ntile - 1) * 64 * ZE; const u32x4 kn = *(const u32x4*)(kg + go), vn = *(const u32x4*)(kg + go + 512);
      *(LAS u32x4*)(Kb + ldst) = kn; *(LAS u32x4*)(Vb + ldst) = vn; }
    const int dh = (lane >> 4) & 1, q_ = (lane & 15) >> 2, p_ = lane & 3;
    for (int kt = ntile - 1; kt >= 0; --kt) {
        const int buf = (ntile - 1 - kt) & 1;
        u32x4 kn, vn;
        if (kt > 0) { const size_t go = (size_t)(kt - 1) * 64 * ZE; kn = *(const u32x4*)(kg + go); vn = *(const u32x4*)(kg + go + 512); }
        LDS_BARRIER();
        const LAS unsigned char* Kc = Kb + buf * SB_TILE; const LAS unsigned char* Vc = Vb + buf * SB_TILE;
        if (64 * kt <= qw0) {
            f32x16 p[2]; p[0] = (f32x16){}; p[1] = (f32x16){};
#pragma unroll
            for (int ks = 0; ks < 4; ++ks) {
                const bf16x8 k0 = *(const LAS bf16x8*)(Kc + r32 * SB_KST + (16 * ks + 8 * hi) * 2);
                const bf16x8 k1 = *(const LAS bf16x8*)(Kc + (32 + r32) * SB_KST + (16 * ks + 8 * hi) * 2);
                p[0] = __builtin_amdgcn_mfma_f32_32x32x16_bf16(k0, qr[ks], p[0], 0, 0, 0);
                p[1] = __builtin_amdgcn_mfma_f32_32x32x16_bf16(k1, qr[ks], p[1], 0, 0, 0);
            }
            const bool need_mask = (64 * kt + 64 > qw0);
            const int kb0 = 64 * kt + 4 * hi;
            float NB[2][16], BE[2][16];
            if (need_mask) {
#pragma unroll
                for (int bk = 0; bk < 2; ++bk)
#pragma unroll
                    for (int r = 0; r < 16; ++r) { const float rc = rcpf_(1.f + ex2(-p[bk][r]));
                        const int key = kb0 + 32 * bk + 8 * (r >> 2) + (r & 3); const bool ok = key < tq;
                        BE[bk][r] = ok ? rc : 0.f; NB[bk][r] = ok ? 1.f - rc : 1.f; }
            } else {
#pragma unroll
                for (int bk = 0; bk < 2; ++bk)
#pragma unroll
                    for (int r = 0; r < 16; ++r) { const float rc = rcpf_(1.f + ex2(-p[bk][r])); BE[bk][r] = rc; NB[bk][r] = 1.f - rc; }
            }
            float acc_c = C;
#pragma unroll
            for (int bk = 1; bk >= 0; --bk)
#pragma unroll
                for (int aa = 3; aa >= 0; --aa) {
                    const float R = (NB[bk][4 * aa] * NB[bk][4 * aa + 1]) * (NB[bk][4 * aa + 2] * NB[bk][4 * aa + 3]);
                    const auto rr = __builtin_amdgcn_permlane32_swap(__float_as_uint(R), __float_as_uint(R), false, false);
                    const float Rp = hi ? __uint_as_float(rr[0]) : __uint_as_float(rr[1]);
                    const float a3 = hi ? acc_c : acc_c * Rp, a2 = a3 * NB[bk][4 * aa + 3], a1 = a2 * NB[bk][4 * aa + 2], a0 = a1 * NB[bk][4 * aa + 1];
                    p[bk][4 * aa + 3] = BE[bk][4 * aa + 3] * a3; p[bk][4 * aa + 2] = BE[bk][4 * aa + 2] * a2;
                    p[bk][4 * aa + 1] = BE[bk][4 * aa + 1] * a1; p[bk][4 * aa + 0] = BE[bk][4 * aa + 0] * a0;
                    acc_c *= R * Rp;
                }
            C = acc_c;
            bf16x8 pa[2][2];
#pragma unroll
            for (int bk = 0; bk < 2; ++bk)
#pragma unroll
                for (int s = 0; s < 2; ++s) { u32x4 w; w.x = cvt_pk_bf16(p[bk][8 * s + 0], p[bk][8 * s + 1]); w.y = cvt_pk_bf16(p[bk][8 * s + 2], p[bk][8 * s + 3]);
                    w.z = cvt_pk_bf16(p[bk][8 * s + 4], p[bk][8 * s + 5]); w.w = cvt_pk_bf16(p[bk][8 * s + 6], p[bk][8 * s + 7]); pa[bk][s] = __builtin_bit_cast(bf16x8, w); }
#pragma unroll
            for (int bk = 0; bk < 2; ++bk)
#pragma unroll
                for (int s = 0; s < 2; ++s) {
                    const LAS unsigned char* vp = Vc + (32 * bk + 16 * s + 4 * hi + q_) * SB_KST + (16 * dh + 4 * p_) * 2;
                    const s16x4 l0 = __builtin_amdgcn_ds_read_tr16_b64_v4i16((LAS s16x4*)(vp));
                    const s16x4 h0 = __builtin_amdgcn_ds_read_tr16_b64_v4i16((LAS s16x4*)(vp + 8 * SB_KST));
                    const s16x4 l1 = __builtin_amdgcn_ds_read_tr16_b64_v4i16((LAS s16x4*)(vp + 64));
                    const s16x4 h1 = __builtin_amdgcn_ds_read_tr16_b64_v4i16((LAS s16x4*)(vp + 8 * SB_KST + 64));
                    const bf16x8 v0 = (bf16x8){l0[0], l0[1], l0[2], l0[3], h0[0], h0[1], h0[2], h0[3]};
                    const bf16x8 v1 = (bf16x8){l1[0], l1[1], l1[2], l1[3], h1[0], h1[1], h1[2], h1[3]};
                    o0 = __builtin_amdgcn_mfma_f32_32x32x16_bf16(pa[bk][s], v0, o0, 0, 0, 0);
                    o1 = __builtin_amdgcn_mfma_f32_32x32x16_bf16(pa[bk][s], v1, o1, 0, 0, 0);
                }
        }
        if (kt > 0) { *(LAS u32x4*)(Kb + (buf ^ 1) * SB_TILE + ldst) = kn; *(LAS u32x4*)(Vb + (buf ^ 1) * SB_TILE + ldst) = vn; }
    }
#pragma unroll
    for (int r = 0; r < 16; ++r) { const int q = (r & 3) + 8 * (r >> 2) + 4 * hi;
        const size_t oo = (rowbase + qw0 + q) * DM + 512 + h * 64 + r32;
        CAT_ST(cat, oo, o0[r]); CAT_ST(cat, oo + 32, o1[r]); }
    __syncthreads();
}

template <int I> struct SelStep {
    static __device__ __forceinline__ void run(const float (&v)[64], float thr, float lo, bool exact, int need_eq, int& eq_seen, unsigned& m0, unsigned& m1) {
        const bool gt = v[I] > thr; const bool eq = (!exact) && !gt && (v[I] > lo);
        const unsigned long long meq = __ballot(eq);
        const int eq_rank = eq_seen + __builtin_amdgcn_mbcnt_hi((unsigned)(meq >> 32), __builtin_amdgcn_mbcnt_lo((unsigned)meq, 0));
        const bool take = gt || (eq && eq_rank < need_eq);
        const unsigned long long mt = __ballot(take);
        const unsigned mlo = (unsigned)mt, mhi = (unsigned)(mt >> 32);
        asm volatile("s_nop 1\n\tv_writelane_b32 %0, %1, %2" : "+v"(m0) : "s"(mlo), "n"(I));
        asm volatile("s_nop 1\n\tv_writelane_b32 %0, %1, %2" : "+v"(m1) : "s"(mhi), "n"(I));
        eq_seen += __builtin_popcountll(meq);
        SelStep<I + 1>::run(v, thr, lo, exact, need_eq, eq_seen, m0, m1);
    }
};
template <> struct SelStep<64> { static __device__ __forceinline__ void run(const float (&)[64], float, float, bool, int, int&, unsigned&, unsigned&) {} };

template <int I> struct SelExact {
    static __device__ __forceinline__ void run(const float (&v)[64], float thr, unsigned& m0, unsigned& m1) {
        const unsigned long long mt = __ballot(v[I] > thr);
        const unsigned mlo = (unsigned)mt, mhi = (unsigned)(mt >> 32);
        asm volatile("s_nop 1\n\tv_writelane_b32 %0, %1, %2" : "+v"(m0) : "s"(mlo), "n"(I));
        asm volatile("s_nop 1\n\tv_writelane_b32 %0, %1, %2" : "+v"(m1) : "s"(mhi), "n"(I));
        SelExact<I + 1>::run(v, thr, m0, m1);
    }
};
template <> struct SelExact<64> { static __device__ __forceinline__ void run(const float (&)[64], float, unsigned&, unsigned&) {} };

__device__ __forceinline__ void dsa_select_unit(Frame& F, const Args& a, int unit) {
    const bf16_t* z1 = (const bf16_t*)(a.ws + WS_Z); unsigned* bm = (unsigned*)(a.ws + WS_BM);
    const int lane = F.lane, wid = F.wave, r32 = lane & 31, hi = lane >> 5;
    const int tok0 = unit * 8;
    const int b = tok0 / SEQ, t0 = tok0 % SEQ;
    const size_t rowbase = (size_t)b * SEQ;
    const int vis = (t0 / 64 + 1) * 64;
    LAS float* sc = (LAS float*)F.lds;
    if (vis > 256) {
        const int tl = 2 * (r32 >> 4) + ((r32 >> 2) & 1), hd = (r32 & 3) + 4 * ((r32 >> 3) & 1);
        bf16x8 af[2][4];
#pragma unroll
        for (int rt = 0; rt < 2; ++rt) { const bf16_t* qp = z1 + (size_t)(tok0 + 4 * rt + tl) * ZO + OQI + hd * 64 + 8 * hi;
#pragma unroll
            for (int ks = 0; ks < 4; ++ks) af[rt][ks] = *(const bf16x8*)(qp + 16 * ks); }
        float wv[4][8];
#pragma unroll
        for (int j = 0; j < 4; ++j) { const u32x4 w = *(const u32x4*)(z1 + (size_t)(tok0 + 2 * j + hi) * ZO + OWI);
            const float s = 0.35355339059f * 0.125f;
            wv[j][0] = bf_lo(w.x) * s; wv[j][1] = bf_hi(w.x) * s; wv[j][2] = bf_lo(w.y) * s; wv[j][3] = bf_hi(w.y) * s;
            wv[j][4] = bf_lo(w.z) * s; wv[j][5] = bf_hi(w.z) * s; wv[j][6] = bf_lo(w.w) * s; wv[j][7] = bf_hi(w.w) * s; }
        const int nkt = vis / 32;
        const bf16_t* kbase = (const bf16_t*)(a.ws + WS_KI1) + rowbase * 64 + (size_t)lane * 8;
        for (int rep14 = 0; rep14 < PM(14); ++rep14)
        for (int kt0 = wid; kt0 < nkt; kt0 += 8 * NWAVES) {
            bf16x8 kq[8][4];
#pragma unroll
            for (int pf = 0; pf < 8; ++pf) { const int kt = min(kt0 + pf * NWAVES, nkt - 1);
#pragma unroll
                for (int ks = 0; ks < 4; ++ks) kq[pf][ks] = *(const bf16x8*)(kbase + (size_t)(kt * 4 + ks) * 512); }
            __builtin_amdgcn_sched_barrier(0);
#pragma unroll
            for (int pf = 0; pf < 8; ++pf) { const int kt = kt0 + pf * NWAVES;
                if (kt < nkt) {
                    f32x16 d0 = {}, d1 = {};
#pragma unroll
                    for (int ks = 0; ks < 4; ++ks) { d0 = __builtin_amdgcn_mfma_f32_32x32x16_bf16(af[0][ks], kq[pf][ks], d0, 0, 0, 0); d1 = __builtin_amdgcn_mfma_f32_32x32x16_bf16(af[1][ks], kq[pf][ks], d1, 0, 0, 0); }
                    float s0 = 0.f, s1 = 0.f, s2 = 0.f, s3 = 0.f;
#pragma unroll
                    for (int r = 0; r < 8; ++r) { s0 += wv[0][r] * relu_i(d0[r]); s1 += wv[1][r] * relu_i(d0[8 + r]); s2 += wv[2][r] * relu_i(d1[r]); s3 += wv[3][r] * relu_i(d1[8 + r]); }
                    const int key = kt * 32 + r32;
                    sc[(hi) * 4096 + key] = s0; sc[(2 + hi) * 4096 + key] = s1; sc[(4 + hi) * 4096 + key] = s2; sc[(6 + hi) * 4096 + key] = s3;
                } }
        }
    }
    __syncthreads();
    for (int rep15 = 0; rep15 < PM(15); ++rep15) {
        unsigned m0 = 0u, m1 = 0u;
        if (vis <= 256) { m0 = 0xffffffffu; m1 = 0xffffffffu; }
        else {
            const LAS float* ms = sc + wid * 4096;
            float v[64];
            float mx = -INFINITY, mn = INFINITY;
#pragma unroll
            for (int i = 0; i < 64; ++i) { const bool in = (i * 64 < vis); v[i] = in ? ms[i * 64 + lane] : -INFINITY; if (in) { mx = fmaxf(mx, v[i]); mn = fminf(mn, v[i]); } }
            mx = wave_max_uniform(mx); mn = -wave_max_uniform(-mn);
            float lo = mn - 1.f - fabsf(mn), hiv = mx;
            float thr = hiv; int cgt = 0; bool exact = false;
            int c_lo = vis, c_hi = 0;
            bool dead = false;
            for (int it = 0; it < 64 && (c_lo - c_hi) > 448; ++it) {
                const float mid = 0.5f * (lo + hiv);
                if (!(mid > lo) || !(mid < hiv)) { dead = true; break; }
                int c = 0;
#pragma unroll
                for (int i = 0; i < 64; ++i) c += (v[i] > mid) ? 1 : 0;
                c = wave_sum_uniform(c);
                if (c == 256) { thr = mid; exact = true; break; }
                if (c > 256) { lo = mid; c_lo = c; } else { hiv = mid; c_hi = c; }
            }
            if (!exact && !dead) {
                LAS float* cand = sc + wid * 4096; int base = 0;
#pragma unroll
                for (int i = 0; i < 64; ++i) { const bool in = (v[i] > lo) && !(v[i] > hiv);
                    const unsigned long long mk = __ballot(in);
                    const int pos = base + __builtin_amdgcn_mbcnt_hi((unsigned)(mk >> 32), __builtin_amdgcn_mbcnt_lo((unsigned)mk, 0));
                    if (in) cand[pos] = v[i];
                    base += __builtin_popcountll(mk); }
                const int nc = c_lo - c_hi, c_hi0 = c_hi;
                float cv[8];
#pragma unroll
                for (int j = 0; j < 8; ++j) cv[j] = (lane + 64 * j < nc) ? cand[lane + 64 * j] : -INFINITY;
                for (int it = 0; it < 64; ++it) {
                    const float mid = 0.5f * (lo + hiv);
                    if (!(mid > lo) || !(mid < hiv)) break;
                    int c = 0;
#pragma unroll
                    for (int j = 0; j < 8; ++j) c += (cv[j] > mid) ? 1 : 0;
                    c = c_hi0 + wave_sum_uniform(c);
                    if (c == 256) { thr = mid; exact = true; break; }
                    if (c > 256) { lo = mid; c_lo = c; } else { hiv = mid; c_hi = c; }
                }
            }
            if (!exact) { thr = hiv; cgt = c_hi; }
            const int need_eq = exact ? 0 : (256 - cgt); int eq_seen = 0;
            if (exact) SelExact<0>::run(v, thr, m0, m1); else SelStep<0>::run(v, thr, lo, exact, need_eq, eq_seen, m0, m1);
        }
        if (lane * 64 < vis) *(u32x2*)(bm + (size_t)(tok0 + wid) * 128 + 2 * lane) = (u32x2){m0, m1};
    }
    __syncthreads();
}

template <int I> struct MaskInit {
    static __device__ __forceinline__ void run(f32x16 (&p)[2], int nw0, int nw1, float slope2, float T, int ninf) {
        constexpr int bk = I >> 4, r = I & 15, pos = 8 * (r >> 2) + (r & 3);
        const float vb = __builtin_fmaf(slope2, (float)(32 * bk + pos), T);
        int off; asm("v_bfe_i32 %0, %1, %2, 1" : "=v"(off) : "v"(bk ? nw1 : nw0), "n"(pos));
        float o; asm("v_bfi_b32 %0, %1, %2, %3" : "=v"(o) : "v"(off), "s"(ninf), "v"(vb));
        p[bk][r] = o;
        MaskInit<I + 1>::run(p, nw0, nw1, slope2, T, ninf);
    }
};
template <> struct MaskInit<32> { static __device__ __forceinline__ void run(f32x16 (&)[2], int, int, float, float, int) {} };
__device__ __forceinline__ float max3_asm(float a, float b, float c) { float r; asm("v_max3_f32 %0, %1, %2, %3" : "=v"(r) : "v"(a), "v"(b), "v"(c)); return r; }
__device__ __forceinline__ void dsa_attn_unit(Frame& F, const Args& a, int b, int ch, int g) {
    const bf16_t* z1 = (const bf16_t*)(a.ws + WS_Z); unsigned char* cat = (unsigned char*)(a.ws + WS_CAT); const unsigned* bm = (const unsigned*)(a.ws + WS_BM);
    const int tid = F.tid, lane = F.lane, wid = F.wave, r32 = lane & 31, hi = lane >> 5;
    const int hr = wid >> 1, qh = wid & 1, head = g * 4 + hr;
    const size_t rowbase = (size_t)b * SEQ;
    const int tq = ch * 64 + 32 * qh + r32;
    const float slope2 = ex2(-0.5f * (float)(head + 1)) * LOG2E;
    bf16x8 qr[4];
    { const bf16_t* qp = z1 + (rowbase + tq) * ZO + OQ + head * 64 + hi * 8;
#pragma unroll
      for (int ks = 0; ks < 4; ++ks) qr[ks] = *(const bf16x8*)(qp + ks * 16); }
    const unsigned* mrow = bm + (rowbase + tq) * 128;
    f32x16 o0 = {}, o1 = {}; float m = 0.f, l = 0.f;
    const int ntile = ch + 1;
    LAS unsigned char* Kb = F.lds; LAS unsigned char* Vb = F.lds + 2 * SB_TILE;
    LAS float* wsf = (LAS float*)(F.lds + 4 * SB_TILE) + wid * 32;
    const bf16_t* kg = (const bf16_t*)(a.ws + WS_KV1) + (rowbase + (tid >> 3)) * 512 + g * 64 + (tid & 7) * 8;
    const unsigned ldst = (unsigned)(tid >> 3) * SB_KST + (unsigned)(tid & 7) * 16;
    { const u32x4 kn = *(const u32x4*)(kg), vn = *(const u32x4*)(kg + 256);
      *(LAS u32x4*)(Kb + ldst) = kn; *(LAS u32x4*)(Vb + ldst) = vn; }
    const int dh = (lane >> 4) & 1, q_ = (lane & 15) >> 2, p_ = lane & 3;
    u32x2 mw = *(const u32x2*)(mrow);
    for (int kt = 0; kt < ntile; ++kt) {
        const int buf = kt & 1;
        u32x4 kn, vn; u32x2 mwn = mw;
        if (kt + 1 < ntile) { const size_t go = (size_t)(kt + 1) * 64 * 512; kn = *(const u32x4*)(kg + go); vn = *(const u32x4*)(kg + go + 256); mwn = *(const u32x2*)(mrow + 2 * (kt + 1)); }
        LDS_BARRIER();
        const LAS unsigned char* Kc = Kb + buf * SB_TILE; const LAS unsigned char* Vc = Vb + buf * SB_TILE;
        const float T = slope2 * (float)(64 * kt + 4 * hi) - m;
        const int nw0 = (int)~(mw.x >> (4 * hi)), nw1 = (int)~(mw.y >> (4 * hi));
        f32x16 p[2];
        MaskInit<0>::run(p, nw0, nw1, slope2, T, (int)0xff800000);
#pragma unroll
        for (int ks = 0; ks < 4; ++ks) {
            const bf16x8 k0 = *(const LAS bf16x8*)(Kc + r32 * SB_KST + (16 * ks + 8 * hi) * 2);
            const bf16x8 k1 = *(const LAS bf16x8*)(Kc + (32 + r32) * SB_KST + (16 * ks + 8 * hi) * 2);
            p[0] = __builtin_amdgcn_mfma_f32_32x32x16_bf16(k0, qr[ks], p[0], 0, 0, 0);
            p[1] = __builtin_amdgcn_mfma_f32_32x32x16_bf16(k1, qr[ks], p[1], 0, 0, 0);
        }
        if (kt == ntile - 1) {
            const float basef = (float)(tq - (64 * kt + 4 * hi));
#pragma unroll
            for (int bk = 0; bk < 2; ++bk)
#pragma unroll
                for (int r = 0; r < 16; ++r) { const float rel = (float)(32 * bk + 8 * (r >> 2) + (r & 3)) - basef; p[bk][r] -= 2.f * slope2 * fmaxf(rel, 0.f); }
        } else asm volatile("s_nop 15\n\ts_nop 7" : "+v"(p[0]), "+v"(p[1]));
        float rm;
        { float a0 = max3_asm(p[0][0], p[0][1], p[1][0]), b0 = max3_asm(p[0][2], p[0][3], p[1][1]); a0 = max3_asm(a0, p[1][2], p[1][3]);
#pragma unroll
          for (int r = 4; r < 16; r += 4) { a0 = max3_asm(a0, p[0][r], p[0][r + 1]); b0 = max3_asm(b0, p[0][r + 2], p[0][r + 3]); a0 = max3_asm(a0, p[1][r], p[1][r + 1]); b0 = max3_asm(b0, p[1][r + 2], p[1][r + 3]); }
          rm = fmaxf(a0, b0); }
        rm = fmaxf(rm, sxf<32>(rm));
        if (__any(rm > 6.f) || kt == 0) {
            const float d = (kt == 0) ? ((rm > -1e30f) ? rm : 0.f) : ((rm > 6.f) ? rm : 0.f);
            const float alpha = ex2(-d);
            l *= alpha; m += d;
#pragma unroll
            for (int bk = 0; bk < 2; ++bk)
#pragma unroll
                for (int r = 0; r < 16; ++r) p[bk][r] -= d;
            if (hi == 0) wsf[r32] = alpha;
#pragma unroll
            for (int r = 0; r < 16; ++r) { const float al = wsf[(r & 3) + 8 * (r >> 2) + 4 * hi]; o0[r] *= al; o1[r] *= al; }
        }
        float ls = 0.f;
#pragma unroll
        for (int bk = 0; bk < 2; ++bk)
#pragma unroll
            for (int r = 0; r < 16; ++r) { const float e = ex2(p[bk][r]); p[bk][r] = e; ls += e; }
        l += ls;
        bf16x8 pa[2][2];
#pragma unroll
        for (int bk = 0; bk < 2; ++bk)
#pragma unroll
            for (int s = 0; s < 2; ++s) { u32x4 w; w.x = cvt_pk_bf16(p[bk][8 * s + 0], p[bk][8 * s + 1]); w.y = cvt_pk_bf16(p[bk][8 * s + 2], p[bk][8 * s + 3]);
                w.z = cvt_pk_bf16(p[bk][8 * s + 4], p[bk][8 * s + 5]); w.w = cvt_pk_bf16(p[bk][8 * s + 6], p[bk][8 * s + 7]); pa[bk][s] = __builtin_bit_cast(bf16x8, w); }
#pragma unroll
        for (int bk = 0; bk < 2; ++bk)
#pragma unroll
            for (int s = 0; s < 2; ++s) {
                const LAS unsigned char* vp = Vc + (32 * bk + 16 * s + 4 * hi + q_) * SB_KST + (16 * dh + 4 * p_) * 2;
                const s16x4 l0 = __builtin_amdgcn_ds_read_tr16_b64_v4i16((LAS s16x4*)(vp));
                const s16x4 h0 = __builtin_amdgcn_ds_read_tr16_b64_v4i16((LAS s16x4*)(vp + 8 * SB_KST));
                const s16x4 l1 = __builtin_amdgcn_ds_read_tr16_b64_v4i16((LAS s16x4*)(vp + 64));
                const s16x4 h1 = __builtin_amdgcn_ds_read_tr16_b64_v4i16((LAS s16x4*)(vp + 8 * SB_KST + 64));
                const bf16x8 v0 = (bf16x8){l0[0], l0[1], l0[2], l0[3], h0[0], h0[1], h0[2], h0[3]};
                const bf16x8 v1 = (bf16x8){l1[0], l1[1], l1[2], l1[3], h1[0], h1[1], h1[2], h1[3]};
                o0 = __builtin_amdgcn_mfma_f32_32x32x16_bf16(pa[bk][s], v0, o0, 0, 0, 0);
                o1 = __builtin_amdgcn_mfma_f32_32x32x16_bf16(pa[bk][s], v1, o1, 0, 0, 0);
            }
        if (kt + 1 < ntile) { *(LAS u32x4*)(Kb + (buf ^ 1) * SB_TILE + ldst) = kn; *(LAS u32x4*)(Vb + (buf ^ 1) * SB_TILE + ldst) = vn; }
        mw = mwn;
    }
    l += sxf<32>(l);
    if (hi == 0) wsf[r32] = 1.f / l;
#pragma unroll
    for (int r = 0; r < 16; ++r) { const int q = (r & 3) + 8 * (r >> 2) + 4 * hi; const float inv = wsf[q];
        const size_t oo = (rowbase + ch * 64 + 32 * qh + q) * DM + head * 64 + r32;
        CAT_ST(cat, oo, o0[r] * inv); CAT_ST(cat, oo + 32, o1[r] * inv); }
    __syncthreads();
}

__device__ __forceinline__ void ln_row16(const bf16_t* src, float (&x)[16], int lane) {
    const u32x4 a = *(const u32x4*)(src + 8 * lane), b = *(const u32x4*)(src + 512 + 8 * lane);
    x[0] = bf_lo(a.x); x[1] = bf_hi(a.x); x[2] = bf_lo(a.y); x[3] = bf_hi(a.y); x[4] = bf_lo(a.z); x[5] = bf_hi(a.z); x[6] = bf_lo(a.w); x[7] = bf_hi(a.w);
    x[8] = bf_lo(b.x); x[9] = bf_hi(b.x); x[10] = bf_lo(b.y); x[11] = bf_hi(b.y); x[12] = bf_lo(b.z); x[13] = bf_hi(b.z); x[14] = bf_lo(b.w); x[15] = bf_hi(b.w);
}
__device__ __forceinline__ void ln_norm16(float (&x)[16], const float* g, const float* bta, int lane) {
    float s = 0.f;
#pragma unroll
    for (int j = 0; j < 16; ++j) s += x[j];
    const float mean = wave_sum(s) * (1.f / DM); float q = 0.f;
#pragma unroll
    for (int j = 0; j < 16; ++j) { x[j] -= mean; q += x[j] * x[j]; }
    const float rstd = 1.f / sqrtf(wave_sum(q) * (1.f / DM) + LN_EPS);
    const f32x4 g0 = *(const f32x4*)(g + 8 * lane), g1 = *(const f32x4*)(g + 8 * lane + 4), g2 = *(const f32x4*)(g + 512 + 8 * lane), g3 = *(const f32x4*)(g + 512 + 8 * lane + 4);
    const f32x4 b0 = *(const f32x4*)(bta + 8 * lane), b1 = *(const f32x4*)(bta + 8 * lane + 4), b2 = *(const f32x4*)(bta + 512 + 8 * lane), b3 = *(const f32x4*)(bta + 512 + 8 * lane + 4);
#pragma unroll
    for (int j = 0; j < 4; ++j) { x[j] = x[j] * rstd * g0[j] + b0[j]; x[4 + j] = x[4 + j] * rstd * g1[j] + b1[j]; x[8 + j] = x[8 + j] * rstd * g2[j] + b2[j]; x[12 + j] = x[12 + j] * rstd * g3[j] + b3[j]; }
}
__device__ __forceinline__ void store16bf(bf16_t* dst, const float (&x)[16], int lane) {
    u32x4 a, b; a.x = cvt_pk_bf16(x[0], x[1]); a.y = cvt_pk_bf16(x[2], x[3]); a.z = cvt_pk_bf16(x[4], x[5]); a.w = cvt_pk_bf16(x[6], x[7]);
    b.x = cvt_pk_bf16(x[8], x[9]); b.y = cvt_pk_bf16(x[10], x[11]); b.z = cvt_pk_bf16(x[12], x[13]); b.w = cvt_pk_bf16(x[14], x[15]);
    *(u32x4*)(dst + 8 * lane) = a; *(u32x4*)(dst + 512 + 8 * lane) = b;
}
__device__ __forceinline__ void store16f8(unsigned char* dst, const float (&x)[16], int lane) {
    *(u32x2*)(dst + 8 * lane) = pg8::pack8_fp8((f32x4){x[0], x[1], x[2], x[3]}, (f32x4){x[4], x[5], x[6], x[7]});
    *(u32x2*)(dst + 512 + 8 * lane) = pg8::pack8_fp8((f32x4){x[8], x[9], x[10], x[11]}, (f32x4){x[12], x[13], x[14], x[15]});
}
constexpr int HS_STRIDE = 2064;
__device__ __forceinline__ void ln1_router_phase(Frame& F, const Args& a, int layer) {
    const bf16_t* t1 = (const bf16_t*)(a.ws + WS_T1); bf16_t* hb = (bf16_t*)(a.ws + WS_HB);
    const bf16_t* wrt = (const bf16_t*)(a.ws + WS_WRT) + (size_t)layer * NEXP * DM;
    const float* g = a.in[10] + layer * DM; const float* bta = a.in[11] + layer * DM; const float* br = a.in[13] + layer * NEXP;
    int* topi = (int*)(a.ws + WS_TOPI); float* gate = (float*)(a.ws + WS_GATE); int* cnt = (int*)(a.ws + WS_CNT);
    const int lane = F.lane, w = F.wave, tid = F.tid;
    LAS unsigned char* hs = F.lds;
    LAS float* part = (LAS float*)(F.lds + 36864);
    LAS float* logit = (LAS float*)(F.lds + 36864 + 16384);
    LAS int* hist = (LAS int*)(F.lds + 36864 + 16384 + 2048);
    LAS int* topk_i = (LAS int*)(F.lds + 36864 + 16384 + 2048 + 256); LAS float* topk_v = (LAS float*)(F.lds + 36864 + 16384 + 2048 + 512);
    const int n16 = lane & 15, kg4 = lane >> 4;
    bf16x8 bw[2][4];
#pragma unroll
    for (int n = 0; n < 2; ++n)
#pragma unroll
        for (int ks = 0; ks < 4; ++ks) bw[n][ks] = *(const bf16x8*)(wrt + (size_t)(16 * n + n16) * DM + 128 * w + 32 * ks + 8 * kg4);
    for (int grp2 = F.bid; grp2 < NGRP * PM(6); grp2 += F.G) { const int grp = grp2 % NGRP;
        if (tid < 32) hist[tid] = 0;
        __syncthreads();
        for (int it = 0; it < 8; ++it) {
            const int r0 = grp * 128 + it * 16;
#pragma unroll
            for (int rr = 0; rr < 2; ++rr) { const int rl = 2 * w + rr; float x[16];
                ln_row16(t1 + (size_t)(r0 + rl) * DM, x, lane); ln_norm16(x, g, bta, lane);
                store16bf(hb + (size_t)(r0 + rl) * DM, x, lane);
                u32x4 p, q; p.x = cvt_pk_bf16(x[0], x[1]); p.y = cvt_pk_bf16(x[2], x[3]); p.z = cvt_pk_bf16(x[4], x[5]); p.w = cvt_pk_bf16(x[6], x[7]);
                q.x = cvt_pk_bf16(x[8], x[9]); q.y = cvt_pk_bf16(x[10], x[11]); q.z = cvt_pk_bf16(x[12], x[13]); q.w = cvt_pk_bf16(x[14], x[15]);
                *(LAS u32x4*)(hs + rl * HS_STRIDE + 16 * lane) = p; *(LAS u32x4*)(hs + rl * HS_STRIDE + 1024 + 16 * lane) = q; }
            __syncthreads();
            { f32x4 d0 = {0.f, 0.f, 0.f, 0.f}, d1 = {0.f, 0.f, 0.f, 0.f};
#pragma unroll
              for (int ks = 0; ks < 4; ++ks) { const bf16x8 af = *(const LAS bf16x8*)(hs + n16 * HS_STRIDE + (128 * w + 32 * ks + 8 * kg4) * 2);
                  d0 = __builtin_amdgcn_mfma_f32_16x16x32_bf16(af, bw[0][ks], d0, 0, 0, 0); d1 = __builtin_amdgcn_mfma_f32_16x16x32_bf16(af, bw[1][ks], d1, 0, 0, 0); }
#pragma unroll
              for (int r = 0; r < 4; ++r) { part[(w * 16 + 4 * kg4 + r) * 32 + n16] = d0[r]; part[(w * 16 + 4 * kg4 + r) * 32 + 16 + n16] = d1[r]; } }
            __syncthreads();
            { const int row = tid >> 5, e = tid & 31; float s = br[e];
#pragma unroll
              for (int ww = 0; ww < 8; ++ww) s += part[(ww * 16 + row) * 32 + e];
              logit[row * 32 + e] = s; }
            __syncthreads();
            { const int row = tid >> 5, e = tid & 31; const float lv = logit[row * 32 + e]; int rank = 0;
#pragma unroll
              for (int e2 = 0; e2 < 32; ++e2) { const float o = logit[row * 32 + e2]; rank += (o > lv || (o == lv && e2 < e)) ? 1 : 0; }
              if (rank < 4) { topk_i[row * 4 + rank] = e; topk_v[row * 4 + rank] = lv; } }
            __syncthreads();
            if (tid < 16) { const int tok = r0 + tid;
                const int t0 = topk_i[tid * 4 + 0], t1 = topk_i[tid * 4 + 1], t2 = topk_i[tid * 4 + 2], t3 = topk_i[tid * 4 + 3];
                const float v0 = topk_v[tid * 4 + 0];
                const float e0 = 1.f, e1 = __expf(topk_v[tid * 4 + 1] - v0), e2 = __expf(topk_v[tid * 4 + 2] - v0), e3 = __expf(topk_v[tid * 4 + 3] - v0); const float inv = 1.f / (e0 + e1 + e2 + e3);
                *(int4*)(topi + (size_t)tok * 4) = make_int4(t0, t1, t2, t3);
                *(float4*)(gate + (size_t)tok * 4) = make_float4(e0 * inv, e1 * inv, e2 * inv, e3 * inv);
                atomicAdd((int*)&hist[t0], 1); atomicAdd((int*)&hist[t1], 1); atomicAdd((int*)&hist[t2], 1); atomicAdd((int*)&hist[t3], 1); }
        }
        __syncthreads();
        if (tid < 32) cnt[grp * 32 + tid] = hist[tid];
        __syncthreads();
    }
}

__device__ __forceinline__ void moe_tables(Frame& F, const Args& a, int grp) {
    const int* cnt = (const int*)(a.ws + WS_CNT);
    LAS int* T = (LAS int*)(F.lds + TAB_OFF);
    const int tid = F.tid, e = tid & 31, j = tid >> 5;
    { int s = 0, bf = 0;
      for (int gg = j * 16; gg < j * 16 + 16; ++gg) { const int c = cnt[gg * 32 + e]; s += c; if (gg < grp) bf += c; }
      T[TB_TOT16 / 4 + j * 32 + e] = s; T[TB_BEF16 / 4 + j * 32 + e] = bf; }
    __syncthreads();
    if (tid < 32) { int s = 0, bf = 0;
#pragma unroll
        for (int jj = 0; jj < 16; ++jj) { s += T[TB_TOT16 / 4 + jj * 32 + tid]; bf += T[TB_BEF16 / 4 + jj * 32 + tid]; }
        T[TB_TOTAL / 4 + tid] = s; T[TB_BEFORE / 4 + tid] = bf; T[TB_LCUR / 4 + tid] = 0; }
    __syncthreads();
    if (tid < 32) {
        int ps = 0;
#pragma nounroll
        for (int ee = 0; ee < tid; ++ee) ps += ((T[TB_TOTAL / 4 + ee] + 255) >> 8) << 8;
        T[TB_PADST / 4 + tid] = ps; T[TB_BASE / 4 + tid] = ps + T[TB_BEFORE / 4 + tid];
        if (tid == 31) { const int end = ps + (((T[TB_TOTAL / 4 + 31] + 255) >> 8) << 8); T[TB_PADST / 4 + 32] = end; T[TB_NTL / 4] = end >> 8; } }
    __syncthreads();
    { LAS unsigned char* t2e = (LAS unsigned char*)(F.lds + TAB_OFF + TB_T2E); const int ntl = T[TB_NTL / 4];
      for (int rt = tid; rt < ntl; rt += NTHR) { int e = 0;
#pragma nounroll
          for (int ee = 1; ee < 32; ++ee) e += (T[TB_PADST / 4 + ee] <= rt * 256) ? 1 : 0;
          t2e[rt] = (unsigned char)e; } }
    __syncthreads();
}
__device__ __forceinline__ void scatter_phase(Frame& F, const Args& a) {
    const bf16_t* hb = (const bf16_t*)(a.ws + WS_HB); unsigned char* xs = (unsigned char*)(a.ws + WS_XS);
    const int* topi = (const int*)(a.ws + WS_TOPI); const float* gate = (const float*)(a.ws + WS_GATE);
    int* slot = (int*)(a.ws + WS_SLOT); float* rowg = (float*)(a.ws + WS_ROWG);
    LAS int* T = (LAS int*)(F.lds + TAB_OFF); LAS int* rows = (LAS int*)(F.lds + XTRA_OFF);
    const int tid = F.tid, lane = F.lane, w = F.wave;
    if (F.bid >= NGRP) moe_tables(F, a, -1);
    for (int grp2 = F.bid; grp2 < NGRP * PM(7); grp2 += F.G) { const int grp = grp2 % NGRP;
        moe_tables(F, a, grp);
        { const int tok = grp * 128 + (tid >> 2), k = tid & 3; const int e = topi[(size_t)tok * 4 + k];
          const int rank = atomicAdd((int*)&T[TB_LCUR / 4 + e], 1); const int row = T[TB_BASE / 4 + e] + rank;
          slot[(size_t)tok * 4 + k] = row; rowg[row] = gate[(size_t)tok * 4 + k]; rows[tid] = row; }
        __syncthreads();
        for (int i = 0; i < 16; ++i) { const int tl = w * 16 + i; const size_t tok = (size_t)grp * 128 + tl;
            float x[16]; ln_row16(hb + tok * DM, x, lane);
            const u32x2 p = pg8::pack8_fp8((f32x4){x[0], x[1], x[2], x[3]}, (f32x4){x[4], x[5], x[6], x[7]}), q = pg8::pack8_fp8((f32x4){x[8], x[9], x[10], x[11]}, (f32x4){x[12], x[13], x[14], x[15]});
#pragma unroll
            for (int k = 0; k < 4; ++k) { const size_t row = (size_t)rows[tl * 4 + k]; *(u32x2*)(xs + row * DM + 8 * lane) = p; *(u32x2*)(xs + row * DM + 512 + 8 * lane) = q; } }
        __syncthreads();
    }
}
__device__ __forceinline__ void combine_phase(Frame& F, const Args& a) {
    const bf16_t* hb = (const bf16_t*)(a.ws + WS_HB); const bf16_t* yb = (const bf16_t*)(a.ws + WS_XS); bf16_t* mid = (bf16_t*)(a.ws + WS_MIDB);
    const int* slot = (const int*)(a.ws + WS_SLOT);
    const int lane = F.lane;
    for (int tok2 = F.bid * NWAVES + F.wave; tok2 < NTOK * PM(10); tok2 += F.G * NWAVES) { const int tok = tok2 % NTOK;
        float x[16]; ln_row16(hb + (size_t)tok * DM, x, lane);
#pragma unroll
        for (int j = 0; j < 16; ++j) x[j] *= ALPHA;
        const int4 sl = *(const int4*)(slot + (size_t)tok * 4);
        const int s4[4] = {sl.x, sl.y, sl.z, sl.w};
        const float4 gt4 = *(const float4*)((const float*)(a.ws + WS_GATE) + (size_t)tok * 4);
        const float g4[4] = {gt4.x * 0.0625f, gt4.y * 0.0625f, gt4.z * 0.0625f, gt4.w * 0.0625f};
#pragma unroll
        for (int k = 0; k < 4; ++k) {
            if (Y_FP8) { const unsigned char* yr = (const unsigned char*)yb + (size_t)s4[k] * DM;
                const u32x2 p = *(const u32x2*)(yr + 8 * lane), q = *(const u32x2*)(yr + 512 + 8 * lane);
                const unsigned w4[4] = {p.x, p.y, q.x, q.y};
#pragma unroll
                for (int i = 0; i < 4; ++i) { const f32x2 lo = __builtin_amdgcn_cvt_pk_f32_fp8((int)w4[i], false), hi2 = __builtin_amdgcn_cvt_pk_f32_fp8((int)w4[i], true);
                    x[4 * i + 0] += lo.x * g4[k]; x[4 * i + 1] += lo.y * g4[k]; x[4 * i + 2] += hi2.x * g4[k]; x[4 * i + 3] += hi2.y * g4[k]; } }
            else { float y[16]; ln_row16(yb + (size_t)s4[k] * DM, y, lane);
#pragma unroll
                for (int j = 0; j < 16; ++j) x[j] += y[j] * (16.f * g4[k]); } }
        store16bf(mid + (size_t)tok * DM, x, lane); store16f8((unsigned char*)(a.ws + WS_MIDQ) + (size_t)tok * DM, x, lane);
    }
}
__device__ __forceinline__ void ln2_phase(Frame& F, const Args& a, int layer) {
    const bf16_t* t2 = (const bf16_t*)(a.ws + WS_T1); bf16_t* xb = (bf16_t*)(a.ws + WS_XB);
    const float* g = a.in[18] + layer * DM; const float* bta = a.in[19] + layer * DM;
    const int lane = F.lane;
    for (int tok2 = F.bid * NWAVES + F.wave; tok2 < NTOK * PM(12); tok2 += F.G * NWAVES) { const int tok = tok2 % NTOK;
        float x[16]; ln_row16(t2 + (size_t)tok * DM, x, lane); ln_norm16(x, g, bta, lane);
        if (layer == 0) { store16bf(xb + (size_t)tok * DM, x, lane); if (FP8_IN1) store16f8((unsigned char*)(a.ws + WS_XQ) + (size_t)tok * DM, x, lane); }
        else { float* o = a.out + (size_t)tok * DM;
            *(f32x4*)(o + 8 * lane) = (f32x4){x[0], x[1], x[2], x[3]}; *(f32x4*)(o + 8 * lane + 4) = (f32x4){x[4], x[5], x[6], x[7]};
            *(f32x4*)(o + 512 + 8 * lane) = (f32x4){x[8], x[9], x[10], x[11]}; *(f32x4*)(o + 512 + 8 * lane + 4) = (f32x4){x[12], x[13], x[14], x[15]}; }
    }
}

__global__ void __launch_bounds__(NTHR, 2) __attribute__((target("no-packed-fp32-ops"))) hybrid_fwd(Args args) {
    extern __shared__ __attribute__((aligned(16))) unsigned char lds_raw[];
    Frame F;
    F.lds = (LAS unsigned char*)lds_raw;
    F.tid = threadIdx.x; F.lane = F.tid & 63; F.wave = __builtin_amdgcn_readfirstlane(F.tid >> 6); F.G = gridDim.x; F.bid = blockIdx.x;
    volatile LAS unsigned* MISC = (volatile LAS unsigned*)(F.lds + MISC_OFF);
    for (int u = F.tid; u < 128; u += NTHR) MISC[u] = 0u;
    __syncthreads();
    XcdBarrier bar = xcd_barrier_post((unsigned*)(args.ws + WS_CTL) + 4096, MISC + 8);
    const int lo = args.ph_lo; int ph = 0; (void)lo; (void)ph;
#ifndef PHMASK
#define PHMASK 0xfffff
#endif
#ifndef PROBE_DUP
#define PROBE_DUP 0
#endif
#define SITE(k) if constexpr ((PHMASK >> (k)) & 1)
typedef const __attribute__((address_space(4))) Args* KArgs;
#define PHASE_REFRESH int t_ = threadIdx.x; asm volatile("" : "+v"(t_)); F.tid = t_; F.lane = t_ & 63; F.wave = __builtin_amdgcn_readfirstlane(t_ >> 6); \
    { int b_ = blockIdx.x; asm volatile("" : "+s"(b_)); F.bid = b_; } \
    { unsigned l_ = 0; asm volatile("" : "+s"(l_)); F.lds = (LAS unsigned char*)lds_raw + l_; } LAS unsigned char* const ring = F.lds; \
    LOAD_ARGS unsigned char* const ws = A.ws;
#if defined(__HIP_DEVICE_COMPILE__)
#define LOAD_ARGS KArgs ap_ = (KArgs)__builtin_amdgcn_kernarg_segment_ptr(); asm volatile("" : "+s"(ap_)); const Args A = *ap_;
#else
#define LOAD_ARGS const Args A = args;
#endif
#ifdef MK_LAUNCHES_PER_PHASE
#define PHASE_BEGIN if (ph == lo) { PHASE_REFRESH
#define PHASE_END   } ++ph;
#define PHASE_END_LAST } ++ph;
#else
#define PHASE_BEGIN { PHASE_REFRESH
#ifdef PROBE_BAR2
#define PHASE_END   xcd_barrier(bar); xcd_barrier(bar); }
#else
#define PHASE_END   xcd_barrier(bar); }
#endif
#define PHASE_END_LAST if (layer == 0) xcd_barrier(bar); }
#endif
    using namespace pg8;

    PHASE_BEGIN SITE(0) p0_prologue(F, A); PHASE_END

    for (int layer = 0; layer < 2; ++layer) {
        PHASE_BEGIN
        SITE(1) {
        if (layer == 0) {
            SITE(16) { DenseOrder S; S.initp(ws + (FP8_IN0 ? WS_XQ : WS_XB), ws + WS_WIN0, NTOK, ZE, FP8_IN0 ? DM : 2 * DM, F.G, F.bid, PM(1)); EpiIn0 E{(bf16_t*)(ws + WS_Z), 0.125f * LOG2E}; int p8 = FP8_IN0 ? DM : 2 * DM; asm volatile("" : "+s"(p8)); gemm_phase<EpiIn0, DenseOrder, FP8_IN0 != 0>(ring, F.tid, p8, S, E); }
            SITE(17) { PleOrder S; S.D.init(ws + WS_PB, ws + WS_WPLE, 2 * NTOK, DM, PLE, F.G, F.bid, PM(1));
              int kple = 2 * PLE; asm volatile("" : "+s"(kple));
              EpiPlain E{(bf16_t*)(ws + WS_PPLE), DM}; gemm_phase(ring, F.tid, kple, S, E); }
        } else {
            SITE(18) { DenseOrder S; S.initp(ws + (FP8_IN1 ? WS_XQ : WS_XB), ws + WS_WIN1, NTOK, ZO, FP8_IN1 ? DM : 2 * DM, F.G, F.bid, PM(1)); EpiIn1 E{(bf16_t*)(ws + WS_Z), (bf16_t*)(ws + WS_KV1), (bf16_t*)(ws + WS_KI1)}; int p8 = FP8_IN1 ? DM : 2 * DM; asm volatile("" : "+s"(p8)); gemm_phase<EpiIn1, DenseOrder, FP8_IN1 != 0>(ring, F.tid, p8, S, E); }
        }
        }
        PHASE_END
        PHASE_BEGIN
        if (layer == 0) {
            SITE(2) for (long L = F.bid; L < 1024 * PM(2); L += F.G) { const int v = (int)(L & 255), rnd = (int)((L >> 8) & 3), s = v & 3, bh = v >> 2;
                const int qb = rnd == 0 ? 15 - s : (rnd == 1 ? 8 + s : (rnd == 2 ? 7 - s : s));
                sb_unit(F, A, bh >> 3, bh & 7, qb); }
            SITE(3) for (int u = F.bid; u < PM(3) * NTOK / 128; u += F.G) gmlp_unit(F, A, u % (NTOK / 128));
        } else {
            SITE(4) for (int L = F.bid; L < PM(4) * NTOK / 8; L += F.G) { const int Lm = L % (NTOK / 8), r = Lm >> 8, cc = Lm & 255;
                const int j = (r & 1) ? 511 - cc : cc; dsa_select_unit(F, A, (r >> 1) * 512 + j); }
        }
        PHASE_END
        if (layer == 1) {
        PHASE_BEGIN
            SITE(13) for (int L = F.bid; L < 1024 * PM(13); L += F.G) { const int idx = L & 1023, pp = idx & 31, g = (idx >> 5) & 3, b = idx >> 7;
                dsa_attn_unit(F, A, b, 63 - pp, g); dsa_attn_unit(F, A, b, pp, g); }
        PHASE_END
        }
        PHASE_BEGIN
        SITE(5) { DenseOrder S; S.initp(ws + WS_CAT, ws + (layer == 0 ? WS_WO0 : WS_WO1), NTOK, DM, FP8_OUT ? DM : 2 * DM, F.G, F.bid, PM(5));
          EpiOut E{layer == 0 ? A.in[0] : nullptr, (const bf16_t*)(ws + WS_XB), (bf16_t*)(ws + WS_T1)}; int p8 = FP8_OUT ? DM : 2 * DM; asm volatile("" : "+s"(p8)); gemm_phase<EpiOut, DenseOrder, FP8_OUT != 0>(ring, F.tid, p8, S, E); }
        PHASE_END
        PHASE_BEGIN SITE(6) ln1_router_phase(F, A, layer); PHASE_END
        PHASE_BEGIN SITE(7) scatter_phase(F, A); PHASE_END
        PHASE_BEGIN
        SITE(8) {
#ifdef MK_LAUNCHES_PER_PHASE
          moe_tables(F, A, -1);
#endif
          const int ntl = __builtin_amdgcn_readfirstlane(((LAS int*)(F.lds + TAB_OFF))[TB_NTL / 4]);
          MoeOrder<8, true> S; S.nunits = ntl * 8; S.G = F.G; S.c = F.bid; S.rep = PM(8); S.t2e = (const LAS unsigned char*)(F.lds + TAB_OFF + TB_T2E);
          S.A = (const char*)(ws + WS_XS); S.W = (const char*)(ws + WS_WGU) + (size_t)layer * 32 * 2048 * DM;
          EpiSwiglu E{(unsigned char*)(ws + WS_ACT), A.in[15] + (size_t)layer * 32 * 2048}; int p8 = DM; asm volatile("" : "+s"(p8)); gemm_phase<EpiSwiglu, MoeOrder<8, true>, true, MOE_ALIGN>(ring, F.tid, p8, S, E); }
        PHASE_END
        PHASE_BEGIN
        SITE(9) {
#ifdef MK_LAUNCHES_PER_PHASE
          moe_tables(F, A, -1);
#endif
          const int ntl = __builtin_amdgcn_readfirstlane(((LAS int*)(F.lds + TAB_OFF))[TB_NTL / 4]);
          MoeOrder<4, false> S; S.nunits = ntl * 4; S.G = F.G; S.c = F.bid; S.rep = PM(9); S.t2e = (const LAS unsigned char*)(F.lds + TAB_OFF + TB_T2E);
          S.A = (const char*)(ws + WS_ACT); S.W = (const char*)(ws + WS_WD) + (size_t)layer * 32 * DM * DM;
          EpiDown E{(unsigned char*)(ws + WS_XS), A.in[17] + (size_t)layer * 32 * DM}; int p8 = DM; asm volatile("" : "+s"(p8)); gemm_phase<EpiDown, MoeOrder<4, false>, true, MOE_ALIGN>(ring, F.tid, p8, S, E); }
        PHASE_END
        PHASE_BEGIN SITE(10) combine_phase(F, A); PHASE_END
        PHASE_BEGIN
        SITE(11) { DenseOrder S; S.initp(ws + (FP8_GATE ? WS_MIDQ : WS_MIDB), ws + WS_WG + (size_t)layer * DM * DM * (FP8_GATE ? 1 : 2), NTOK, DM, FP8_GATE ? DM : 2 * DM, F.G, F.bid, PM(11));
          EpiGate E{(const bf16_t*)(ws + WS_MIDB), (const bf16_t*)(ws + WS_PPLE) + (size_t)layer * NTOK * DM, A.in[22] + layer * DM, (bf16_t*)(ws + WS_T1)}; int p8 = FP8_GATE ? DM : 2 * DM; asm volatile("" : "+s"(p8)); gemm_phase<EpiGate, DenseOrder, FP8_GATE != 0>(ring, F.tid, p8, S, E); }
        PHASE_END
        PHASE_BEGIN SITE(12) ln2_phase(F, A, layer); PHASE_END_LAST
    }
#undef PHASE_BEGIN
#undef PHASE_END
#undef PHASE_END_LAST
}
constexpr int N_PHASES = 22;

extern "C" void kernel_launch(void* const* d_in, const int* in_sizes, int n_in, void* d_out, int out_size, void* d_ws, size_t ws_size, hipStream_t stream) {
    static int grid = 0;
    if (grid == 0) {
        if (n_in != 23 || out_size != NTOK * DM || ws_size < WS_END) { fprintf(stderr, "kernel_launch: unexpected problem: n_in %d out %d ws %zu (need %zu)\n", n_in, out_size, ws_size, (size_t)WS_END); grid = -1; return; }
        int dev = 0, cus = 0, per_cu = 0;
        if (hipGetDevice(&dev) != hipSuccess || hipDeviceGetAttribute(&cus, hipDeviceAttributeMultiprocessorCount, dev) != hipSuccess) { grid = -1; return; }
        if (hipFuncSetAttribute((const void*)hybrid_fwd, hipFuncAttributeMaxDynamicSharedMemorySize, LDS_BYTES) != hipSuccess) { fprintf(stderr, "kernel_launch: hipFuncSetAttribute failed\n"); grid = -1; return; }
        if (hipOccupancyMaxActiveBlocksPerMultiprocessor(&per_cu, (const void*)hybrid_fwd, NTHR, LDS_BYTES) != hipSuccess || per_cu < 1) fprintf(stderr, "kernel_launch: occupancy query says %d\n", per_cu);
        (void)hipGetLastError();
        grid = cus;
    }
    if (grid < 0) return;
    (void)hipMemsetAsync((char*)d_ws + WS_CTL, 0, CTL_ZERO_BYTES, stream);
    Args a{};
    for (int i = 0; i < 23; ++i) a.in[i] = (const float*)d_in[i];
    a.out = (float*)d_out; a.ws = (unsigned char*)d_ws;
#ifndef MK_LAUNCHES_PER_PHASE
    a.ph_lo = 0; a.ph_hi = N_PHASES;
    hipLaunchKernelGGL(hybrid_fwd, dim3(grid), dim3(NTHR), LDS_BYTES, stream, a);
#else
    for (int p = 0; p < N_PHASES; ++p) { a.ph_lo = p; a.ph_hi = p + 1; hipLaunchKernelGGL(hybrid_fwd, dim3(grid), dim3(NTHR), LDS_BYTES, stream, a); }
#endif
}
```

```cpp
#include <hip/hip_runtime.h>
#include <cstdio>
#include <cstdint>

#define LAS __attribute__((address_space(3)))
#define GAS __attribute__((address_space(1)))
typedef unsigned short bf16_t;
typedef short bf16x8 __attribute__((ext_vector_type(8)));
typedef short s16x4 __attribute__((ext_vector_type(4)));
typedef float f32x2 __attribute__((ext_vector_type(2)));
typedef float f32x4 __attribute__((ext_vector_type(4)));
typedef float f32x16 __attribute__((ext_vector_type(16)));
typedef unsigned u32x2 __attribute__((ext_vector_type(2)));
typedef unsigned u32x4 __attribute__((ext_vector_type(4)));

constexpr int DM = 1024, NB = 8, SEQ = 4096, NTOK = NB * SEQ;
constexpr int ZE = 2560;
constexpr int ZO = 2304, ZO_REAL = 2120;
constexpr int OQ = 0, OK_ = 1024, OV = 1280, OQI = 1536, OKI = 2048, OWI = 2112;
constexpr int NEXP = 32, PLE = 256;
constexpr int NGRP = NTOK / 128;
constexpr int MAXTILES = NTOK * 4 / 256 + NEXP;
constexpr int MAXROWS = MAXTILES * 256;
constexpr float LN_EPS = 1e-5f;
constexpr float ALPHA = 1.4142135623730951f;
constexpr float LOG2E = 1.4426950408889634f;
constexpr float WSC = 64.f, WSC_INV = 1.f / 64.f;

#ifndef FP8_IN0
#define FP8_IN0 1
#endif
#ifndef Y_FP8
#define Y_FP8 1
#endif
#ifndef MOE_ALIGN
#define MOE_ALIGN true
#endif
#ifndef FP8_IN1
#define FP8_IN1 0
#endif
#ifndef FP8_OUT
#define FP8_OUT 1
#endif
#ifndef FP8_GATE
#define FP8_GATE 1
#endif
#ifndef PROBE_DUP
#define PROBE_DUP 0
#endif
#define PM(k) (((PROBE_DUP >> (k)) & 1) ? 2 : 1)

constexpr size_t MiB = 1u << 20;
constexpr size_t WS_CTL = 0, CTL_ZERO_BYTES = 1 * MiB;
constexpr size_t WS_WRT = 1 * MiB;
constexpr size_t WS_WSB = WS_WRT + 256 * 1024;
constexpr size_t WS_CNT = WS_WSB + 256 * 1024;
constexpr size_t WS_TOPI = 2 * MiB;
constexpr size_t WS_GATE = WS_TOPI + 512 * 1024;
constexpr size_t WS_SLOT = 3 * MiB;
constexpr size_t WS_ROWG = WS_SLOT + 512 * 1024;
constexpr size_t WS_HQ = 1056 * MiB + 160 * MiB;
constexpr size_t WS_WIN0 = 8 * MiB, WS_WO0 = 13 * MiB, WS_WIN1 = 15 * MiB, WS_WO1 = 20 * MiB, WS_WG = 22 * MiB, WS_WPLE = 26 * MiB;
constexpr size_t WS_WGU = 32 * MiB, WS_WD = 288 * MiB;
constexpr size_t WS_XB = 416 * MiB, WS_PB = 480 * MiB, WS_PPLE = 512 * MiB, WS_Z = 640 * MiB, WS_CAT = 800 * MiB, WS_T1 = 864 * MiB;
constexpr size_t WS_BM = 1328 * MiB;
constexpr size_t WS_KV1 = WS_BM + 16 * MiB;
constexpr size_t WS_KI1 = WS_KV1 + 32 * MiB;
constexpr size_t WS_HB = 928 * MiB, WS_MIDB = 992 * MiB, WS_XS = 1056 * MiB, WS_ACT = 1328 * MiB;
constexpr size_t WS_XQ = 1600 * MiB, WS_MIDQ = 1632 * MiB, WS_END = 1664 * MiB;
static_assert(WS_ROWG + (size_t)MAXROWS * 4 <= WS_WIN0, "small buffers");
static_assert(WS_XS + (size_t)MAXROWS * DM * 2 <= WS_ACT && WS_ACT + (size_t)MAXROWS * DM * 2 <= WS_END, "moe buffers");

constexpr int RING_BYTES = 131072;
constexpr int MISC_OFF = RING_BYTES;
constexpr int TAB_OFF = MISC_OFF + 512;
constexpr int XTRA_OFF = TAB_OFF + 6144;
constexpr int LDS_BYTES = 147456;
static_assert(XTRA_OFF + 8192 <= LDS_BYTES, "LDS map");
constexpr int TB_TOT16 = 0, TB_BEF16 = 2048, TB_TOTAL = 4096, TB_BEFORE = 4224, TB_PADST = 4352  , TB_NTL = 4488, TB_LCUR = 4608  , TB_BASE = 4736  , TB_T2E = 5120  ;
static_assert(TB_T2E + 544 <= 6144, "tab");

#define RLX_AGENT __ATOMIC_RELAXED, __HIP_MEMORY_SCOPE_AGENT
typedef __bf16 bf16x2_t __attribute__((ext_vector_type(2)));
__device__ __forceinline__ unsigned cvt_pk_bf16(float lo, float hi) { const f32x2 v = {lo, hi}; const bf16x2_t b = __builtin_convertvector(v, bf16x2_t); return __builtin_bit_cast(unsigned, b); }
__device__ __forceinline__ unsigned char f8_1(float v) { return (unsigned char)(__builtin_amdgcn_cvt_pk_fp8_f32(v, v, 0, false) & 0xff); }
#if FP8_OUT
#define CAT_ST(cat, idx, v) ((cat)[idx] = f8_1(v))
#else
#define CAT_ST(cat, idx, v) (((bf16_t*)(cat))[idx] = (bf16_t)(cvt_pk_bf16((v), 0.f) & 0xffffu))
#endif
__device__ __forceinline__ float bf_lo(unsigned u) { return __uint_as_float(u << 16); }
__device__ __forceinline__ float bf_hi(unsigned u) { return __uint_as_float(u & 0xffff0000u); }
__device__ __forceinline__ float bf1(bf16_t u) { return __uint_as_float(((unsigned)u) << 16); }
template <int K> __device__ __forceinline__ int sxi(int v) {
    if constexpr (K == 32) { const auto rr = __builtin_amdgcn_permlane32_swap((unsigned)v, (unsigned)v, false, false); return (int)(rr[0] ^ rr[1] ^ (unsigned)v); }
    else return __builtin_amdgcn_ds_swizzle(v, (K << 10) | 0x1f);
}
template <int K> __device__ __forceinline__ float sxf(float v) { return __int_as_float(sxi<K>(__float_as_int(v))); }
__device__ __forceinline__ float wave_sum(float x) {
    int v = __float_as_int(x);
#define WSF_STEP(ctrl, rm) { const int o = __builtin_amdgcn_update_dpp(0, v, ctrl, rm, 0xf, false); v = __float_as_int(__int_as_float(v) + __int_as_float(o)); }
    WSF_STEP(0x111, 0xf) WSF_STEP(0x112, 0xf) WSF_STEP(0x114, 0xf) WSF_STEP(0x118, 0xf) WSF_STEP(0x142, 0xa) WSF_STEP(0x143, 0xc)
#undef WSF_STEP
    return __int_as_float(__builtin_amdgcn_readlane(v, 63));
}
__device__ __forceinline__ float wave_max(float v) {
    v = fmaxf(v, sxf<1>(v)); v = fmaxf(v, sxf<2>(v)); v = fmaxf(v, sxf<4>(v)); v = fmaxf(v, sxf<8>(v)); v = fmaxf(v, sxf<16>(v)); v = fmaxf(v, sxf<32>(v));
    return v;
}
__device__ __forceinline__ float wave_min(float v) {
    v = fminf(v, sxf<1>(v)); v = fminf(v, sxf<2>(v)); v = fminf(v, sxf<4>(v)); v = fminf(v, sxf<8>(v)); v = fminf(v, sxf<16>(v)); v = fminf(v, sxf<32>(v));
    return v;
}
__device__ __forceinline__ int wave_sumi(int v) {
    v += sxi<1>(v); v += sxi<2>(v); v += sxi<4>(v); v += sxi<8>(v); v += sxi<16>(v); v += sxi<32>(v);
    return v;
}
__device__ __forceinline__ int wave_sum_uniform(int v) {
    v += __builtin_amdgcn_update_dpp(0, v, 0x111, 0xf, 0xf, false);
    v += __builtin_amdgcn_update_dpp(0, v, 0x112, 0xf, 0xf, false);
    v += __builtin_amdgcn_update_dpp(0, v, 0x114, 0xf, 0xf, false);
    v += __builtin_amdgcn_update_dpp(0, v, 0x118, 0xf, 0xf, false);
    v += __builtin_amdgcn_update_dpp(0, v, 0x142, 0xa, 0xf, false);
    v += __builtin_amdgcn_update_dpp(0, v, 0x143, 0xc, 0xf, false);
    return __builtin_amdgcn_readlane(v, 63);
}
__device__ __forceinline__ float wave_max_uniform(float x) {
    int v = __float_as_int(x);
#define WMX_STEP(ctrl, rm) { const int o = __builtin_amdgcn_update_dpp(v, v, ctrl, rm, 0xf, false); v = __float_as_int(fmaxf(__int_as_float(v), __int_as_float(o))); }
    WMX_STEP(0x111, 0xf) WMX_STEP(0x112, 0xf) WMX_STEP(0x114, 0xf) WMX_STEP(0x118, 0xf) WMX_STEP(0x142, 0xa) WMX_STEP(0x143, 0xc)
#undef WMX_STEP
    return __int_as_float(__builtin_amdgcn_readlane(v, 63));
}
__device__ __forceinline__ float relu_i(float x) { const int i = __float_as_int(x); return __int_as_float(i > 0 ? i : 0); }
__device__ __forceinline__ float ex2(float x) { return __builtin_amdgcn_exp2f(x); }
__device__ __forceinline__ float lg2(float x) { return __builtin_amdgcn_logf(x); }
__device__ __forceinline__ float rcpf_(float x) { return __builtin_amdgcn_rcpf(x); }
__device__ __forceinline__ float sigmoidf_(float x) { return rcpf_(1.f + ex2(-LOG2E * x)); }
__device__ __forceinline__ float gelu_tanh(float x) { return x * rcpf_(1.f + ex2(-2.302208198f * (x + 0.044715f * x * x * x))); }

namespace pg8 {
constexpr int BM = 256, BK = 64, HALF = 128, HTB = HALF * BK * 2, STAGE_BYTES = 8 * HTB, NXCD = 8, WGM = 8;
__host__ __device__ __forceinline__ int lds_byte(int r, int c) { const int st = (r >> 4) * 2 + (c >> 5), rr = r & 15, cc = c & 31, ob = rr * 64 + cc * 2; return st * 1024 + (ob ^ (((ob >> 9) & 1) << 5)); }
__host__ __device__ __forceinline__ void stage_rc(int b, int& R, int& C) { const int st = b / 1024, sb = b % 1024, swz = sb ^ (((sb >> 9) & 1) << 5); R = (st >> 1) * 16 + swz / 64; C = (st & 1) * 32 + (swz % 64) / 2; }
__host__ __device__ __forceinline__ int perm32(int rho) { const int n = rho >> 4, i = rho & 15; return 8 * (i >> 2) + 4 * n + (i & 3); }

struct Unit { int pm, pn, e; const char* b0; };
typedef int v8i_t __attribute__((ext_vector_type(8)));
typedef int v4i_t __attribute__((ext_vector_type(4)));
__device__ __forceinline__ v8i_t cat8(const bf16x8 a, const bf16x8 b) { const v4i_t x = __builtin_bit_cast(v4i_t, a), y = __builtin_bit_cast(v4i_t, b); return __builtin_shufflevector(x, y, 0, 1, 2, 3, 4, 5, 6, 7); }

struct DenseOrder {
    static constexpr bool GATHER = false;
    int nM, nN, nwg, G, c, rep; const char* A; const char* B; size_t tstep, hstep;
    __device__ __forceinline__ void init(const void* A_, const void* B_, int M, int N, int K, int G_, int c_, int rep_ = 1) { initp(A_, B_, M, N, 2 * K, G_, c_, rep_); }
    __device__ __forceinline__ void initp(const void* A_, const void* B_, int M, int N, int pitch, int G_, int c_, int rep_ = 1) { A = (const char*)A_; B = (const char*)B_; nM = M / BM; nN = N / BM; nwg = nM * nN; G = G_; c = c_; rep = rep_; hstep = (size_t)HALF * pitch; tstep = 2 * hstep; }
    __device__ __forceinline__ bool next(int i, Unit& u) const {
        long L = (long)i * G + c; if (L >= (long)nwg * rep) return false; if (L >= nwg) L -= nwg;
        int wgid = (int)L; { const int q = nwg / NXCD, r = nwg % NXCD, xcd = wgid % NXCD, off = wgid / NXCD; wgid = (xcd < r ? xcd * (q + 1) : r * (q + 1) + (xcd - r) * q) + off; }
        const int nig = WGM * nN, gid = wgid / nig, fm = gid * WGM, gsz = (nM - fm) < WGM ? (nM - fm) : WGM;
        u.pm = fm + ((wgid % nig) % gsz); u.pn = (wgid % nig) / gsz; u.e = 0;
        u.b0 = B + (size_t)u.pn * tstep; return true;
    }
    __device__ __forceinline__ const char* aptr(const Unit& u) const { return A + (size_t)u.pm * tstep; }
    __device__ __forceinline__ size_t b1off() const { return hstep; }
    __device__ __forceinline__ int rowtok_at(int) const { return 0; }
};
struct PleOrder {
    static constexpr bool GATHER = false;
    DenseOrder D;
    __device__ __forceinline__ bool next(int i, Unit& u) const { if (!D.next(i, u)) return false; if (u.pm >= 32768 / BM) u.b0 += (size_t)1024 * 256 * 2; return true; }
    __device__ __forceinline__ const char* aptr(const Unit& u) const { return D.aptr(u); }
    __device__ __forceinline__ size_t b1off() const { return D.b1off(); }
    __device__ __forceinline__ int rowtok_at(int) const { return 0; }
};
template <int NT, bool SWIGLU>
struct MoeOrder {
    static constexpr bool GATHER = SWIGLU;
    int nunits, G, c, rep; const LAS unsigned char* t2e; const char* A; const char* W; const int* rowtok;
    static constexpr size_t hstep = (size_t)HALF * 1024, tstep = 2 * hstep;
    __device__ __forceinline__ bool next(int i, Unit& u) const {
        const int vc = ((G & 7) == 0) ? (c & 7) * (G >> 3) + (c >> 3) : c;
        int L = i * G + vc; if (L >= nunits * rep) return false; if (L >= nunits) L -= nunits;
        const int rt = L / NT, pn = L % NT;
        const int e = __builtin_amdgcn_readfirstlane((int)t2e[rt]);
        u.pm = rt; u.pn = pn; u.e = e;
        if (SWIGLU) u.b0 = W + (size_t)e * (16 * hstep) + (size_t)pn * hstep;
        else u.b0 = W + (size_t)e * (8 * hstep) + (size_t)pn * tstep;
        return true;
    }
    __device__ __forceinline__ const char* aptr(const Unit& u) const { return GATHER ? A : A + (size_t)u.pm * tstep; }
    __device__ __forceinline__ size_t b1off() const { return SWIGLU ? 8 * hstep : hstep; }
    __device__ __forceinline__ int rowtok_at(int row) const { return rowtok[row]; }
};

template <class Epi, class Sched, bool FP8 = false, bool ALIGN_EPI = true>
__device__ __forceinline__ void gemm_phase(LAS unsigned char* lds, const int tid, const int pitch, const Sched& S, const Epi& E) {
    const int wid = __builtin_amdgcn_readfirstlane(tid >> 6), lane = tid & 63, wr = wid >> 2, wc = wid & 3, fr = lane & 15, fq = lane >> 4;
    const int nt = pitch / (BK * 2);
    unsigned voffA[2], voffB[2];
#pragma unroll
    for (int i = 0; i < 2; ++i) { int R, C; stage_rc(tid * 16 + i * 8192, R, C); const int Rb = (R & ~31) + perm32(R & 31);
        voffA[i] = (unsigned)(R * pitch + C * 2); voffB[i] = (unsigned)(Rb * pitch + C * 2); }
    const size_t kstep = (size_t)(BK * 2);
    const size_t hstep = (size_t)HALF * pitch;
    constexpr bool GATHER = Sched::GATHER;
    unsigned vA[2][2], vAn[2][2]; int gR[2], gC[2];
    if constexpr (GATHER) {
#pragma unroll
        for (int i = 0; i < 2; ++i) { int R, C; stage_rc(tid * 16 + i * 8192, R, C); gR[i] = R; gC[i] = C * 2; } }
    auto gather_tok = [&](const Unit& u, int (&tk)[2][2]) {
#pragma unroll
        for (int h = 0; h < 2; ++h)
#pragma unroll
            for (int i = 0; i < 2; ++i) tk[h][i] = S.rowtok_at(u.pm * BM + h * HALF + gR[i]); };
    auto gather_off = [&](const int (&tk)[2][2], unsigned (&v)[2][2]) {
#pragma unroll
        for (int h = 0; h < 2; ++h)
#pragma unroll
            for (int i = 0; i < 2; ++i) v[h][i] = (unsigned)(tk[h][i] * pitch + gC[i]); };
    const unsigned ldsw = (unsigned)wid * 1024u;
    int sc127 = 127, scw = Epi::SCALE_EXP; asm volatile("" : "+v"(sc127), "+v"(scw));
    const unsigned ldsu = (unsigned)__builtin_amdgcn_readfirstlane((int)(unsigned)(uintptr_t)lds) + ldsw;
    const int aoff = lds_byte(wr * 64 + fr, fq * 8), boff = lds_byte(wc * 32 + fr, fq * 8);
#define PG8_SA(b, h) (((b) * 2 + (h)) * HTB)
#define PG8_SB(b, h) ((4 + (b) * 2 + (h)) * HTB)
#define PG8_STAGE(bufoff, gbase, voff) do { _Pragma("unroll") for (int _i = 0; _i < 2; ++_i) { unsigned _keep; \
        asm volatile("s_mov_b32 %0, m0\n\ts_mov_b32 m0, %3\n\ts_nop 0\n\tglobal_load_lds_dwordx4 %1, %2\n\ts_mov_b32 m0, %0" : "=&s"(_keep) : "v"((voff)[_i]), "s"((const char*)(gbase)), "s"(ldsu + (unsigned)((bufoff) + _i * 8192)) : "memory"); } } while (0)
#define PG8_STAGE_A(b, h, base, VG) do { if constexpr (GATHER) { PG8_STAGE(PG8_SA(b, h), base, (VG)[h]); } else { PG8_STAGE(PG8_SA(b, h), (base) + (h) * hstep, voffA); } } while (0)
#define PG8_LDA(dst, b, h) do { _Pragma("unroll") for (int m = 0; m < 4; ++m) _Pragma("unroll") for (int k = 0; k < 2; ++k) dst[m][k] = *(const LAS bf16x8*)(lds + PG8_SA(b, h) + aoff + m * 2048 + k * 1024); } while (0)
#define PG8_LDB(dst, b, h) do { _Pragma("unroll") for (int n = 0; n < 2; ++n) _Pragma("unroll") for (int k = 0; k < 2; ++k) dst[n][k] = *(const LAS bf16x8*)(lds + PG8_SB(b, h) + boff + n * 2048 + k * 1024); } while (0)
#define PG8_MMA(ai, bj, At, Bt) do { __builtin_amdgcn_s_setprio(1); _Pragma("unroll") for (int m = 0; m < 4; ++m) _Pragma("unroll") for (int n = 0; n < 2; ++n) { \
        if constexpr (FP8) { const v8i_t _a = cat8(Bt[n][0], Bt[n][1]), _b = cat8(At[m][0], At[m][1]); \
            asm volatile("v_mfma_scale_f32_16x16x128_f8f6f4 %0, %1, %2, %0, %3, %4 op_sel_hi:[0,0,0]" : "+v"(acc[ai][bj][m][n]) : "v"(_a), "v"(_b), "v"(scw), "v"(sc127)); } \
        else { _Pragma("unroll") for (int k = 0; k < 2; ++k) acc[ai][bj][m][n] = __builtin_amdgcn_mfma_f32_16x16x32_bf16(Bt[n][k], At[m][k], acc[ai][bj][m][n], 0, 0, 0); } } __builtin_amdgcn_s_setprio(0); } while (0)
#define PG8_WAIT_V(n) asm volatile("s_waitcnt vmcnt(" #n ")" ::: "memory")
#define PG8_WAIT_L(n) asm volatile("s_waitcnt lgkmcnt(" #n ")" ::: "memory")
#define PG8_BAR __builtin_amdgcn_s_barrier()
#define PG8_SCHED __builtin_amdgcn_sched_barrier(0)
    Unit cur, nxt; int ui = 0;
    if (!S.next(0, cur)) return;
    f32x4 acc[2][2][4][2];
    { typename Epi::Pre pre0; E.prefetch(pre0, cur, wr, wc, fr, fq); E.init(acc, pre0); }
    bf16x8 At[4][2], B0[2][2], B1[2][2];
    const char* cA = S.aptr(cur); const char* cB0 = cur.b0; const char* cB1 = cB0 + S.b1off();
    if constexpr (GATHER) { int tk[2][2]; gather_tok(cur, tk); gather_off(tk, vA); Unit u1; const bool h1 = S.next(1, u1); gather_tok(h1 ? u1 : cur, tk); gather_off(tk, vAn); }
    PG8_STAGE(PG8_SB(0, 0), cB0, voffB); PG8_STAGE(PG8_SB(0, 1), cB1, voffB); PG8_STAGE_A(0, 0, cA, vA); PG8_STAGE_A(0, 1, cA, vA);
    if (wr == 1) PG8_BAR;
    PG8_WAIT_V(2); PG8_BAR;
    PG8_STAGE(PG8_SB(1, 0), cB0 + kstep, voffB); PG8_STAGE_A(1, 0, cA + kstep, vA); PG8_STAGE(PG8_SB(1, 1), cB1 + kstep, voffB);
    PG8_WAIT_V(6); PG8_BAR;
    for (;;) {
        const bool has_next = S.next(ui + 1, nxt);
        const char* nA = has_next ? S.aptr(nxt) : cA; const char* nB0 = has_next ? nxt.b0 : cB0; const char* nB1 = nB0 + S.b1off();
        for (int t = 0; t < nt; t += 2) {
            const bool last = (t == nt - 2);
            const char* a1 = cA + (size_t)(t + 1) * kstep;
            const char* a2 = last ? nA : cA + (size_t)(t + 2) * kstep;
            const char* b20 = last ? nB0 : cB0 + (size_t)(t + 2) * kstep; const char* b21 = last ? nB1 : cB1 + (size_t)(t + 2) * kstep;
            const char* a3 = a2 + kstep; const char* b30 = b20 + kstep; const char* b31 = b21 + kstep;
            unsigned vS[2][2];
            if constexpr (GATHER) {
#pragma unroll
                for (int h = 0; h < 2; ++h)
#pragma unroll
                    for (int i = 0; i < 2; ++i) vS[h][i] = last ? vAn[h][i] : vA[h][i]; }
            PG8_LDB(B0, 0, 0); PG8_LDB(B1, 0, 1); PG8_SCHED; PG8_LDA(At, 0, 0); PG8_STAGE_A(1, 1, a1, vA);
            PG8_WAIT_V(8); PG8_WAIT_L(0); PG8_BAR; PG8_MMA(0, 0, At, B0); PG8_MMA(0, 1, At, B1); PG8_BAR; PG8_SCHED;
            PG8_LDA(At, 0, 1); PG8_STAGE(PG8_SB(0, 0), b20, voffB); PG8_STAGE(PG8_SB(0, 1), b21, voffB); PG8_STAGE_A(0, 0, a2, vS);
            PG8_WAIT_V(8); PG8_WAIT_L(0); PG8_BAR; PG8_MMA(1, 0, At, B0); PG8_MMA(1, 1, At, B1); PG8_BAR; PG8_SCHED;
            PG8_LDB(B0, 1, 0); PG8_LDB(B1, 1, 1); PG8_SCHED; PG8_LDA(At, 1, 0); PG8_STAGE_A(0, 1, a2, vS);
            PG8_WAIT_V(8); PG8_WAIT_L(0); PG8_BAR; PG8_MMA(0, 0, At, B0); PG8_MMA(0, 1, At, B1); PG8_BAR; PG8_SCHED;
            PG8_LDA(At, 1, 1); PG8_STAGE(PG8_SB(1, 0), b30, voffB); PG8_STAGE(PG8_SB(1, 1), b31, voffB); PG8_STAGE_A(1, 0, a3, vS);
            PG8_WAIT_V(8); PG8_WAIT_L(0); PG8_BAR; PG8_MMA(1, 0, At, B0); PG8_MMA(1, 1, At, B1); PG8_BAR; PG8_SCHED;
        }
        if constexpr (ALIGN_EPI) { if (wr == 0) PG8_BAR; }
        typename Epi::Pre pre; E.prefetch(pre, has_next ? nxt : cur, wr, wc, fr, fq);
        int tkn[2][2];
        if constexpr (GATHER) { Unit u2; const bool h2 = S.next(ui + 2, u2); gather_tok(h2 ? u2 : cur, tkn); }
        PG8_SCHED;
        E(acc, cur, wr, wc, fr, fq);
        if (!has_next) break;
        E.init(acc, pre);
        if constexpr (GATHER) { asm volatile("" : "+v"(tkn[0][0]), "+v"(tkn[0][1]), "+v"(tkn[1][0]), "+v"(tkn[1][1]));
#pragma unroll
            for (int h = 0; h < 2; ++h)
#pragma unroll
                for (int i = 0; i < 2; ++i) vA[h][i] = vAn[h][i];
            gather_off(tkn, vAn); }
        cur = nxt; cA = nA; cB0 = nB0; cB1 = nB1; ++ui;
        if constexpr (ALIGN_EPI) { if (wr == 1) PG8_BAR; }
    }
    PG8_WAIT_V(0);
    if constexpr (!ALIGN_EPI) { if (wr == 0) PG8_BAR; }
    PG8_BAR;
#undef PG8_SA
#undef PG8_SB
#undef PG8_STAGE
#undef PG8_STAGE_A
#undef PG8_LDA
#undef PG8_LDB
#undef PG8_MMA
#undef PG8_WAIT_V
#undef PG8_WAIT_L
#undef PG8_BAR
#undef PG8_SCHED
}

#define EPI_ROWS_BEGIN const int row0 = u.pm * BM + wr * 64 + fr; const int cl = wc * 32 + 8 * fq;
__device__ __forceinline__ void store8(bf16_t* p, const f32x4 v0, const f32x4 v1) {
    u32x4 w; w.x = cvt_pk_bf16(v0[0], v0[1]); w.y = cvt_pk_bf16(v0[2], v0[3]); w.z = cvt_pk_bf16(v1[0], v1[1]); w.w = cvt_pk_bf16(v1[2], v1[3]); *(u32x4*)p = w;
}
__device__ __forceinline__ u32x2 pack8_fp8(const f32x4 v0, const f32x4 v1) {
    int a = 0, b = 0; a = __builtin_amdgcn_cvt_pk_fp8_f32(v0[0], v0[1], a, false); a = __builtin_amdgcn_cvt_pk_fp8_f32(v0[2], v0[3], a, true);
    b = __builtin_amdgcn_cvt_pk_fp8_f32(v1[0], v1[1], b, false); b = __builtin_amdgcn_cvt_pk_fp8_f32(v1[2], v1[3], b, true); return (u32x2){(unsigned)a, (unsigned)b};
}
__device__ __forceinline__ void store8_fp8(unsigned char* p, const f32x4 v0, const f32x4 v1) { *(u32x2*)p = pack8_fp8(v0, v1); }
__device__ __forceinline__ void load8bf(const bf16_t* p, f32x4& v0, f32x4& v1) {
    const u32x4 w = *(const u32x4*)p; v0 = (f32x4){bf_lo(w.x), bf_hi(w.x), bf_lo(w.y), bf_hi(w.y)}; v1 = (f32x4){bf_lo(w.z), bf_hi(w.z), bf_lo(w.w), bf_hi(w.w)};
}
__device__ __forceinline__ void acc_zero(f32x4 (&acc)[2][2][4][2]) {
#pragma unroll
    for (int a = 0; a < 2; ++a)
#pragma unroll
        for (int b = 0; b < 2; ++b)
#pragma unroll
            for (int m = 0; m < 4; ++m)
#pragma unroll
                for (int n = 0; n < 2; ++n) acc[a][b][m][n] = (f32x4){0.f, 0.f, 0.f, 0.f};
}
#define EPI_NO_PRE static constexpr int SCALE_EXP = 121; struct Pre {}; \
    __device__ __forceinline__ void prefetch(Pre&, const Unit&, int, int, int, int) const {} \
    __device__ __forceinline__ void init(f32x4 (&acc)[2][2][4][2], const Pre&) const { acc_zero(acc); }
struct EpiPlain {
    EPI_NO_PRE
    bf16_t* O; int ldc;
    __device__ __forceinline__ void operator()(const f32x4 (&acc)[2][2][4][2], const Unit& u, int wr, int wc, int fr, int fq) const {
        EPI_ROWS_BEGIN
#pragma unroll
        for (int ai = 0; ai < 2; ++ai)
#pragma unroll
            for (int m = 0; m < 4; ++m) { bf16_t* rowp = O + (unsigned)((row0 + ai * HALF + m * 16) * ldc + u.pn * BM + cl);
#pragma unroll
                for (int bj = 0; bj < 2; ++bj) store8(rowp + bj * HALF, acc[ai][bj][m][0], acc[ai][bj][m][1]); asm volatile("" ::: "memory"); }
    }
};
struct EpiIn0 {
    EPI_NO_PRE
    static constexpr float WSI = 1.f;
    bf16_t* O; float qscale;
    __device__ __forceinline__ void operator()(const f32x4 (&acc)[2][2][4][2], const Unit& u, int wr, int wc, int fr, int fq) const {
        EPI_ROWS_BEGIN
        if (u.pn < 4) {
#pragma unroll
            for (int ai = 0; ai < 2; ++ai)
#pragma unroll
                for (int m = 0; m < 4; ++m) { bf16_t* rowp = O + (unsigned)((row0 + ai * HALF + m * 16) * ZE + u.pn * BM + cl);
#pragma unroll
                    for (int bj = 0; bj < 2; ++bj) { f32x4 v0 = acc[ai][bj][m][0] * WSI, v1 = acc[ai][bj][m][1] * WSI;
#pragma unroll
                        for (int j = 0; j < 4; ++j) { v0[j] = gelu_tanh(v0[j]); v1[j] = gelu_tanh(v1[j]); }
                        store8(rowp + bj * HALF, v0, v1); asm volatile("" ::: "memory"); } }
        } else {
            const float sc = (u.pn < 6 ? qscale : 1.f) * WSI;
#pragma unroll
            for (int ai = 0; ai < 2; ++ai)
#pragma unroll
                for (int m = 0; m < 4; ++m) { bf16_t* rowp = O + (unsigned)((row0 + ai * HALF + m * 16) * ZE + u.pn * BM + cl);
#pragma unroll
                    for (int bj = 0; bj < 2; ++bj) store8(rowp + bj * HALF, acc[ai][bj][m][0] * sc, acc[ai][bj][m][1] * sc);
                    asm volatile("" ::: "memory"); }
        }
    }
};
struct EpiIn1 {
    EPI_NO_PRE
    static constexpr float WSI = 1.f;
    bf16_t* O; bf16_t* KV; bf16_t* KI;
    __device__ __forceinline__ void operator()(const f32x4 (&acc)[2][2][4][2], const Unit& u, int wr, int wc, int fr, int fq) const {
        EPI_ROWS_BEGIN
        if (u.pn == 4 || u.pn == 5) {
            bf16_t* base = KV + (u.pn - 4) * 256 + cl;
#pragma unroll
            for (int ai = 0; ai < 2; ++ai)
#pragma unroll
                for (int m = 0; m < 4; ++m) { bf16_t* rowp = base + (unsigned)((row0 + ai * HALF + m * 16) * 512);
#pragma unroll
                    for (int bj = 0; bj < 2; ++bj) store8(rowp + bj * HALF, acc[ai][bj][m][0] * WSI, acc[ai][bj][m][1] * WSI);
                    asm volatile("" ::: "memory"); }
        } else {
            const float sc = (u.pn < 4 ? 0.125f * LOG2E : 1.f) * WSI;
#pragma unroll
            for (int ai = 0; ai < 2; ++ai)
#pragma unroll
                for (int m = 0; m < 4; ++m) { bf16_t* rowp = O + (unsigned)((row0 + ai * HALF + m * 16) * ZO + u.pn * BM + cl);
#pragma unroll
                    for (int bj = 0; bj < 2; ++bj) store8(rowp + bj * HALF, acc[ai][bj][m][0] * sc, acc[ai][bj][m][1] * sc);
                    asm volatile("" ::: "memory"); }
            if (u.pn == 8 && wc < 2) {
#pragma unroll
                for (int ai = 0; ai < 2; ++ai)
#pragma unroll
                    for (int m = 0; m < 4; ++m) { const int row = row0 + ai * HALF + m * 16;
                        store8(KI + (unsigned)(((((row >> 5) * 4 + (cl >> 4)) * 64) + (((cl >> 3) & 1) * 32 + (row & 31))) * 8), acc[ai][0][m][0] * WSI, acc[ai][0][m][1] * WSI); asm volatile("" ::: "memory"); }
            }
        }
    }
};
struct EpiOut {
    EPI_NO_PRE
    const float* xf; const bf16_t* xb; bf16_t* O;
    __device__ __forceinline__ void operator()(const f32x4 (&acc)[2][2][4][2], const Unit& u, int wr, int wc, int fr, int fq) const {
        EPI_ROWS_BEGIN
#pragma unroll
        for (int ai = 0; ai < 2; ++ai) {
            f32x4 xr[4][2][2];
#pragma unroll
            for (int m = 0; m < 4; ++m) { const unsigned off = (unsigned)((row0 + ai * HALF + m * 16) * DM + u.pn * BM + cl);
#pragma unroll
                for (int bj = 0; bj < 2; ++bj) {
                    if (xf) { xr[m][bj][0] = *(const f32x4*)(xf + off + bj * HALF); xr[m][bj][1] = *(const f32x4*)(xf + off + bj * HALF + 4); }
                    else load8bf(xb + off + bj * HALF, xr[m][bj][0], xr[m][bj][1]); } }
            asm volatile("" ::: "memory");
#pragma unroll
            for (int m = 0; m < 4; ++m) { const unsigned off = (unsigned)((row0 + ai * HALF + m * 16) * DM + u.pn * BM + cl);
#pragma unroll
                for (int bj = 0; bj < 2; ++bj)
                    store8(O + off + bj * HALF, xr[m][bj][0] * ALPHA + acc[ai][bj][m][0], xr[m][bj][1] * ALPHA + acc[ai][bj][m][1]); }
            asm volatile("" ::: "memory");
        }
    }
};
constexpr float SWC = -1.702f * LOG2E;
struct EpiSwiglu {
    static constexpr int SCALE_EXP = 121;
    unsigned char* O; const float* bgu;
    struct Pre { f32x4 b[4]; };
    __device__ __forceinline__ void prefetch(Pre& p, const Unit& u, int wr, int wc, int fr, int fq) const {
        const float* bp = bgu + (unsigned)(u.e * 2048 + u.pn * HALF + wc * 32 + 8 * fq);
        p.b[0] = *(const f32x4*)bp; p.b[1] = *(const f32x4*)(bp + 4); p.b[2] = *(const f32x4*)(bp + 1024); p.b[3] = *(const f32x4*)(bp + 1028);
    }
    __device__ __forceinline__ void init(f32x4 (&acc)[2][2][4][2], const Pre& p) const {
        const f32x4 g0 = p.b[0] * SWC, g1 = p.b[1] * SWC, u0 = (p.b[2] + 1.0f) * (1.0f / SWC), u1 = (p.b[3] + 1.0f) * (1.0f / SWC);
#pragma unroll
        for (int ai = 0; ai < 2; ++ai)
#pragma unroll
            for (int m = 0; m < 4; ++m) { acc[ai][0][m][0] = g0; acc[ai][0][m][1] = g1; acc[ai][1][m][0] = u0; acc[ai][1][m][1] = u1; }
    }
    __device__ __forceinline__ void operator()(const f32x4 (&acc)[2][2][4][2], const Unit& u, int wr, int wc, int fr, int fq) const {
        EPI_ROWS_BEGIN
        const int col = u.pn * HALF + cl;
        float c7 = 7.0f * SWC, ya = -6.0f / SWC, yb = 8.0f / SWC; asm volatile("" : "+v"(c7), "+v"(ya), "+v"(yb));
#pragma unroll
        for (int ai = 0; ai < 2; ++ai)
#pragma unroll
            for (int m = 0; m < 4; ++m) { float t[8], y[8], e[8];
#pragma unroll
                for (int j = 0; j < 8; ++j) { asm("v_max_f32 %0, %1, %2" : "=v"(t[j]) : "v"(acc[ai][0][m][j >> 2][j & 3]), "v"(c7)); }
#pragma unroll
                for (int j = 0; j < 8; ++j) e[j] = __builtin_amdgcn_exp2f(t[j]);
#pragma unroll
                for (int j = 0; j < 8; ++j) { asm("v_med3_f32 %0, %1, %2, %3" : "=v"(y[j]) : "v"(acc[ai][1][m][j >> 2][j & 3]), "v"(ya), "v"(yb)); }
                __builtin_amdgcn_sched_barrier(0);
#pragma unroll
                for (int j = 0; j < 8; ++j) e[j] += 1.0f;
#pragma unroll
                for (int j = 0; j < 8; ++j) e[j] = __builtin_amdgcn_rcpf(e[j]);
#pragma unroll
                for (int j = 0; j < 8; ++j) y[j] *= t[j];
                __builtin_amdgcn_sched_barrier(0);
#pragma unroll
                for (int j = 0; j < 8; ++j) y[j] *= e[j];
                store8_fp8(O + (unsigned)((row0 + ai * HALF + m * 16) * DM + col), (f32x4){y[0], y[1], y[2], y[3]}, (f32x4){y[4], y[5], y[6], y[7]}); asm volatile("" ::: "memory"); }
    }
};
struct EpiDown {
    static constexpr int SCALE_EXP = 125;
    unsigned char* O; const float* bd;
    struct Pre { f32x4 b[2][2]; };
    __device__ __forceinline__ void prefetch(Pre& p, const Unit& u, int wr, int wc, int fr, int fq) const {
        const float* bp = bd + (unsigned)(u.e * DM + u.pn * BM + wc * 32 + 8 * fq);
#pragma unroll
        for (int bj = 0; bj < 2; ++bj) { p.b[bj][0] = *(const f32x4*)(bp + bj * HALF); p.b[bj][1] = *(const f32x4*)(bp + bj * HALF + 4); }
    }
    __device__ __forceinline__ void init(f32x4 (&acc)[2][2][4][2], const Pre& p) const {
#pragma unroll
        for (int bj = 0; bj < 2; ++bj) { const f32x4 b0 = p.b[bj][0] * 16.f, b1 = p.b[bj][1] * 16.f;
#pragma unroll
            for (int ai = 0; ai < 2; ++ai)
#pragma unroll
                for (int m = 0; m < 4; ++m) { acc[ai][bj][m][0] = b0; acc[ai][bj][m][1] = b1; } }
    }
    __device__ __forceinline__ void operator()(const f32x4 (&acc)[2][2][4][2], const Unit& u, int wr, int wc, int fr, int fq) const {
        EPI_ROWS_BEGIN
        const int col = u.pn * BM + cl;
#pragma unroll
        for (int ai = 0; ai < 2; ++ai)
#pragma unroll
            for (int m = 0; m < 4; ++m) { const int row = row0 + ai * HALF + m * 16;
#pragma unroll
                for (int bj = 0; bj < 2; ++bj) store8_fp8(O + (unsigned)(row * DM + col + bj * HALF), acc[ai][bj][m][0], acc[ai][bj][m][1]);
                asm volatile("" ::: "memory"); }
    }
};
struct EpiGate {
    EPI_NO_PRE
    const bf16_t* mid; const bf16_t* P; const float* bg; bf16_t* O;
    __device__ __forceinline__ void operator()(const f32x4 (&acc)[2][2][4][2], const Unit& u, int wr, int wc, int fr, int fq) const {
        EPI_ROWS_BEGIN
        const int col = u.pn * BM + cl;
        f32x4 bv[2][2];
#pragma unroll
        for (int bj = 0; bj < 2; ++bj) { bv[bj][0] = *(const f32x4*)(bg + col + bj * HALF); bv[bj][1] = *(const f32x4*)(bg + col + bj * HALF + 4); }
#pragma unroll
        for (int ai = 0; ai < 2; ++ai) {
            u32x4 mr[4][2], pr[4][2];
#pragma unroll
            for (int m = 0; m < 4; ++m) { const unsigned off = (unsigned)((row0 + ai * HALF + m * 16) * DM + col);
#pragma unroll
                for (int bj = 0; bj < 2; ++bj) { mr[m][bj] = *(const u32x4*)(mid + off + bj * HALF); pr[m][bj] = *(const u32x4*)(P + off + bj * HALF); } }
            asm volatile("" ::: "memory");
#pragma unroll
            for (int m = 0; m < 4; ++m) { const unsigned off = (unsigned)((row0 + ai * HALF + m * 16) * DM + col);
#pragma unroll
                for (int bj = 0; bj < 2; ++bj) { const u32x4 mw = mr[m][bj], pw = pr[m][bj];
                    const f32x4 m0 = {bf_lo(mw.x), bf_hi(mw.x), bf_lo(mw.y), bf_hi(mw.y)}, m1 = {bf_lo(mw.z), bf_hi(mw.z), bf_lo(mw.w), bf_hi(mw.w)};
                    const f32x4 p0 = {bf_lo(pw.x), bf_hi(pw.x), bf_lo(pw.y), bf_hi(pw.y)}, p1 = {bf_lo(pw.z), bf_hi(pw.z), bf_lo(pw.w), bf_hi(pw.w)};
                    f32x4 r0, r1;
                    const f32x4 a0 = acc[ai][bj][m][0] + bv[bj][0], a1 = acc[ai][bj][m][1] + bv[bj][1];
#pragma unroll
                    for (int j = 0; j < 4; ++j) { r0[j] = m0[j] + sigmoidf_(a0[j]) * p0[j]; r1[j] = m1[j] + sigmoidf_(a1[j]) * p1[j]; }
                    store8(O + off + bj * HALF, r0, r1); } }
            asm volatile("" ::: "memory");
        }
    }
};
}

#define XB_TMO      128
#define XB_XCNT(j)  (256  + 64 * (j))
#define XB_XSUB(j)  (1280 + 64 * (j))
#define XB_XGEN(j)  (2304 + 64 * (j))
#define XB_TOP      3328
#define XB_TOPGEN   3392
#define XCD_BAR_WORDS 3456
#define XB_SPIN_CAP (1u << 18)
__device__ __forceinline__ unsigned xb_ld(unsigned* p)              { return __hip_atomic_load(p, __ATOMIC_RELAXED, __HIP_MEMORY_SCOPE_AGENT); }
__device__ __forceinline__ unsigned xb_add(unsigned* p, unsigned v) { return __hip_atomic_fetch_add(p, v, __ATOMIC_RELAXED, __HIP_MEMORY_SCOPE_AGENT); }
__device__ __forceinline__ unsigned xb_xcc_id() { return (unsigned)__builtin_amdgcn_s_getreg((3 << 11) | 20) & 0xFu; }
#define XB_SPIN(cond, bar) do { unsigned _sp = 0; while (cond) { __builtin_amdgcn_s_sleep(1); \
    if ((++_sp & 255u) == 0u) { if (xb_ld(&(bar)[XB_TMO])) break; if (_sp > XB_SPIN_CAP) { atomicAdd(&(bar)[XB_TMO], 1u); break; } } } } while (0)
struct XcdBarrier { unsigned* bar; unsigned x; volatile LAS unsigned* st; };
__device__ __forceinline__ XcdBarrier xcd_barrier_post(unsigned* bar, volatile LAS unsigned* st) {
    XcdBarrier b; b.bar = bar; b.x = xb_xcc_id(); b.st = st;
    if (threadIdx.x == 0) (void)xb_add(&bar[XB_XCNT(b.x)], 1u);
    return b;
}
__device__ __forceinline__ void xcd_barrier_complete(unsigned* bar, unsigned x, unsigned& nloc, unsigned& nx) {
    const unsigned G = gridDim.x * gridDim.y * gridDim.z;
    unsigned sum, cnt, mine, sp = 0u;
    for (;;) {
        sum = 0u; cnt = 0u; mine = 0u;
#pragma unroll
        for (unsigned j = 0; j < 16; ++j) { const unsigned c = xb_ld(&bar[XB_XCNT(j)]); sum += c; cnt += (c > 0u) ? 1u : 0u; mine = (j == x) ? c : mine; }
        if (sum == G) break;
        __builtin_amdgcn_s_sleep(1);
        if ((++sp & 255u) == 0u) { if (xb_ld(&bar[XB_TMO])) break; if (sp > XB_SPIN_CAP) { atomicAdd(&bar[XB_TMO], 1u); break; } }
    }
    nloc = mine > 0u ? mine : 1u; nx = cnt > 0u ? cnt : 1u;
}
__device__ __forceinline__ void xcd_barrier(const XcdBarrier& b) {
    asm volatile("s_waitcnt vmcnt(0)" ::: "memory");
    __syncthreads();
    if (threadIdx.x == 0) {
        unsigned* bar = b.bar; asm volatile("" : "+s"(bar));
        unsigned bx = b.x; asm volatile("" : "+s"(bx));
        __builtin_amdgcn_s_waitcnt(0);
        unsigned nloc = b.st[0], nx = b.st[1];
        if (nloc == 0u) { xcd_barrier_complete(bar, bx, nloc, nx); b.st[0] = nloc; b.st[1] = nx; }
        const unsigned old = xb_add(&bar[XB_XSUB(bx)], 1u);
        const unsigned gen = old / nloc;
        if (old + 1u == (gen + 1u) * nloc) {
            __builtin_amdgcn_fence(__ATOMIC_RELEASE, "agent");
            asm volatile("s_waitcnt vmcnt(0)" ::: "memory");
            const unsigned og = xb_add(&bar[XB_TOP], 1u);
            const unsigned tg = og / nx;
            if (og + 1u == (tg + 1u) * nx) xb_add(&bar[XB_TOPGEN], 1u);
            else XB_SPIN(xb_ld(&bar[XB_TOPGEN]) == tg, bar);
            __builtin_amdgcn_fence(__ATOMIC_ACQUIRE, "agent");
            xb_add(&bar[XB_XGEN(bx)], 1u);
            asm volatile("s_waitcnt vmcnt(0)" ::: "memory");
        } else {
            XB_SPIN(xb_ld(&bar[XB_XGEN(bx)]) == gen, bar);
            __builtin_amdgcn_fence(__ATOMIC_ACQUIRE, "agent");
            asm volatile("s_waitcnt vmcnt(0)" ::: "memory");
        }
    }
    __syncthreads();
}

constexpr int NWAVES = 8, NTHR = 512;
struct Args { const float* in[23]; float* out; unsigned char* ws; int ph_lo, ph_hi; };
struct Frame { LAS unsigned char* lds; int tid, lane, wave, G, bid; };
#define LDS_WAIT() asm volatile("s_waitcnt lgkmcnt(0)" ::: "memory")
#define LDS_BARRIER() asm volatile("s_waitcnt lgkmcnt(0)\n\ts_barrier" ::: "memory")

template <bool F8>
__device__ __forceinline__ void p0_transpose_item(const float* W, int K, int N, int Npad, void* WT_, LAS float* scr, int item, int lane) {
    const int nblk = Npad / 32, kb = item / nblk, nb = item % nblk, k0 = 128 * kb, n0 = 32 * nb;
    const int r = lane >> 3, c4 = (lane & 7) * 4;
    const bool ok = n0 + c4 < N;
    const float* src = W + (size_t)(k0 + r) * N + (ok ? n0 + c4 : 0);
    f32x4 v[16];
#pragma unroll
    for (int i = 0; i < 16; ++i) v[i] = *(const f32x4*)(src + (size_t)(8 * i) * N);
    __builtin_amdgcn_sched_barrier(0);
    const float sc = ok ? (F8 ? WSC : 1.f) : 0.f;
#pragma unroll
    for (int i = 0; i < 16; ++i) *(LAS f32x4*)(scr + (8 * i + r) * 32 + (c4 ^ ((i >> 1) << 2))) = v[i] * sc;
    LDS_WAIT(); asm volatile("" ::: "memory");
    const int c = lane & 7;
#pragma unroll
    for (int j = 0; j < 4; ++j) { const int nn = (lane >> 3) + 8 * j; const LAS float* sp = scr + (16 * c) * 32 + (nn ^ (c << 2));
        float t[16];
#pragma unroll
        for (int q = 0; q < 16; ++q) t[q] = sp[q * 32];
        if constexpr (F8) { const u32x2 lo = pg8::pack8_fp8(f32x4{t[0], t[1], t[2], t[3]}, f32x4{t[4], t[5], t[6], t[7]}), hi = pg8::pack8_fp8(f32x4{t[8], t[9], t[10], t[11]}, f32x4{t[12], t[13], t[14], t[15]});
            u32x4 o; o.x = lo.x; o.y = lo.y; o.z = hi.x; o.w = hi.y; *(u32x4*)((unsigned char*)WT_ + (size_t)(n0 + nn) * K + k0 + 16 * c) = o; }
        else { u32x4 o0, o1; o0.x = cvt_pk_bf16(t[0], t[1]); o0.y = cvt_pk_bf16(t[2], t[3]); o0.z = cvt_pk_bf16(t[4], t[5]); o0.w = cvt_pk_bf16(t[6], t[7]);
            o1.x = cvt_pk_bf16(t[8], t[9]); o1.y = cvt_pk_bf16(t[10], t[11]); o1.z = cvt_pk_bf16(t[12], t[13]); o1.w = cvt_pk_bf16(t[14], t[15]);
            bf16_t* d = (bf16_t*)WT_ + (size_t)(n0 + nn) * K + k0 + 16 * c; *(u32x4*)d = o0; *(u32x4*)(d + 8) = o1; } }
    LDS_WAIT(); asm volatile("" ::: "memory");
}
template <int U, bool F8>
__device__ __forceinline__ void cvt_stream(const float* src, void* dst_, size_t n, int gtid, int gthreads) {
    const size_t st = (size_t)gthreads * 8;
    size_t i = (size_t)gtid * 8;
    for (; i + (U - 1) * st < n; i += U * st) {
        f32x4 a[U], b[U];
#pragma unroll
        for (int q = 0; q < U; ++q) { const float* p = src + i + q * st; a[q] = *(const f32x4*)p; b[q] = *(const f32x4*)(p + 4); }
        __builtin_amdgcn_sched_barrier(0);
#pragma unroll
        for (int q = 0; q < U; ++q) { const size_t o = i + q * st;
            if constexpr (F8) *(u32x2*)((unsigned char*)dst_ + o) = pg8::pack8_fp8(a[q], b[q]);
            else { u32x4 w; w.x = cvt_pk_bf16(a[q][0], a[q][1]); w.y = cvt_pk_bf16(a[q][2], a[q][3]); w.z = cvt_pk_bf16(b[q][0], b[q][1]); w.w = cvt_pk_bf16(b[q][2], b[q][3]); *(u32x4*)((bf16_t*)dst_ + o) = w; } }
    }
    for (; i < n; i += st) { const f32x4 a = *(const f32x4*)(src + i), b = *(const f32x4*)(src + i + 4);
        if constexpr (F8) *(u32x2*)((unsigned char*)dst_ + i) = pg8::pack8_fp8(a, b);
        else { u32x4 w; w.x = cvt_pk_bf16(a[0], a[1]); w.y = cvt_pk_bf16(a[2], a[3]); w.z = cvt_pk_bf16(b[0], b[1]); w.w = cvt_pk_bf16(b[2], b[3]); *(u32x4*)((bf16_t*)dst_ + i) = w; } }
}
struct P0Desc { const float* W; unsigned char* WT; int K, N, Npad, tile, f8; float s0, s1; int split; };
constexpr int P0_IN0 = 8 * (ZE / 256), P0_SQ = 8 * 4, P0_IN1 = 8 * (ZO / 256), P0_PLE = 2 * 4, P0_GU = 8 * 8;
constexpr int P0_C0 = P0_IN0, P0_C1 = P0_C0 + P0_SQ, P0_C2 = P0_C1 + P0_IN1, P0_C3 = P0_C2 + P0_SQ, P0_C4 = P0_C3 + 2 * P0_SQ, P0_C5 = P0_C4 + 2 * P0_PLE, P0_C6 = P0_C5 + 64 * P0_GU, P0_C7 = P0_C6 + 64 * P0_SQ;
__device__ __forceinline__ P0Desc p0_desc(const Args& a, int it) {
    unsigned char* ws = a.ws;
    if (it < P0_C0) return P0Desc{a.in[2], ws + WS_WIN0, DM, ZE, ZE, it, FP8_IN0, FP8_IN0 ? WSC : 1.f, FP8_IN0 ? WSC : 1.f, 0};
    if (it < P0_C1) return P0Desc{a.in[7], ws + WS_WO0, DM, DM, DM, it - P0_C0, FP8_OUT, FP8_OUT ? WSC : 1.f, FP8_OUT ? WSC : 1.f, 0};
    if (it < P0_C2) return P0Desc{a.in[8], ws + WS_WIN1, DM, ZO_REAL, ZO, it - P0_C1, FP8_IN1, FP8_IN1 ? WSC : 1.f, FP8_IN1 ? WSC : 1.f, 0};
    if (it < P0_C3) return P0Desc{a.in[9], ws + WS_WO1, DM, DM, DM, it - P0_C2, FP8_OUT, FP8_OUT ? WSC : 1.f, FP8_OUT ? WSC : 1.f, 0};
    if (it < P0_C4) { const int r = it - P0_C3, l = r / P0_SQ; return P0Desc{a.in[21] + (size_t)l * DM * DM, ws + WS_WG + (size_t)l * DM * DM * (FP8_GATE ? 1 : 2), DM, DM, DM, r % P0_SQ, FP8_GATE, FP8_GATE ? WSC : 1.f, FP8_GATE ? WSC : 1.f, 0}; }
    if (it < P0_C5) { const int r = it - P0_C4, l = r / P0_PLE; return P0Desc{a.in[20] + (size_t)l * PLE * DM, ws + WS_WPLE + (size_t)l * DM * PLE * 2, PLE, DM, DM, r % P0_PLE, 0, 1.f, 1.f, 0}; }
    if (it < P0_C6) { const int r = it - P0_C5, l = r / P0_GU; return P0Desc{a.in[14] + (size_t)l * DM * 2048, ws + WS_WGU + (size_t)l * 2048 * DM, DM, 2048, 2048, r % P0_GU, 1, WSC * pg8::SWC, WSC / pg8::SWC, 1024}; }
    const int r = it - P0_C6, l = r / P0_SQ; return P0Desc{a.in[16] + (size_t)l * DM * DM, ws + WS_WD + (size_t)l * DM * DM, DM, DM, DM, r % P0_SQ, 1, WSC, WSC, 0};
}
__device__ __forceinline__ void p0_tile_load(const P0Desc& d, int wave, int lane, f32x4 (&v)[16], float& sc) {
    const int nblk = d.Npad / 256, kb = d.tile / nblk, nb = d.tile % nblk;
    const int n = nb * 256 + 4 * lane; const bool ok = n < d.N;
    const float* src = d.W + (size_t)(kb * 128 + 16 * wave) * d.N + (ok ? n : 0);
#pragma unroll
    for (int i = 0; i < 16; ++i) v[i] = *(const f32x4*)(src + (size_t)i * d.N);
    sc = ok ? (n < d.split ? d.s0 : d.s1) : 0.f;
}
__device__ __forceinline__ void p0_tile_emit(const P0Desc& d, LAS float* img, int wave, int lane) {
    const int nblk = d.Npad / 256, kb = d.tile / nblk, nb = d.tile % nblk, k0 = 128 * kb, n0 = 256 * nb;
    const int c = lane & 7;
#pragma unroll
    for (int j = 0; j < 4; ++j) { const int nn = 32 * wave + (lane >> 3) + 8 * j; const LAS float* sp = img + (16 * c) * 256 + (nn ^ (c << 2));
        float t[16];
#pragma unroll
        for (int q = 0; q < 16; ++q) t[q] = sp[q * 256];
        const size_t o = (size_t)(n0 + nn) * d.K + k0 + 16 * c;
        if (d.f8) { const u32x2 lo = pg8::pack8_fp8(f32x4{t[0], t[1], t[2], t[3]}, f32x4{t[4], t[5], t[6], t[7]}), hi = pg8::pack8_fp8(f32x4{t[8], t[9], t[10], t[11]}, f32x4{t[12], t[13], t[14], t[15]});
            u32x4 w; w.x = lo.x; w.y = lo.y; w.z = hi.x; w.w = hi.y; *(u32x4*)(d.WT + o) = w; }
        else { u32x4 o0, o1; o0.x = cvt_pk_bf16(t[0], t[1]); o0.y = cvt_pk_bf16(t[2], t[3]); o0.z = cvt_pk_bf16(t[4], t[5]); o0.w = cvt_pk_bf16(t[6], t[7]);
            o1.x = cvt_pk_bf16(t[8], t[9]); o1.y = cvt_pk_bf16(t[10], t[11]); o1.z = cvt_pk_bf16(t[12], t[13]); o1.w = cvt_pk_bf16(t[14], t[15]);
            bf16_t* dp = (bf16_t*)d.WT + o; *(u32x4*)dp = o0; *(u32x4*)(dp + 8) = o1; } }
}
__device__ __forceinline__ void p0_prologue(Frame& F, const Args& a) {
    unsigned char* ws = a.ws;
    LAS float* img = (LAS float*)F.lds;
    { const int TOT = P0_C7 * PM(0);
      int it = F.bid; f32x4 v[16]; float sc = 0.f; P0Desc d = p0_desc(a, it % P0_C7);
      if (it < TOT) p0_tile_load(d, F.wave, F.lane, v, sc);
      for (; it < TOT; it += F.G) {
#pragma unroll
        for (int i = 0; i < 16; ++i) *(LAS f32x4*)(img + (16 * F.wave + i) * 256 + ((4 * F.lane) ^ (F.wave << 2))) = v[i] * sc;
        LDS_BARRIER();
        const P0Desc dc = d; const int nx = it + F.G;
        if (nx < TOT) { d = p0_desc(a, nx % P0_C7); p0_tile_load(d, F.wave, F.lane, v, sc); }
        __builtin_amdgcn_sched_barrier(0);
        p0_tile_emit(dc, img, F.wave, F.lane);
        LDS_BARRIER();
      } }
    {
      LAS float* scr = (LAS float*)(F.lds + F.wave * 16384);
      const int gw = F.bid * NWAVES + F.wave;
      if (gw < 16) p0_transpose_item<false>(a.in[12] + (size_t)(gw >> 3) * DM * NEXP, DM, NEXP, NEXP, (bf16_t*)(ws + WS_WRT) + (size_t)(gw >> 3) * NEXP * DM, scr, gw & 7, F.lane); }
    const int gtid = F.bid * NTHR + F.tid, gth = F.G * NTHR;
    if (!FP8_IN0) cvt_stream<8, false>(a.in[0], ws + WS_XB, (size_t)NTOK * DM, gtid, gth);
    else cvt_stream<8, true>(a.in[0], ws + WS_XQ, (size_t)NTOK * DM, gtid, gth);
    cvt_stream<8, false>(a.in[1], ws + WS_PB, (size_t)2 * NTOK * PLE, gtid, gth);
    for (int i = gtid; i < 8 * 128 * 128; i += gth) { const int t = (i >> 7) & 127, s = i & 127; const float v = (s <= t) ? a.in[5][i] : 0.f; ((bf16_t*)(ws + WS_WSB))[i] = (bf16_t)(cvt_pk_bf16(v, 0.f) & 0xffffu); }
}

__device__ __forceinline__ void gmlp_unit(Frame& F, const Args& a, int unit) {
    const bf16_t* z0 = (const bf16_t*)(a.ws + WS_Z); unsigned char* cat = (unsigned char*)(a.ws + WS_CAT); const bf16_t* wsb = (const bf16_t*)(a.ws + WS_WSB);
    const float* lng = a.in[3]; const float* lnb = a.in[4]; const float* bs = a.in[6];
    const size_t tok0 = (size_t)unit * 128;
    const int lane = F.lane, w = F.wave, r32 = lane & 31, hi = lane >> 5;
    LAS f32x2* stats = (LAS f32x2*)(F.lds + XTRA_OFF);
    for (int i = 0; i < 16; ++i) { const int tl = w * 16 + i;
        const u32x4 v = *(const u32x4*)(z0 + (tok0 + tl) * ZE + 512 + 8 * lane);
        float x[8] = {bf_lo(v.x), bf_hi(v.x), bf_lo(v.y), bf_hi(v.y), bf_lo(v.z), bf_hi(v.z), bf_lo(v.w), bf_hi(v.w)};
        float s = 0.f;
#pragma unroll
        for (int j = 0; j < 8; ++j) s += x[j];
        const float mean = wave_sum(s) * (1.f / 512.f); float q = 0.f;
#pragma unroll
        for (int j = 0; j < 8; ++j) { const float d = x[j] - mean; q += d * d; }
        const float rstd = 1.f / sqrtf(wave_sum(q) * (1.f / 512.f) + LN_EPS);
        if (lane == 0) stats[tl] = (f32x2){mean, rstd}; }
    __syncthreads();
    const int g = w;
    LAS unsigned char* vt = F.lds + w * 16384;
    { const int tl8 = lane >> 3, cc = lane & 7;
      float gg[8], bb[8];
#pragma unroll
      for (int j = 0; j < 8; ++j) { gg[j] = lng[g * 64 + 8 * cc + j]; bb[j] = lnb[g * 64 + 8 * cc + j]; }
      for (int it = 0; it < 16; ++it) { const int tl = 8 * it + tl8;
          const u32x4 v = *(const u32x4*)(z0 + (tok0 + tl) * ZE + 512 + g * 64 + 8 * cc);
          const f32x2 st = stats[tl];
          float x[8] = {bf_lo(v.x), bf_hi(v.x), bf_lo(v.y), bf_hi(v.y), bf_lo(v.z), bf_hi(v.z), bf_lo(v.w), bf_hi(v.w)};
#pragma unroll
          for (int j = 0; j < 8; ++j) { const int c = 8 * cc + j; const float y = (x[j] - st.x) * st.y * gg[j] + bb[j];
              *(LAS bf16_t*)(vt + c * 256 + ((((tl >> 3) ^ (c & 15))) << 4) + (tl & 7) * 2) = (bf16_t)(cvt_pk_bf16(y, 0.f) & 0xffffu); } } }
    LDS_WAIT(); asm volatile("" ::: "memory");
    for (int tb = 0; tb < 4; ++tb) {
        f32x16 d0 = {}, d1 = {};
        const bf16_t* wrow = wsb + ((size_t)g * 128 + tb * 32 + r32) * 128 + 8 * hi;
        bf16x8 afr[8];
#pragma unroll
        for (int ks = 0; ks < 8; ++ks) afr[ks] = *(const bf16x8*)(wrow + 16 * ks);
#pragma unroll
        for (int ks = 0; ks < 8; ++ks) { if (ks >= 2 * (tb + 1)) break;
            const bf16x8 af = afr[ks];
            const int chunk = 2 * ks + hi;
            const bf16x8 b0 = *(const LAS bf16x8*)(vt + r32 * 256 + ((chunk ^ (r32 & 15)) << 4));
            const bf16x8 b1 = *(const LAS bf16x8*)(vt + (32 + r32) * 256 + ((chunk ^ (r32 & 15)) << 4));
            d0 = __builtin_amdgcn_mfma_f32_32x32x16_bf16(af, b0, d0, 0, 0, 0);
            d1 = __builtin_amdgcn_mfma_f32_32x32x16_bf16(af, b1, d1, 0, 0, 0);
        }
#pragma unroll
        for (int r = 0; r < 16; ++r) { const int t = tb * 32 + (r & 3) + 8 * (r >> 2) + 4 * hi; const float bsv = bs[g * 128 + t];
            const size_t ro = (tok0 + t) * ZE + g * 64 + r32; const size_t co = (tok0 + t) * DM + g * 64 + r32;
            const float u0 = bf1(z0[ro]), u1 = bf1(z0[ro + 32]);
            CAT_ST(cat, co, u0 * (d0[r] + bsv)); CAT_ST(cat, co + 32, u1 * (d1[r] + bsv)); }
    }
    __syncthreads();
}

constexpr int SB_KST = 144;
constexpr int SB_TILE = 64 * SB_KST;
__device__ __forceinline__ void sb_unit(Frame& F, const Args& a, int b, int h, int qb) {
    const bf16_t* z0 = (const bf16_t*)(a.ws + WS_Z); unsigned char* cat = (unsigned char*)(a.ws + WS_CAT);
    const int tid = F.tid, lane = F.lane, wid = F.wave, r32 = lane & 31, hi = lane >> 5;
    const size_t rowbase = (size_t)b * SEQ;
    const int q0 = qb * 256, qw0 = q0 + wid * 32, tq = qw0 + r32;
    bf16x8 qr[4];
    { const bf16_t* qp = z0 + (rowbase + tq) * ZE + 1024 + h * 64 + hi * 8;
#pragma unroll
      for (int ks = 0; ks < 4; ++ks) qr[ks] = *(const bf16x8*)(qp + ks * 16); }
    f32x16 o0 = {}, o1 = {}; float C = 1.f;
    const int ntile = q0 / 64 + 4;
    LAS unsigned char* Kb = F.lds; LAS unsigned char* Vb = F.lds + 2 * SB_TILE;
    const bf16_t* kg = z0 + (rowbase + (tid >> 3)) * ZE + 1536 + h * 64 + (tid & 7) * 8;
    const unsigned ldst = (unsigned)(tid >> 3) * SB_KST + (unsigned)(tid & 7) * 16;
    { const size_t go = (size_t)(ntile - 1) * 64 * ZE; const u32x4 kn = *(const u32x4*)(kg + go), vn = *(const u32x4*)(kg + go + 512);
      *(LAS u32x4*)(Kb + ldst) = kn; *(LAS u32x4*)(Vb + ldst) = vn; }
    const int dh = (lane >> 4) & 1, q_ = (lane & 15) >> 2, p_ = lane & 3;
    for (int kt = ntile - 1; kt >= 0; --kt) {
        const int buf = (ntile - 1 - kt) & 1;
        u32x4 kn, vn;
        if (kt > 0) { const size_t go = (size_t)(kt - 1) * 64 * ZE; kn = *(const u32x4*)(kg + go); vn = *(const u32x4*)(kg + go + 512); }
        LDS_BARRIER();
        const LAS unsigned char* Kc = Kb + buf * SB_TILE; const LAS unsigned char* Vc = Vb + buf * SB_TILE;
        if (64 * kt <= qw0) {
            f32x16 p[2]; p[0] = (f32x16){}; p[1] = (f32x16){};
#pragma unroll
            for (int ks = 0; ks < 4; ++ks) {
                const bf16x8 k0 = *(const LAS bf16x8*)(Kc + r32 * SB_KST + (16 * ks + 8 * hi) * 2);
                const bf16x8 k1 = *(const LAS bf16x8*)(Kc + (32 + r32) * SB_KST + (16 * ks + 8 * hi) * 2);
                p[0] = __builtin_amdgcn_mfma_f32_32x32x16_bf16(k0, qr[ks], p[0], 0, 0, 0);
                p[1] = __builtin_amdgcn_mfma_f32_32x32x16_bf16(k1, qr[ks], p[1], 0, 0, 0);
            }
            const bool need_mask = (64 * kt + 64 > qw0);
            const int kb0 = 64 * kt + 4 * hi;
            float NB[2][16], BE[2][16];
            if (need_mask) {
#pragma unroll
                for (int bk = 0; bk < 2; ++bk)
#pragma unroll
                    for (int r = 0; r < 16; ++r) { const float rc = rcpf_(1.f + ex2(-p[bk][r]));
                        const int key = kb0 + 32 * bk + 8 * (r >> 2) + (r & 3); const bool ok = key < tq;
                        BE[bk][r] = ok ? rc : 0.f; NB[bk][r] = ok ? 1.f - rc : 1.f; }
            } else {
#pragma unroll
                for (int bk = 0; bk < 2; ++bk)
#pragma unroll
                    for (int r = 0; r < 16; ++r) { const float rc = rcpf_(1.f + ex2(-p[bk][r])); BE[bk][r] = rc; NB[bk][r] = 1.f - rc; }
            }
            float acc_c = C;
#pragma unroll
            for (int bk = 1; bk >= 0; --bk)
#pragma unroll
                for (int aa = 3; aa >= 0; --aa) {
                    const float R = (NB[bk][4 * aa] * NB[bk][4 * aa + 1]) * (NB[bk][4 * aa + 2] * NB[bk][4 * aa + 3]);
                    const auto rr = __builtin_amdgcn_permlane32_swap(__float_as_uint(R), __float_as_uint(R), false, false);
                    const float Rp = hi ? __uint_as_float(rr[0]) : __uint_as_float(rr[1]);
                    const float a3 = hi ? acc_c : acc_c * Rp, a2 = a3 * NB[bk][4 * aa + 3], a1 = a2 * NB[bk][4 * aa + 2], a0 = a1 * NB[bk][4 * aa + 1];
                    p[bk][4 * aa + 3] = BE[bk][4 * aa + 3] * a3; p[bk][4 * aa + 2] = BE[bk][4 * aa + 2] * a2;
                    p[bk][4 * aa + 1] = BE[bk][4 * aa + 1] * a1; p[bk][4 * aa + 0] = BE[bk][4 * aa + 0] * a0;
                    acc_c *= R * Rp;
                }
            C = acc_c;
            bf16x8 pa[2][2];
#pragma unroll
            for (int bk = 0; bk < 2; ++bk)
#pragma unroll
                for (int s = 0; s < 2; ++s) { u32x4 w; w.x = cvt_pk_bf16(p[bk][8 * s + 0], p[bk][8 * s + 1]); w.y = cvt_pk_bf16(p[bk][8 * s + 2], p[bk][8 * s + 3]);
                    w.z = cvt_pk_bf16(p[bk][8 * s + 4], p[bk][8 * s + 5]); w.w = cvt_pk_bf16(p[bk][8 * s + 6], p[bk][8 * s + 7]); pa[bk][s] = __builtin_bit_cast(bf16x8, w); }
#pragma unroll
            for (int bk = 0; bk < 2; ++bk)
#pragma unroll
                for (int s = 0; s < 2; ++s) {
                    const LAS unsigned char* vp = Vc + (32 * bk + 16 * s + 4 * hi + q_) * SB_KST + (16 * dh + 4 * p_) * 2;
                    const s16x4 l0 = __builtin_amdgcn_ds_read_tr16_b64_v4i16((LAS s16x4*)(vp));
                    const s16x4 h0 = __builtin_amdgcn_ds_read_tr16_b64_v4i16((LAS s16x4*)(vp + 8 * SB_KST));
                    const s16x4 l1 = __builtin_amdgcn_ds_read_tr16_b64_v4i16((LAS s16x4*)(vp + 64));
                    const s16x4 h1 = __builtin_amdgcn_ds_read_tr16_b64_v4i16((LAS s16x4*)(vp + 8 * SB_KST + 64));
                    const bf16x8 v0 = (bf16x8){l0[0], l0[1], l0[2], l0[3], h0[0], h0[1], h0[2], h0[3]};
                    const bf16x8 v1 = (bf16x8){l1[0], l1[1], l1[2], l1[3], h1[0], h1[1], h1[2], h1[3]};
                    o0 = __builtin_amdgcn_mfma_f32_32x32x16_bf16(pa[bk][s], v0, o0, 0, 0, 0);
                    o1 = __builtin_amdgcn_mfma_f32_32x32x16_bf16(pa[bk][s], v1, o1, 0, 0, 0);
                }
        }
        if (kt > 0) { *(LAS u32x4*)(Kb + (buf ^ 1) * SB_TILE + ldst) = kn; *(LAS u32x4*)(Vb + (buf ^ 1) * SB_TILE + ldst) = vn; }
    }
#pragma unroll
    for (int r = 0; r < 16; ++r) { const int q = (r & 3) + 8 * (r >> 2) + 4 * hi;
        const size_t oo = (rowbase + qw0 + q) * DM + 512 + h * 64 + r32;
        CAT_ST(cat, oo, o0[r]); CAT_ST(cat, oo + 32, o1[r]); }
    __syncthreads();
}

template <int I> struct SelStep {
    static __device__ __forceinline__ void run(const float (&v)[64], float thr, float lo, bool exact, int need_eq, int& eq_seen, unsigned& m0, unsigned& m1) {
        const bool gt = v[I] > thr; const bool eq = (!exact) && !gt && (v[I] > lo);
        const unsigned long long meq = __ballot(eq);
        const int eq_rank = eq_seen + __builtin_amdgcn_mbcnt_hi((unsigned)(meq >> 32), __builtin_amdgcn_mbcnt_lo((unsigned)meq, 0));
        const bool take = gt || (eq && eq_rank < need_eq);
        const unsigned long long mt = __ballot(take);
        const unsigned mlo = (unsigned)mt, mhi = (unsigned)(mt >> 32);
        asm volatile("s_nop 1\n\tv_writelane_b32 %0, %1, %2" : "+v"(m0) : "s"(mlo), "n"(I));
        asm volatile("s_nop 1\n\tv_writelane_b32 %0, %1, %2" : "+v"(m1) : "s"(mhi), "n"(I));
        eq_seen += __builtin_popcountll(meq);
        SelStep<I + 1>::run(v, thr, lo, exact, need_eq, eq_seen, m0, m1);
    }
};
template <> struct SelStep<64> { static __device__ __forceinline__ void run(const float (&)[64], float, float, bool, int, int&, unsigned&, unsigned&) {} };

template <int I> struct SelExact {
    static __device__ __forceinline__ void run(const float (&v)[64], float thr, unsigned& m0, unsigned& m1) {
        const unsigned long long mt = __ballot(v[I] > thr);
        const unsigned mlo = (unsigned)mt, mhi = (unsigned)(mt >> 32);
        asm volatile("s_nop 1\n\tv_writelane_b32 %0, %1, %2" : "+v"(m0) : "s"(mlo), "n"(I));
        asm volatile("s_nop 1\n\tv_writelane_b32 %0, %1, %2" : "+v"(m1) : "s"(mhi), "n"(I));
        SelExact<I + 1>::run(v, thr, m0, m1);
    }
};
template <> struct SelExact<64> { static __device__ __forceinline__ void run(const float (&)[64], float, unsigned&, unsigned&) {} };

__device__ __forceinline__ void dsa_select_unit(Frame& F, const Args& a, int unit) {
    const bf16_t* z1 = (const bf16_t*)(a.ws + WS_Z); unsigned* bm = (unsigned*)(a.ws + WS_BM);
    const int lane = F.lane, wid = F.wave, r32 = lane & 31, hi = lane >> 5;
    const int tok0 = unit * 8;
    const int b = tok0 / SEQ, t0 = tok0 % SEQ;
    const size_t rowbase = (size_t)b * SEQ;
    const int vis = (t0 / 64 + 1) * 64;
    LAS float* sc = (LAS float*)F.lds;
    if (vis > 256) {
        const int tl = 2 * (r32 >> 4) + ((r32 >> 2) & 1), hd = (r32 & 3) + 4 * ((r32 >> 3) & 1);
        bf16x8 af[2][4];
#pragma unroll
        for (int rt = 0; rt < 2; ++rt) { const bf16_t* qp = z1 + (size_t)(tok0 + 4 * rt + tl) * ZO + OQI + hd * 64 + 8 * hi;
#pragma unroll
            for (int ks = 0; ks < 4; ++ks) af[rt][ks] = *(const bf16x8*)(qp + 16 * ks); }
        float wv[4][8];
#pragma unroll
        for (int j = 0; j < 4; ++j) { const u32x4 w = *(const u32x4*)(z1 + (size_t)(tok0 + 2 * j + hi) * ZO + OWI);
            const float s = 0.35355339059f * 0.125f;
            wv[j][0] = bf_lo(w.x) * s; wv[j][1] = bf_hi(w.x) * s; wv[j][2] = bf_lo(w.y) * s; wv[j][3] = bf_hi(w.y) * s;
            wv[j][4] = bf_lo(w.z) * s; wv[j][5] = bf_hi(w.z) * s; wv[j][6] = bf_lo(w.w) * s; wv[j][7] = bf_hi(w.w) * s; }
        const int nkt = vis / 32;
        const bf16_t* kbase = (const bf16_t*)(a.ws + WS_KI1) + rowbase * 64 + (size_t)lane * 8;
        for (int rep14 = 0; rep14 < PM(14); ++rep14)
        for (int kt0 = wid; kt0 < nkt; kt0 += 8 * NWAVES) {
            bf16x8 kq[8][4];
#pragma unroll
            for (int pf = 0; pf < 8; ++pf) { const int kt = min(kt0 + pf * NWAVES, nkt - 1);
#pragma unroll
                for (int ks = 0; ks < 4; ++ks) kq[pf][ks] = *(const bf16x8*)(kbase + (size_t)(kt * 4 + ks) * 512); }
            __builtin_amdgcn_sched_barrier(0);
#pragma unroll
            for (int pf = 0; pf < 8; ++pf) { const int kt = kt0 + pf * NWAVES;
                if (kt < nkt) {
                    f32x16 d0 = {}, d1 = {};
#pragma unroll
                    for (int ks = 0; ks < 4; ++ks) { d0 = __builtin_amdgcn_mfma_f32_32x32x16_bf16(af[0][ks], kq[pf][ks], d0, 0, 0, 0); d1 = __builtin_amdgcn_mfma_f32_32x32x16_bf16(af[1][ks], kq[pf][ks], d1, 0, 0, 0); }
                    float s0 = 0.f, s1 = 0.f, s2 = 0.f, s3 = 0.f;
#pragma unroll
                    for (int r = 0; r < 8; ++r) { s0 += wv[0][r] * relu_i(d0[r]); s1 += wv[1][r] * relu_i(d0[8 + r]); s2 += wv[2][r] * relu_i(d1[r]); s3 += wv[3][r] * relu_i(d1[8 + r]); }
                    const int key = kt * 32 + r32;
                    sc[(hi) * 4096 + key] = s0; sc[(2 + hi) * 4096 + key] = s1; sc[(4 + hi) * 4096 + key] = s2; sc[(6 + hi) * 4096 + key] = s3;
                } }
        }
    }
    __syncthreads();
    for (int rep15 = 0; rep15 < PM(15); ++rep15) {
        unsigned m0 = 0u, m1 = 0u;
        if (vis <= 256) { m0 = 0xffffffffu; m1 = 0xffffffffu; }
        else {
            const LAS float* ms = sc + wid * 4096;
            float v[64];
            float mx = -INFINITY, mn = INFINITY;
#pragma unroll
            for (int i = 0; i < 64; ++i) { const bool in = (i * 64 < vis); v[i] = in ? ms[i * 64 + lane] : -INFINITY; if (in) { mx = fmaxf(mx, v[i]); mn = fminf(mn, v[i]); } }
            mx = wave_max_uniform(mx); mn = -wave_max_uniform(-mn);
            float lo = mn - 1.f - fabsf(mn), hiv = mx;
            float thr = hiv; int cgt = 0; bool exact = false;
            int c_lo = vis, c_hi = 0;
            bool dead = false;
            for (int it = 0; it < 64 && (c_lo - c_hi) > 448; ++it) {
                const float mid = 0.5f * (lo + hiv);
                if (!(mid > lo) || !(mid < hiv)) { dead = true; break; }
                int c = 0;
#pragma unroll
                for (int i = 0; i < 64; ++i) c += (v[i] > mid) ? 1 : 0;
                c = wave_sum_uniform(c);
                if (c == 256) { thr = mid; exact = true; break; }
                if (c > 256) { lo = mid; c_lo = c; } else { hiv = mid; c_hi = c; }
            }
            if (!exact && !dead) {
                LAS float* cand = sc + wid * 4096; int base = 0;
#pragma unroll
                for (int i = 0; i < 64; ++i) { const bool in = (v[i] > lo) && !(v[i] > hiv);
                    const unsigned long long mk = __ballot(in);
                    const int pos = base + __builtin_amdgcn_mbcnt_hi((unsigned)(mk >> 32), __builtin_amdgcn_mbcnt_lo((unsigned)mk, 0));
                    if (in) cand[pos] = v[i];
                    base += __builtin_popcountll(mk); }
                const int nc = c_lo - c_hi, c_hi0 = c_hi;
                float cv[8];
#pragma unroll
                for (int j = 0; j < 8; ++j) cv[j] = (lane + 64 * j < nc) ? cand[lane + 64 * j] : -INFINITY;
                for (int it = 0; it < 64; ++it) {
                    const float mid = 0.5f * (lo + hiv);
                    if (!(mid > lo) || !(mid < hiv)) break;
                    int c = 0;
#pragma unroll
                    for (int j = 0; j < 8; ++j) c += (cv[j] > mid) ? 1 : 0;
                    c = c_hi0 + wave_sum_uniform(c);
                    if (c == 256) { thr = mid; exact = true; break; }
                    if (c > 256) { lo = mid; c_lo = c; } else { hiv = mid; c_hi = c; }
                }
            }
            if (!exact) { thr = hiv; cgt = c_hi; }
            const int need_eq = exact ? 0 : (256 - cgt); int eq_seen = 0;
            if (exact) SelExact<0>::run(v, thr, m0, m1); else SelStep<0>::run(v, thr, lo, exact, need_eq, eq_seen, m0, m1);
        }
        if (lane * 64 < vis) *(u32x2*)(bm + (size_t)(tok0 + wid) * 128 + 2 * lane) = (u32x2){m0, m1};
    }
    __syncthreads();
}

template <int I> struct MaskInit {
    static __device__ __forceinline__ void run(f32x16 (&p)[2], int nw0, int nw1, float slope2, float T, int ninf) {
        constexpr int bk = I >> 4, r = I & 15, pos = 8 * (r >> 2) + (r & 3);
        const float vb = __builtin_fmaf(slope2, (float)(32 * bk + pos), T);
        int off; asm("v_bfe_i32 %0, %1, %2, 1" : "=v"(off) : "v"(bk ? nw1 : nw0), "n"(pos));
        float o; asm("v_bfi_b32 %0, %1, %2, %3" : "=v"(o) : "v"(off), "s"(ninf), "v"(vb));
        p[bk][r] = o;
        MaskInit<I + 1>::run(p, nw0, nw1, slope2, T, ninf);
    }
};
template <> struct MaskInit<32> { static __device__ __forceinline__ void run(f32x16 (&)[2], int, int, float, float, int) {} };
__device__ __forceinline__ float max3_asm(float a, float b, float c) { float r; asm("v_max3_f32 %0, %1, %2, %3" : "=v"(r) : "v"(a), "v"(b), "v"(c)); return r; }
__device__ __forceinline__ void dsa_attn_unit(Frame& F, const Args& a, int b, int ch, int g) {
    const bf16_t* z1 = (const bf16_t*)(a.ws + WS_Z); unsigned char* cat = (unsigned char*)(a.ws + WS_CAT); const unsigned* bm = (const unsigned*)(a.ws + WS_BM);
    const int tid = F.tid, lane = F.lane, wid = F.wave, r32 = lane & 31, hi = lane >> 5;
    const int hr = wid >> 1, qh = wid & 1, head = g * 4 + hr;
    const size_t rowbase = (size_t)b * SEQ;
    const int tq = ch * 64 + 32 * qh + r32;
    const float slope2 = ex2(-0.5f * (float)(head + 1)) * LOG2E;
    bf16x8 qr[4];
    { const bf16_t* qp = z1 + (rowbase + tq) * ZO + OQ + head * 64 + hi * 8;
#pragma unroll
      for (int ks = 0; ks < 4; ++ks) qr[ks] = *(const bf16x8*)(qp + ks * 16); }
    const unsigned* mrow = bm + (rowbase + tq) * 128;
    f32x16 o0 = {}, o1 = {}; float m = 0.f, l = 0.f;
    const int ntile = ch + 1;
    LAS unsigned char* Kb = F.lds; LAS unsigned char* Vb = F.lds + 2 * SB_TILE;
    LAS float* wsf = (LAS float*)(F.lds + 4 * SB_TILE) + wid * 32;
    const bf16_t* kg = (const bf16_t*)(a.ws + WS_KV1) + (rowbase + (tid >> 3)) * 512 + g * 64 + (tid & 7) * 8;
    const unsigned ldst = (unsigned)(tid >> 3) * SB_KST + (unsigned)(tid & 7) * 16;
    { const u32x4 kn = *(const u32x4*)(kg), vn = *(const u32x4*)(kg + 256);
      *(LAS u32x4*)(Kb + ldst) = kn; *(LAS u32x4*)(Vb + ldst) = vn; }
    const int dh = (lane >> 4) & 1, q_ = (lane & 15) >> 2, p_ = lane & 3;
    u32x2 mw = *(const u32x2*)(mrow);
    for (int kt = 0; kt < ntile; ++kt) {
        const int buf = kt & 1;
        u32x4 kn, vn; u32x2 mwn = mw;
        if (kt + 1 < ntile) { const size_t go = (size_t)(kt + 1) * 64 * 512; kn = *(const u32x4*)(kg + go); vn = *(const u32x4*)(kg + go + 256); mwn = *(const u32x2*)(mrow + 2 * (kt + 1)); }
        LDS_BARRIER();
        const LAS unsigned char* Kc = Kb + buf * SB_TILE; const LAS unsigned char* Vc = Vb + buf * SB_TILE;
        const float T = slope2 * (float)(64 * kt + 4 * hi) - m;
        const int nw0 = (int)~(mw.x >> (4 * hi)), nw1 = (int)~(mw.y >> (4 * hi));
        f32x16 p[2];
        MaskInit<0>::run(p, nw0, nw1, slope2, T, (int)0xff800000);
#pragma unroll
        for (int ks = 0; ks < 4; ++ks) {
            const bf16x8 k0 = *(const LAS bf16x8*)(Kc + r32 * SB_KST + (16 * ks + 8 * hi) * 2);
            const bf16x8 k1 = *(const LAS bf16x8*)(Kc + (32 + r32) * SB_KST + (16 * ks + 8 * hi) * 2);
            p[0] = __builtin_amdgcn_mfma_f32_32x32x16_bf16(k0, qr[ks], p[0], 0, 0, 0);
            p[1] = __builtin_amdgcn_mfma_f32_32x32x16_bf16(k1, qr[ks], p[1], 0, 0, 0);
        }
        if (kt == ntile - 1) {
            const float basef = (float)(tq - (64 * kt + 4 * hi));
#pragma unroll
            for (int bk = 0; bk < 2; ++bk)
#pragma unroll
                for (int r = 0; r < 16; ++r) { const float rel = (float)(32 * bk + 8 * (r >> 2) + (r & 3)) - basef; p[bk][r] -= 2.f * slope2 * fmaxf(rel, 0.f); }
        } else asm volatile("s_nop 15\n\ts_nop 7" : "+v"(p[0]), "+v"(p[1]));
        float rm;
        { float a0 = max3_asm(p[0][0], p[0][1], p[1][0]), b0 = max3_asm(p[0][2], p[0][3], p[1][1]); a0 = max3_asm(a0, p[1][2], p[1][3]);
#pragma unroll
          for (int r = 4; r < 16; r += 4) { a0 = max3_asm(a0, p[0][r], p[0][r + 1]); b0 = max3_asm(b0, p[0][r + 2], p[0][r + 3]); a0 = max3_asm(a0, p[1][r], p[1][r + 1]); b0 = max3_asm(b0, p[1][r + 2], p[1][r + 3]); }
          rm = fmaxf(a0, b0); }
        rm = fmaxf(rm, sxf<32>(rm));
        if (__any(rm > 6.f) || kt == 0) {
            const float d = (kt == 0) ? ((rm > -1e30f) ? rm : 0.f) : ((rm > 6.f) ? rm : 0.f);
            const float alpha = ex2(-d);
            l *= alpha; m += d;
#pragma unroll
            for (int bk = 0; bk < 2; ++bk)
#pragma unroll
                for (int r = 0; r < 16; ++r) p[bk][r] -= d;
            if (hi == 0) wsf[r32] = alpha;
#pragma unroll
            for (int r = 0; r < 16; ++r) { const float al = wsf[(r & 3) + 8 * (r >> 2) + 4 * hi]; o0[r] *= al; o1[r] *= al; }
        }
        float ls = 0.f;
#pragma unroll
        for (int bk = 0; bk < 2; ++bk)
#pragma unroll
            for (int r = 0; r < 16; ++r) { const float e = ex2(p[bk][r]); p[bk][r] = e; ls += e; }
        l += ls;
        bf16x8 pa[2][2];
#pragma unroll
        for (int bk = 0; bk < 2; ++bk)
#pragma unroll
            for (int s = 0; s < 2; ++s) { u32x4 w; w.x = cvt_pk_bf16(p[bk][8 * s + 0], p[bk][8 * s + 1]); w.y = cvt_pk_bf16(p[bk][8 * s + 2], p[bk][8 * s + 3]);
                w.z = cvt_pk_bf16(p[bk][8 * s + 4], p[bk][8 * s + 5]); w.w = cvt_pk_bf16(p[bk][8 * s + 6], p[bk][8 * s + 7]); pa[bk][s] = __builtin_bit_cast(bf16x8, w); }
#pragma unroll
        for (int bk = 0; bk < 2; ++bk)
#pragma unroll
            for (int s = 0; s < 2; ++s) {
                const LAS unsigned char* vp = Vc + (32 * bk + 16 * s + 4 * hi + q_) * SB_KST + (16 * dh + 4 * p_) * 2;
                const s16x4 l0 = __builtin_amdgcn_ds_read_tr16_b64_v4i16((LAS s16x4*)(vp));
                const s16x4 h0 = __builtin_amdgcn_ds_read_tr16_b64_v4i16((LAS s16x4*)(vp + 8 * SB_KST));
                const s16x4 l1 = __builtin_amdgcn_ds_read_tr16_b64_v4i16((LAS s16x4*)(vp + 64));
                const s16x4 h1 = __builtin_amdgcn_ds_read_tr16_b64_v4i16((LAS s16x4*)(vp + 8 * SB_KST + 64));
                const bf16x8 v0 = (bf16x8){l0[0], l0[1], l0[2], l0[3], h0[0], h0[1], h0[2], h0[3]};
                const bf16x8 v1 = (bf16x8){l1[0], l1[1], l1[2], l1[3], h1[0], h1[1], h1[2], h1[3]};
                o0 = __builtin_amdgcn_mfma_f32_32x32x16_bf16(pa[bk][s], v0, o0, 0, 0, 0);
                o1 = __builtin_amdgcn_mfma_f32_32x32x16_bf16(pa[bk][s], v1, o1, 0, 0, 0);
            }
        if (kt + 1 < ntile) { *(LAS u32x4*)(Kb + (buf ^ 1) * SB_TILE + ldst) = kn; *(LAS u32x4*)(Vb + (buf ^ 1) * SB_TILE + ldst) = vn; }
        mw = mwn;
    }
    l += sxf<32>(l);
    if (hi == 0) wsf[r32] = 1.f / l;
#pragma unroll
    for (int r = 0; r < 16; ++r) { const int q = (r & 3) + 8 * (r >> 2) + 4 * hi; const float inv = wsf[q];
        const size_t oo = (rowbase + ch * 64 + 32 * qh + q) * DM + head * 64 + r32;
        CAT_ST(cat, oo, o0[r] * inv); CAT_ST(cat, oo + 32, o1[r] * inv); }
    __syncthreads();
}

__device__ __forceinline__ void ln_row16(const bf16_t* src, float (&x)[16], int lane) {
    const u32x4 a = *(const u32x4*)(src + 8 * lane), b = *(const u32x4*)(src + 512 + 8 * lane);
    x[0] = bf_lo(a.x); x[1] = bf_hi(a.x); x[2] = bf_lo(a.y); x[3] = bf_hi(a.y); x[4] = bf_lo(a.z); x[5] = bf_hi(a.z); x[6] = bf_lo(a.w); x[7] = bf_hi(a.w);
    x[8] = bf_lo(b.x); x[9] = bf_hi(b.x); x[10] = bf_lo(b.y); x[11] = bf_hi(b.y); x[12] = bf_lo(b.z); x[13] = bf_hi(b.z); x[14] = bf_lo(b.w); x[15] = bf_hi(b.w);
}
__device__ __forceinline__ void ln_norm16(float (&x)[16], const float* g, const float* bta, int lane) {
    float s = 0.f;
#pragma unroll
    for (int j = 0; j < 16; ++j) s += x[j];
    const float mean = wave_sum(s) * (1.f / DM); float q = 0.f;
#pragma unroll
    for (int j = 0; j < 16; ++j) { x[j] -= mean; q += x[j] * x[j]; }
    const float rstd = 1.f / sqrtf(wave_sum(q) * (1.f / DM) + LN_EPS);
    const f32x4 g0 = *(const f32x4*)(g + 8 * lane), g1 = *(const f32x4*)(g + 8 * lane + 4), g2 = *(const f32x4*)(g + 512 + 8 * lane), g3 = *(const f32x4*)(g + 512 + 8 * lane + 4);
    const f32x4 b0 = *(const f32x4*)(bta + 8 * lane), b1 = *(const f32x4*)(bta + 8 * lane + 4), b2 = *(const f32x4*)(bta + 512 + 8 * lane), b3 = *(const f32x4*)(bta + 512 + 8 * lane + 4);
#pragma unroll
    for (int j = 0; j < 4; ++j) { x[j] = x[j] * rstd * g0[j] + b0[j]; x[4 + j] = x[4 + j] * rstd * g1[j] + b1[j]; x[8 + j] = x[8 + j] * rstd * g2[j] + b2[j]; x[12 + j] = x[12 + j] * rstd * g3[j] + b3[j]; }
}
__device__ __forceinline__ void store16bf(bf16_t* dst, const float (&x)[16], int lane) {
    u32x4 a, b; a.x = cvt_pk_bf16(x[0], x[1]); a.y = cvt_pk_bf16(x[2], x[3]); a.z = cvt_pk_bf16(x[4], x[5]); a.w = cvt_pk_bf16(x[6], x[7]);
    b.x = cvt_pk_bf16(x[8], x[9]); b.y = cvt_pk_bf16(x[10], x[11]); b.z = cvt_pk_bf16(x[12], x[13]); b.w = cvt_pk_bf16(x[14], x[15]);
    *(u32x4*)(dst + 8 * lane) = a; *(u32x4*)(dst + 512 + 8 * lane) = b;
}
__device__ __forceinline__ void store16f8(unsigned char* dst, const float (&x)[16], int lane) {
    *(u32x2*)(dst + 8 * lane) = pg8::pack8_fp8((f32x4){x[0], x[1], x[2], x[3]}, (f32x4){x[4], x[5], x[6], x[7]});
    *(u32x2*)(dst + 512 + 8 * lane) = pg8::pack8_fp8((f32x4){x[8], x[9], x[10], x[11]}, (f32x4){x[12], x[13], x[14], x[15]});
}
constexpr int HS_STRIDE = 2064;
__device__ __forceinline__ void ln1_router_phase(Frame& F, const Args& a, int layer) {
    const bf16_t* t1 = (const bf16_t*)(a.ws + WS_T1); bf16_t* hb = (bf16_t*)(a.ws + WS_HB);
    const bf16_t* wrt = (const bf16_t*)(a.ws + WS_WRT) + (size_t)layer * NEXP * DM;
    const float* g = a.in[10] + layer * DM; const float* bta = a.in[11] + layer * DM; const float* br = a.in[13] + layer * NEXP;
    int* topi = (int*)(a.ws + WS_TOPI); float* gate = (float*)(a.ws + WS_GATE); int* cnt = (int*)(a.ws + WS_CNT);
    const int lane = F.lane, w = F.wave, tid = F.tid;
    LAS unsigned char* hs = F.lds;
    LAS float* part = (LAS float*)(F.lds + 36864);
    LAS float* logit = (LAS float*)(F.lds + 36864 + 16384);
    LAS int* hist = (LAS int*)(F.lds + 36864 + 16384 + 2048);
    LAS int* topk_i = (LAS int*)(F.lds + 36864 + 16384 + 2048 + 256); LAS float* topk_v = (LAS float*)(F.lds + 36864 + 16384 + 2048 + 512);
    const int n16 = lane & 15, kg4 = lane >> 4;
    bf16x8 bw[2][4];
#pragma unroll
    for (int n = 0; n < 2; ++n)
#pragma unroll
        for (int ks = 0; ks < 4; ++ks) bw[n][ks] = *(const bf16x8*)(wrt + (size_t)(16 * n + n16) * DM + 128 * w + 32 * ks + 8 * kg4);
    for (int grp2 = F.bid; grp2 < NGRP * PM(6); grp2 += F.G) { const int grp = grp2 % NGRP;
        if (tid < 32) hist[tid] = 0;
        __syncthreads();
        for (int it = 0; it < 8; ++it) {
            const int r0 = grp * 128 + it * 16;
#pragma unroll
            for (int rr = 0; rr < 2; ++rr) { const int rl = 2 * w + rr; float x[16];
                ln_row16(t1 + (size_t)(r0 + rl) * DM, x, lane); ln_norm16(x, g, bta, lane);
                store16bf(hb + (size_t)(r0 + rl) * DM, x, lane); store16f8((unsigned char*)(a.ws + WS_HQ) + (size_t)(r0 + rl) * DM, x, lane);
                u32x4 p, q; p.x = cvt_pk_bf16(x[0], x[1]); p.y = cvt_pk_bf16(x[2], x[3]); p.z = cvt_pk_bf16(x[4], x[5]); p.w = cvt_pk_bf16(x[6], x[7]);
                q.x = cvt_pk_bf16(x[8], x[9]); q.y = cvt_pk_bf16(x[10], x[11]); q.z = cvt_pk_bf16(x[12], x[13]); q.w = cvt_pk_bf16(x[14], x[15]);
                *(LAS u32x4*)(hs + rl * HS_STRIDE + 16 * lane) = p; *(LAS u32x4*)(hs + rl * HS_STRIDE + 1024 + 16 * lane) = q; }
            __syncthreads();
            { f32x4 d0 = {0.f, 0.f, 0.f, 0.f}, d1 = {0.f, 0.f, 0.f, 0.f};
#pragma unroll
              for (int ks = 0; ks < 4; ++ks) { const bf16x8 af = *(const LAS bf16x8*)(hs + n16 * HS_STRIDE + (128 * w + 32 * ks + 8 * kg4) * 2);
                  d0 = __builtin_amdgcn_mfma_f32_16x16x32_bf16(af, bw[0][ks], d0, 0, 0, 0); d1 = __builtin_amdgcn_mfma_f32_16x16x32_bf16(af, bw[1][ks], d1, 0, 0, 0); }
#pragma unroll
              for (int r = 0; r < 4; ++r) { part[(w * 16 + 4 * kg4 + r) * 32 + n16] = d0[r]; part[(w * 16 + 4 * kg4 + r) * 32 + 16 + n16] = d1[r]; } }
            __syncthreads();
            { const int row = tid >> 5, e = tid & 31; float s = br[e];
#pragma unroll
              for (int ww = 0; ww < 8; ++ww) s += part[(ww * 16 + row) * 32 + e];
              logit[row * 32 + e] = s; }
            __syncthreads();
            { const int row = tid >> 5, e = tid & 31; const float lv = logit[row * 32 + e]; int rank = 0;
#pragma unroll
              for (int e2 = 0; e2 < 32; ++e2) { const float o = logit[row * 32 + e2]; rank += (o > lv || (o == lv && e2 < e)) ? 1 : 0; }
              if (rank < 4) { topk_i[row * 4 + rank] = e; topk_v[row * 4 + rank] = lv; } }
            __syncthreads();
            if (tid < 16) { const int tok = r0 + tid;
                const int t0 = topk_i[tid * 4 + 0], t1 = topk_i[tid * 4 + 1], t2 = topk_i[tid * 4 + 2], t3 = topk_i[tid * 4 + 3];
                const float v0 = topk_v[tid * 4 + 0];
                const float e0 = 1.f, e1 = __expf(topk_v[tid * 4 + 1] - v0), e2 = __expf(topk_v[tid * 4 + 2] - v0), e3 = __expf(topk_v[tid * 4 + 3] - v0); const float inv = 1.f / (e0 + e1 + e2 + e3);
                *(int4*)(topi + (size_t)tok * 4) = make_int4(t0, t1, t2, t3);
                *(float4*)(gate + (size_t)tok * 4) = make_float4(e0 * inv, e1 * inv, e2 * inv, e3 * inv);
                atomicAdd((int*)&hist[t0], 1); atomicAdd((int*)&hist[t1], 1); atomicAdd((int*)&hist[t2], 1); atomicAdd((int*)&hist[t3], 1); }
        }
        __syncthreads();
        if (tid < 32) cnt[grp * 32 + tid] = hist[tid];
        __syncthreads();
    }
}

__device__ __forceinline__ void moe_tables(Frame& F, const Args& a, int grp) {
    const int* cnt = (const int*)(a.ws + WS_CNT);
    LAS int* T = (LAS int*)(F.lds + TAB_OFF);
    const int tid = F.tid, e = tid & 31, j = tid >> 5;
    { int s = 0, bf = 0;
      for (int gg = j * 16; gg < j * 16 + 16; ++gg) { const int c = cnt[gg * 32 + e]; s += c; if (gg < grp) bf += c; }
      T[TB_TOT16 / 4 + j * 32 + e] = s; T[TB_BEF16 / 4 + j * 32 + e] = bf; }
    __syncthreads();
    if (tid < 32) { int s = 0, bf = 0;
#pragma unroll
        for (int jj = 0; jj < 16; ++jj) { s += T[TB_TOT16 / 4 + jj * 32 + tid]; bf += T[TB_BEF16 / 4 + jj * 32 + tid]; }
        T[TB_TOTAL / 4 + tid] = s; T[TB_BEFORE / 4 + tid] = bf; T[TB_LCUR / 4 + tid] = 0; }
    __syncthreads();
    if (tid < 32) {
        int ps = 0;
#pragma nounroll
        for (int ee = 0; ee < tid; ++ee) ps += ((T[TB_TOTAL / 4 + ee] + 255) >> 8) << 8;
        T[TB_PADST / 4 + tid] = ps; T[TB_BASE / 4 + tid] = ps + T[TB_BEFORE / 4 + tid];
        if (tid == 31) { const int end = ps + (((T[TB_TOTAL / 4 + 31] + 255) >> 8) << 8); T[TB_PADST / 4 + 32] = end; T[TB_NTL / 4] = end >> 8; } }
    __syncthreads();
    { LAS unsigned char* t2e = (LAS unsigned char*)(F.lds + TAB_OFF + TB_T2E); const int ntl = T[TB_NTL / 4];
      for (int rt = tid; rt < ntl; rt += NTHR) { int e = 0;
#pragma nounroll
          for (int ee = 1; ee < 32; ++ee) e += (T[TB_PADST / 4 + ee] <= rt * 256) ? 1 : 0;
          t2e[rt] = (unsigned char)e; } }
    __syncthreads();
}
__device__ __forceinline__ void scatter_phase(Frame& F, const Args& a) {
    const int* topi = (const int*)(a.ws + WS_TOPI);
    int* slot = (int*)(a.ws + WS_SLOT); int* rowtok = (int*)(a.ws + WS_ROWG);
    LAS int* T = (LAS int*)(F.lds + TAB_OFF);
    const int tid = F.tid;
    if (F.bid >= NGRP) moe_tables(F, a, -1);
    for (int grp2 = F.bid; grp2 < NGRP * PM(7); grp2 += F.G) { const int grp = grp2 % NGRP;
        moe_tables(F, a, grp);
        { const int tok = grp * 128 + (tid >> 2), k = tid & 3; const int e = topi[(size_t)tok * 4 + k];
          const int rank = atomicAdd((int*)&T[TB_LCUR / 4 + e], 1); const int row = T[TB_BASE / 4 + e] + rank;
          slot[(size_t)tok * 4 + k] = row; rowtok[row] = tok; }
        if (grp < NEXP) {
            const int tot = T[TB_TOTAL / 4 + grp], st = T[TB_PADST / 4 + grp], en = T[TB_PADST / 4 + grp + 1];
            for (int r = st + tot + tid; r < en; r += NTHR) rowtok[r] = 0; }
        __syncthreads();
    }
}
__device__ __forceinline__ void combine_phase(Frame& F, const Args& a) {
    const bf16_t* hb = (const bf16_t*)(a.ws + WS_HB); const bf16_t* yb = (const bf16_t*)(a.ws + WS_XS); bf16_t* mid = (bf16_t*)(a.ws + WS_MIDB);
    const int* slot = (const int*)(a.ws + WS_SLOT);
    const int lane = F.lane;
    for (int tok2 = F.bid * NWAVES + F.wave; tok2 < NTOK * PM(10); tok2 += F.G * NWAVES) { const int tok = tok2 % NTOK;
        float x[16]; ln_row16(hb + (size_t)tok * DM, x, lane);
#pragma unroll
        for (int j = 0; j < 16; ++j) x[j] *= ALPHA;
        const int4 sl = *(const int4*)(slot + (size_t)tok * 4);
        const int s4[4] = {sl.x, sl.y, sl.z, sl.w};
        const float4 gt4 = *(const float4*)((const float*)(a.ws + WS_GATE) + (size_t)tok * 4);
        const float g4[4] = {gt4.x * 0.0625f, gt4.y * 0.0625f, gt4.z * 0.0625f, gt4.w * 0.0625f};
#pragma unroll
        for (int k = 0; k < 4; ++k) {
            if (Y_FP8) { const unsigned char* yr = (const unsigned char*)yb + (size_t)s4[k] * DM;
                const u32x2 p = *(const u32x2*)(yr + 8 * lane), q = *(const u32x2*)(yr + 512 + 8 * lane);
                const unsigned w4[4] = {p.x, p.y, q.x, q.y};
#pragma unroll
                for (int i = 0; i < 4; ++i) { const f32x2 lo = __builtin_amdgcn_cvt_pk_f32_fp8((int)w4[i], false), hi2 = __builtin_amdgcn_cvt_pk_f32_fp8((int)w4[i], true);
                    x[4 * i + 0] += lo.x * g4[k]; x[4 * i + 1] += lo.y * g4[k]; x[4 * i + 2] += hi2.x * g4[k]; x[4 * i + 3] += hi2.y * g4[k]; } }
            else { float y[16]; ln_row16(yb + (size_t)s4[k] * DM, y, lane);
#pragma unroll
                for (int j = 0; j < 16; ++j) x[j] += y[j] * (16.f * g4[k]); } }
        store16bf(mid + (size_t)tok * DM, x, lane); store16f8((unsigned char*)(a.ws + WS_MIDQ) + (size_t)tok * DM, x, lane);
    }
}
__device__ __forceinline__ void ln2_phase(Frame& F, const Args& a, int layer) {
    const bf16_t* t2 = (const bf16_t*)(a.ws + WS_T1); bf16_t* xb = (bf16_t*)(a.ws + WS_XB);
    const float* g = a.in[18] + layer * DM; const float* bta = a.in[19] + layer * DM;
    const int lane = F.lane;
    for (int tok2 = F.bid * NWAVES + F.wave; tok2 < NTOK * PM(12); tok2 += F.G * NWAVES) { const int tok = tok2 % NTOK;
        float x[16]; ln_row16(t2 + (size_t)tok * DM, x, lane); ln_norm16(x, g, bta, lane);
        if (layer == 0) { store16bf(xb + (size_t)tok * DM, x, lane); if (FP8_IN1) store16f8((unsigned char*)(a.ws + WS_XQ) + (size_t)tok * DM, x, lane); }
        else { float* o = a.out + (size_t)tok * DM;
            *(f32x4*)(o + 8 * lane) = (f32x4){x[0], x[1], x[2], x[3]}; *(f32x4*)(o + 8 * lane + 4) = (f32x4){x[4], x[5], x[6], x[7]};
            *(f32x4*)(o + 512 + 8 * lane) = (f32x4){x[8], x[9], x[10], x[11]}; *(f32x4*)(o + 512 + 8 * lane + 4) = (f32x4){x[12], x[13], x[14], x[15]}; }
    }
}

__global__ void __launch_bounds__(NTHR, 2) __attribute__((target("no-packed-fp32-ops"))) hybrid_fwd(Args args) {
    extern __shared__ __attribute__((aligned(16))) unsigned char lds_raw[];
    Frame F;
    F.lds = (LAS unsigned char*)lds_raw;
    F.tid = threadIdx.x; F.lane = F.tid & 63; F.wave = __builtin_amdgcn_readfirstlane(F.tid >> 6); F.G = gridDim.x; F.bid = blockIdx.x;
    volatile LAS unsigned* MISC = (volatile LAS unsigned*)(F.lds + MISC_OFF);
    for (int u = F.tid; u < 128; u += NTHR) MISC[u] = 0u;
    __syncthreads();
    XcdBarrier bar = xcd_barrier_post((unsigned*)(args.ws + WS_CTL) + 4096, MISC + 8);
    const int lo = args.ph_lo; int ph = 0; (void)lo; (void)ph;
#ifndef PHMASK
#define PHMASK 0xfffff
#endif
#ifndef PROBE_DUP
#define PROBE_DUP 0
#endif
#define SITE(k) if constexpr ((PHMASK >> (k)) & 1)
typedef const __attribute__((address_space(4))) Args* KArgs;
#define PHASE_REFRESH int t_ = threadIdx.x; asm volatile("" : "+v"(t_)); F.tid = t_; F.lane = t_ & 63; F.wave = __builtin_amdgcn_readfirstlane(t_ >> 6); \
    { int b_ = blockIdx.x; asm volatile("" : "+s"(b_)); F.bid = b_; } \
    { unsigned l_ = 0; asm volatile("" : "+s"(l_)); F.lds = (LAS unsigned char*)lds_raw + l_; } LAS unsigned char* const ring = F.lds; \
    LOAD_ARGS unsigned char* const ws = A.ws;
#if defined(__HIP_DEVICE_COMPILE__)
#define LOAD_ARGS KArgs ap_ = (KArgs)__builtin_amdgcn_kernarg_segment_ptr(); asm volatile("" : "+s"(ap_)); const Args A = *ap_;
#else
#define LOAD_ARGS const Args A = args;
#endif
#ifdef MK_LAUNCHES_PER_PHASE
#define PHASE_BEGIN if (ph == lo) { PHASE_REFRESH
#define PHASE_END   } ++ph;
#define PHASE_END_LAST } ++ph;
#else
#define PHASE_BEGIN { PHASE_REFRESH
#ifdef PROBE_BAR2
#define PHASE_END   xcd_barrier(bar); xcd_barrier(bar); }
#else
#define PHASE_END   xcd_barrier(bar); }
#endif
#define PHASE_END_LAST if (layer == 0) xcd_barrier(bar); }
#endif
    using namespace pg8;

    PHASE_BEGIN SITE(0) p0_prologue(F, A); PHASE_END

    for (int layer = 0; layer < 2; ++layer) {
        PHASE_BEGIN
        SITE(1) {
        if (layer == 0) {
            SITE(16) { DenseOrder S; S.initp(ws + (FP8_IN0 ? WS_XQ : WS_XB), ws + WS_WIN0, NTOK, ZE, FP8_IN0 ? DM : 2 * DM, F.G, F.bid, PM(1)); EpiIn0 E{(bf16_t*)(ws + WS_Z), 0.125f * LOG2E}; int p8 = FP8_IN0 ? DM : 2 * DM; asm volatile("" : "+s"(p8)); gemm_phase<EpiIn0, DenseOrder, FP8_IN0 != 0>(ring, F.tid, p8, S, E); }
            SITE(17) { PleOrder S; S.D.init(ws + WS_PB, ws + WS_WPLE, 2 * NTOK, DM, PLE, F.G, F.bid, PM(1));
              int kple = 2 * PLE; asm volatile("" : "+s"(kple));
              EpiPlain E{(bf16_t*)(ws + WS_PPLE), DM}; gemm_phase(ring, F.tid, kple, S, E); }
        } else {
            SITE(18) { DenseOrder S; S.initp(ws + (FP8_IN1 ? WS_XQ : WS_XB), ws + WS_WIN1, NTOK, ZO, FP8_IN1 ? DM : 2 * DM, F.G, F.bid, PM(1)); EpiIn1 E{(bf16_t*)(ws + WS_Z), (bf16_t*)(ws + WS_KV1), (bf16_t*)(ws + WS_KI1)}; int p8 = FP8_IN1 ? DM : 2 * DM; asm volatile("" : "+s"(p8)); gemm_phase<EpiIn1, DenseOrder, FP8_IN1 != 0>(ring, F.tid, p8, S, E); }
        }
        }
        PHASE_END
        PHASE_BEGIN
        if (layer == 0) {
            SITE(2) for (long L = F.bid; L < 1024 * PM(2); L += F.G) { const int v = (int)(L & 255), rnd = (int)((L >> 8) & 3), s = v & 3, bh = v >> 2;
                const int qb = rnd == 0 ? 15 - s : (rnd == 1 ? 8 + s : (rnd == 2 ? 7 - s : s));
                sb_unit(F, A, bh >> 3, bh & 7, qb); }
            SITE(3) for (int u = F.bid; u < PM(3) * NTOK / 128; u += F.G) gmlp_unit(F, A, u % (NTOK / 128));
        } else {
            SITE(4) for (int L = F.bid; L < PM(4) * NTOK / 8; L += F.G) { const int Lm = L % (NTOK / 8), r = Lm >> 8, cc = Lm & 255;
                const int j = (r & 1) ? 511 - cc : cc; dsa_select_unit(F, A, (r >> 1) * 512 + j); }
        }
        PHASE_END
        if (layer == 1) {
        PHASE_BEGIN
            SITE(13) for (int L = F.bid; L < 1024 * PM(13); L += F.G) { const int idx = L & 1023, pp = idx & 31, g = (idx >> 5) & 3, b = idx >> 7;
                dsa_attn_unit(F, A, b, 63 - pp, g); dsa_attn_unit(F, A, b, pp, g); }
        PHASE_END
        }
        PHASE_BEGIN
        SITE(5) { DenseOrder S; S.initp(ws + WS_CAT, ws + (layer == 0 ? WS_WO0 : WS_WO1), NTOK, DM, FP8_OUT ? DM : 2 * DM, F.G, F.bid, PM(5));
          EpiOut E{layer == 0 ? A.in[0] : nullptr, (const bf16_t*)(ws + WS_XB), (bf16_t*)(ws + WS_T1)}; int p8 = FP8_OUT ? DM : 2 * DM; asm volatile("" : "+s"(p8)); gemm_phase<EpiOut, DenseOrder, FP8_OUT != 0>(ring, F.tid, p8, S, E); }
        PHASE_END
        PHASE_BEGIN SITE(6) ln1_router_phase(F, A, layer); PHASE_END
        PHASE_BEGIN SITE(7) scatter_phase(F, A); PHASE_END
        PHASE_BEGIN
        SITE(8) {
#ifdef MK_LAUNCHES_PER_PHASE
          moe_tables(F, A, -1);
#endif
          const int ntl = __builtin_amdgcn_readfirstlane(((LAS int*)(F.lds + TAB_OFF))[TB_NTL / 4]);
          MoeOrder<8, true> S; S.nunits = ntl * 8; S.G = F.G; S.c = F.bid; S.rep = PM(8); S.t2e = (const LAS unsigned char*)(F.lds + TAB_OFF + TB_T2E);
          S.A = (const char*)(ws + WS_HQ); S.rowtok = (const int*)(ws + WS_ROWG); S.W = (const char*)(ws + WS_WGU) + (size_t)layer * 32 * 2048 * DM;
          EpiSwiglu E{(unsigned char*)(ws + WS_ACT), A.in[15] + (size_t)layer * 32 * 2048}; int p8 = DM; asm volatile("" : "+s"(p8)); gemm_phase<EpiSwiglu, MoeOrder<8, true>, true, MOE_ALIGN>(ring, F.tid, p8, S, E); }
        PHASE_END
        PHASE_BEGIN
        SITE(9) {
#ifdef MK_LAUNCHES_PER_PHASE
          moe_tables(F, A, -1);
#endif
          const int ntl = __builtin_amdgcn_readfirstlane(((LAS int*)(F.lds + TAB_OFF))[TB_NTL / 4]);
          MoeOrder<4, false> S; S.nunits = ntl * 4; S.G = F.G; S.c = F.bid; S.rep = PM(9); S.t2e = (const LAS unsigned char*)(F.lds + TAB_OFF + TB_T2E);
          S.A = (const char*)(ws + WS_ACT); S.rowtok = nullptr; S.W = (const char*)(ws + WS_WD) + (size_t)layer * 32 * DM * DM;
          EpiDown E{(unsigned char*)(ws + WS_XS), A.in[17] + (size_t)layer * 32 * DM}; int p8 = DM; asm volatile("" : "+s"(p8)); gemm_phase<EpiDown, MoeOrder<4, false>, true, MOE_ALIGN>(ring, F.tid, p8, S, E); }
        PHASE_END
        PHASE_BEGIN SITE(10) combine_phase(F, A); PHASE_END
        PHASE_BEGIN
        SITE(11) { DenseOrder S; S.initp(ws + (FP8_GATE ? WS_MIDQ : WS_MIDB), ws + WS_WG + (size_t)layer * DM * DM * (FP8_GATE ? 1 : 2), NTOK, DM, FP8_GATE ? DM : 2 * DM, F.G, F.bid, PM(11));
          EpiGate E{(const bf16_t*)(ws + WS_MIDB), (const bf16_t*)(ws + WS_PPLE) + (size_t)layer * NTOK * DM, A.in[22] + layer * DM, (bf16_t*)(ws + WS_T1)}; int p8 = FP8_GATE ? DM : 2 * DM; asm volatile("" : "+s"(p8)); gemm_phase<EpiGate, DenseOrder, FP8_GATE != 0>(ring, F.tid, p8, S, E); }
        PHASE_END
        PHASE_BEGIN SITE(12) ln2_phase(F, A, layer); PHASE_END_LAST
    }
#undef PHASE_BEGIN
#undef PHASE_END
#undef PHASE_END_LAST
}
constexpr int N_PHASES = 22;

extern "C" void kernel_launch(void* const* d_in, const int* in_sizes, int n_in, void* d_out, int out_size, void* d_ws, size_t ws_size, hipStream_t stream) {
    static int grid = 0;
    if (grid == 0) {
        if (n_in != 23 || out_size != NTOK * DM || ws_size < WS_END) { fprintf(stderr, "kernel_launch: unexpected problem: n_in %d out %d ws %zu (need %zu)\n", n_in, out_size, ws_size, (size_t)WS_END); grid = -1; return; }
        int dev = 0, cus = 0, per_cu = 0;
        if (hipGetDevice(&dev) != hipSuccess || hipDeviceGetAttribute(&cus, hipDeviceAttributeMultiprocessorCount, dev) != hipSuccess) { grid = -1; return; }
        if (hipFuncSetAttribute((const void*)hybrid_fwd, hipFuncAttributeMaxDynamicSharedMemorySize, LDS_BYTES) != hipSuccess) { fprintf(stderr, "kernel_launch: hipFuncSetAttribute failed\n"); grid = -1; return; }
        if (hipOccupancyMaxActiveBlocksPerMultiprocessor(&per_cu, (const void*)hybrid_fwd, NTHR, LDS_BYTES) != hipSuccess || per_cu < 1) fprintf(stderr, "kernel_launch: occupancy query says %d\n", per_cu);
        (void)hipGetLastError();
        grid = cus;
    }
    if (grid < 0) return;
    (void)hipMemsetAsync((char*)d_ws + WS_CTL, 0, CTL_ZERO_BYTES, stream);
    Args a{};
    for (int i = 0; i < 23; ++i) a.in[i] = (const float*)d_in[i];
    a.out = (float*)d_out; a.ws = (unsigned char*)d_ws;
#ifndef MK_LAUNCHES_PER_PHASE
    a.ph_lo = 0; a.ph_hi = N_PHASES;
    hipLaunchKernelGGL(hybrid_fwd, dim3(grid), dim3(NTHR), LDS_BYTES, stream, a);
#else
    for (int p = 0; p < N_PHASES; ++p) { a.ph_lo = p; a.ph_hi = p + 1; hipLaunchKernelGGL(hybrid_fwd, dim3(grid), dim3(NTHR), LDS_BYTES, stream, a); }
#endif
}
```

```cpp
#include <hip/hip_runtime.h>
#include <cstdio>
#include <cstdint>

#define LAS __attribute__((address_space(3)))
#define GAS __attribute__((address_space(1)))
typedef unsigned short bf16_t;
typedef short bf16x8 __attribute__((ext_vector_type(8)));
typedef short s16x4 __attribute__((ext_vector_type(4)));
typedef float f32x2 __attribute__((ext_vector_type(2)));
typedef float f32x4 __attribute__((ext_vector_type(4)));
typedef float f32x16 __attribute__((ext_vector_type(16)));
typedef unsigned u32x2 __attribute__((ext_vector_type(2)));
typedef unsigned u32x4 __attribute__((ext_vector_type(4)));

constexpr int DM = 1024, NB = 8, SEQ = 4096, NTOK = NB * SEQ;
constexpr int ZE = 2560;
constexpr int ZO = 2304, ZO_REAL = 2120;
constexpr int OQ = 0, OK_ = 1024, OV = 1280, OQI = 1536, OKI = 2048, OWI = 2112;
constexpr int NEXP = 32, PLE = 256;
constexpr int NGRP = NTOK / 128;
constexpr int MAXTILES = NTOK * 4 / 256 + NEXP;
constexpr int MAXROWS = MAXTILES * 256;
constexpr float LN_EPS = 1e-5f;
constexpr float ALPHA = 1.4142135623730951f;
constexpr float LOG2E = 1.4426950408889634f;
constexpr float WSC = 64.f, WSC_INV = 1.f / 64.f;

#ifndef FP8_IN0
#define FP8_IN0 1
#endif
#ifndef Y_FP8
#define Y_FP8 1
#endif
#ifndef MOE_ALIGN
#define MOE_ALIGN true
#endif
#ifndef FP8_IN1Q
#define FP8_IN1Q 1
#endif
#ifndef FP8_IN1
#define FP8_IN1 0
#endif
#ifndef FP8_OUT
#define FP8_OUT 1
#endif
#ifndef FP8_GATE
#define FP8_GATE 1
#endif
#ifndef PROBE_DUP
#define PROBE_DUP 0
#endif
#define PM(k) (((PROBE_DUP >> (k)) & 1) ? 2 : 1)

constexpr size_t MiB = 1u << 20;
constexpr size_t WS_CTL = 0, CTL_ZERO_BYTES = 1 * MiB;
constexpr size_t WS_WRT = 1 * MiB;
constexpr size_t WS_WSB = WS_WRT + 256 * 1024;
constexpr size_t WS_CNT = WS_WSB + 256 * 1024;
constexpr size_t WS_TOPI = 2 * MiB;
constexpr size_t WS_GATE = WS_TOPI + 512 * 1024;
constexpr size_t WS_SLOT = 3 * MiB;
constexpr size_t WS_ROWG = WS_SLOT + 512 * 1024;
constexpr size_t WS_HQ = 1056 * MiB + 160 * MiB;
constexpr size_t WS_WIN0 = 8 * MiB, WS_WO0 = 13 * MiB, WS_WIN1 = 15 * MiB, WS_WO1 = 20 * MiB, WS_WG = 22 * MiB, WS_WPLE = 26 * MiB;
constexpr size_t WS_WGU = 32 * MiB, WS_WD = 288 * MiB;
constexpr size_t WS_WIN1Q = 28 * MiB;
constexpr size_t WS_XB = 416 * MiB, WS_PB = 480 * MiB, WS_PPLE = 512 * MiB, WS_Z = 640 * MiB, WS_CAT = 800 * MiB, WS_T1 = 864 * MiB;
constexpr size_t WS_BM = 1328 * MiB;
constexpr size_t WS_KV1 = WS_BM + 16 * MiB;
constexpr size_t WS_KI1 = WS_KV1 + 32 * MiB;
constexpr size_t WS_HB = 928 * MiB, WS_MIDB = 992 * MiB, WS_XS = 1056 * MiB, WS_ACT = 1328 * MiB;
constexpr size_t WS_XQ = 1600 * MiB, WS_MIDQ = 1632 * MiB, WS_END = 1664 * MiB;
static_assert(WS_ROWG + (size_t)MAXROWS * 4 <= WS_WIN0, "small buffers");
static_assert(WS_XS + (size_t)MAXROWS * DM * 2 <= WS_ACT && WS_ACT + (size_t)MAXROWS * DM * 2 <= WS_END, "moe buffers");

constexpr int RING_BYTES = 131072;
constexpr int MISC_OFF = RING_BYTES;
constexpr int TAB_OFF = MISC_OFF + 512;
constexpr int XTRA_OFF = TAB_OFF + 6144;
constexpr int LDS_BYTES = 147456;
static_assert(XTRA_OFF + 8192 <= LDS_BYTES, "LDS map");
constexpr int TB_TOT16 = 0, TB_BEF16 = 2048, TB_TOTAL = 4096, TB_BEFORE = 4224, TB_PADST = 4352  , TB_NTL = 4488, TB_LCUR = 4608  , TB_BASE = 4736  , TB_T2E = 5120  ;
static_assert(TB_T2E + 544 <= 6144, "tab");

#define RLX_AGENT __ATOMIC_RELAXED, __HIP_MEMORY_SCOPE_AGENT
typedef __bf16 bf16x2_t __attribute__((ext_vector_type(2)));
__device__ __forceinline__ unsigned cvt_pk_bf16(float lo, float hi) { const f32x2 v = {lo, hi}; const bf16x2_t b = __builtin_convertvector(v, bf16x2_t); return __builtin_bit_cast(unsigned, b); }
__device__ __forceinline__ unsigned char f8_1(float v) { return (unsigned char)(__builtin_amdgcn_cvt_pk_fp8_f32(v, v, 0, false) & 0xff); }
#if FP8_OUT
#define CAT_ST(cat, idx, v) ((cat)[idx] = f8_1(v))
#else
#define CAT_ST(cat, idx, v) (((bf16_t*)(cat))[idx] = (bf16_t)(cvt_pk_bf16((v), 0.f) & 0xffffu))
#endif
__device__ __forceinline__ float bf_lo(unsigned u) { return __uint_as_float(u << 16); }
__device__ __forceinline__ float bf_hi(unsigned u) { return __uint_as_float(u & 0xffff0000u); }
__device__ __forceinline__ float bf1(bf16_t u) { return __uint_as_float(((unsigned)u) << 16); }
template <int K> __device__ __forceinline__ int sxi(int v) {
    if constexpr (K == 32) { const auto rr = __builtin_amdgcn_permlane32_swap((unsigned)v, (unsigned)v, false, false); return (int)(rr[0] ^ rr[1] ^ (unsigned)v); }
    else return __builtin_amdgcn_ds_swizzle(v, (K << 10) | 0x1f);
}
template <int K> __device__ __forceinline__ float sxf(float v) { return __int_as_float(sxi<K>(__float_as_int(v))); }
__device__ __forceinline__ float wave_sum(float x) {
    int v = __float_as_int(x);
#define WSF_STEP(ctrl, rm) { const int o = __builtin_amdgcn_update_dpp(0, v, ctrl, rm, 0xf, false); v = __float_as_int(__int_as_float(v) + __int_as_float(o)); }
    WSF_STEP(0x111, 0xf) WSF_STEP(0x112, 0xf) WSF_STEP(0x114, 0xf) WSF_STEP(0x118, 0xf) WSF_STEP(0x142, 0xa) WSF_STEP(0x143, 0xc)
#undef WSF_STEP
    return __int_as_float(__builtin_amdgcn_readlane(v, 63));
}
__device__ __forceinline__ float wave_max(float v) {
    v = fmaxf(v, sxf<1>(v)); v = fmaxf(v, sxf<2>(v)); v = fmaxf(v, sxf<4>(v)); v = fmaxf(v, sxf<8>(v)); v = fmaxf(v, sxf<16>(v)); v = fmaxf(v, sxf<32>(v));
    return v;
}
__device__ __forceinline__ float wave_min(float v) {
    v = fminf(v, sxf<1>(v)); v = fminf(v, sxf<2>(v)); v = fminf(v, sxf<4>(v)); v = fminf(v, sxf<8>(v)); v = fminf(v, sxf<16>(v)); v = fminf(v, sxf<32>(v));
    return v;
}
__device__ __forceinline__ int wave_sumi(int v) {
    v += sxi<1>(v); v += sxi<2>(v); v += sxi<4>(v); v += sxi<8>(v); v += sxi<16>(v); v += sxi<32>(v);
    return v;
}
__device__ __forceinline__ int wave_sum_uniform(int v) {
    v += __builtin_amdgcn_update_dpp(0, v, 0x111, 0xf, 0xf, false);
    v += __builtin_amdgcn_update_dpp(0, v, 0x112, 0xf, 0xf, false);
    v += __builtin_amdgcn_update_dpp(0, v, 0x114, 0xf, 0xf, false);
    v += __builtin_amdgcn_update_dpp(0, v, 0x118, 0xf, 0xf, false);
    v += __builtin_amdgcn_update_dpp(0, v, 0x142, 0xa, 0xf, false);
    v += __builtin_amdgcn_update_dpp(0, v, 0x143, 0xc, 0xf, false);
    return __builtin_amdgcn_readlane(v, 63);
}
__device__ __forceinline__ float wave_max_uniform(float x) {
    int v = __float_as_int(x);
#define WMX_STEP(ctrl, rm) { const int o = __builtin_amdgcn_update_dpp(v, v, ctrl, rm, 0xf, false); v = __float_as_int(fmaxf(__int_as_float(v), __int_as_float(o))); }
    WMX_STEP(0x111, 0xf) WMX_STEP(0x112, 0xf) WMX_STEP(0x114, 0xf) WMX_STEP(0x118, 0xf) WMX_STEP(0x142, 0xa) WMX_STEP(0x143, 0xc)
#undef WMX_STEP
    return __int_as_float(__builtin_amdgcn_readlane(v, 63));
}
__device__ __forceinline__ float relu_i(float x) { const int i = __float_as_int(x); return __int_as_float(i > 0 ? i : 0); }
__device__ __forceinline__ float ex2(float x) { return __builtin_amdgcn_exp2f(x); }
__device__ __forceinline__ float lg2(float x) { return __builtin_amdgcn_logf(x); }
__device__ __forceinline__ float rcpf_(float x) { return __builtin_amdgcn_rcpf(x); }
__device__ __forceinline__ float sigmoidf_(float x) { return rcpf_(1.f + ex2(-LOG2E * x)); }
__device__ __forceinline__ float gelu_tanh(float x) { return x * rcpf_(1.f + ex2(-2.302208198f * (x + 0.044715f * x * x * x))); }

namespace pg8 {
constexpr int BM = 256, BK = 64, HALF = 128, HTB = HALF * BK * 2, STAGE_BYTES = 8 * HTB, NXCD = 8, WGM = 8;
__host__ __device__ __forceinline__ int lds_byte(int r, int c) { const int st = (r >> 4) * 2 + (c >> 5), rr = r & 15, cc = c & 31, ob = rr * 64 + cc * 2; return st * 1024 + (ob ^ (((ob >> 9) & 1) << 5)); }
__host__ __device__ __forceinline__ void stage_rc(int b, int& R, int& C) { const int st = b / 1024, sb = b % 1024, swz = sb ^ (((sb >> 9) & 1) << 5); R = (st >> 1) * 16 + swz / 64; C = (st & 1) * 32 + (swz % 64) / 2; }
__host__ __device__ __forceinline__ int perm32(int rho) { const int n = rho >> 4, i = rho & 15; return 8 * (i >> 2) + 4 * n + (i & 3); }

struct Unit { int pm, pn, e; const char* b0; };
typedef int v8i_t __attribute__((ext_vector_type(8)));
typedef int v4i_t __attribute__((ext_vector_type(4)));
__device__ __forceinline__ v8i_t cat8(const bf16x8 a, const bf16x8 b) { const v4i_t x = __builtin_bit_cast(v4i_t, a), y = __builtin_bit_cast(v4i_t, b); return __builtin_shufflevector(x, y, 0, 1, 2, 3, 4, 5, 6, 7); }

struct DenseOrder {
    static constexpr bool GATHER = false;
    int nM, nN, nwg, G, c, rep; const char* A; const char* B; size_t tstep, hstep;
    __device__ __forceinline__ void init(const void* A_, const void* B_, int M, int N, int K, int G_, int c_, int rep_ = 1) { initp(A_, B_, M, N, 2 * K, G_, c_, rep_); }
    __device__ __forceinline__ void initp(const void* A_, const void* B_, int M, int N, int pitch, int G_, int c_, int rep_ = 1) { A = (const char*)A_; B = (const char*)B_; nM = M / BM; nN = N / BM; nwg = nM * nN; G = G_; c = c_; rep = rep_; hstep = (size_t)HALF * pitch; tstep = 2 * hstep; }
    __device__ __forceinline__ bool next(int i, Unit& u) const {
        const int mode = rep < 0 ? -rep : 0, rp = rep < 0 ? 1 : rep;
        int L = i * G + c, ok = 1;
        if (mode == 1) { const int hG = G >> 1; if (i >= 2) { ok = (c >= hG && i < 4) ? 1 : 0; L = 2 * G + (i - 2) * hG + (c - hG); } }
        else if (mode == 2) { if (i >= 1) { ok = (i == 1 && c < (G >> 1)) ? 1 : 0; L = G + c; } }
        if (L >= nwg * rp) ok = 0;
        if (!__builtin_amdgcn_readfirstlane(ok)) return false;
        if (L >= nwg) L -= nwg;
        int wgid = __builtin_amdgcn_readfirstlane(L); { const int q = nwg / NXCD, r = nwg % NXCD, xcd = wgid % NXCD, off = wgid / NXCD; wgid = (xcd < r ? xcd * (q + 1) : r * (q + 1) + (xcd - r) * q) + off; }
        const int nig = WGM * nN, gid = wgid / nig, fm = gid * WGM, gsz = (nM - fm) < WGM ? (nM - fm) : WGM;
        u.pm = fm + ((wgid % nig) % gsz); u.pn = (wgid % nig) / gsz; u.e = 0;
        u.b0 = B + (size_t)u.pn * tstep; return true;
    }
    __device__ __forceinline__ const char* aptr(const Unit& u) const { return A + (size_t)u.pm * tstep; }
    __device__ __forceinline__ size_t b1off() const { return hstep; }
    __device__ __forceinline__ int rowtok_at(int) const { return 0; }
};
struct PleOrder {
    static constexpr bool GATHER = false;
    DenseOrder D;
    __device__ __forceinline__ bool next(int i, Unit& u) const { if (!D.next(i, u)) return false; if (u.pm >= 32768 / BM) u.b0 += (size_t)1024 * 256 * 2; return true; }
    __device__ __forceinline__ const char* aptr(const Unit& u) const { return D.aptr(u); }
    __device__ __forceinline__ size_t b1off() const { return D.b1off(); }
    __device__ __forceinline__ int rowtok_at(int) const { return 0; }
};
template <int NT, bool SWIGLU>
struct MoeOrder {
    static constexpr bool GATHER = SWIGLU;
    int nunits, G, c, rep; const LAS unsigned char* t2e; const char* A; const char* W; const int* rowtok;
    static constexpr size_t hstep = (size_t)HALF * 1024, tstep = 2 * hstep;
    __device__ __forceinline__ bool next(int i, Unit& u) const {
        const int vc = ((G & 7) == 0) ? (c & 7) * (G >> 3) + (c >> 3) : c;
        int L = i * G + vc; if (L >= nunits * rep) return false; if (L >= nunits) L -= nunits;
        const int rt = L / NT, pn = L % NT;
        const int e = __builtin_amdgcn_readfirstlane((int)t2e[rt]);
        u.pm = rt; u.pn = pn; u.e = e;
        if (SWIGLU) u.b0 = W + (size_t)e * (16 * hstep) + (size_t)pn * hstep;
        else u.b0 = W + (size_t)e * (8 * hstep) + (size_t)pn * tstep;
        return true;
    }
    __device__ __forceinline__ const char* aptr(const Unit& u) const { return GATHER ? A : A + (size_t)u.pm * tstep; }
    __device__ __forceinline__ size_t b1off() const { return SWIGLU ? 8 * hstep : hstep; }
    __device__ __forceinline__ int rowtok_at(int row) const { return rowtok[row]; }
};

template <class Epi, class Sched, bool FP8 = false, bool ALIGN_EPI = true>
__device__ __forceinline__ void gemm_phase(LAS unsigned char* lds, const int tid, const int pitch, const Sched& S, const Epi& E) {
    const int wid = __builtin_amdgcn_readfirstlane(tid >> 6), lane = tid & 63, wr = wid >> 2, wc = wid & 3, fr = lane & 15, fq = lane >> 4;
    const int nt = pitch / (BK * 2);
    unsigned voffA[2], voffB[2];
#pragma unroll
    for (int i = 0; i < 2; ++i) { int R, C; stage_rc(tid * 16 + i * 8192, R, C); const int Rb = (R & ~31) + perm32(R & 31);
        voffA[i] = (unsigned)(R * pitch + C * 2); voffB[i] = (unsigned)(Rb * pitch + C * 2); }
    const size_t kstep = (size_t)(BK * 2);
    const size_t hstep = (size_t)HALF * pitch;
    constexpr bool GATHER = Sched::GATHER;
    unsigned vA[2][2], vAn[2][2]; int gR[2], gC[2];
    if constexpr (GATHER) {
#pragma unroll
        for (int i = 0; i < 2; ++i) { int R, C; stage_rc(tid * 16 + i * 8192, R, C); gR[i] = R; gC[i] = C * 2; } }
    auto gather_tok = [&](const Unit& u, int (&tk)[2][2]) {
#pragma unroll
        for (int h = 0; h < 2; ++h)
#pragma unroll
            for (int i = 0; i < 2; ++i) tk[h][i] = S.rowtok_at(u.pm * BM + h * HALF + gR[i]); };
    auto gather_off = [&](const int (&tk)[2][2], unsigned (&v)[2][2]) {
#pragma unroll
        for (int h = 0; h < 2; ++h)
#pragma unroll
            for (int i = 0; i < 2; ++i) v[h][i] = (unsigned)(tk[h][i] * pitch + gC[i]); };
    const unsigned ldsw = (unsigned)wid * 1024u;
    int sc127 = 127, scw = Epi::SCALE_EXP; asm volatile("" : "+v"(sc127), "+v"(scw));
    const unsigned ldsu = (unsigned)__builtin_amdgcn_readfirstlane((int)(unsigned)(uintptr_t)lds) + ldsw;
    const int aoff = lds_byte(wr * 64 + fr, fq * 8), boff = lds_byte(wc * 32 + fr, fq * 8);
#define PG8_SA(b, h) (((b) * 2 + (h)) * HTB)
#define PG8_SB(b, h) ((4 + (b) * 2 + (h)) * HTB)
#define PG8_STAGE(bufoff, gbase, voff) do { _Pragma("unroll") for (int _i = 0; _i < 2; ++_i) { unsigned _keep; \
        asm volatile("s_mov_b32 %0, m0\n\ts_mov_b32 m0, %3\n\ts_nop 0\n\tglobal_load_lds_dwordx4 %1, %2\n\ts_mov_b32 m0, %0" : "=&s"(_keep) : "v"((voff)[_i]), "s"((const char*)(gbase)), "s"(ldsu + (unsigned)((bufoff) + _i * 8192)) : "memory"); } } while (0)
#define PG8_STAGE_A(b, h, base, VG) do { if constexpr (GATHER) { PG8_STAGE(PG8_SA(b, h), base, (VG)[h]); } else { PG8_STAGE(PG8_SA(b, h), (base) + (h) * hstep, voffA); } } while (0)
#define PG8_LDA(dst, b, h) do { _Pragma("unroll") for (int m = 0; m < 4; ++m) _Pragma("unroll") for (int k = 0; k < 2; ++k) dst[m][k] = *(const LAS bf16x8*)(lds + PG8_SA(b, h) + aoff + m * 2048 + k * 1024); } while (0)
#define PG8_LDB(dst, b, h) do { _Pragma("unroll") for (int n = 0; n < 2; ++n) _Pragma("unroll") for (int k = 0; k < 2; ++k) dst[n][k] = *(const LAS bf16x8*)(lds + PG8_SB(b, h) + boff + n * 2048 + k * 1024); } while (0)
#define PG8_MMA(ai, bj, At, Bt) do { __builtin_amdgcn_s_setprio(1); _Pragma("unroll") for (int m = 0; m < 4; ++m) _Pragma("unroll") for (int n = 0; n < 2; ++n) { \
        if constexpr (FP8) { const v8i_t _a = cat8(Bt[n][0], Bt[n][1]), _b = cat8(At[m][0], At[m][1]); \
            asm volatile("v_mfma_scale_f32_16x16x128_f8f6f4 %0, %1, %2, %0, %3, %4 op_sel_hi:[0,0,0]" : "+v"(acc[ai][bj][m][n]) : "v"(_a), "v"(_b), "v"(scw), "v"(sc127)); } \
        else { _Pragma("unroll") for (int k = 0; k < 2; ++k) acc[ai][bj][m][n] = __builtin_amdgcn_mfma_f32_16x16x32_bf16(Bt[n][k], At[m][k], acc[ai][bj][m][n], 0, 0, 0); } } __builtin_amdgcn_s_setprio(0); } while (0)
#define PG8_WAIT_V(n) asm volatile("s_waitcnt vmcnt(" #n ")" ::: "memory")
#define PG8_WAIT_L(n) asm volatile("s_waitcnt lgkmcnt(" #n ")" ::: "memory")
#define PG8_BAR __builtin_amdgcn_s_barrier()
#define PG8_SCHED __builtin_amdgcn_sched_barrier(0)
    Unit cur, nxt; int ui = 0;
    if (!S.next(0, cur)) return;
    f32x4 acc[2][2][4][2];
    { typename Epi::Pre pre0; E.prefetch(pre0, cur, wr, wc, fr, fq); E.init(acc, pre0); }
    bf16x8 At[4][2], B0[2][2], B1[2][2];
    const char* cA = S.aptr(cur); const char* cB0 = cur.b0; const char* cB1 = cB0 + S.b1off();
    if constexpr (GATHER) { int tk[2][2]; gather_tok(cur, tk); gather_off(tk, vA); Unit u1; const bool h1 = S.next(1, u1); gather_tok(h1 ? u1 : cur, tk); gather_off(tk, vAn); }
    PG8_STAGE(PG8_SB(0, 0), cB0, voffB); PG8_STAGE(PG8_SB(0, 1), cB1, voffB); PG8_STAGE_A(0, 0, cA, vA); PG8_STAGE_A(0, 1, cA, vA);
    if (wr == 1) PG8_BAR;
    PG8_WAIT_V(2); PG8_BAR;
    PG8_STAGE(PG8_SB(1, 0), cB0 + kstep, voffB); PG8_STAGE_A(1, 0, cA + kstep, vA); PG8_STAGE(PG8_SB(1, 1), cB1 + kstep, voffB);
    PG8_WAIT_V(6); PG8_BAR;
    for (;;) {
        const bool has_next = S.next(ui + 1, nxt);
        const char* nA = has_next ? S.aptr(nxt) : cA; const char* nB0 = has_next ? nxt.b0 : cB0; const char* nB1 = nB0 + S.b1off();
        for (int t = 0; t < nt; t += 2) {
            const bool last = (t == nt - 2);
            const char* a1 = cA + (size_t)(t + 1) * kstep;
            const char* a2 = last ? nA : cA + (size_t)(t + 2) * kstep;
            const char* b20 = last ? nB0 : cB0 + (size_t)(t + 2) * kstep; const char* b21 = last ? nB1 : cB1 + (size_t)(t + 2) * kstep;
            const char* a3 = a2 + kstep; const char* b30 = b20 + kstep; const char* b31 = b21 + kstep;
            unsigned vS[2][2];
            if constexpr (GATHER) {
#pragma unroll
                for (int h = 0; h < 2; ++h)
#pragma unroll
                    for (int i = 0; i < 2; ++i) vS[h][i] = last ? vAn[h][i] : vA[h][i]; }
            PG8_LDB(B0, 0, 0); PG8_LDB(B1, 0, 1); PG8_SCHED; PG8_LDA(At, 0, 0); PG8_STAGE_A(1, 1, a1, vA);
            PG8_WAIT_V(8); PG8_WAIT_L(0); PG8_BAR; PG8_MMA(0, 0, At, B0); PG8_MMA(0, 1, At, B1); PG8_BAR; PG8_SCHED;
            PG8_LDA(At, 0, 1); PG8_STAGE(PG8_SB(0, 0), b20, voffB); PG8_STAGE(PG8_SB(0, 1), b21, voffB); PG8_STAGE_A(0, 0, a2, vS);
            PG8_WAIT_V(8); PG8_WAIT_L(0); PG8_BAR; PG8_MMA(1, 0, At, B0); PG8_MMA(1, 1, At, B1); PG8_BAR; PG8_SCHED;
            PG8_LDB(B0, 1, 0); PG8_LDB(B1, 1, 1); PG8_SCHED; PG8_LDA(At, 1, 0); PG8_STAGE_A(0, 1, a2, vS);
            PG8_WAIT_V(8); PG8_WAIT_L(0); PG8_BAR; PG8_MMA(0, 0, At, B0); PG8_MMA(0, 1, At, B1); PG8_BAR; PG8_SCHED;
            PG8_LDA(At, 1, 1); PG8_STAGE(PG8_SB(1, 0), b30, voffB); PG8_STAGE(PG8_SB(1, 1), b31, voffB); PG8_STAGE_A(1, 0, a3, vS);
            PG8_WAIT_V(8); PG8_WAIT_L(0); PG8_BAR; PG8_MMA(1, 0, At, B0); PG8_MMA(1, 1, At, B1); PG8_BAR; PG8_SCHED;
        }
        if constexpr (ALIGN_EPI) { if (wr == 0) PG8_BAR; }
        typename Epi::Pre pre; E.prefetch(pre, has_next ? nxt : cur, wr, wc, fr, fq);
        int tkn[2][2];
        if constexpr (GATHER) { Unit u2; const bool h2 = S.next(ui + 2, u2); gather_tok(h2 ? u2 : cur, tkn); }
        PG8_SCHED;
        E(acc, cur, wr, wc, fr, fq);
        if (!has_next) break;
        E.init(acc, pre);
        if constexpr (GATHER) { asm volatile("" : "+v"(tkn[0][0]), "+v"(tkn[0][1]), "+v"(tkn[1][0]), "+v"(tkn[1][1]));
#pragma unroll
            for (int h = 0; h < 2; ++h)
#pragma unroll
                for (int i = 0; i < 2; ++i) vA[h][i] = vAn[h][i];
            gather_off(tkn, vAn); }
        cur = nxt; cA = nA; cB0 = nB0; cB1 = nB1; ++ui;
        if constexpr (ALIGN_EPI) { if (wr == 1) PG8_BAR; }
    }
    PG8_WAIT_V(0);
    if constexpr (!ALIGN_EPI) { if (wr == 0) PG8_BAR; }
    PG8_BAR;
#undef PG8_SA
#undef PG8_SB
#undef PG8_STAGE
#undef PG8_STAGE_A
#undef PG8_LDA
#undef PG8_LDB
#undef PG8_MMA
#undef PG8_WAIT_V
#undef PG8_WAIT_L
#undef PG8_BAR
#undef PG8_SCHED
}

#define EPI_ROWS_BEGIN const int row0 = u.pm * BM + wr * 64 + fr; const int cl = wc * 32 + 8 * fq;
__device__ __forceinline__ void store8(bf16_t* p, const f32x4 v0, const f32x4 v1) {
    u32x4 w; w.x = cvt_pk_bf16(v0[0], v0[1]); w.y = cvt_pk_bf16(v0[2], v0[3]); w.z = cvt_pk_bf16(v1[0], v1[1]); w.w = cvt_pk_bf16(v1[2], v1[3]); *(u32x4*)p = w;
}
__device__ __forceinline__ u32x2 pack8_fp8(const f32x4 v0, const f32x4 v1) {
    int a = 0, b = 0; a = __builtin_amdgcn_cvt_pk_fp8_f32(v0[0], v0[1], a, false); a = __builtin_amdgcn_cvt_pk_fp8_f32(v0[2], v0[3], a, true);
    b = __builtin_amdgcn_cvt_pk_fp8_f32(v1[0], v1[1], b, false); b = __builtin_amdgcn_cvt_pk_fp8_f32(v1[2], v1[3], b, true); return (u32x2){(unsigned)a, (unsigned)b};
}
__device__ __forceinline__ void store8_fp8(unsigned char* p, const f32x4 v0, const f32x4 v1) { *(u32x2*)p = pack8_fp8(v0, v1); }
__device__ __forceinline__ void load8bf(const bf16_t* p, f32x4& v0, f32x4& v1) {
    const u32x4 w = *(const u32x4*)p; v0 = (f32x4){bf_lo(w.x), bf_hi(w.x), bf_lo(w.y), bf_hi(w.y)}; v1 = (f32x4){bf_lo(w.z), bf_hi(w.z), bf_lo(w.w), bf_hi(w.w)};
}
__device__ __forceinline__ void acc_zero(f32x4 (&acc)[2][2][4][2]) {
#pragma unroll
    for (int a = 0; a < 2; ++a)
#pragma unroll
        for (int b = 0; b < 2; ++b)
#pragma unroll
            for (int m = 0; m < 4; ++m)
#pragma unroll
                for (int n = 0; n < 2; ++n) acc[a][b][m][n] = (f32x4){0.f, 0.f, 0.f, 0.f};
}
#define EPI_NO_PRE static constexpr int SCALE_EXP = 121; struct Pre {}; \
    __device__ __forceinline__ void prefetch(Pre&, const Unit&, int, int, int, int) const {} \
    __device__ __forceinline__ void init(f32x4 (&acc)[2][2][4][2], const Pre&) const { acc_zero(acc); }
struct EpiPlain {
    EPI_NO_PRE
    bf16_t* O; int ldc;
    __device__ __forceinline__ void operator()(const f32x4 (&acc)[2][2][4][2], const Unit& u, int wr, int wc, int fr, int fq) const {
        EPI_ROWS_BEGIN
#pragma unroll
        for (int ai = 0; ai < 2; ++ai)
#pragma unroll
            for (int m = 0; m < 4; ++m) { bf16_t* rowp = O + (unsigned)((row0 + ai * HALF + m * 16) * ldc + u.pn * BM + cl);
#pragma unroll
                for (int bj = 0; bj < 2; ++bj) store8(rowp + bj * HALF, acc[ai][bj][m][0], acc[ai][bj][m][1]); asm volatile("" ::: "memory"); }
    }
};
struct EpiIn0 {
    EPI_NO_PRE
    static constexpr float WSI = 1.f;
    bf16_t* O; float qscale;
    __device__ __forceinline__ void operator()(const f32x4 (&acc)[2][2][4][2], const Unit& u, int wr, int wc, int fr, int fq) const {
        EPI_ROWS_BEGIN
        if (u.pn < 4) {
#pragma unroll
            for (int ai = 0; ai < 2; ++ai)
#pragma unroll
                for (int m = 0; m < 4; ++m) { bf16_t* rowp = O + (unsigned)((row0 + ai * HALF + m * 16) * ZE + u.pn * BM + cl);
#pragma unroll
                    for (int bj = 0; bj < 2; ++bj) { f32x4 v0 = acc[ai][bj][m][0] * WSI, v1 = acc[ai][bj][m][1] * WSI;
#pragma unroll
                        for (int j = 0; j < 4; ++j) { v0[j] = gelu_tanh(v0[j]); v1[j] = gelu_tanh(v1[j]); }
                        store8(rowp + bj * HALF, v0, v1); asm volatile("" ::: "memory"); } }
        } else {
            const float sc = (u.pn < 6 ? qscale : 1.f) * WSI;
#pragma unroll
            for (int ai = 0; ai < 2; ++ai)
#pragma unroll
                for (int m = 0; m < 4; ++m) { bf16_t* rowp = O + (unsigned)((row0 + ai * HALF + m * 16) * ZE + u.pn * BM + cl);
#pragma unroll
                    for (int bj = 0; bj < 2; ++bj) store8(rowp + bj * HALF, acc[ai][bj][m][0] * sc, acc[ai][bj][m][1] * sc);
                    asm volatile("" ::: "memory"); }
        }
    }
};
struct EpiIn1 {
    EPI_NO_PRE
    static constexpr float WSI = 1.f;
    bf16_t* O; bf16_t* KV; bf16_t* KI; int pn0;
    __device__ __forceinline__ void operator()(const f32x4 (&acc)[2][2][4][2], const Unit& u_, int wr, int wc, int fr, int fq) const {
        Unit u = u_; u.pn += pn0;
        EPI_ROWS_BEGIN
        if (u.pn == 4 || u.pn == 5) {
            bf16_t* base = KV + (u.pn - 4) * 256 + cl;
#pragma unroll
            for (int ai = 0; ai < 2; ++ai)
#pragma unroll
                for (int m = 0; m < 4; ++m) { bf16_t* rowp = base + (unsigned)((row0 + ai * HALF + m * 16) * 512);
#pragma unroll
                    for (int bj = 0; bj < 2; ++bj) store8(rowp + bj * HALF, acc[ai][bj][m][0] * WSI, acc[ai][bj][m][1] * WSI);
                    asm volatile("" ::: "memory"); }
        } else {
            const float sc = (u.pn < 4 ? 0.125f * LOG2E : 1.f) * WSI;
#pragma unroll
            for (int ai = 0; ai < 2; ++ai)
#pragma unroll
                for (int m = 0; m < 4; ++m) { bf16_t* rowp = O + (unsigned)((row0 + ai * HALF + m * 16) * ZO + u.pn * BM + cl);
#pragma unroll
                    for (int bj = 0; bj < 2; ++bj) store8(rowp + bj * HALF, acc[ai][bj][m][0] * sc, acc[ai][bj][m][1] * sc);
                    asm volatile("" ::: "memory"); }
            if (u.pn == 8 && wc < 2) {
#pragma unroll
                for (int ai = 0; ai < 2; ++ai)
#pragma unroll
                    for (int m = 0; m < 4; ++m) { const int row = row0 + ai * HALF + m * 16;
                        store8(KI + (unsigned)(((((row >> 5) * 4 + (cl >> 4)) * 64) + (((cl >> 3) & 1) * 32 + (row & 31))) * 8), acc[ai][0][m][0] * WSI, acc[ai][0][m][1] * WSI); asm volatile("" ::: "memory"); }
            }
        }
    }
};
struct EpiOut {
    EPI_NO_PRE
    const float* xf; const bf16_t* xb; bf16_t* O;
    __device__ __forceinline__ void operator()(const f32x4 (&acc)[2][2][4][2], const Unit& u, int wr, int wc, int fr, int fq) const {
        EPI_ROWS_BEGIN
#pragma unroll
        for (int ai = 0; ai < 2; ++ai) {
            f32x4 xr[4][2][2];
#pragma unroll
            for (int m = 0; m < 4; ++m) { const unsigned off = (unsigned)((row0 + ai * HALF + m * 16) * DM + u.pn * BM + cl);
#pragma unroll
                for (int bj = 0; bj < 2; ++bj) {
                    if (xf) { xr[m][bj][0] = *(const f32x4*)(xf + off + bj * HALF); xr[m][bj][1] = *(const f32x4*)(xf + off + bj * HALF + 4); }
                    else load8bf(xb + off + bj * HALF, xr[m][bj][0], xr[m][bj][1]); } }
            asm volatile("" ::: "memory");
#pragma unroll
            for (int m = 0; m < 4; ++m) { const unsigned off = (unsigned)((row0 + ai * HALF + m * 16) * DM + u.pn * BM + cl);
#pragma unroll
                for (int bj = 0; bj < 2; ++bj)
                    store8(O + off + bj * HALF, xr[m][bj][0] * ALPHA + acc[ai][bj][m][0], xr[m][bj][1] * ALPHA + acc[ai][bj][m][1]); }
            asm volatile("" ::: "memory");
        }
    }
};
constexpr float SWC = -1.702f * LOG2E;
struct EpiSwiglu {
    static constexpr int SCALE_EXP = 121;
    unsigned char* O; const float* bgu;
    struct Pre { f32x4 b[4]; };
    __device__ __forceinline__ void prefetch(Pre& p, const Unit& u, int wr, int wc, int fr, int fq) const {
        const float* bp = bgu + (unsigned)(u.e * 2048 + u.pn * HALF + wc * 32 + 8 * fq);
        p.b[0] = *(const f32x4*)bp; p.b[1] = *(const f32x4*)(bp + 4); p.b[2] = *(const f32x4*)(bp + 1024); p.b[3] = *(const f32x4*)(bp + 1028);
    }
    __device__ __forceinline__ void init(f32x4 (&acc)[2][2][4][2], const Pre& p) const {
        const f32x4 g0 = p.b[0] * SWC, g1 = p.b[1] * SWC, u0 = (p.b[2] + 1.0f) * (1.0f / SWC), u1 = (p.b[3] + 1.0f) * (1.0f / SWC);
#pragma unroll
        for (int ai = 0; ai < 2; ++ai)
#pragma unroll
            for (int m = 0; m < 4; ++m) { acc[ai][0][m][0] = g0; acc[ai][0][m][1] = g1; acc[ai][1][m][0] = u0; acc[ai][1][m][1] = u1; }
    }
    __device__ __forceinline__ void operator()(const f32x4 (&acc)[2][2][4][2], const Unit& u, int wr, int wc, int fr, int fq) const {
        EPI_ROWS_BEGIN
        const int col = u.pn * HALF + cl;
        float c7 = 7.0f * SWC, ya = -6.0f / SWC, yb = 8.0f / SWC; asm volatile("" : "+v"(c7), "+v"(ya), "+v"(yb));
#pragma unroll
        for (int ai = 0; ai < 2; ++ai)
#pragma unroll
            for (int m = 0; m < 4; ++m) { float t[8], y[8], e[8];
#pragma unroll
                for (int j = 0; j < 8; ++j) { asm("v_max_f32 %0, %1, %2" : "=v"(t[j]) : "v"(acc[ai][0][m][j >> 2][j & 3]), "v"(c7)); }
#pragma unroll
                for (int j = 0; j < 8; ++j) e[j] = __builtin_amdgcn_exp2f(t[j]);
#pragma unroll
                for (int j = 0; j < 8; ++j) { asm("v_med3_f32 %0, %1, %2, %3" : "=v"(y[j]) : "v"(acc[ai][1][m][j >> 2][j & 3]), "v"(ya), "v"(yb)); }
                __builtin_amdgcn_sched_barrier(0);
#pragma unroll
                for (int j = 0; j < 8; ++j) e[j] += 1.0f;
#pragma unroll
                for (int j = 0; j < 8; ++j) e[j] = __builtin_amdgcn_rcpf(e[j]);
#pragma unroll
                for (int j = 0; j < 8; ++j) y[j] *= t[j];
                __builtin_amdgcn_sched_barrier(0);
#pragma unroll
                for (int j = 0; j < 8; ++j) y[j] *= e[j];
                store8_fp8(O + (unsigned)((row0 + ai * HALF + m * 16) * DM + col), (f32x4){y[0], y[1], y[2], y[3]}, (f32x4){y[4], y[5], y[6], y[7]}); asm volatile("" ::: "memory"); }
    }
};
struct EpiDown {
    static constexpr int SCALE_EXP = 125;
    unsigned char* O; const float* bd;
    struct Pre { f32x4 b[2][2]; };
    __device__ __forceinline__ void prefetch(Pre& p, const Unit& u, int wr, int wc, int fr, int fq) const {
        const float* bp = bd + (unsigned)(u.e * DM + u.pn * BM + wc * 32 + 8 * fq);
#pragma unroll
        for (int bj = 0; bj < 2; ++bj) { p.b[bj][0] = *(const f32x4*)(bp + bj * HALF); p.b[bj][1] = *(const f32x4*)(bp + bj * HALF + 4); }
    }
    __device__ __forceinline__ void init(f32x4 (&acc)[2][2][4][2], const Pre& p) const {
#pragma unroll
        for (int bj = 0; bj < 2; ++bj) { const f32x4 b0 = p.b[bj][0] * 16.f, b1 = p.b[bj][1] * 16.f;
#pragma unroll
            for (int ai = 0; ai < 2; ++ai)
#pragma unroll
                for (int m = 0; m < 4; ++m) { acc[ai][bj][m][0] = b0; acc[ai][bj][m][1] = b1; } }
    }
    __device__ __forceinline__ void operator()(const f32x4 (&acc)[2][2][4][2], const Unit& u, int wr, int wc, int fr, int fq) const {
        EPI_ROWS_BEGIN
        const int col = u.pn * BM + cl;
#pragma unroll
        for (int ai = 0; ai < 2; ++ai)
#pragma unroll
            for (int m = 0; m < 4; ++m) { const int row = row0 + ai * HALF + m * 16;
#pragma unroll
                for (int bj = 0; bj < 2; ++bj) store8_fp8(O + (unsigned)(row * DM + col + bj * HALF), acc[ai][bj][m][0], acc[ai][bj][m][1]);
                asm volatile("" ::: "memory"); }
    }
};
struct EpiGate {
    EPI_NO_PRE
    const bf16_t* mid; const bf16_t* P; const float* bg; bf16_t* O;
    __device__ __forceinline__ void operator()(const f32x4 (&acc)[2][2][4][2], const Unit& u, int wr, int wc, int fr, int fq) const {
        EPI_ROWS_BEGIN
        const int col = u.pn * BM + cl;
        f32x4 bv[2][2];
#pragma unroll
        for (int bj = 0; bj < 2; ++bj) { bv[bj][0] = *(const f32x4*)(bg + col + bj * HALF); bv[bj][1] = *(const f32x4*)(bg + col + bj * HALF + 4); }
#pragma unroll
        for (int ai = 0; ai < 2; ++ai) {
            u32x4 mr[4][2], pr[4][2];
#pragma unroll
            for (int m = 0; m < 4; ++m) { const unsigned off = (unsigned)((row0 + ai * HALF + m * 16) * DM + col);
#pragma unroll
                for (int bj = 0; bj < 2; ++bj) { mr[m][bj] = *(const u32x4*)(mid + off + bj * HALF); pr[m][bj] = *(const u32x4*)(P + off + bj * HALF); } }
            asm volatile("" ::: "memory");
#pragma unroll
            for (int m = 0; m < 4; ++m) { const unsigned off = (unsigned)((row0 + ai * HALF + m * 16) * DM + col);
#pragma unroll
                for (int bj = 0; bj < 2; ++bj) { const u32x4 mw = mr[m][bj], pw = pr[m][bj];
                    const f32x4 m0 = {bf_lo(mw.x), bf_hi(mw.x), bf_lo(mw.y), bf_hi(mw.y)}, m1 = {bf_lo(mw.z), bf_hi(mw.z), bf_lo(mw.w), bf_hi(mw.w)};
                    const f32x4 p0 = {bf_lo(pw.x), bf_hi(pw.x), bf_lo(pw.y), bf_hi(pw.y)}, p1 = {bf_lo(pw.z), bf_hi(pw.z), bf_lo(pw.w), bf_hi(pw.w)};
                    f32x4 r0, r1;
                    const f32x4 a0 = acc[ai][bj][m][0] + bv[bj][0], a1 = acc[ai][bj][m][1] + bv[bj][1];
#pragma unroll
                    for (int j = 0; j < 4; ++j) { r0[j] = m0[j] + sigmoidf_(a0[j]) * p0[j]; r1[j] = m1[j] + sigmoidf_(a1[j]) * p1[j]; }
                    store8(O + off + bj * HALF, r0, r1); } }
            asm volatile("" ::: "memory");
        }
    }
};
}

#define XB_TMO      128
#define XB_XCNT(j)  (256  + 64 * (j))
#define XB_XSUB(j)  (1280 + 64 * (j))
#define XB_XGEN(j)  (2304 + 64 * (j))
#define XB_TOP      3328
#define XB_TOPGEN   3392
#define XCD_BAR_WORDS 3456
#define XB_SPIN_CAP (1u << 18)
__device__ __forceinline__ unsigned xb_ld(unsigned* p)              { return __hip_atomic_load(p, __ATOMIC_RELAXED, __HIP_MEMORY_SCOPE_AGENT); }
__device__ __forceinline__ unsigned xb_add(unsigned* p, unsigned v) { return __hip_atomic_fetch_add(p, v, __ATOMIC_RELAXED, __HIP_MEMORY_SCOPE_AGENT); }
__device__ __forceinline__ unsigned xb_xcc_id() { return (unsigned)__builtin_amdgcn_s_getreg((3 << 11) | 20) & 0xFu; }
#define XB_SPIN(cond, bar) do { unsigned _sp = 0; while (cond) { __builtin_amdgcn_s_sleep(1); \
    if ((++_sp & 255u) == 0u) { if (xb_ld(&(bar)[XB_TMO])) break; if (_sp > XB_SPIN_CAP) { atomicAdd(&(bar)[XB_TMO], 1u); break; } } } } while (0)
struct XcdBarrier { unsigned* bar; unsigned x; volatile LAS unsigned* st; };
__device__ __forceinline__ XcdBarrier xcd_barrier_post(unsigned* bar, volatile LAS unsigned* st) {
    XcdBarrier b; b.bar = bar; b.x = xb_xcc_id(); b.st = st;
    if (threadIdx.x == 0) (void)xb_add(&bar[XB_XCNT(b.x)], 1u);
    return b;
}
__device__ __forceinline__ void xcd_barrier_complete(unsigned* bar, unsigned x, unsigned& nloc, unsigned& nx) {
    const unsigned G = gridDim.x * gridDim.y * gridDim.z;
    unsigned sum, cnt, mine, sp = 0u;
    for (;;) {
        sum = 0u; cnt = 0u; mine = 0u;
#pragma unroll
        for (unsigned j = 0; j < 16; ++j) { const unsigned c = xb_ld(&bar[XB_XCNT(j)]); sum += c; cnt += (c > 0u) ? 1u : 0u; mine = (j == x) ? c : mine; }
        if (sum == G) break;
        __builtin_amdgcn_s_sleep(1);
        if ((++sp & 255u) == 0u) { if (xb_ld(&bar[XB_TMO])) break; if (sp > XB_SPIN_CAP) { atomicAdd(&bar[XB_TMO], 1u); break; } }
    }
    nloc = mine > 0u ? mine : 1u; nx = cnt > 0u ? cnt : 1u;
}
__device__ __forceinline__ void xcd_barrier(const XcdBarrier& b) {
    asm volatile("s_waitcnt vmcnt(0)" ::: "memory");
    __syncthreads();
    if (threadIdx.x == 0) {
        unsigned* bar = b.bar; asm volatile("" : "+s"(bar));
        unsigned bx = b.x; asm volatile("" : "+s"(bx));
        __builtin_amdgcn_s_waitcnt(0);
        unsigned nloc = b.st[0], nx = b.st[1];
        if (nloc == 0u) { xcd_barrier_complete(bar, bx, nloc, nx); b.st[0] = nloc; b.st[1] = nx; }
        const unsigned old = xb_add(&bar[XB_XSUB(bx)], 1u);
        const unsigned gen = old / nloc;
        if (old + 1u == (gen + 1u) * nloc) {
            __builtin_amdgcn_fence(__ATOMIC_RELEASE, "agent");
            asm volatile("s_waitcnt vmcnt(0)" ::: "memory");
            const unsigned og = xb_add(&bar[XB_TOP], 1u);
            const unsigned tg = og / nx;
            if (og + 1u == (tg + 1u) * nx) xb_add(&bar[XB_TOPGEN], 1u);
            else XB_SPIN(xb_ld(&bar[XB_TOPGEN]) == tg, bar);
            __builtin_amdgcn_fence(__ATOMIC_ACQUIRE, "agent");
            xb_add(&bar[XB_XGEN(bx)], 1u);
            asm volatile("s_waitcnt vmcnt(0)" ::: "memory");
        } else {
            XB_SPIN(xb_ld(&bar[XB_XGEN(bx)]) == gen, bar);
            __builtin_amdgcn_fence(__ATOMIC_ACQUIRE, "agent");
            asm volatile("s_waitcnt vmcnt(0)" ::: "memory");
        }
    }
    __syncthreads();
}

constexpr int NWAVES = 8, NTHR = 512;
struct Args { const float* in[23]; float* out; unsigned char* ws; int ph_lo, ph_hi; };
struct Frame { LAS unsigned char* lds; int tid, lane, wave, G, bid; };
#define LDS_WAIT() asm volatile("s_waitcnt lgkmcnt(0)" ::: "memory")
#define LDS_BARRIER() asm volatile("s_waitcnt lgkmcnt(0)\n\ts_barrier" ::: "memory")

template <bool F8>
__device__ __forceinline__ void p0_transpose_item(const float* W, int K, int N, int Npad, void* WT_, LAS float* scr, int item, int lane) {
    const int nblk = Npad / 32, kb = item / nblk, nb = item % nblk, k0 = 128 * kb, n0 = 32 * nb;
    const int r = lane >> 3, c4 = (lane & 7) * 4;
    const bool ok = n0 + c4 < N;
    const float* src = W + (size_t)(k0 + r) * N + (ok ? n0 + c4 : 0);
    f32x4 v[16];
#pragma unroll
    for (int i = 0; i < 16; ++i) v[i] = *(const f32x4*)(src + (size_t)(8 * i) * N);
    __builtin_amdgcn_sched_barrier(0);
    const float sc = ok ? (F8 ? WSC : 1.f) : 0.f;
#pragma unroll
    for (int i = 0; i < 16; ++i) *(LAS f32x4*)(scr + (8 * i + r) * 32 + (c4 ^ ((i >> 1) << 2))) = v[i] * sc;
    LDS_WAIT(); asm volatile("" ::: "memory");
    const int c = lane & 7;
#pragma unroll
    for (int j = 0; j < 4; ++j) { const int nn = (lane >> 3) + 8 * j; const LAS float* sp = scr + (16 * c) * 32 + (nn ^ (c << 2));
        float t[16];
#pragma unroll
        for (int q = 0; q < 16; ++q) t[q] = sp[q * 32];
        if constexpr (F8) { const u32x2 lo = pg8::pack8_fp8(f32x4{t[0], t[1], t[2], t[3]}, f32x4{t[4], t[5], t[6], t[7]}), hi = pg8::pack8_fp8(f32x4{t[8], t[9], t[10], t[11]}, f32x4{t[12], t[13], t[14], t[15]});
            u32x4 o; o.x = lo.x; o.y = lo.y; o.z = hi.x; o.w = hi.y; *(u32x4*)((unsigned char*)WT_ + (size_t)(n0 + nn) * K + k0 + 16 * c) = o; }
        else { u32x4 o0, o1; o0.x = cvt_pk_bf16(t[0], t[1]); o0.y = cvt_pk_bf16(t[2], t[3]); o0.z = cvt_pk_bf16(t[4], t[5]); o0.w = cvt_pk_bf16(t[6], t[7]);
            o1.x = cvt_pk_bf16(t[8], t[9]); o1.y = cvt_pk_bf16(t[10], t[11]); o1.z = cvt_pk_bf16(t[12], t[13]); o1.w = cvt_pk_bf16(t[14], t[15]);
            bf16_t* d = (bf16_t*)WT_ + (size_t)(n0 + nn) * K + k0 + 16 * c; *(u32x4*)d = o0; *(u32x4*)(d + 8) = o1; } }
    LDS_WAIT(); asm volatile("" ::: "memory");
}
template <int U, bool F8>
__device__ __forceinline__ void cvt_stream(const float* src, void* dst_, size_t n, int gtid, int gthreads) {
    const size_t st = (size_t)gthreads * 8;
    size_t i = (size_t)gtid * 8;
    for (; i + (U - 1) * st < n; i += U * st) {
        f32x4 a[U], b[U];
#pragma unroll
        for (int q = 0; q < U; ++q) { const float* p = src + i + q * st; a[q] = *(const f32x4*)p; b[q] = *(const f32x4*)(p + 4); }
        __builtin_amdgcn_sched_barrier(0);
#pragma unroll
        for (int q = 0; q < U; ++q) { const size_t o = i + q * st;
            if constexpr (F8) *(u32x2*)((unsigned char*)dst_ + o) = pg8::pack8_fp8(a[q], b[q]);
            else { u32x4 w; w.x = cvt_pk_bf16(a[q][0], a[q][1]); w.y = cvt_pk_bf16(a[q][2], a[q][3]); w.z = cvt_pk_bf16(b[q][0], b[q][1]); w.w = cvt_pk_bf16(b[q][2], b[q][3]); *(u32x4*)((bf16_t*)dst_ + o) = w; } }
    }
    for (; i < n; i += st) { const f32x4 a = *(const f32x4*)(src + i), b = *(const f32x4*)(src + i + 4);
        if constexpr (F8) *(u32x2*)((unsigned char*)dst_ + i) = pg8::pack8_fp8(a, b);
        else { u32x4 w; w.x = cvt_pk_bf16(a[0], a[1]); w.y = cvt_pk_bf16(a[2], a[3]); w.z = cvt_pk_bf16(b[0], b[1]); w.w = cvt_pk_bf16(b[2], b[3]); *(u32x4*)((bf16_t*)dst_ + i) = w; } }
}
struct P0Desc { const float* W; unsigned char* WT; int K, N, Npad, tile, f8; float s0, s1; int split; };
constexpr int P0_IN0 = 8 * (ZE / 256), P0_SQ = 8 * 4, P0_IN1 = 8 * (ZO / 256), P0_PLE = 2 * 4, P0_GU = 8 * 8;
constexpr int P0_IN1Q = FP8_IN1Q ? 8 * 6 : 0;
constexpr int P0_C0 = P0_IN0, P0_C1 = P0_C0 + P0_SQ, P0_C2 = P0_C1 + P0_IN1, P0_C3 = P0_C2 + P0_SQ, P0_C4 = P0_C3 + 2 * P0_SQ, P0_C5 = P0_C4 + 2 * P0_PLE, P0_C6 = P0_C5 + 64 * P0_GU, P0_C7Q = P0_C6 + 64 * P0_SQ, P0_C7 = P0_C7Q + P0_IN1Q;
__device__ __forceinline__ P0Desc p0_desc(const Args& a, int it) {
    unsigned char* ws = a.ws;
    if (it < P0_C0) return P0Desc{a.in[2], ws + WS_WIN0, DM, ZE, ZE, it, FP8_IN0, FP8_IN0 ? WSC : 1.f, FP8_IN0 ? WSC : 1.f, 0};
    if (it < P0_C1) return P0Desc{a.in[7], ws + WS_WO0, DM, DM, DM, it - P0_C0, FP8_OUT, FP8_OUT ? WSC : 1.f, FP8_OUT ? WSC : 1.f, 0};
    if (it < P0_C2) return P0Desc{a.in[8], ws + WS_WIN1, DM, ZO_REAL, ZO, it - P0_C1, FP8_IN1, FP8_IN1 ? WSC : 1.f, FP8_IN1 ? WSC : 1.f, 0};
    if (it < P0_C3) return P0Desc{a.in[9], ws + WS_WO1, DM, DM, DM, it - P0_C2, FP8_OUT, FP8_OUT ? WSC : 1.f, FP8_OUT ? WSC : 1.f, 0};
    if (it < P0_C4) { const int r = it - P0_C3, l = r / P0_SQ; return P0Desc{a.in[21] + (size_t)l * DM * DM, ws + WS_WG + (size_t)l * DM * DM * (FP8_GATE ? 1 : 2), DM, DM, DM, r % P0_SQ, FP8_GATE, FP8_GATE ? WSC : 1.f, FP8_GATE ? WSC : 1.f, 0}; }
    if (it < P0_C5) { const int r = it - P0_C4, l = r / P0_PLE; return P0Desc{a.in[20] + (size_t)l * PLE * DM, ws + WS_WPLE + (size_t)l * DM * PLE * 2, PLE, DM, DM, r % P0_PLE, 0, 1.f, 1.f, 0}; }
    if (it < P0_C6) { const int r = it - P0_C5, l = r / P0_GU; return P0Desc{a.in[14] + (size_t)l * DM * 2048, ws + WS_WGU + (size_t)l * 2048 * DM, DM, 2048, 2048, r % P0_GU, 1, WSC * pg8::SWC, WSC / pg8::SWC, 1024}; }
    if (it >= P0_C7Q) return P0Desc{a.in[8], ws + WS_WIN1Q, DM, ZO_REAL, 1536, it - P0_C7Q, 1, WSC, WSC, 0};
    const int r = it - P0_C6, l = r / P0_SQ; return P0Desc{a.in[16] + (size_t)l * DM * DM, ws + WS_WD + (size_t)l * DM * DM, DM, DM, DM, r % P0_SQ, 1, WSC, WSC, 0};
}
__device__ __forceinline__ void p0_tile_load(const P0Desc& d, int wave, int lane, f32x4 (&v)[16], float& sc) {
    const int nblk = d.Npad / 256, kb = d.tile / nblk, nb = d.tile % nblk;
    const int n = nb * 256 + 4 * lane; const bool ok = n < d.N;
    const float* src = d.W + (size_t)(kb * 128 + 16 * wave) * d.N + (ok ? n : 0);
#pragma unroll
    for (int i = 0; i < 16; ++i) v[i] = *(const f32x4*)(src + (size_t)i * d.N);
    sc = ok ? (n < d.split ? d.s0 : d.s1) : 0.f;
}
__device__ __forceinline__ void p0_tile_emit(const P0Desc& d, LAS float* img, int wave, int lane) {
    const int nblk = d.Npad / 256, kb = d.tile / nblk, nb = d.tile % nblk, k0 = 128 * kb, n0 = 256 * nb;
    const int c = lane & 7;
#pragma unroll
    for (int j = 0; j < 4; ++j) { const int nn = 32 * wave + (lane >> 3) + 8 * j; const LAS float* sp = img + (16 * c) * 256 + (nn ^ (c << 2));
        float t[16];
#pragma unroll
        for (int q = 0; q < 16; ++q) t[q] = sp[q * 256];
        const size_t o = (size_t)(n0 + nn) * d.K + k0 + 16 * c;
        if (d.f8) { const u32x2 lo = pg8::pack8_fp8(f32x4{t[0], t[1], t[2], t[3]}, f32x4{t[4], t[5], t[6], t[7]}), hi = pg8::pack8_fp8(f32x4{t[8], t[9], t[10], t[11]}, f32x4{t[12], t[13], t[14], t[15]});
            u32x4 w; w.x = lo.x; w.y = lo.y; w.z = hi.x; w.w = hi.y; *(u32x4*)(d.WT + o) = w; }
        else { u32x4 o0, o1; o0.x = cvt_pk_bf16(t[0], t[1]); o0.y = cvt_pk_bf16(t[2], t[3]); o0.z = cvt_pk_bf16(t[4], t[5]); o0.w = cvt_pk_bf16(t[6], t[7]);
            o1.x = cvt_pk_bf16(t[8], t[9]); o1.y = cvt_pk_bf16(t[10], t[11]); o1.z = cvt_pk_bf16(t[12], t[13]); o1.w = cvt_pk_bf16(t[14], t[15]);
            bf16_t* dp = (bf16_t*)d.WT + o; *(u32x4*)dp = o0; *(u32x4*)(dp + 8) = o1; } }
}
__device__ __forceinline__ void p0_prologue(Frame& F, const Args& a) {
    unsigned char* ws = a.ws;
    LAS float* img = (LAS float*)F.lds;
    { const int TOT = P0_C7 * PM(0);
      int it = F.bid; f32x4 v[16]; float sc = 0.f; P0Desc d = p0_desc(a, it % P0_C7);
      if (it < TOT) p0_tile_load(d, F.wave, F.lane, v, sc);
      for (; it < TOT; it += F.G) {
#pragma unroll
        for (int i = 0; i < 16; ++i) *(LAS f32x4*)(img + (16 * F.wave + i) * 256 + ((4 * F.lane) ^ (F.wave << 2))) = v[i] * sc;
        LDS_BARRIER();
        const P0Desc dc = d; const int nx = it + F.G;
        if (nx < TOT) { d = p0_desc(a, nx % P0_C7); p0_tile_load(d, F.wave, F.lane, v, sc); }
        __builtin_amdgcn_sched_barrier(0);
        p0_tile_emit(dc, img, F.wave, F.lane);
        LDS_BARRIER();
      } }
    {
      LAS float* scr = (LAS float*)(F.lds + F.wave * 16384);
      const int gw = F.bid * NWAVES + F.wave;
      if (gw < 16) p0_transpose_item<false>(a.in[12] + (size_t)(gw >> 3) * DM * NEXP, DM, NEXP, NEXP, (bf16_t*)(ws + WS_WRT) + (size_t)(gw >> 3) * NEXP * DM, scr, gw & 7, F.lane); }
    const int gtid = F.bid * NTHR + F.tid, gth = F.G * NTHR;
    if (!FP8_IN0) cvt_stream<8, false>(a.in[0], ws + WS_XB, (size_t)NTOK * DM, gtid, gth);
    else cvt_stream<8, true>(a.in[0], ws + WS_XQ, (size_t)NTOK * DM, gtid, gth);
    cvt_stream<8, false>(a.in[1], ws + WS_PB, (size_t)2 * NTOK * PLE, gtid, gth);
    for (int i = gtid; i < 8 * 128 * 128; i += gth) { const int t = (i >> 7) & 127, s = i & 127; const float v = (s <= t) ? a.in[5][i] : 0.f; ((bf16_t*)(ws + WS_WSB))[i] = (bf16_t)(cvt_pk_bf16(v, 0.f) & 0xffffu); }
}

__device__ __forceinline__ void gmlp_unit(Frame& F, const Args& a, int unit) {
    const bf16_t* z0 = (const bf16_t*)(a.ws + WS_Z); unsigned char* cat = (unsigned char*)(a.ws + WS_CAT); const bf16_t* wsb = (const bf16_t*)(a.ws + WS_WSB);
    const float* lng = a.in[3]; const float* lnb = a.in[4]; const float* bs = a.in[6];
    const size_t tok0 = (size_t)unit * 128;
    const int lane = F.lane, w = F.wave, r32 = lane & 31, hi = lane >> 5;
    LAS f32x2* stats = (LAS f32x2*)(F.lds + XTRA_OFF);
    for (int i = 0; i < 16; ++i) { const int tl = w * 16 + i;
        const u32x4 v = *(const u32x4*)(z0 + (tok0 + tl) * ZE + 512 + 8 * lane);
        float x[8] = {bf_lo(v.x), bf_hi(v.x), bf_lo(v.y), bf_hi(v.y), bf_lo(v.z), bf_hi(v.z), bf_lo(v.w), bf_hi(v.w)};
        float s = 0.f;
#pragma unroll
        for (int j = 0; j < 8; ++j) s += x[j];
        const float mean = wave_sum(s) * (1.f / 512.f); float q = 0.f;
#pragma unroll
        for (int j = 0; j < 8; ++j) { const float d = x[j] - mean; q += d * d; }
        const float rstd = 1.f / sqrtf(wave_sum(q) * (1.f / 512.f) + LN_EPS);
        if (lane == 0) stats[tl] = (f32x2){mean, rstd}; }
    __syncthreads();
    const int g = w;
    LAS unsigned char* vt = F.lds + w * 16384;
    { const int tl8 = lane >> 3, cc = lane & 7;
      float gg[8], bb[8];
#pragma unroll
      for (int j = 0; j < 8; ++j) { gg[j] = lng[g * 64 + 8 * cc + j]; bb[j] = lnb[g * 64 + 8 * cc + j]; }
      for (int it = 0; it < 16; ++it) { const int tl = 8 * it + tl8;
          const u32x4 v = *(const u32x4*)(z0 + (tok0 + tl) * ZE + 512 + g * 64 + 8 * cc);
          const f32x2 st = stats[tl];
          float x[8] = {bf_lo(v.x), bf_hi(v.x), bf_lo(v.y), bf_hi(v.y), bf_lo(v.z), bf_hi(v.z), bf_lo(v.w), bf_hi(v.w)};
#pragma unroll
          for (int j = 0; j < 8; ++j) { const int c = 8 * cc + j; const float y = (x[j] - st.x) * st.y * gg[j] + bb[j];
              *(LAS bf16_t*)(vt + c * 256 + ((((tl >> 3) ^ (c & 15))) << 4) + (tl & 7) * 2) = (bf16_t)(cvt_pk_bf16(y, 0.f) & 0xffffu); } } }
    LDS_WAIT(); asm volatile("" ::: "memory");
    for (int tb = 0; tb < 4; ++tb) {
        f32x16 d0 = {}, d1 = {};
        const bf16_t* wrow = wsb + ((size_t)g * 128 + tb * 32 + r32) * 128 + 8 * hi;
        bf16x8 afr[8];
#pragma unroll
        for (int ks = 0; ks < 8; ++ks) afr[ks] = *(const bf16x8*)(wrow + 16 * ks);
#pragma unroll
        for (int ks = 0; ks < 8; ++ks) { if (ks >= 2 * (tb + 1)) break;
            const bf16x8 af = afr[ks];
            const int chunk = 2 * ks + hi;
            const bf16x8 b0 = *(const LAS bf16x8*)(vt + r32 * 256 + ((chunk ^ (r32 & 15)) << 4));
            const bf16x8 b1 = *(const LAS bf16x8*)(vt + (32 + r32) * 256 + ((chunk ^ (r32 & 15)) << 4));
            d0 = __builtin_amdgcn_mfma_f32_32x32x16_bf16(af, b0, d0, 0, 0, 0);
            d1 = __builtin_amdgcn_mfma_f32_32x32x16_bf16(af, b1, d1, 0, 0, 0);
        }
#pragma unroll
        for (int r = 0; r < 16; ++r) { const int t = tb * 32 + (r & 3) + 8 * (r >> 2) + 4 * hi; const float bsv = bs[g * 128 + t];
            const size_t ro = (tok0 + t) * ZE + g * 64 + r32; const size_t co = (tok0 + t) * DM + g * 64 + r32;
            const float u0 = bf1(z0[ro]), u1 = bf1(z0[ro + 32]);
            CAT_ST(cat, co, u0 * (d0[r] + bsv)); CAT_ST(cat, co + 32, u1 * (d1[r] + bsv)); }
    }
    __syncthreads();
}

constexpr int SB_KST = 144;
constexpr int SB_TILE = 64 * SB_KST;
__device__ __forceinline__ void sb_unit(Frame& F, const Args& a, int b, int h, int qb) {
    const bf16_t* z0 = (const bf16_t*)(a.ws + WS_Z); unsigned char* cat = (unsigned char*)(a.ws + WS_CAT);
    const int tid = F.tid, lane = F.lane, wid = F.wave, r32 = lane & 31, hi = lane >> 5;
    const size_t rowbase = (size_t)b * SEQ;
    const int q0 = qb * 256, qw0 = q0 + wid * 32, tq = qw0 + r32;
    bf16x8 qr[4];
    { const bf16_t* qp = z0 + (rowbase + tq) * ZE + 1024 + h * 64 + hi * 8;
#pragma unroll
      for (int ks = 0; ks < 4; ++ks) qr[ks] = *(const bf16x8*)(qp + ks * 16); }
    f32x16 o0 = {}, o1 = {}; float C = 1.f;
    const int ntile = q0 / 64 + 4;
    LAS unsigned char* Kb = F.lds; LAS unsigned char* Vb = F.lds + 2 * SB_TILE;
    const bf16_t* kg = z0 + (rowbase + (tid >> 3)) * ZE + 1536 + h * 64 + (tid & 7) * 8;
    const unsigned ldst = (unsigned)(tid >> 3) * SB_KST + (unsigned)(tid & 7) * 16;
    { const size_t go = (size_t)(ntile - 1) * 64 * ZE; const u32x4 kn = *(const u32x4*)(kg + go), vn = *(const u32x4*)(kg + go + 512);
      *(LAS u32x4*)(Kb + ldst) = kn; *(LAS u32x4*)(Vb + ldst) = vn; }
    const int dh = (lane >> 4) & 1, q_ = (lane & 15) >> 2, p_ = lane & 3;
    for (int kt = ntile - 1; kt >= 0; --kt) {
        const int buf = (ntile - 1 - kt) & 1;
        u32x4 kn, vn;
        if (kt > 0) { const size_t go = (size_t)(kt - 1) * 64 * ZE; kn = *(const u32x4*)(kg + go); vn = *(const u32x4*)(kg + go + 512); }
        LDS_BARRIER();
        const LAS unsigned char* Kc = Kb + buf * SB_TILE; const LAS unsigned char* Vc = Vb + buf * SB_TILE;
        if (64 * kt <= qw0) {
            f32x16 p[2]; p[0] = (f32x16){}; p[1] = (f32x16){};
#pragma unroll
            for (int ks = 0; ks < 4; ++ks) {
                const bf16x8 k0 = *(const LAS bf16x8*)(Kc + r32 * SB_KST + (16 * ks + 8 * hi) * 2);
                const bf16x8 k1 = *(const LAS bf16x8*)(Kc + (32 + r32) * SB_KST + (16 * ks + 8 * hi) * 2);
                p[0] = __builtin_amdgcn_mfma_f32_32x32x16_bf16(k0, qr[ks], p[0], 0, 0, 0);
                p[1] = __builtin_amdgcn_mfma_f32_32x32x16_bf16(k1, qr[ks], p[1], 0, 0, 0);
            }
            const bool need_mask = (64 * kt + 64 > qw0);
            const int kb0 = 64 * kt + 4 * hi;
            float NB[2][16], BE[2][16];
            if (need_mask) {
#pragma unroll
                for (int bk = 0; bk < 2; ++bk)
#pragma unroll
                    for (int r = 0; r < 16; ++r) { const float rc = rcpf_(1.f + ex2(-p[bk][r]));
                        const int key = kb0 + 32 * bk + 8 * (r >> 2) + (r & 3); const bool ok = key < tq;
                        BE[bk][r] = ok ? rc : 0.f; NB[bk][r] = ok ? 1.f - rc : 1.f; }
            } else {
#pragma unroll
                for (int bk = 0; bk < 2; ++bk)
#pragma unroll
                    for (int r = 0; r < 16; ++r) { const float rc = rcpf_(1.f + ex2(-p[bk][r])); BE[bk][r] = rc; NB[bk][r] = 1.f - rc; }
            }
            float acc_c = C;
#pragma unroll
            for (int bk = 1; bk >= 0; --bk)
#pragma unroll
                for (int aa = 3; aa >= 0; --aa) {
                    const float R = (NB[bk][4 * aa] * NB[bk][4 * aa + 1]) * (NB[bk][4 * aa + 2] * NB[bk][4 * aa + 3]);
                    const auto rr = __builtin_amdgcn_permlane32_swap(__float_as_uint(R), __float_as_uint(R), false, false);
                    const float Rp = hi ? __uint_as_float(rr[0]) : __uint_as_float(rr[1]);
                    const float a3 = hi ? acc_c : acc_c * Rp, a2 = a3 * NB[bk][4 * aa + 3], a1 = a2 * NB[bk][4 * aa + 2], a0 = a1 * NB[bk][4 * aa + 1];
                    p[bk][4 * aa + 3] = BE[bk][4 * aa + 3] * a3; p[bk][4 * aa + 2] = BE[bk][4 * aa + 2] * a2;
                    p[bk][4 * aa + 1] = BE[bk][4 * aa + 1] * a1; p[bk][4 * aa + 0] = BE[bk][4 * aa + 0] * a0;
                    acc_c *= R * Rp;
                }
            C = acc_c;
            bf16x8 pa[2][2];
#pragma unroll
            for (int bk = 0; bk < 2; ++bk)
#pragma unroll
                for (int s = 0; s < 2; ++s) { u32x4 w; w.x = cvt_pk_bf16(p[bk][8 * s + 0], p[bk][8 * s + 1]); w.y = cvt_pk_bf16(p[bk][8 * s + 2], p[bk][8 * s + 3]);
                    w.z = cvt_pk_bf16(p[bk][8 * s + 4], p[bk][8 * s + 5]); w.w = cvt_pk_bf16(p[bk][8 * s + 6], p[bk][8 * s + 7]); pa[bk][s] = __builtin_bit_cast(bf16x8, w); }
#pragma unroll
            for (int bk = 0; bk < 2; ++bk)
#pragma unroll
                for (int s = 0; s < 2; ++s) {
                    const LAS unsigned char* vp = Vc + (32 * bk + 16 * s + 4 * hi + q_) * SB_KST + (16 * dh + 4 * p_) * 2;
                    const s16x4 l0 = __builtin_amdgcn_ds_read_tr16_b64_v4i16((LAS s16x4*)(vp));
                    const s16x4 h0 = __builtin_amdgcn_ds_read_tr16_b64_v4i16((LAS s16x4*)(vp + 8 * SB_KST));
                    const s16x4 l1 = __builtin_amdgcn_ds_read_tr16_b64_v4i16((LAS s16x4*)(vp + 64));
                    const s16x4 h1 = __builtin_amdgcn_ds_read_tr16_b64_v4i16((LAS s16x4*)(vp + 8 * SB_KST + 64));
                    const bf16x8 v0 = (bf16x8){l0[0], l0[1], l0[2], l0[3], h0[0], h0[1], h0[2], h0[3]};
                    const bf16x8 v1 = (bf16x8){l1[0], l1[1], l1[2], l1[3], h1[0], h1[1], h1[2], h1[3]};
                    o0 = __builtin_amdgcn_mfma_f32_32x32x16_bf16(pa[bk][s], v0, o0, 0, 0, 0);
                    o1 = __builtin_amdgcn_mfma_f32_32x32x16_bf16(pa[bk][s], v1, o1, 0, 0, 0);
                }
        }
        if (kt > 0) { *(LAS u32x4*)(Kb + (buf ^ 1) * SB_TILE + ldst) = kn; *(LAS u32x4*)(Vb + (buf ^ 1) * SB_TILE + ldst) = vn; }
    }
#pragma unroll
    for (int r = 0; r < 16; ++r) { const int q = (r & 3) + 8 * (r >> 2) + 4 * hi;
        const size_t oo = (rowbase + qw0 + q) * DM + 512 + h * 64 + r32;
        CAT_ST(cat, oo, o0[r]); CAT_ST(cat, oo + 32, o1[r]); }
    __syncthreads();
}

template <int I> struct SelStep {
    static __device__ __forceinline__ void run(const float (&v)[64], float thr, float lo, bool exact, int need_eq, int& eq_seen, unsigned& m0, unsigned& m1) {
        const bool gt = v[I] > thr; const bool eq = (!exact) && !gt && (v[I] > lo);
        const unsigned long long meq = __ballot(eq);
        const int eq_rank = eq_seen + __builtin_amdgcn_mbcnt_hi((unsigned)(meq >> 32), __builtin_amdgcn_mbcnt_lo((unsigned)meq, 0));
        const bool take = gt || (eq && eq_rank < need_eq);
        const unsigned long long mt = __ballot(take);
        const unsigned mlo = (unsigned)mt, mhi = (unsigned)(mt >> 32);
        asm volatile("s_nop 1\n\tv_writelane_b32 %0, %1, %2" : "+v"(m0) : "s"(mlo), "n"(I));
        asm volatile("s_nop 1\n\tv_writelane_b32 %0, %1, %2" : "+v"(m1) : "s"(mhi), "n"(I));
        eq_seen += __builtin_popcountll(meq);
        SelStep<I + 1>::run(v, thr, lo, exact, need_eq, eq_seen, m0, m1);
    }
};
template <> struct SelStep<64> { static __device__ __forceinline__ void run(const float (&)[64], float, float, bool, int, int&, unsigned&, unsigned&) {} };

template <int I> struct SelExact {
    static __device__ __forceinline__ void run(const float (&v)[64], float thr, unsigned& m0, unsigned& m1) {
        const unsigned long long mt = __ballot(v[I] > thr);
        const unsigned mlo = (unsigned)mt, mhi = (unsigned)(mt >> 32);
        asm volatile("s_nop 1\n\tv_writelane_b32 %0, %1, %2" : "+v"(m0) : "s"(mlo), "n"(I));
        asm volatile("s_nop 1\n\tv_writelane_b32 %0, %1, %2" : "+v"(m1) : "s"(mhi), "n"(I));
        SelExact<I + 1>::run(v, thr, m0, m1);
    }
};
template <> struct SelExact<64> { static __device__ __forceinline__ void run(const float (&)[64], float, unsigned&, unsigned&) {} };

__device__ __forceinline__ void dsa_select_unit(Frame& F, const Args& a, int unit) {
    const bf16_t* z1 = (const bf16_t*)(a.ws + WS_Z); unsigned* bm = (unsigned*)(a.ws + WS_BM);
    const int lane = F.lane, wid = F.wave, r32 = lane & 31, hi = lane >> 5;
    const int tok0 = unit * 8;
    const int b = tok0 / SEQ, t0 = tok0 % SEQ;
    const size_t rowbase = (size_t)b * SEQ;
    const int vis = (t0 / 64 + 1) * 64;
    LAS float* sc = (LAS float*)F.lds;
    if (vis > 256) {
        const int tl = 2 * (r32 >> 4) + ((r32 >> 2) & 1), hd = (r32 & 3) + 4 * ((r32 >> 3) & 1);
        bf16x8 af[2][4];
#pragma unroll
        for (int rt = 0; rt < 2; ++rt) { const bf16_t* qp = z1 + (size_t)(tok0 + 4 * rt + tl) * ZO + OQI + hd * 64 + 8 * hi;
#pragma unroll
            for (int ks = 0; ks < 4; ++ks) af[rt][ks] = *(const bf16x8*)(qp + 16 * ks); }
        float wv[4][8];
#pragma unroll
        for (int j = 0; j < 4; ++j) { const u32x4 w = *(const u32x4*)(z1 + (size_t)(tok0 + 2 * j + hi) * ZO + OWI);
            const float s = 0.35355339059f * 0.125f;
            wv[j][0] = bf_lo(w.x) * s; wv[j][1] = bf_hi(w.x) * s; wv[j][2] = bf_lo(w.y) * s; wv[j][3] = bf_hi(w.y) * s;
            wv[j][4] = bf_lo(w.z) * s; wv[j][5] = bf_hi(w.z) * s; wv[j][6] = bf_lo(w.w) * s; wv[j][7] = bf_hi(w.w) * s; }
        const int nkt = vis / 32;
        const bf16_t* kbase = (const bf16_t*)(a.ws + WS_KI1) + rowbase * 64 + (size_t)lane * 8;
        for (int rep14 = 0; rep14 < PM(14); ++rep14)
        for (int kt0 = wid; kt0 < nkt; kt0 += 8 * NWAVES) {
            bf16x8 kq[8][4];
#pragma unroll
            for (int pf = 0; pf < 8; ++pf) { const int kt = min(kt0 + pf * NWAVES, nkt - 1);
#pragma unroll
                for (int ks = 0; ks < 4; ++ks) kq[pf][ks] = *(const bf16x8*)(kbase + (size_t)(kt * 4 + ks) * 512); }
            __builtin_amdgcn_sched_barrier(0);
#pragma unroll
            for (int pf = 0; pf < 8; ++pf) { const int kt = kt0 + pf * NWAVES;
                if (kt < nkt) {
                    f32x16 d0 = {}, d1 = {};
#pragma unroll
                    for (int ks = 0; ks < 4; ++ks) { d0 = __builtin_amdgcn_mfma_f32_32x32x16_bf16(af[0][ks], kq[pf][ks], d0, 0, 0, 0); d1 = __builtin_amdgcn_mfma_f32_32x32x16_bf16(af[1][ks], kq[pf][ks], d1, 0, 0, 0); }
                    float s0 = 0.f, s1 = 0.f, s2 = 0.f, s3 = 0.f;
#pragma unroll
                    for (int r = 0; r < 8; ++r) { s0 += wv[0][r] * relu_i(d0[r]); s1 += wv[1][r] * relu_i(d0[8 + r]); s2 += wv[2][r] * relu_i(d1[r]); s3 += wv[3][r] * relu_i(d1[8 + r]); }
                    const int key = kt * 32 + r32;
                    sc[(hi) * 4096 + key] = s0; sc[(2 + hi) * 4096 + key] = s1; sc[(4 + hi) * 4096 + key] = s2; sc[(6 + hi) * 4096 + key] = s3;
                } }
        }
    }
    __syncthreads();
    for (int rep15 = 0; rep15 < PM(15); ++rep15) {
        unsigned m0 = 0u, m1 = 0u;
        if (vis <= 256) { m0 = 0xffffffffu; m1 = 0xffffffffu; }
        else {
            const LAS float* ms = sc + wid * 4096;
            float v[64];
            float mx = -INFINITY, mn = INFINITY;
#pragma unroll
            for (int i = 0; i < 64; ++i) { const bool in = (i * 64 < vis); v[i] = in ? ms[i * 64 + lane] : -INFINITY; if (in) { mx = fmaxf(mx, v[i]); mn = fminf(mn, v[i]); } }
            mx = wave_max_uniform(mx); mn = -wave_max_uniform(-mn);
            float lo = mn - 1.f - fabsf(mn), hiv = mx;
            float thr = hiv; int cgt = 0; bool exact = false;
            int c_lo = vis, c_hi = 0;
            bool dead = false;
            for (int it = 0; it < 64 && (c_lo - c_hi) > 448; ++it) {
                const float mid = 0.5f * (lo + hiv);
                if (!(mid > lo) || !(mid < hiv)) { dead = true; break; }
                int c = 0;
#pragma unroll
                for (int i = 0; i < 64; ++i) c += (v[i] > mid) ? 1 : 0;
                c = wave_sum_uniform(c);
                if (c == 256) { thr = mid; exact = true; break; }
                if (c > 256) { lo = mid; c_lo = c; } else { hiv = mid; c_hi = c; }
            }
            if (!exact && !dead) {
                LAS float* cand = sc + wid * 4096; int base = 0;
#pragma unroll
                for (int i = 0; i < 64; ++i) { const bool in = (v[i] > lo) && !(v[i] > hiv);
                    const unsigned long long mk = __ballot(in);
                    const int pos = base + __builtin_amdgcn_mbcnt_hi((unsigned)(mk >> 32), __builtin_amdgcn_mbcnt_lo((unsigned)mk, 0));
                    if (in) cand[pos] = v[i];
                    base += __builtin_popcountll(mk); }
                const int nc = c_lo - c_hi, c_hi0 = c_hi;
                float cv[8];
#pragma unroll
                for (int j = 0; j < 8; ++j) cv[j] = (lane + 64 * j < nc) ? cand[lane + 64 * j] : -INFINITY;
                for (int it = 0; it < 64; ++it) {
                    const float mid = 0.5f * (lo + hiv);
                    if (!(mid > lo) || !(mid < hiv)) break;
                    int c = 0;
#pragma unroll
                    for (int j = 0; j < 8; ++j) c += (cv[j] > mid) ? 1 : 0;
                    c = c_hi0 + wave_sum_uniform(c);
                    if (c == 256) { thr = mid; exact = true; break; }
                    if (c > 256) { lo = mid; c_lo = c; } else { hiv = mid; c_hi = c; }
                }
            }
            if (!exact) { thr = hiv; cgt = c_hi; }
            const int need_eq = exact ? 0 : (256 - cgt); int eq_seen = 0;
            if (exact) SelExact<0>::run(v, thr, m0, m1); else SelStep<0>::run(v, thr, lo, exact, need_eq, eq_seen, m0, m1);
        }
        if (lane * 64 < vis) *(u32x2*)(bm + (size_t)(tok0 + wid) * 128 + 2 * lane) = (u32x2){m0, m1};
    }
    __syncthreads();
}

template <int I> struct MaskInit {
    static __device__ __forceinline__ void run(f32x16 (&p)[2], int nw0, int nw1, float slope2, float T, int ninf) {
        constexpr int bk = I >> 4, r = I & 15, pos = 8 * (r >> 2) + (r & 3);
        const float vb = __builtin_fmaf(slope2, (float)(32 * bk + pos), T);
        int off; asm("v_bfe_i32 %0, %1, %2, 1" : "=v"(off) : "v"(bk ? nw1 : nw0), "n"(pos));
        float o; asm("v_bfi_b32 %0, %1, %2, %3" : "=v"(o) : "v"(off), "s"(ninf), "v"(vb));
        p[bk][r] = o;
        MaskInit<I + 1>::run(p, nw0, nw1, slope2, T, ninf);
    }
};
template <> struct MaskInit<32> { static __device__ __forceinline__ void run(f32x16 (&)[2], int, int, float, float, int) {} };
__device__ __forceinline__ float max3_asm(float a, float b, float c) { float r; asm("v_max3_f32 %0, %1, %2, %3" : "=v"(r) : "v"(a), "v"(b), "v"(c)); return r; }
__device__ __forceinline__ void dsa_attn_unit(Frame& F, const Args& a, int b, int ch, int g) {
    const bf16_t* z1 = (const bf16_t*)(a.ws + WS_Z); unsigned char* cat = (unsigned char*)(a.ws + WS_CAT); const unsigned* bm = (const unsigned*)(a.ws + WS_BM);
    const int tid = F.tid, lane = F.lane, wid = F.wave, r32 = lane & 31, hi = lane >> 5;
    const int hr = wid >> 1, qh = wid & 1, head = g * 4 + hr;
    const size_t rowbase = (size_t)b * SEQ;
    const int tq = ch * 64 + 32 * qh + r32;
    const float slope2 = ex2(-0.5f * (float)(head + 1)) * LOG2E;
    bf16x8 qr[4];
    { const bf16_t* qp = z1 + (rowbase + tq) * ZO + OQ + head * 64 + hi * 8;
#pragma unroll
      for (int ks = 0; ks < 4; ++ks) qr[ks] = *(const bf16x8*)(qp + ks * 16); }
    const unsigned* mrow = bm + (rowbase + tq) * 128;
    f32x16 o0 = {}, o1 = {}; float m = 0.f, l = 0.f;
    const int ntile = ch + 1;
    LAS unsigned char* Kb = F.lds; LAS unsigned char* Vb = F.lds + 2 * SB_TILE;
    LAS float* wsf = (LAS float*)(F.lds + 4 * SB_TILE) + wid * 32;
    const bf16_t* kg = (const bf16_t*)(a.ws + WS_KV1) + (rowbase + (tid >> 3)) * 512 + g * 64 + (tid & 7) * 8;
    const unsigned ldst = (unsigned)(tid >> 3) * SB_KST + (unsigned)(tid & 7) * 16;
    { const u32x4 kn = *(const u32x4*)(kg), vn = *(const u32x4*)(kg + 256);
      *(LAS u32x4*)(Kb + ldst) = kn; *(LAS u32x4*)(Vb + ldst) = vn; }
    const int dh = (lane >> 4) & 1, q_ = (lane & 15) >> 2, p_ = lane & 3;
    u32x2 mw = *(const u32x2*)(mrow);
    for (int kt = 0; kt < ntile; ++kt) {
        const int buf = kt & 1;
        u32x4 kn, vn; u32x2 mwn = mw;
        if (kt + 1 < ntile) { const size_t go = (size_t)(kt + 1) * 64 * 512; kn = *(const u32x4*)(kg + go); vn = *(const u32x4*)(kg + go + 256); mwn = *(const u32x2*)(mrow + 2 * (kt + 1)); }
        LDS_BARRIER();
        const LAS unsigned char* Kc = Kb + buf * SB_TILE; const LAS unsigned char* Vc = Vb + buf * SB_TILE;
        const float T = slope2 * (float)(64 * kt + 4 * hi) - m;
        const int nw0 = (int)~(mw.x >> (4 * hi)), nw1 = (int)~(mw.y >> (4 * hi));
        f32x16 p[2];
        MaskInit<0>::run(p, nw0, nw1, slope2, T, (int)0xff800000);
#pragma unroll
        for (int ks = 0; ks < 4; ++ks) {
            const bf16x8 k0 = *(const LAS bf16x8*)(Kc + r32 * SB_KST + (16 * ks + 8 * hi) * 2);
            const bf16x8 k1 = *(const LAS bf16x8*)(Kc + (32 + r32) * SB_KST + (16 * ks + 8 * hi) * 2);
            p[0] = __builtin_amdgcn_mfma_f32_32x32x16_bf16(k0, qr[ks], p[0], 0, 0, 0);
            p[1] = __builtin_amdgcn_mfma_f32_32x32x16_bf16(k1, qr[ks], p[1], 0, 0, 0);
        }
        if (kt == ntile - 1) {
            const float basef = (float)(tq - (64 * kt + 4 * hi));
#pragma unroll
            for (int bk = 0; bk < 2; ++bk)
#pragma unroll
                for (int r = 0; r < 16; ++r) { const float rel = (float)(32 * bk + 8 * (r >> 2) + (r & 3)) - basef; p[bk][r] -= 2.f * slope2 * fmaxf(rel, 0.f); }
        } else asm volatile("s_nop 15\n\ts_nop 7" : "+v"(p[0]), "+v"(p[1]));
        float rm;
        { float a0 = max3_asm(p[0][0], p[0][1], p[1][0]), b0 = max3_asm(p[0][2], p[0][3], p[1][1]); a0 = max3_asm(a0, p[1][2], p[1][3]);
#pragma unroll
          for (int r = 4; r < 16; r += 4) { a0 = max3_asm(a0, p[0][r], p[0][r + 1]); b0 = max3_asm(b0, p[0][r + 2], p[0][r + 3]); a0 = max3_asm(a0, p[1][r], p[1][r + 1]); b0 = max3_asm(b0, p[1][r + 2], p[1][r + 3]); }
          rm = fmaxf(a0, b0); }
        rm = fmaxf(rm, sxf<32>(rm));
        if (__any(rm > 6.f) || kt == 0) {
            const float d = (kt == 0) ? ((rm > -1e30f) ? rm : 0.f) : ((rm > 6.f) ? rm : 0.f);
            const float alpha = ex2(-d);
            l *= alpha; m += d;
#pragma unroll
            for (int bk = 0; bk < 2; ++bk)
#pragma unroll
                for (int r = 0; r < 16; ++r) p[bk][r] -= d;
            if (hi == 0) wsf[r32] = alpha;
#pragma unroll
            for (int r = 0; r < 16; ++r) { const float al = wsf[(r & 3) + 8 * (r >> 2) + 4 * hi]; o0[r] *= al; o1[r] *= al; }
        }
        float ls = 0.f;
#pragma unroll
        for (int bk = 0; bk < 2; ++bk)
#pragma unroll
            for (int r = 0; r < 16; ++r) { const float e = ex2(p[bk][r]); p[bk][r] = e; ls += e; }
        l += ls;
        bf16x8 pa[2][2];
#pragma unroll
        for (int bk = 0; bk < 2; ++bk)
#pragma unroll
            for (int s = 0; s < 2; ++s) { u32x4 w; w.x = cvt_pk_bf16(p[bk][8 * s + 0], p[bk][8 * s + 1]); w.y = cvt_pk_bf16(p[bk][8 * s + 2], p[bk][8 * s + 3]);
                w.z = cvt_pk_bf16(p[bk][8 * s + 4], p[bk][8 * s + 5]); w.w = cvt_pk_bf16(p[bk][8 * s + 6], p[bk][8 * s + 7]); pa[bk][s] = __builtin_bit_cast(bf16x8, w); }
#pragma unroll
        for (int bk = 0; bk < 2; ++bk)
#pragma unroll
            for (int s = 0; s < 2; ++s) {
                const LAS unsigned char* vp = Vc + (32 * bk + 16 * s + 4 * hi + q_) * SB_KST + (16 * dh + 4 * p_) * 2;
                const s16x4 l0 = __builtin_amdgcn_ds_read_tr16_b64_v4i16((LAS s16x4*)(vp));
                const s16x4 h0 = __builtin_amdgcn_ds_read_tr16_b64_v4i16((LAS s16x4*)(vp + 8 * SB_KST));
                const s16x4 l1 = __builtin_amdgcn_ds_read_tr16_b64_v4i16((LAS s16x4*)(vp + 64));
                const s16x4 h1 = __builtin_amdgcn_ds_read_tr16_b64_v4i16((LAS s16x4*)(vp + 8 * SB_KST + 64));
                const bf16x8 v0 = (bf16x8){l0[0], l0[1], l0[2], l0[3], h0[0], h0[1], h0[2], h0[3]};
                const bf16x8 v1 = (bf16x8){l1[0], l1[1], l1[2], l1[3], h1[0], h1[1], h1[2], h1[3]};
                o0 = __builtin_amdgcn_mfma_f32_32x32x16_bf16(pa[bk][s], v0, o0, 0, 0, 0);
                o1 = __builtin_amdgcn_mfma_f32_32x32x16_bf16(pa[bk][s], v1, o1, 0, 0, 0);
            }
        if (kt + 1 < ntile) { *(LAS u32x4*)(Kb + (buf ^ 1) * SB_TILE + ldst) = kn; *(LAS u32x4*)(Vb + (buf ^ 1) * SB_TILE + ldst) = vn; }
        mw = mwn;
    }
    l += sxf<32>(l);
    if (hi == 0) wsf[r32] = 1.f / l;
#pragma unroll
    for (int r = 0; r < 16; ++r) { const int q = (r & 3) + 8 * (r >> 2) + 4 * hi; const float inv = wsf[q];
        const size_t oo = (rowbase + ch * 64 + 32 * qh + q) * DM + head * 64 + r32;
        CAT_ST(cat, oo, o0[r] * inv); CAT_ST(cat, oo + 32, o1[r] * inv); }
    __syncthreads();
}

__device__ __forceinline__ void ln_row16(const bf16_t* src, float (&x)[16], int lane) {
    const u32x4 a = *(const u32x4*)(src + 8 * lane), b = *(const u32x4*)(src + 512 + 8 * lane);
    x[0] = bf_lo(a.x); x[1] = bf_hi(a.x); x[2] = bf_lo(a.y); x[3] = bf_hi(a.y); x[4] = bf_lo(a.z); x[5] = bf_hi(a.z); x[6] = bf_lo(a.w); x[7] = bf_hi(a.w);
    x[8] = bf_lo(b.x); x[9] = bf_hi(b.x); x[10] = bf_lo(b.y); x[11] = bf_hi(b.y); x[12] = bf_lo(b.z); x[13] = bf_hi(b.z); x[14] = bf_lo(b.w); x[15] = bf_hi(b.w);
}
__device__ __forceinline__ void ln_norm16(float (&x)[16], const float* g, const float* bta, int lane) {
    float s = 0.f;
#pragma unroll
    for (int j = 0; j < 16; ++j) s += x[j];
    const float mean = wave_sum(s) * (1.f / DM); float q = 0.f;
#pragma unroll
    for (int j = 0; j < 16; ++j) { x[j] -= mean; q += x[j] * x[j]; }
    const float rstd = 1.f / sqrtf(wave_sum(q) * (1.f / DM) + LN_EPS);
    const f32x4 g0 = *(const f32x4*)(g + 8 * lane), g1 = *(const f32x4*)(g + 8 * lane + 4), g2 = *(const f32x4*)(g + 512 + 8 * lane), g3 = *(const f32x4*)(g + 512 + 8 * lane + 4);
    const f32x4 b0 = *(const f32x4*)(bta + 8 * lane), b1 = *(const f32x4*)(bta + 8 * lane + 4), b2 = *(const f32x4*)(bta + 512 + 8 * lane), b3 = *(const f32x4*)(bta + 512 + 8 * lane + 4);
#pragma unroll
    for (int j = 0; j < 4; ++j) { x[j] = x[j] * rstd * g0[j] + b0[j]; x[4 + j] = x[4 + j] * rstd * g1[j] + b1[j]; x[8 + j] = x[8 + j] * rstd * g2[j] + b2[j]; x[12 + j] = x[12 + j] * rstd * g3[j] + b3[j]; }
}
__device__ __forceinline__ void store16bf(bf16_t* dst, const float (&x)[16], int lane) {
    u32x4 a, b; a.x = cvt_pk_bf16(x[0], x[1]); a.y = cvt_pk_bf16(x[2], x[3]); a.z = cvt_pk_bf16(x[4], x[5]); a.w = cvt_pk_bf16(x[6], x[7]);
    b.x = cvt_pk_bf16(x[8], x[9]); b.y = cvt_pk_bf16(x[10], x[11]); b.z = cvt_pk_bf16(x[12], x[13]); b.w = cvt_pk_bf16(x[14], x[15]);
    *(u32x4*)(dst + 8 * lane) = a; *(u32x4*)(dst + 512 + 8 * lane) = b;
}
__device__ __forceinline__ void store16f8(unsigned char* dst, const float (&x)[16], int lane) {
    *(u32x2*)(dst + 8 * lane) = pg8::pack8_fp8((f32x4){x[0], x[1], x[2], x[3]}, (f32x4){x[4], x[5], x[6], x[7]});
    *(u32x2*)(dst + 512 + 8 * lane) = pg8::pack8_fp8((f32x4){x[8], x[9], x[10], x[11]}, (f32x4){x[12], x[13], x[14], x[15]});
}
constexpr int HS_STRIDE = 2064;
__device__ __forceinline__ void ln1_router_phase(Frame& F, const Args& a, int layer) {
    const bf16_t* t1 = (const bf16_t*)(a.ws + WS_T1); bf16_t* hb = (bf16_t*)(a.ws + WS_HB);
    const bf16_t* wrt = (const bf16_t*)(a.ws + WS_WRT) + (size_t)layer * NEXP * DM;
    const float* g = a.in[10] + layer * DM; const float* bta = a.in[11] + layer * DM; const float* br = a.in[13] + layer * NEXP;
    int* topi = (int*)(a.ws + WS_TOPI); float* gate = (float*)(a.ws + WS_GATE); int* cnt = (int*)(a.ws + WS_CNT);
    const int lane = F.lane, w = F.wave, tid = F.tid;
    LAS unsigned char* hs = F.lds;
    LAS float* part = (LAS float*)(F.lds + 36864);
    LAS float* logit = (LAS float*)(F.lds + 36864 + 16384);
    LAS int* hist = (LAS int*)(F.lds + 36864 + 16384 + 2048);
    LAS int* topk_i = (LAS int*)(F.lds + 36864 + 16384 + 2048 + 256); LAS float* topk_v = (LAS float*)(F.lds + 36864 + 16384 + 2048 + 512);
    const int n16 = lane & 15, kg4 = lane >> 4;
    bf16x8 bw[2][4];
#pragma unroll
    for (int n = 0; n < 2; ++n)
#pragma unroll
        for (int ks = 0; ks < 4; ++ks) bw[n][ks] = *(const bf16x8*)(wrt + (size_t)(16 * n + n16) * DM + 128 * w + 32 * ks + 8 * kg4);
    for (int grp2 = F.bid; grp2 < NGRP * PM(6); grp2 += F.G) { const int grp = grp2 % NGRP;
        if (tid < 32) hist[tid] = 0;
        __syncthreads();
        for (int it = 0; it < 8; ++it) {
            const int r0 = grp * 128 + it * 16;
#pragma unroll
            for (int rr = 0; rr < 2; ++rr) { const int rl = 2 * w + rr; float x[16];
                ln_row16(t1 + (size_t)(r0 + rl) * DM, x, lane); ln_norm16(x, g, bta, lane);
                store16bf(hb + (size_t)(r0 + rl) * DM, x, lane); store16f8((unsigned char*)(a.ws + WS_HQ) + (size_t)(r0 + rl) * DM, x, lane);
                u32x4 p, q; p.x = cvt_pk_bf16(x[0], x[1]); p.y = cvt_pk_bf16(x[2], x[3]); p.z = cvt_pk_bf16(x[4], x[5]); p.w = cvt_pk_bf16(x[6], x[7]);
                q.x = cvt_pk_bf16(x[8], x[9]); q.y = cvt_pk_bf16(x[10], x[11]); q.z = cvt_pk_bf16(x[12], x[13]); q.w = cvt_pk_bf16(x[14], x[15]);
                *(LAS u32x4*)(hs + rl * HS_STRIDE + 16 * lane) = p; *(LAS u32x4*)(hs + rl * HS_STRIDE + 1024 + 16 * lane) = q; }
            __syncthreads();
            { f32x4 d0 = {0.f, 0.f, 0.f, 0.f}, d1 = {0.f, 0.f, 0.f, 0.f};
#pragma unroll
              for (int ks = 0; ks < 4; ++ks) { const bf16x8 af = *(const LAS bf16x8*)(hs + n16 * HS_STRIDE + (128 * w + 32 * ks + 8 * kg4) * 2);
                  d0 = __builtin_amdgcn_mfma_f32_16x16x32_bf16(af, bw[0][ks], d0, 0, 0, 0); d1 = __builtin_amdgcn_mfma_f32_16x16x32_bf16(af, bw[1][ks], d1, 0, 0, 0); }
#pragma unroll
              for (int r = 0; r < 4; ++r) { part[(w * 16 + 4 * kg4 + r) * 32 + n16] = d0[r]; part[(w * 16 + 4 * kg4 + r) * 32 + 16 + n16] = d1[r]; } }
            __syncthreads();
            { const int row = tid >> 5, e = tid & 31; float s = br[e];
#pragma unroll
              for (int ww = 0; ww < 8; ++ww) s += part[(ww * 16 + row) * 32 + e];
              logit[row * 32 + e] = s; }
            __syncthreads();
            { const int row = tid >> 5, e = tid & 31; const float lv = logit[row * 32 + e]; int rank = 0;
#pragma unroll
              for (int e2 = 0; e2 < 32; ++e2) { const float o = logit[row * 32 + e2]; rank += (o > lv || (o == lv && e2 < e)) ? 1 : 0; }
              if (rank < 4) { topk_i[row * 4 + rank] = e; topk_v[row * 4 + rank] = lv; } }
            __syncthreads();
            if (tid < 16) { const int tok = r0 + tid;
                const int t0 = topk_i[tid * 4 + 0], t1 = topk_i[tid * 4 + 1], t2 = topk_i[tid * 4 + 2], t3 = topk_i[tid * 4 + 3];
                const float v0 = topk_v[tid * 4 + 0];
                const float e0 = 1.f, e1 = __expf(topk_v[tid * 4 + 1] - v0), e2 = __expf(topk_v[tid * 4 + 2] - v0), e3 = __expf(topk_v[tid * 4 + 3] - v0); const float inv = 1.f / (e0 + e1 + e2 + e3);
                *(int4*)(topi + (size_t)tok * 4) = make_int4(t0, t1, t2, t3);
                *(float4*)(gate + (size_t)tok * 4) = make_float4(e0 * inv, e1 * inv, e2 * inv, e3 * inv);
                atomicAdd((int*)&hist[t0], 1); atomicAdd((int*)&hist[t1], 1); atomicAdd((int*)&hist[t2], 1); atomicAdd((int*)&hist[t3], 1); }
        }
        __syncthreads();
        if (tid < 32) cnt[grp * 32 + tid] = hist[tid];
        __syncthreads();
    }
}

__device__ __forceinline__ void moe_tables(Frame& F, const Args& a, int grp) {
    const int* cnt = (const int*)(a.ws + WS_CNT);
    LAS int* T = (LAS int*)(F.lds + TAB_OFF);
    const int tid = F.tid, e = tid & 31, j = tid >> 5;
    { int s = 0, bf = 0;
      for (int gg = j * 16; gg < j * 16 + 16; ++gg) { const int c = cnt[gg * 32 + e]; s += c; if (gg < grp) bf += c; }
      T[TB_TOT16 / 4 + j * 32 + e] = s; T[TB_BEF16 / 4 + j * 32 + e] = bf; }
    __syncthreads();
    if (tid < 32) { int s = 0, bf = 0;
#pragma unroll
        for (int jj = 0; jj < 16; ++jj) { s += T[TB_TOT16 / 4 + jj * 32 + tid]; bf += T[TB_BEF16 / 4 + jj * 32 + tid]; }
        T[TB_TOTAL / 4 + tid] = s; T[TB_BEFORE / 4 + tid] = bf; T[TB_LCUR / 4 + tid] = 0; }
    __syncthreads();
    if (tid < 32) {
        int ps = 0;
#pragma nounroll
        for (int ee = 0; ee < tid; ++ee) ps += ((T[TB_TOTAL / 4 + ee] + 255) >> 8) << 8;
        T[TB_PADST / 4 + tid] = ps; T[TB_BASE / 4 + tid] = ps + T[TB_BEFORE / 4 + tid];
        if (tid == 31) { const int end = ps + (((T[TB_TOTAL / 4 + 31] + 255) >> 8) << 8); T[TB_PADST / 4 + 32] = end; T[TB_NTL / 4] = end >> 8; } }
    __syncthreads();
    { LAS unsigned char* t2e = (LAS unsigned char*)(F.lds + TAB_OFF + TB_T2E); const int ntl = T[TB_NTL / 4];
      for (int rt = tid; rt < ntl; rt += NTHR) { int e = 0;
#pragma nounroll
          for (int ee = 1; ee < 32; ++ee) e += (T[TB_PADST / 4 + ee] <= rt * 256) ? 1 : 0;
          t2e[rt] = (unsigned char)e; } }
    __syncthreads();
}
__device__ __forceinline__ void scatter_phase(Frame& F, const Args& a) {
    const int* topi = (const int*)(a.ws + WS_TOPI);
    int* slot = (int*)(a.ws + WS_SLOT); int* rowtok = (int*)(a.ws + WS_ROWG);
    LAS int* T = (LAS int*)(F.lds + TAB_OFF);
    const int tid = F.tid;
    if (F.bid >= NGRP) moe_tables(F, a, -1);
    for (int grp2 = F.bid; grp2 < NGRP * PM(7); grp2 += F.G) { const int grp = grp2 % NGRP;
        moe_tables(F, a, grp);
        { const int tok = grp * 128 + (tid >> 2), k = tid & 3; const int e = topi[(size_t)tok * 4 + k];
          const int rank = atomicAdd((int*)&T[TB_LCUR / 4 + e], 1); const int row = T[TB_BASE / 4 + e] + rank;
          slot[(size_t)tok * 4 + k] = row; rowtok[row] = tok; }
        if (grp < NEXP) {
            const int tot = T[TB_TOTAL / 4 + grp], st = T[TB_PADST / 4 + grp], en = T[TB_PADST / 4 + grp + 1];
            for (int r = st + tot + tid; r < en; r += NTHR) rowtok[r] = 0; }
        __syncthreads();
    }
}
__device__ __forceinline__ void combine_phase(Frame& F, const Args& a) {
    const bf16_t* hb = (const bf16_t*)(a.ws + WS_HB); const bf16_t* yb = (const bf16_t*)(a.ws + WS_XS); bf16_t* mid = (bf16_t*)(a.ws + WS_MIDB);
    const int* slot = (const int*)(a.ws + WS_SLOT);
    const int lane = F.lane;
    for (int tok2 = F.bid * NWAVES + F.wave; tok2 < NTOK * PM(10); tok2 += F.G * NWAVES) { const int tok = tok2 % NTOK;
        float x[16]; ln_row16(hb + (size_t)tok * DM, x, lane);
#pragma unroll
        for (int j = 0; j < 16; ++j) x[j] *= ALPHA;
        const int4 sl = *(const int4*)(slot + (size_t)tok * 4);
        const int s4[4] = {sl.x, sl.y, sl.z, sl.w};
        const float4 gt4 = *(const float4*)((const float*)(a.ws + WS_GATE) + (size_t)tok * 4);
        const float g4[4] = {gt4.x * 0.0625f, gt4.y * 0.0625f, gt4.z * 0.0625f, gt4.w * 0.0625f};
#pragma unroll
        for (int k = 0; k < 4; ++k) {
            if (Y_FP8) { const unsigned char* yr = (const unsigned char*)yb + (size_t)s4[k] * DM;
                const u32x2 p = *(const u32x2*)(yr + 8 * lane), q = *(const u32x2*)(yr + 512 + 8 * lane);
                const unsigned w4[4] = {p.x, p.y, q.x, q.y};
#pragma unroll
                for (int i = 0; i < 4; ++i) { const f32x2 lo = __builtin_amdgcn_cvt_pk_f32_fp8((int)w4[i], false), hi2 = __builtin_amdgcn_cvt_pk_f32_fp8((int)w4[i], true);
                    x[4 * i + 0] += lo.x * g4[k]; x[4 * i + 1] += lo.y * g4[k]; x[4 * i + 2] += hi2.x * g4[k]; x[4 * i + 3] += hi2.y * g4[k]; } }
            else { float y[16]; ln_row16(yb + (size_t)s4[k] * DM, y, lane);
#pragma unroll
                for (int j = 0; j < 16; ++j) x[j] += y[j] * (16.f * g4[k]); } }
        store16bf(mid + (size_t)tok * DM, x, lane); store16f8((unsigned char*)(a.ws + WS_MIDQ) + (size_t)tok * DM, x, lane);
    }
}
__device__ __forceinline__ void ln2_phase(Frame& F, const Args& a, int layer) {
    const bf16_t* t2 = (const bf16_t*)(a.ws + WS_T1); bf16_t* xb = (bf16_t*)(a.ws + WS_XB);
    const float* g = a.in[18] + layer * DM; const float* bta = a.in[19] + layer * DM;
    const int lane = F.lane;
    for (int tok2 = F.bid * NWAVES + F.wave; tok2 < NTOK * PM(12); tok2 += F.G * NWAVES) { const int tok = tok2 % NTOK;
        float x[16]; ln_row16(t2 + (size_t)tok * DM, x, lane); ln_norm16(x, g, bta, lane);
        if (layer == 0) { store16bf(xb + (size_t)tok * DM, x, lane); if (FP8_IN1 || FP8_IN1Q) store16f8((unsigned char*)(a.ws + WS_XQ) + (size_t)tok * DM, x, lane); }
        else { float* o = a.out + (size_t)tok * DM;
            *(f32x4*)(o + 8 * lane) = (f32x4){x[0], x[1], x[2], x[3]}; *(f32x4*)(o + 8 * lane + 4) = (f32x4){x[4], x[5], x[6], x[7]};
            *(f32x4*)(o + 512 + 8 * lane) = (f32x4){x[8], x[9], x[10], x[11]}; *(f32x4*)(o + 512 + 8 * lane + 4) = (f32x4){x[12], x[13], x[14], x[15]}; }
    }
}

__global__ void __launch_bounds__(NTHR, 2) __attribute__((target("no-packed-fp32-ops"))) hybrid_fwd(Args args) {
    extern __shared__ __attribute__((aligned(16))) unsigned char lds_raw[];
    Frame F;
    F.lds = (LAS unsigned char*)lds_raw;
    F.tid = threadIdx.x; F.lane = F.tid & 63; F.wave = __builtin_amdgcn_readfirstlane(F.tid >> 6); F.G = gridDim.x; F.bid = blockIdx.x;
    volatile LAS unsigned* MISC = (volatile LAS unsigned*)(F.lds + MISC_OFF);
    for (int u = F.tid; u < 128; u += NTHR) MISC[u] = 0u;
    __syncthreads();
    XcdBarrier bar = xcd_barrier_post((unsigned*)(args.ws + WS_CTL) + 4096, MISC + 8);
    const int lo = args.ph_lo; int ph = 0; (void)lo; (void)ph;
#ifndef PHMASK
#define PHMASK 0xfffff
#endif
#ifndef PROBE_DUP
#define PROBE_DUP 0
#endif
#define SITE(k) if constexpr ((PHMASK >> (k)) & 1)
typedef const __attribute__((address_space(4))) Args* KArgs;
#define PHASE_REFRESH int t_ = threadIdx.x; asm volatile("" : "+v"(t_)); F.tid = t_; F.lane = t_ & 63; F.wave = __builtin_amdgcn_readfirstlane(t_ >> 6); \
    { int b_ = blockIdx.x; asm volatile("" : "+s"(b_)); F.bid = b_; } \
    { unsigned l_ = 0; asm volatile("" : "+s"(l_)); F.lds = (LAS unsigned char*)lds_raw + l_; } LAS unsigned char* const ring = F.lds; \
    LOAD_ARGS unsigned char* const ws = A.ws;
#if defined(__HIP_DEVICE_COMPILE__)
#define LOAD_ARGS KArgs ap_ = (KArgs)__builtin_amdgcn_kernarg_segment_ptr(); asm volatile("" : "+s"(ap_)); const Args A = *ap_;
#else
#define LOAD_ARGS const Args A = args;
#endif
#ifdef MK_LAUNCHES_PER_PHASE
#define PHASE_BEGIN if (ph == lo) { PHASE_REFRESH
#define PHASE_END   } ++ph;
#define PHASE_END_LAST } ++ph;
#else
#define PHASE_BEGIN { PHASE_REFRESH
#ifdef PROBE_BAR2
#define PHASE_END   xcd_barrier(bar); xcd_barrier(bar); }
#else
#define PHASE_END   xcd_barrier(bar); }
#endif
#define PHASE_END_LAST if (layer == 0) xcd_barrier(bar); }
#endif
    using namespace pg8;

    PHASE_BEGIN SITE(0) p0_prologue(F, A); PHASE_END

    for (int layer = 0; layer < 2; ++layer) {
        PHASE_BEGIN
        SITE(1) {
        if (layer == 0) {
            SITE(16) { DenseOrder S; S.initp(ws + (FP8_IN0 ? WS_XQ : WS_XB), ws + WS_WIN0, NTOK, ZE, FP8_IN0 ? DM : 2 * DM, F.G, F.bid, PM(1)); EpiIn0 E{(bf16_t*)(ws + WS_Z), 0.125f * LOG2E}; int p8 = FP8_IN0 ? DM : 2 * DM; asm volatile("" : "+s"(p8)); gemm_phase<EpiIn0, DenseOrder, FP8_IN0 != 0>(ring, F.tid, p8, S, E); }
            SITE(17) { PleOrder S; S.D.init(ws + WS_PB, ws + WS_WPLE, 2 * NTOK, DM, PLE, F.G, F.bid, PM(1));
              int kple = 2 * PLE; asm volatile("" : "+s"(kple));
              EpiPlain E{(bf16_t*)(ws + WS_PPLE), DM}; gemm_phase(ring, F.tid, kple, S, E); }
        } else {
#if FP8_IN1Q
            SITE(18) { { DenseOrder S; S.initp(ws + WS_XQ, ws + WS_WIN1Q, NTOK, 1536, DM, F.G, F.bid, PM(1)); if (F.G == 256 && PM(1) == 1) S.rep = -1; EpiIn1 E{(bf16_t*)(ws + WS_Z), (bf16_t*)(ws + WS_KV1), (bf16_t*)(ws + WS_KI1), 0}; int p8 = DM; asm volatile("" : "+s"(p8)); gemm_phase<EpiIn1, DenseOrder, true>(ring, F.tid, p8, S, E); }
                       { DenseOrder S; S.initp(ws + WS_XB, ws + WS_WIN1 + (size_t)1536 * DM * 2, NTOK, ZO - 1536, 2 * DM, F.G, F.bid, PM(1)); if (F.G == 256 && PM(1) == 1) S.rep = -2; EpiIn1 E{(bf16_t*)(ws + WS_Z), (bf16_t*)(ws + WS_KV1), (bf16_t*)(ws + WS_KI1), 6}; int p8 = 2 * DM; asm volatile("" : "+s"(p8)); gemm_phase<EpiIn1, DenseOrder, false>(ring, F.tid, p8, S, E); } }
#else
            SITE(18) { DenseOrder S; S.initp(ws + (FP8_IN1 ? WS_XQ : WS_XB), ws + WS_WIN1, NTOK, ZO, FP8_IN1 ? DM : 2 * DM, F.G, F.bid, PM(1)); EpiIn1 E{(bf16_t*)(ws + WS_Z), (bf16_t*)(ws + WS_KV1), (bf16_t*)(ws + WS_KI1), 0}; int p8 = FP8_IN1 ? DM : 2 * DM; asm volatile("" : "+s"(p8)); gemm_phase<EpiIn1, DenseOrder, FP8_IN1 != 0>(ring, F.tid, p8, S, E); }
#endif
        }
        }
        PHASE_END
        PHASE_BEGIN
        if (layer == 0) {
            SITE(2) for (long L = F.bid; L < 1024 * PM(2); L += F.G) { const int v = (int)(L & 255), rnd = (int)((L >> 8) & 3), s = v & 3, bh = v >> 2;
                const int qb = rnd == 0 ? 15 - s : (rnd == 1 ? 8 + s : (rnd == 2 ? 7 - s : s));
                sb_unit(F, A, bh >> 3, bh & 7, qb); }
            SITE(3) for (int u = F.bid; u < PM(3) * NTOK / 128; u += F.G) gmlp_unit(F, A, u % (NTOK / 128));
        } else {
            SITE(4) for (int L = F.bid; L < PM(4) * NTOK / 8; L += F.G) { const int Lm = L % (NTOK / 8), r = Lm >> 8, cc = Lm & 255;
                const int j = (r & 1) ? 511 - cc : cc; dsa_select_unit(F, A, (r >> 1) * 512 + j); }
        }
        PHASE_END
        if (layer == 1) {
        PHASE_BEGIN
            SITE(13) for (int L = F.bid; L < 1024 * PM(13); L += F.G) { const int idx = L & 1023, pp = idx & 31, g = (idx >> 5) & 3, b = idx >> 7;
                dsa_attn_unit(F, A, b, 63 - pp, g); dsa_attn_unit(F, A, b, pp, g); }
        PHASE_END
        }
        PHASE_BEGIN
        SITE(5) { DenseOrder S; S.initp(ws + WS_CAT, ws + (layer == 0 ? WS_WO0 : WS_WO1), NTOK, DM, FP8_OUT ? DM : 2 * DM, F.G, F.bid, PM(5));
          EpiOut E{layer == 0 ? A.in[0] : nullptr, (const bf16_t*)(ws + WS_XB), (bf16_t*)(ws + WS_T1)}; int p8 = FP8_OUT ? DM : 2 * DM; asm volatile("" : "+s"(p8)); gemm_phase<EpiOut, DenseOrder, FP8_OUT != 0>(ring, F.tid, p8, S, E); }
        PHASE_END
        PHASE_BEGIN SITE(6) ln1_router_phase(F, A, layer); PHASE_END
        PHASE_BEGIN SITE(7) scatter_phase(F, A); PHASE_END
        PHASE_BEGIN
        SITE(8) {
#ifdef MK_LAUNCHES_PER_PHASE
          moe_tables(F, A, -1);
#endif
          const int ntl = __builtin_amdgcn_readfirstlane(((LAS int*)(F.lds + TAB_OFF))[TB_NTL / 4]);
          MoeOrder<8, true> S; S.nunits = ntl * 8; S.G = F.G; S.c = F.bid; S.rep = PM(8); S.t2e = (const LAS unsigned char*)(F.lds + TAB_OFF + TB_T2E);
          S.A = (const char*)(ws + WS_HQ); S.rowtok = (const int*)(ws + WS_ROWG); S.W = (const char*)(ws + WS_WGU) + (size_t)layer * 32 * 2048 * DM;
          EpiSwiglu E{(unsigned char*)(ws + WS_ACT), A.in[15] + (size_t)layer * 32 * 2048}; int p8 = DM; asm volatile("" : "+s"(p8)); gemm_phase<EpiSwiglu, MoeOrder<8, true>, true, MOE_ALIGN>(ring, F.tid, p8, S, E); }
        PHASE_END
        PHASE_BEGIN
        SITE(9) {
#ifdef MK_LAUNCHES_PER_PHASE
          moe_tables(F, A, -1);
#endif
          const int ntl = __builtin_amdgcn_readfirstlane(((LAS int*)(F.lds + TAB_OFF))[TB_NTL / 4]);
          MoeOrder<4, false> S; S.nunits = ntl * 4; S.G = F.G; S.c = F.bid; S.rep = PM(9); S.t2e = (const LAS unsigned char*)(F.lds + TAB_OFF + TB_T2E);
          S.A = (const char*)(ws + WS_ACT); S.rowtok = nullptr; S.W = (const char*)(ws + WS_WD) + (size_t)layer * 32 * DM * DM;
          EpiDown E{(unsigned char*)(ws + WS_XS), A.in[17] + (size_t)layer * 32 * DM}; int p8 = DM; asm volatile("" : "+s"(p8)); gemm_phase<EpiDown, MoeOrder<4, false>, true, MOE_ALIGN>(ring, F.tid, p8, S, E); }
        PHASE_END
        PHASE_BEGIN SITE(10) combine_phase(F, A); PHASE_END
        PHASE_BEGIN
        SITE(11) { DenseOrder S; S.initp(ws + (FP8_GATE ? WS_MIDQ : WS_MIDB), ws + WS_WG + (size_t)layer * DM * DM * (FP8_GATE ? 1 : 2), NTOK, DM, FP8_GATE ? DM : 2 * DM, F.G, F.bid, PM(11));
          EpiGate E{(const bf16_t*)(ws + WS_MIDB), (const bf16_t*)(ws + WS_PPLE) + (size_t)layer * NTOK * DM, A.in[22] + layer * DM, (bf16_t*)(ws + WS_T1)}; int p8 = FP8_GATE ? DM : 2 * DM; asm volatile("" : "+s"(p8)); gemm_phase<EpiGate, DenseOrder, FP8_GATE != 0>(ring, F.tid, p8, S, E); }
        PHASE_END
        PHASE_BEGIN SITE(12) ln2_phase(F, A, layer); PHASE_END_LAST
    }
#undef PHASE_BEGIN
#undef PHASE_END
#undef PHASE_END_LAST
}
constexpr int N_PHASES = 22;

extern "C" void kernel_launch(void* const* d_in, const int* in_sizes, int n_in, void* d_out, int out_size, void* d_ws, size_t ws_size, hipStream_t stream) {
    static int grid = 0;
    if (grid == 0) {
        if (n_in != 23 || out_size != NTOK * DM || ws_size < WS_END) { fprintf(stderr, "kernel_launch: unexpected problem: n_in %d out %d ws %zu (need %zu)\n", n_in, out_size, ws_size, (size_t)WS_END); grid = -1; return; }
        int dev = 0, cus = 0, per_cu = 0;
        if (hipGetDevice(&dev) != hipSuccess || hipDeviceGetAttribute(&cus, hipDeviceAttributeMultiprocessorCount, dev) != hipSuccess) { grid = -1; return; }
        if (hipFuncSetAttribute((const void*)hybrid_fwd, hipFuncAttributeMaxDynamicSharedMemorySize, LDS_BYTES) != hipSuccess) { fprintf(stderr, "kernel_launch: hipFuncSetAttribute failed\n"); grid = -1; return; }
        if (hipOccupancyMaxActiveBlocksPerMultiprocessor(&per_cu, (const void*)hybrid_fwd, NTHR, LDS_BYTES) != hipSuccess || per_cu < 1) fprintf(stderr, "kernel_launch: occupancy query says %d\n", per_cu);
        (void)hipGetLastError();
        grid = cus;
    }
    if (grid < 0) return;
    (void)hipMemsetAsync((char*)d_ws + WS_CTL, 0, CTL_ZERO_BYTES, stream);
    Args a{};
    for (int i = 0; i < 23; ++i) a.in[i] = (const float*)d_in[i];
    a.out = (float*)d_out; a.ws = (unsigned char*)d_ws;
#ifndef MK_LAUNCHES_PER_PHASE
    a.ph_lo = 0; a.ph_hi = N_PHASES;
    hipLaunchKernelGGL(hybrid_fwd, dim3(grid), dim3(NTHR), LDS_BYTES, stream, a);
#else
    for (int p = 0; p < N_PHASES; ++p) { a.ph_lo = p; a.ph_hi = p + 1; hipLaunchKernelGGL(hybrid_fwd, dim3(grid), dim3(NTHR), LDS_BYTES, stream, a); }
#endif
}
```

```cpp
#include <hip/hip_runtime.h>
#include <cstdio>
#include <cstdint>

#define LAS __attribute__((address_space(3)))
#define GAS __attribute__((address_space(1)))
typedef unsigned short bf16_t;
typedef short bf16x8 __attribute__((ext_vector_type(8)));
typedef short s16x4 __attribute__((ext_vector_type(4)));
typedef float f32x2 __attribute__((ext_vector_type(2)));
typedef float f32x4 __attribute__((ext_vector_type(4)));
typedef float f32x16 __attribute__((ext_vector_type(16)));
typedef unsigned u32x2 __attribute__((ext_vector_type(2)));
typedef unsigned u32x4 __attribute__((ext_vector_type(4)));

constexpr int DM = 1024, NB = 8, SEQ = 4096, NTOK = NB * SEQ;
constexpr int ZE = 2560;
constexpr int ZO = 2304, ZO_REAL = 2120;
constexpr int OQ = 0, OK_ = 1024, OV = 1280, OQI = 1536, OKI = 2048, OWI = 2112;
constexpr int NEXP = 32, PLE = 256;
constexpr int NGRP = NTOK / 128;
constexpr int MAXTILES = NTOK * 4 / 256 + NEXP;
constexpr int MAXROWS = MAXTILES * 256;
constexpr float LN_EPS = 1e-5f;
constexpr float ALPHA = 1.4142135623730951f;
constexpr float LOG2E = 1.4426950408889634f;
constexpr float WSC = 64.f, WSC_INV = 1.f / 64.f;

#ifndef FP8_IN0
#define FP8_IN0 1
#endif
#ifndef Y_FP8
#define Y_FP8 1
#endif
#ifndef MOE_ALIGN
#define MOE_ALIGN true
#endif
#ifndef FP8_IN1Q
#define FP8_IN1Q 1
#endif
#ifndef FP8_IN1
#define FP8_IN1 0
#endif
#ifndef FP8_OUT
#define FP8_OUT 1
#endif
#ifndef FP8_GATE
#define FP8_GATE 1
#endif
#ifndef PROBE_DUP
#define PROBE_DUP 0
#endif
#define PM(k) (((PROBE_DUP >> (k)) & 1) ? 2 : 1)

constexpr size_t MiB = 1u << 20;
constexpr size_t WS_CTL = 0, CTL_ZERO_BYTES = 1 * MiB;
constexpr size_t WS_WRT = 1 * MiB;
constexpr size_t WS_WSB = WS_WRT + 256 * 1024;
constexpr size_t WS_CNT = WS_WSB + 256 * 1024;
constexpr size_t WS_TOPI = 2 * MiB;
constexpr size_t WS_GATE = WS_TOPI + 512 * 1024;
constexpr size_t WS_SLOT = 3 * MiB;
constexpr size_t WS_ROWG = WS_SLOT + 512 * 1024;
constexpr size_t WS_HQ = 1056 * MiB + 160 * MiB;
constexpr size_t WS_WIN0 = 8 * MiB, WS_WO0 = 13 * MiB, WS_WIN1 = 15 * MiB, WS_WO1 = 20 * MiB, WS_WG = 22 * MiB, WS_WPLE = 26 * MiB;
constexpr size_t WS_WGU = 32 * MiB, WS_WD = 288 * MiB;
constexpr size_t WS_WIN1Q = 28 * MiB;
constexpr size_t WS_XB = 416 * MiB, WS_PB = 480 * MiB, WS_PPLE = 512 * MiB, WS_Z = 640 * MiB, WS_CAT = 800 * MiB, WS_T1 = 864 * MiB;
constexpr size_t WS_BM = 1328 * MiB;
constexpr size_t WS_KV1 = WS_BM + 16 * MiB;
constexpr size_t WS_KI1 = WS_KV1 + 32 * MiB;
constexpr size_t WS_HB = 928 * MiB, WS_MIDB = 992 * MiB, WS_XS = 1056 * MiB, WS_ACT = 1328 * MiB;
constexpr size_t WS_XQ = 1600 * MiB, WS_MIDQ = 1632 * MiB, WS_END = 1664 * MiB;
static_assert(WS_ROWG + (size_t)MAXROWS * 4 <= WS_WIN0, "small buffers");
static_assert(WS_XS + (size_t)MAXROWS * DM * 2 <= WS_ACT && WS_ACT + (size_t)MAXROWS * DM * 2 <= WS_END, "moe buffers");

constexpr int RING_BYTES = 131072;
constexpr int MISC_OFF = RING_BYTES;
constexpr int TAB_OFF = MISC_OFF + 512;
constexpr int XTRA_OFF = TAB_OFF + 6144;
constexpr int LDS_BYTES = 147456;
static_assert(XTRA_OFF + 8192 <= LDS_BYTES, "LDS map");
constexpr int TB_TOT16 = 0, TB_BEF16 = 2048, TB_TOTAL = 4096, TB_BEFORE = 4224, TB_PADST = 4352  , TB_NTL = 4488, TB_LCUR = 4608  , TB_BASE = 4736  , TB_T2E = 5120  ;
static_assert(TB_T2E + 544 <= 6144, "tab");

#define RLX_AGENT __ATOMIC_RELAXED, __HIP_MEMORY_SCOPE_AGENT
typedef __bf16 bf16x2_t __attribute__((ext_vector_type(2)));
__device__ __forceinline__ unsigned cvt_pk_bf16(float lo, float hi) { const f32x2 v = {lo, hi}; const bf16x2_t b = __builtin_convertvector(v, bf16x2_t); return __builtin_bit_cast(unsigned, b); }
__device__ __forceinline__ unsigned char f8_1(float v) { return (unsigned char)(__builtin_amdgcn_cvt_pk_fp8_f32(v, v, 0, false) & 0xff); }
#if FP8_OUT
#define CAT_ST(cat, idx, v) ((cat)[idx] = f8_1(v))
#else
#define CAT_ST(cat, idx, v) (((bf16_t*)(cat))[idx] = (bf16_t)(cvt_pk_bf16((v), 0.f) & 0xffffu))
#endif
__device__ __forceinline__ float bf_lo(unsigned u) { return __uint_as_float(u << 16); }
__device__ __forceinline__ float bf_hi(unsigned u) { return __uint_as_float(u & 0xffff0000u); }
__device__ __forceinline__ float bf1(bf16_t u) { return __uint_as_float(((unsigned)u) << 16); }
template <int K> __device__ __forceinline__ int sxi(int v) {
    if constexpr (K == 32) { const auto rr = __builtin_amdgcn_permlane32_swap((unsigned)v, (unsigned)v, false, false); return (int)(rr[0] ^ rr[1] ^ (unsigned)v); }
    else return __builtin_amdgcn_ds_swizzle(v, (K << 10) | 0x1f);
}
template <int K> __device__ __forceinline__ float sxf(float v) { return __int_as_float(sxi<K>(__float_as_int(v))); }
__device__ __forceinline__ float wave_sum(float x) {
    int v = __float_as_int(x);
#define WSF_STEP(ctrl, rm) { const int o = __builtin_amdgcn_update_dpp(0, v, ctrl, rm, 0xf, false); v = __float_as_int(__int_as_float(v) + __int_as_float(o)); }
    WSF_STEP(0x111, 0xf) WSF_STEP(0x112, 0xf) WSF_STEP(0x114, 0xf) WSF_STEP(0x118, 0xf) WSF_STEP(0x142, 0xa) WSF_STEP(0x143, 0xc)
#undef WSF_STEP
    return __int_as_float(__builtin_amdgcn_readlane(v, 63));
}
__device__ __forceinline__ float wave_max(float v) {
    v = fmaxf(v, sxf<1>(v)); v = fmaxf(v, sxf<2>(v)); v = fmaxf(v, sxf<4>(v)); v = fmaxf(v, sxf<8>(v)); v = fmaxf(v, sxf<16>(v)); v = fmaxf(v, sxf<32>(v));
    return v;
}
__device__ __forceinline__ float wave_min(float v) {
    v = fminf(v, sxf<1>(v)); v = fminf(v, sxf<2>(v)); v = fminf(v, sxf<4>(v)); v = fminf(v, sxf<8>(v)); v = fminf(v, sxf<16>(v)); v = fminf(v, sxf<32>(v));
    return v;
}
__device__ __forceinline__ int wave_sumi(int v) {
    v += sxi<1>(v); v += sxi<2>(v); v += sxi<4>(v); v += sxi<8>(v); v += sxi<16>(v); v += sxi<32>(v);
    return v;
}
__device__ __forceinline__ int wave_sum_uniform(int v) {
    v += __builtin_amdgcn_update_dpp(0, v, 0x111, 0xf, 0xf, false);
    v += __builtin_amdgcn_update_dpp(0, v, 0x112, 0xf, 0xf, false);
    v += __builtin_amdgcn_update_dpp(0, v, 0x114, 0xf, 0xf, false);
    v += __builtin_amdgcn_update_dpp(0, v, 0x118, 0xf, 0xf, false);
    v += __builtin_amdgcn_update_dpp(0, v, 0x142, 0xa, 0xf, false);
    v += __builtin_amdgcn_update_dpp(0, v, 0x143, 0xc, 0xf, false);
    return __builtin_amdgcn_readlane(v, 63);
}
__device__ __forceinline__ float wave_max_uniform(float x) {
    int v = __float_as_int(x);
#define WMX_STEP(ctrl, rm) { const int o = __builtin_amdgcn_update_dpp(v, v, ctrl, rm, 0xf, false); v = __float_as_int(fmaxf(__int_as_float(v), __int_as_float(o))); }
    WMX_STEP(0x111, 0xf) WMX_STEP(0x112, 0xf) WMX_STEP(0x114, 0xf) WMX_STEP(0x118, 0xf) WMX_STEP(0x142, 0xa) WMX_STEP(0x143, 0xc)
#undef WMX_STEP
    return __int_as_float(__builtin_amdgcn_readlane(v, 63));
}
__device__ __forceinline__ float relu_i(float x) { const int i = __float_as_int(x); return __int_as_float(i > 0 ? i : 0); }
__device__ __forceinline__ float ex2(float x) { return __builtin_amdgcn_exp2f(x); }
__device__ __forceinline__ float lg2(float x) { return __builtin_amdgcn_logf(x); }
__device__ __forceinline__ float rcpf_(float x) { return __builtin_amdgcn_rcpf(x); }
__device__ __forceinline__ float sigmoidf_(float x) { return rcpf_(1.f + ex2(-LOG2E * x)); }
__device__ __forceinline__ float gelu_tanh(float x) { return x * rcpf_(1.f + ex2(-2.302208198f * (x + 0.044715f * x * x * x))); }

namespace pg8 {
constexpr int BM = 256, BK = 64, HALF = 128, HTB = HALF * BK * 2, STAGE_BYTES = 8 * HTB, NXCD = 8, WGM = 8;
__host__ __device__ __forceinline__ int lds_byte(int r, int c) { const int st = (r >> 4) * 2 + (c >> 5), rr = r & 15, cc = c & 31, ob = rr * 64 + cc * 2; return st * 1024 + (ob ^ (((ob >> 9) & 1) << 5)); }
__host__ __device__ __forceinline__ void stage_rc(int b, int& R, int& C) { const int st = b / 1024, sb = b % 1024, swz = sb ^ (((sb >> 9) & 1) << 5); R = (st >> 1) * 16 + swz / 64; C = (st & 1) * 32 + (swz % 64) / 2; }
__host__ __device__ __forceinline__ int perm32(int rho) { const int n = rho >> 4, i = rho & 15; return 8 * (i >> 2) + 4 * n + (i & 3); }

struct Unit { int pm, pn, e; const char* b0; };
typedef int v8i_t __attribute__((ext_vector_type(8)));
typedef int v4i_t __attribute__((ext_vector_type(4)));
__device__ __forceinline__ v8i_t cat8(const bf16x8 a, const bf16x8 b) { const v4i_t x = __builtin_bit_cast(v4i_t, a), y = __builtin_bit_cast(v4i_t, b); return __builtin_shufflevector(x, y, 0, 1, 2, 3, 4, 5, 6, 7); }

struct DenseOrder {
    static constexpr bool GATHER = false;
    int nM, nN, nwg, G, c, rep; const char* A; const char* B; size_t tstep, hstep;
    __device__ __forceinline__ void init(const void* A_, const void* B_, int M, int N, int K, int G_, int c_, int rep_ = 1) { initp(A_, B_, M, N, 2 * K, G_, c_, rep_); }
    __device__ __forceinline__ void initp(const void* A_, const void* B_, int M, int N, int pitch, int G_, int c_, int rep_ = 1) { A = (const char*)A_; B = (const char*)B_; nM = M / BM; nN = N / BM; nwg = nM * nN; G = G_; c = c_; rep = rep_; hstep = (size_t)HALF * pitch; tstep = 2 * hstep; }
    __device__ __forceinline__ bool next(int i, Unit& u) const {
        const int mode = rep < 0 ? -rep : 0, rp = rep < 0 ? 1 : rep;
        int L = i * G + c, ok = 1;
        if (mode == 1) { const int hG = G >> 1; if (i >= 2) { ok = (c >= hG && i < 4) ? 1 : 0; L = 2 * G + (i - 2) * hG + (c - hG); } }
        else if (mode == 2) { if (i >= 1) { ok = (i == 1 && c < (G >> 1)) ? 1 : 0; L = G + c; } }
        if (L >= nwg * rp) ok = 0;
        if (!__builtin_amdgcn_readfirstlane(ok)) return false;
        if (L >= nwg) L -= nwg;
        int wgid = __builtin_amdgcn_readfirstlane(L); { const int q = nwg / NXCD, r = nwg % NXCD, xcd = wgid % NXCD, off = wgid / NXCD; wgid = (xcd < r ? xcd * (q + 1) : r * (q + 1) + (xcd - r) * q) + off; }
        const int nig = WGM * nN, gid = wgid / nig, fm = gid * WGM, gsz = (nM - fm) < WGM ? (nM - fm) : WGM;
        u.pm = fm + ((wgid % nig) % gsz); u.pn = (wgid % nig) / gsz; u.e = 0;
        u.b0 = B + (size_t)u.pn * tstep; return true;
    }
    __device__ __forceinline__ const char* aptr(const Unit& u) const { return A + (size_t)u.pm * tstep; }
    __device__ __forceinline__ size_t b1off() const { return hstep; }
    __device__ __forceinline__ int rowtok_at(int) const { return 0; }
};
struct PleOrder {
    static constexpr bool GATHER = false;
    DenseOrder D;
    __device__ __forceinline__ bool next(int i, Unit& u) const { if (!D.next(i, u)) return false; if (u.pm >= 32768 / BM) u.b0 += (size_t)1024 * 256 * 2; return true; }
    __device__ __forceinline__ const char* aptr(const Unit& u) const { return D.aptr(u); }
    __device__ __forceinline__ size_t b1off() const { return D.b1off(); }
    __device__ __forceinline__ int rowtok_at(int) const { return 0; }
};
template <int NT, bool SWIGLU>
struct MoeOrder {
    static constexpr bool GATHER = SWIGLU;
    int nunits, G, c, rep; const LAS unsigned char* t2e; const char* A; const char* W; const int* rowtok;
    static constexpr size_t hstep = (size_t)HALF * 1024, tstep = 2 * hstep;
    __device__ __forceinline__ bool next(int i, Unit& u) const {
        const int vc = ((G & 7) == 0) ? (c & 7) * (G >> 3) + (c >> 3) : c;
        int L = i * G + vc; if (L >= nunits * rep) return false; if (L >= nunits) L -= nunits;
        const int rt = L / NT, pn = L % NT;
        const int e = __builtin_amdgcn_readfirstlane((int)t2e[rt]);
        u.pm = rt; u.pn = pn; u.e = e;
        if (SWIGLU) u.b0 = W + (size_t)e * (16 * hstep) + (size_t)pn * hstep;
        else u.b0 = W + (size_t)e * (8 * hstep) + (size_t)pn * tstep;
        return true;
    }
    __device__ __forceinline__ const char* aptr(const Unit& u) const { return GATHER ? A : A + (size_t)u.pm * tstep; }
    __device__ __forceinline__ size_t b1off() const { return SWIGLU ? 8 * hstep : hstep; }
    __device__ __forceinline__ int rowtok_at(int row) const { return rowtok[row]; }
};

template <class Epi, class Sched, bool FP8 = false, bool ALIGN_EPI = true>
__device__ __forceinline__ void gemm_phase(LAS unsigned char* lds, const int tid, const int pitch, const Sched& S, const Epi& E) {
    const int wid = __builtin_amdgcn_readfirstlane(tid >> 6), lane = tid & 63, wr = wid >> 2, wc = wid & 3, fr = lane & 15, fq = lane >> 4;
    const int nt = pitch / (BK * 2);
    unsigned voffA[2], voffB[2];
#pragma unroll
    for (int i = 0; i < 2; ++i) { int R, C; stage_rc(tid * 16 + i * 8192, R, C); const int Rb = (R & ~31) + perm32(R & 31);
        voffA[i] = (unsigned)(R * pitch + C * 2); voffB[i] = (unsigned)(Rb * pitch + C * 2); }
    const size_t kstep = (size_t)(BK * 2);
    const size_t hstep = (size_t)HALF * pitch;
    constexpr bool GATHER = Sched::GATHER;
    unsigned vA[2][2], vAn[2][2]; int gR[2], gC[2];
    if constexpr (GATHER) {
#pragma unroll
        for (int i = 0; i < 2; ++i) { int R, C; stage_rc(tid * 16 + i * 8192, R, C); gR[i] = R; gC[i] = C * 2; } }
    auto gather_tok = [&](const Unit& u, int (&tk)[2][2]) {
#pragma unroll
        for (int h = 0; h < 2; ++h)
#pragma unroll
            for (int i = 0; i < 2; ++i) tk[h][i] = S.rowtok_at(u.pm * BM + h * HALF + gR[i]); };
    auto gather_off = [&](const int (&tk)[2][2], unsigned (&v)[2][2]) {
#pragma unroll
        for (int h = 0; h < 2; ++h)
#pragma unroll
            for (int i = 0; i < 2; ++i) v[h][i] = (unsigned)(tk[h][i] * pitch + gC[i]); };
    const unsigned ldsw = (unsigned)wid * 1024u;
    int sc127 = 127, scw = Epi::SCALE_EXP; asm volatile("" : "+v"(sc127), "+v"(scw));
    const unsigned ldsu = (unsigned)__builtin_amdgcn_readfirstlane((int)(unsigned)(uintptr_t)lds) + ldsw;
    const int aoff = lds_byte(wr * 64 + fr, fq * 8), boff = lds_byte(wc * 32 + fr, fq * 8);
#define PG8_SA(b, h) (((b) * 2 + (h)) * HTB)
#define PG8_SB(b, h) ((4 + (b) * 2 + (h)) * HTB)
#define PG8_STAGE(bufoff, gbase, voff) do { _Pragma("unroll") for (int _i = 0; _i < 2; ++_i) { unsigned _keep; \
        asm volatile("s_mov_b32 %0, m0\n\ts_mov_b32 m0, %3\n\ts_nop 0\n\tglobal_load_lds_dwordx4 %1, %2\n\ts_mov_b32 m0, %0" : "=&s"(_keep) : "v"((voff)[_i]), "s"((const char*)(gbase)), "s"(ldsu + (unsigned)((bufoff) + _i * 8192)) : "memory"); } } while (0)
#define PG8_STAGE_A(b, h, base, VG) do { if constexpr (GATHER) { PG8_STAGE(PG8_SA(b, h), base, (VG)[h]); } else { PG8_STAGE(PG8_SA(b, h), (base) + (h) * hstep, voffA); } } while (0)
#define PG8_LDA(dst, b, h) do { _Pragma("unroll") for (int m = 0; m < 4; ++m) _Pragma("unroll") for (int k = 0; k < 2; ++k) dst[m][k] = *(const LAS bf16x8*)(lds + PG8_SA(b, h) + aoff + m * 2048 + k * 1024); } while (0)
#define PG8_LDB(dst, b, h) do { _Pragma("unroll") for (int n = 0; n < 2; ++n) _Pragma("unroll") for (int k = 0; k < 2; ++k) dst[n][k] = *(const LAS bf16x8*)(lds + PG8_SB(b, h) + boff + n * 2048 + k * 1024); } while (0)
#define PG8_MMA(ai, bj, At, Bt) do { __builtin_amdgcn_s_setprio(1); _Pragma("unroll") for (int m = 0; m < 4; ++m) _Pragma("unroll") for (int n = 0; n < 2; ++n) { \
        if constexpr (FP8) { const v8i_t _a = cat8(Bt[n][0], Bt[n][1]), _b = cat8(At[m][0], At[m][1]); \
            asm volatile("v_mfma_scale_f32_16x16x128_f8f6f4 %0, %1, %2, %0, %3, %4 op_sel_hi:[0,0,0]" : "+v"(acc[ai][bj][m][n]) : "v"(_a), "v"(_b), "v"(scw), "v"(sc127)); } \
        else { _Pragma("unroll") for (int k = 0; k < 2; ++k) acc[ai][bj][m][n] = __builtin_amdgcn_mfma_f32_16x16x32_bf16(Bt[n][k], At[m][k], acc[ai][bj][m][n], 0, 0, 0); } } __builtin_amdgcn_s_setprio(0); } while (0)
#define PG8_WAIT_V(n) asm volatile("s_waitcnt vmcnt(" #n ")" ::: "memory")
#define PG8_WAIT_L(n) asm volatile("s_waitcnt lgkmcnt(" #n ")" ::: "memory")
#define PG8_BAR __builtin_amdgcn_s_barrier()
#define PG8_SCHED __builtin_amdgcn_sched_barrier(0)
    Unit cur, nxt; int ui = 0;
    if (!S.next(0, cur)) return;
    f32x4 acc[2][2][4][2];
    { typename Epi::Pre pre0; E.prefetch(pre0, cur, wr, wc, fr, fq); E.init(acc, pre0); }
    bf16x8 At[4][2], B0[2][2], B1[2][2];
    const char* cA = S.aptr(cur); const char* cB0 = cur.b0; const char* cB1 = cB0 + S.b1off();
    if constexpr (GATHER) { int tk[2][2]; gather_tok(cur, tk); gather_off(tk, vA); Unit u1; const bool h1 = S.next(1, u1); gather_tok(h1 ? u1 : cur, tk); gather_off(tk, vAn); }
    PG8_STAGE(PG8_SB(0, 0), cB0, voffB); PG8_STAGE(PG8_SB(0, 1), cB1, voffB); PG8_STAGE_A(0, 0, cA, vA); PG8_STAGE_A(0, 1, cA, vA);
    if (wr == 1) PG8_BAR;
    PG8_WAIT_V(2); PG8_BAR;
    PG8_STAGE(PG8_SB(1, 0), cB0 + kstep, voffB); PG8_STAGE_A(1, 0, cA + kstep, vA); PG8_STAGE(PG8_SB(1, 1), cB1 + kstep, voffB);
    PG8_WAIT_V(6); PG8_BAR;
    for (;;) {
        const bool has_next = S.next(ui + 1, nxt);
        const char* nA = has_next ? S.aptr(nxt) : cA; const char* nB0 = has_next ? nxt.b0 : cB0; const char* nB1 = nB0 + S.b1off();
        for (int t = 0; t < nt; t += 2) {
            const bool last = (t == nt - 2);
            const char* a1 = cA + (size_t)(t + 1) * kstep;
            const char* a2 = last ? nA : cA + (size_t)(t + 2) * kstep;
            const char* b20 = last ? nB0 : cB0 + (size_t)(t + 2) * kstep; const char* b21 = last ? nB1 : cB1 + (size_t)(t + 2) * kstep;
            const char* a3 = a2 + kstep; const char* b30 = b20 + kstep; const char* b31 = b21 + kstep;
            unsigned vS[2][2];
            if constexpr (GATHER) {
#pragma unroll
                for (int h = 0; h < 2; ++h)
#pragma unroll
                    for (int i = 0; i < 2; ++i) vS[h][i] = last ? vAn[h][i] : vA[h][i]; }
            PG8_LDB(B0, 0, 0); PG8_LDB(B1, 0, 1); PG8_SCHED; PG8_LDA(At, 0, 0); PG8_STAGE_A(1, 1, a1, vA);
            PG8_WAIT_V(8); PG8_WAIT_L(0); PG8_BAR; PG8_MMA(0, 0, At, B0); PG8_MMA(0, 1, At, B1); PG8_BAR; PG8_SCHED;
            PG8_LDA(At, 0, 1); PG8_STAGE(PG8_SB(0, 0), b20, voffB); PG8_STAGE(PG8_SB(0, 1), b21, voffB); PG8_STAGE_A(0, 0, a2, vS);
            PG8_WAIT_V(8); PG8_WAIT_L(0); PG8_BAR; PG8_MMA(1, 0, At, B0); PG8_MMA(1, 1, At, B1); PG8_BAR; PG8_SCHED;
            PG8_LDB(B0, 1, 0); PG8_LDB(B1, 1, 1); PG8_SCHED; PG8_LDA(At, 1, 0); PG8_STAGE_A(0, 1, a2, vS);
            PG8_WAIT_V(8); PG8_WAIT_L(0); PG8_BAR; PG8_MMA(0, 0, At, B0); PG8_MMA(0, 1, At, B1); PG8_BAR; PG8_SCHED;
            PG8_LDA(At, 1, 1); PG8_STAGE(PG8_SB(1, 0), b30, voffB); PG8_STAGE(PG8_SB(1, 1), b31, voffB); PG8_STAGE_A(1, 0, a3, vS);
            PG8_WAIT_V(8); PG8_WAIT_L(0); PG8_BAR; PG8_MMA(1, 0, At, B0); PG8_MMA(1, 1, At, B1); PG8_BAR; PG8_SCHED;
        }
        if constexpr (ALIGN_EPI) { if (wr == 0) PG8_BAR; }
        typename Epi::Pre pre; E.prefetch(pre, has_next ? nxt : cur, wr, wc, fr, fq);
        int tkn[2][2];
        if constexpr (GATHER) { Unit u2; const bool h2 = S.next(ui + 2, u2); gather_tok(h2 ? u2 : cur, tkn); }
        PG8_SCHED;
        E(acc, cur, wr, wc, fr, fq);
        if (!has_next) break;
        E.init(acc, pre);
        if constexpr (GATHER) { asm volatile("" : "+v"(tkn[0][0]), "+v"(tkn[0][1]), "+v"(tkn[1][0]), "+v"(tkn[1][1]));
#pragma unroll
            for (int h = 0; h < 2; ++h)
#pragma unroll
                for (int i = 0; i < 2; ++i) vA[h][i] = vAn[h][i];
            gather_off(tkn, vAn); }
        cur = nxt; cA = nA; cB0 = nB0; cB1 = nB1; ++ui;
        if constexpr (ALIGN_EPI) { if (wr == 1) PG8_BAR; }
    }
    PG8_WAIT_V(0);
    if constexpr (!ALIGN_EPI) { if (wr == 0) PG8_BAR; }
    PG8_BAR;
#undef PG8_SA
#undef PG8_SB
#undef PG8_STAGE
#undef PG8_STAGE_A
#undef PG8_LDA
#undef PG8_LDB
#undef PG8_MMA
#undef PG8_WAIT_V
#undef PG8_WAIT_L
#undef PG8_BAR
#undef PG8_SCHED
}

#define EPI_ROWS_BEGIN const int row0 = u.pm * BM + wr * 64 + fr; const int cl = wc * 32 + 8 * fq;
__device__ __forceinline__ void store8(bf16_t* p, const f32x4 v0, const f32x4 v1) {
    u32x4 w; w.x = cvt_pk_bf16(v0[0], v0[1]); w.y = cvt_pk_bf16(v0[2], v0[3]); w.z = cvt_pk_bf16(v1[0], v1[1]); w.w = cvt_pk_bf16(v1[2], v1[3]); *(u32x4*)p = w;
}
__device__ __forceinline__ u32x2 pack8_fp8(const f32x4 v0, const f32x4 v1) {
    int a = 0, b = 0; a = __builtin_amdgcn_cvt_pk_fp8_f32(v0[0], v0[1], a, false); a = __builtin_amdgcn_cvt_pk_fp8_f32(v0[2], v0[3], a, true);
    b = __builtin_amdgcn_cvt_pk_fp8_f32(v1[0], v1[1], b, false); b = __builtin_amdgcn_cvt_pk_fp8_f32(v1[2], v1[3], b, true); return (u32x2){(unsigned)a, (unsigned)b};
}
__device__ __forceinline__ void store8_fp8(unsigned char* p, const f32x4 v0, const f32x4 v1) { *(u32x2*)p = pack8_fp8(v0, v1); }
__device__ __forceinline__ void load8bf(const bf16_t* p, f32x4& v0, f32x4& v1) {
    const u32x4 w = *(const u32x4*)p; v0 = (f32x4){bf_lo(w.x), bf_hi(w.x), bf_lo(w.y), bf_hi(w.y)}; v1 = (f32x4){bf_lo(w.z), bf_hi(w.z), bf_lo(w.w), bf_hi(w.w)};
}
__device__ __forceinline__ void acc_zero(f32x4 (&acc)[2][2][4][2]) {
#pragma unroll
    for (int a = 0; a < 2; ++a)
#pragma unroll
        for (int b = 0; b < 2; ++b)
#pragma unroll
            for (int m = 0; m < 4; ++m)
#pragma unroll
                for (int n = 0; n < 2; ++n) acc[a][b][m][n] = (f32x4){0.f, 0.f, 0.f, 0.f};
}
#define EPI_NO_PRE static constexpr int SCALE_EXP = 121; struct Pre {}; \
    __device__ __forceinline__ void prefetch(Pre&, const Unit&, int, int, int, int) const {} \
    __device__ __forceinline__ void init(f32x4 (&acc)[2][2][4][2], const Pre&) const { acc_zero(acc); }
struct EpiPlain {
    EPI_NO_PRE
    bf16_t* O; int ldc;
    __device__ __forceinline__ void operator()(const f32x4 (&acc)[2][2][4][2], const Unit& u, int wr, int wc, int fr, int fq) const {
        EPI_ROWS_BEGIN
#pragma unroll
        for (int ai = 0; ai < 2; ++ai)
#pragma unroll
            for (int m = 0; m < 4; ++m) { bf16_t* rowp = O + (unsigned)((row0 + ai * HALF + m * 16) * ldc + u.pn * BM + cl);
#pragma unroll
                for (int bj = 0; bj < 2; ++bj) store8(rowp + bj * HALF, acc[ai][bj][m][0], acc[ai][bj][m][1]); asm volatile("" ::: "memory"); }
    }
};
struct EpiIn0 {
    EPI_NO_PRE
    static constexpr float WSI = 1.f;
    bf16_t* O; float qscale;
    __device__ __forceinline__ void operator()(const f32x4 (&acc)[2][2][4][2], const Unit& u, int wr, int wc, int fr, int fq) const {
        EPI_ROWS_BEGIN
        if (u.pn < 4) {
#pragma unroll
            for (int ai = 0; ai < 2; ++ai)
#pragma unroll
                for (int m = 0; m < 4; ++m) { bf16_t* rowp = O + (unsigned)((row0 + ai * HALF + m * 16) * ZE + u.pn * BM + cl);
#pragma unroll
                    for (int bj = 0; bj < 2; ++bj) { f32x4 v0 = acc[ai][bj][m][0] * WSI, v1 = acc[ai][bj][m][1] * WSI;
#pragma unroll
                        for (int j = 0; j < 4; ++j) { v0[j] = gelu_tanh(v0[j]); v1[j] = gelu_tanh(v1[j]); }
                        store8(rowp + bj * HALF, v0, v1); asm volatile("" ::: "memory"); } }
        } else {
            const float sc = (u.pn < 6 ? qscale : 1.f) * WSI;
#pragma unroll
            for (int ai = 0; ai < 2; ++ai)
#pragma unroll
                for (int m = 0; m < 4; ++m) { bf16_t* rowp = O + (unsigned)((row0 + ai * HALF + m * 16) * ZE + u.pn * BM + cl);
#pragma unroll
                    for (int bj = 0; bj < 2; ++bj) store8(rowp + bj * HALF, acc[ai][bj][m][0] * sc, acc[ai][bj][m][1] * sc);
                    asm volatile("" ::: "memory"); }
        }
    }
};
struct EpiIn1 {
    EPI_NO_PRE
    static constexpr float WSI = 1.f;
    bf16_t* O; bf16_t* KV; bf16_t* KI; int pn0;
    __device__ __forceinline__ void operator()(const f32x4 (&acc)[2][2][4][2], const Unit& u_, int wr, int wc, int fr, int fq) const {
        Unit u = u_; u.pn += pn0;
        EPI_ROWS_BEGIN
        if (u.pn == 4 || u.pn == 5) {
            bf16_t* base = KV + (u.pn - 4) * 256 + cl;
#pragma unroll
            for (int ai = 0; ai < 2; ++ai)
#pragma unroll
                for (int m = 0; m < 4; ++m) { bf16_t* rowp = base + (unsigned)((row0 + ai * HALF + m * 16) * 512);
#pragma unroll
                    for (int bj = 0; bj < 2; ++bj) store8(rowp + bj * HALF, acc[ai][bj][m][0] * WSI, acc[ai][bj][m][1] * WSI);
                    asm volatile("" ::: "memory"); }
        } else {
            const float sc = (u.pn < 4 ? 0.125f * LOG2E : 1.f) * WSI;
#pragma unroll
            for (int ai = 0; ai < 2; ++ai)
#pragma unroll
                for (int m = 0; m < 4; ++m) { bf16_t* rowp = O + (unsigned)((row0 + ai * HALF + m * 16) * ZO + u.pn * BM + cl);
#pragma unroll
                    for (int bj = 0; bj < 2; ++bj) store8(rowp + bj * HALF, acc[ai][bj][m][0] * sc, acc[ai][bj][m][1] * sc);
                    asm volatile("" ::: "memory"); }
            if (u.pn == 8 && wc < 2) {
#pragma unroll
                for (int ai = 0; ai < 2; ++ai)
#pragma unroll
                    for (int m = 0; m < 4; ++m) { const int row = row0 + ai * HALF + m * 16;
                        store8(KI + (unsigned)(((((row >> 5) * 4 + (cl >> 4)) * 64) + (((cl >> 3) & 1) * 32 + (row & 31))) * 8), acc[ai][0][m][0] * WSI, acc[ai][0][m][1] * WSI); asm volatile("" ::: "memory"); }
            }
        }
    }
};
struct EpiOut {
    EPI_NO_PRE
    const float* xf; const bf16_t* xb; bf16_t* O;
    __device__ __forceinline__ void operator()(const f32x4 (&acc)[2][2][4][2], const Unit& u, int wr, int wc, int fr, int fq) const {
        EPI_ROWS_BEGIN
#pragma unroll
        for (int ai = 0; ai < 2; ++ai) {
            f32x4 xr[4][2][2];
#pragma unroll
            for (int m = 0; m < 4; ++m) { const unsigned off = (unsigned)((row0 + ai * HALF + m * 16) * DM + u.pn * BM + cl);
#pragma unroll
                for (int bj = 0; bj < 2; ++bj) {
                    if (xf) { xr[m][bj][0] = *(const f32x4*)(xf + off + bj * HALF); xr[m][bj][1] = *(const f32x4*)(xf + off + bj * HALF + 4); }
                    else load8bf(xb + off + bj * HALF, xr[m][bj][0], xr[m][bj][1]); } }
            asm volatile("" ::: "memory");
#pragma unroll
            for (int m = 0; m < 4; ++m) { const unsigned off = (unsigned)((row0 + ai * HALF + m * 16) * DM + u.pn * BM + cl);
#pragma unroll
                for (int bj = 0; bj < 2; ++bj)
                    store8(O + off + bj * HALF, xr[m][bj][0] * ALPHA + acc[ai][bj][m][0], xr[m][bj][1] * ALPHA + acc[ai][bj][m][1]); }
            asm volatile("" ::: "memory");
        }
    }
};
constexpr float SWC = -1.702f * LOG2E;
struct EpiSwiglu {
    static constexpr int SCALE_EXP = 121;
    unsigned char* O; const float* bgu;
    struct Pre { f32x4 b[4]; };
    __device__ __forceinline__ void prefetch(Pre& p, const Unit& u, int wr, int wc, int fr, int fq) const {
        const float* bp = bgu + (unsigned)(u.e * 2048 + u.pn * HALF + wc * 32 + 8 * fq);
        p.b[0] = *(const f32x4*)bp; p.b[1] = *(const f32x4*)(bp + 4); p.b[2] = *(const f32x4*)(bp + 1024); p.b[3] = *(const f32x4*)(bp + 1028);
    }
    __device__ __forceinline__ void init(f32x4 (&acc)[2][2][4][2], const Pre& p) const {
        const f32x4 g0 = p.b[0] * SWC, g1 = p.b[1] * SWC, u0 = (p.b[2] + 1.0f) * (1.0f / SWC), u1 = (p.b[3] + 1.0f) * (1.0f / SWC);
#pragma unroll
        for (int ai = 0; ai < 2; ++ai)
#pragma unroll
            for (int m = 0; m < 4; ++m) { acc[ai][0][m][0] = g0; acc[ai][0][m][1] = g1; acc[ai][1][m][0] = u0; acc[ai][1][m][1] = u1; }
    }
    __device__ __forceinline__ void operator()(const f32x4 (&acc)[2][2][4][2], const Unit& u, int wr, int wc, int fr, int fq) const {
        EPI_ROWS_BEGIN
        const int col = u.pn * HALF + cl;
        float c7 = 7.0f * SWC, ya = -6.0f / SWC, yb = 8.0f / SWC; asm volatile("" : "+v"(c7), "+v"(ya), "+v"(yb));
#pragma unroll
        for (int ai = 0; ai < 2; ++ai)
#pragma unroll
            for (int m = 0; m < 4; ++m) { float t[8], y[8], e[8];
#pragma unroll
                for (int j = 0; j < 8; ++j) { asm("v_max_f32 %0, %1, %2" : "=v"(t[j]) : "v"(acc[ai][0][m][j >> 2][j & 3]), "v"(c7)); }
#pragma unroll
                for (int j = 0; j < 8; ++j) e[j] = __builtin_amdgcn_exp2f(t[j]);
#pragma unroll
                for (int j = 0; j < 8; ++j) { asm("v_med3_f32 %0, %1, %2, %3" : "=v"(y[j]) : "v"(acc[ai][1][m][j >> 2][j & 3]), "v"(ya), "v"(yb)); }
                __builtin_amdgcn_sched_barrier(0);
#pragma unroll
                for (int j = 0; j < 8; ++j) e[j] += 1.0f;
#pragma unroll
                for (int j = 0; j < 8; ++j) e[j] = __builtin_amdgcn_rcpf(e[j]);
#pragma unroll
                for (int j = 0; j < 8; ++j) y[j] *= t[j];
                __builtin_amdgcn_sched_barrier(0);
#pragma unroll
                for (int j = 0; j < 8; ++j) y[j] *= e[j];
                store8_fp8(O + (unsigned)((row0 + ai * HALF + m * 16) * DM + col), (f32x4){y[0], y[1], y[2], y[3]}, (f32x4){y[4], y[5], y[6], y[7]}); asm volatile("" ::: "memory"); }
    }
};
struct EpiDown {
    static constexpr int SCALE_EXP = 125;
    unsigned char* O; const float* bd;
    struct Pre { f32x4 b[2][2]; };
    __device__ __forceinline__ void prefetch(Pre& p, const Unit& u, int wr, int wc, int fr, int fq) const {
        const float* bp = bd + (unsigned)(u.e * DM + u.pn * BM + wc * 32 + 8 * fq);
#pragma unroll
        for (int bj = 0; bj < 2; ++bj) { p.b[bj][0] = *(const f32x4*)(bp + bj * HALF); p.b[bj][1] = *(const f32x4*)(bp + bj * HALF + 4); }
    }
    __device__ __forceinline__ void init(f32x4 (&acc)[2][2][4][2], const Pre& p) const {
#pragma unroll
        for (int bj = 0; bj < 2; ++bj) { const f32x4 b0 = p.b[bj][0] * 16.f, b1 = p.b[bj][1] * 16.f;
#pragma unroll
            for (int ai = 0; ai < 2; ++ai)
#pragma unroll
                for (int m = 0; m < 4; ++m) { acc[ai][bj][m][0] = b0; acc[ai][bj][m][1] = b1; } }
    }
    __device__ __forceinline__ void operator()(const f32x4 (&acc)[2][2][4][2], const Unit& u, int wr, int wc, int fr, int fq) const {
        EPI_ROWS_BEGIN
        const int col = u.pn * BM + cl;
#pragma unroll
        for (int ai = 0; ai < 2; ++ai)
#pragma unroll
            for (int m = 0; m < 4; ++m) { const int row = row0 + ai * HALF + m * 16;
#pragma unroll
                for (int bj = 0; bj < 2; ++bj) store8_fp8(O + (unsigned)(row * DM + col + bj * HALF), acc[ai][bj][m][0], acc[ai][bj][m][1]);
                asm volatile("" ::: "memory"); }
    }
};
struct EpiGate {
    EPI_NO_PRE
    const bf16_t* mid; const bf16_t* P; const float* bg; bf16_t* O;
    __device__ __forceinline__ void operator()(const f32x4 (&acc)[2][2][4][2], const Unit& u, int wr, int wc, int fr, int fq) const {
        EPI_ROWS_BEGIN
        const int col = u.pn * BM + cl;
        f32x4 bv[2][2];
#pragma unroll
        for (int bj = 0; bj < 2; ++bj) { bv[bj][0] = *(const f32x4*)(bg + col + bj * HALF); bv[bj][1] = *(const f32x4*)(bg + col + bj * HALF + 4); }
#pragma unroll
        for (int ai = 0; ai < 2; ++ai) {
            u32x4 mr[4][2], pr[4][2];
#pragma unroll
            for (int m = 0; m < 4; ++m) { const unsigned off = (unsigned)((row0 + ai * HALF + m * 16) * DM + col);
#pragma unroll
                for (int bj = 0; bj < 2; ++bj) { mr[m][bj] = *(const u32x4*)(mid + off + bj * HALF); pr[m][bj] = *(const u32x4*)(P + off + bj * HALF); } }
            asm volatile("" ::: "memory");
#pragma unroll
            for (int m = 0; m < 4; ++m) { const unsigned off = (unsigned)((row0 + ai * HALF + m * 16) * DM + col);
#pragma unroll
                for (int bj = 0; bj < 2; ++bj) { const u32x4 mw = mr[m][bj], pw = pr[m][bj];
                    const f32x4 m0 = {bf_lo(mw.x), bf_hi(mw.x), bf_lo(mw.y), bf_hi(mw.y)}, m1 = {bf_lo(mw.z), bf_hi(mw.z), bf_lo(mw.w), bf_hi(mw.w)};
                    const f32x4 p0 = {bf_lo(pw.x), bf_hi(pw.x), bf_lo(pw.y), bf_hi(pw.y)}, p1 = {bf_lo(pw.z), bf_hi(pw.z), bf_lo(pw.w), bf_hi(pw.w)};
                    f32x4 r0, r1;
                    const f32x4 a0 = acc[ai][bj][m][0] + bv[bj][0], a1 = acc[ai][bj][m][1] + bv[bj][1];
#pragma unroll
                    for (int j = 0; j < 4; ++j) { r0[j] = m0[j] + sigmoidf_(a0[j]) * p0[j]; r1[j] = m1[j] + sigmoidf_(a1[j]) * p1[j]; }
                    store8(O + off + bj * HALF, r0, r1); } }
            asm volatile("" ::: "memory");
        }
    }
};
}

#define XB_TMO      128
#define XB_XCNT(j)  (256  + 64 * (j))
#define XB_XSUB(j)  (1280 + 64 * (j))
#define XB_XGEN(j)  (2304 + 64 * (j))
#define XB_TOP      3328
#define XB_TOPGEN   3392
#define XCD_BAR_WORDS 3456
#define XB_SPIN_CAP (1u << 18)
__device__ __forceinline__ unsigned xb_ld(unsigned* p)              { return __hip_atomic_load(p, __ATOMIC_RELAXED, __HIP_MEMORY_SCOPE_AGENT); }
__device__ __forceinline__ unsigned xb_add(unsigned* p, unsigned v) { return __hip_atomic_fetch_add(p, v, __ATOMIC_RELAXED, __HIP_MEMORY_SCOPE_AGENT); }
__device__ __forceinline__ unsigned xb_xcc_id() { return (unsigned)__builtin_amdgcn_s_getreg((3 << 11) | 20) & 0xFu; }
#define XB_SPIN(cond, bar) do { unsigned _sp = 0; while (cond) { __builtin_amdgcn_s_sleep(1); \
    if ((++_sp & 255u) == 0u) { if (xb_ld(&(bar)[XB_TMO])) break; if (_sp > XB_SPIN_CAP) { atomicAdd(&(bar)[XB_TMO], 1u); break; } } } } while (0)
struct XcdBarrier { unsigned* bar; unsigned x; volatile LAS unsigned* st; };
__device__ __forceinline__ XcdBarrier xcd_barrier_post(unsigned* bar, volatile LAS unsigned* st) {
    XcdBarrier b; b.bar = bar; b.x = xb_xcc_id(); b.st = st;
    if (threadIdx.x == 0) (void)xb_add(&bar[XB_XCNT(b.x)], 1u);
    return b;
}
__device__ __forceinline__ void xcd_barrier_complete(unsigned* bar, unsigned x, unsigned& nloc, unsigned& nx) {
    const unsigned G = gridDim.x * gridDim.y * gridDim.z;
    unsigned sum, cnt, mine, sp = 0u;
    for (;;) {
        sum = 0u; cnt = 0u; mine = 0u;
#pragma unroll
        for (unsigned j = 0; j < 16; ++j) { const unsigned c = xb_ld(&bar[XB_XCNT(j)]); sum += c; cnt += (c > 0u) ? 1u : 0u; mine = (j == x) ? c : mine; }
        if (sum == G) break;
        __builtin_amdgcn_s_sleep(1);
        if ((++sp & 255u) == 0u) { if (xb_ld(&bar[XB_TMO])) break; if (sp > XB_SPIN_CAP) { atomicAdd(&bar[XB_TMO], 1u); break; } }
    }
    nloc = mine > 0u ? mine : 1u; nx = cnt > 0u ? cnt : 1u;
}
__device__ __forceinline__ void xcd_barrier(const XcdBarrier& b) {
    asm volatile("s_waitcnt vmcnt(0)" ::: "memory");
    __syncthreads();
    if (threadIdx.x == 0) {
        unsigned* bar = b.bar; asm volatile("" : "+s"(bar));
        unsigned bx = b.x; asm volatile("" : "+s"(bx));
        __builtin_amdgcn_s_waitcnt(0);
        unsigned nloc = b.st[0], nx = b.st[1];
        if (nloc == 0u) { xcd_barrier_complete(bar, bx, nloc, nx); b.st[0] = nloc; b.st[1] = nx; }
        const unsigned old = xb_add(&bar[XB_XSUB(bx)], 1u);
        const unsigned gen = old / nloc;
        if (old + 1u == (gen + 1u) * nloc) {
            __builtin_amdgcn_fence(__ATOMIC_RELEASE, "agent");
            asm volatile("s_waitcnt vmcnt(0)" ::: "memory");
            const unsigned og = xb_add(&bar[XB_TOP], 1u);
            const unsigned tg = og / nx;
            if (og + 1u == (tg + 1u) * nx) xb_add(&bar[XB_TOPGEN], 1u);
            else XB_SPIN(xb_ld(&bar[XB_TOPGEN]) == tg, bar);
            __builtin_amdgcn_fence(__ATOMIC_ACQUIRE, "agent");
            xb_add(&bar[XB_XGEN(bx)], 1u);
            asm volatile("s_waitcnt vmcnt(0)" ::: "memory");
        } else {
            XB_SPIN(xb_ld(&bar[XB_XGEN(bx)]) == gen, bar);
            __builtin_amdgcn_fence(__ATOMIC_ACQUIRE, "agent");
            asm volatile("s_waitcnt vmcnt(0)" ::: "memory");
        }
    }
    __syncthreads();
}

constexpr int NWAVES = 8, NTHR = 512;
struct Args { const float* in[23]; float* out; unsigned char* ws; int ph_lo, ph_hi; };
struct Frame { LAS unsigned char* lds; int tid, lane, wave, G, bid; };
#define LDS_WAIT() asm volatile("s_waitcnt lgkmcnt(0)" ::: "memory")
#define LDS_BARRIER() asm volatile("s_waitcnt lgkmcnt(0)\n\ts_barrier" ::: "memory")

template <bool F8>
__device__ __forceinline__ void p0_transpose_item(const float* W, int K, int N, int Npad, void* WT_, LAS float* scr, int item, int lane) {
    const int nblk = Npad / 32, kb = item / nblk, nb = item % nblk, k0 = 128 * kb, n0 = 32 * nb;
    const int r = lane >> 3, c4 = (lane & 7) * 4;
    const bool ok = n0 + c4 < N;
    const float* src = W + (size_t)(k0 + r) * N + (ok ? n0 + c4 : 0);
    f32x4 v[16];
#pragma unroll
    for (int i = 0; i < 16; ++i) v[i] = *(const f32x4*)(src + (size_t)(8 * i) * N);
    __builtin_amdgcn_sched_barrier(0);
    const float sc = ok ? (F8 ? WSC : 1.f) : 0.f;
#pragma unroll
    for (int i = 0; i < 16; ++i) *(LAS f32x4*)(scr + (8 * i + r) * 32 + (c4 ^ ((i >> 1) << 2))) = v[i] * sc;
    LDS_WAIT(); asm volatile("" ::: "memory");
    const int c = lane & 7;
#pragma unroll
    for (int j = 0; j < 4; ++j) { const int nn = (lane >> 3) + 8 * j; const LAS float* sp = scr + (16 * c) * 32 + (nn ^ (c << 2));
        float t[16];
#pragma unroll
        for (int q = 0; q < 16; ++q) t[q] = sp[q * 32];
        if constexpr (F8) { const u32x2 lo = pg8::pack8_fp8(f32x4{t[0], t[1], t[2], t[3]}, f32x4{t[4], t[5], t[6], t[7]}), hi = pg8::pack8_fp8(f32x4{t[8], t[9], t[10], t[11]}, f32x4{t[12], t[13], t[14], t[15]});
            u32x4 o; o.x = lo.x; o.y = lo.y; o.z = hi.x; o.w = hi.y; *(u32x4*)((unsigned char*)WT_ + (size_t)(n0 + nn) * K + k0 + 16 * c) = o; }
        else { u32x4 o0, o1; o0.x = cvt_pk_bf16(t[0], t[1]); o0.y = cvt_pk_bf16(t[2], t[3]); o0.z = cvt_pk_bf16(t[4], t[5]); o0.w = cvt_pk_bf16(t[6], t[7]);
            o1.x = cvt_pk_bf16(t[8], t[9]); o1.y = cvt_pk_bf16(t[10], t[11]); o1.z = cvt_pk_bf16(t[12], t[13]); o1.w = cvt_pk_bf16(t[14], t[15]);
            bf16_t* d = (bf16_t*)WT_ + (size_t)(n0 + nn) * K + k0 + 16 * c; *(u32x4*)d = o0; *(u32x4*)(d + 8) = o1; } }
    LDS_WAIT(); asm volatile("" ::: "memory");
}
template <int U, bool F8>
__device__ __forceinline__ void cvt_stream(const float* src, void* dst_, size_t n, int gtid, int gthreads) {
    const size_t st = (size_t)gthreads * 8;
    size_t i = (size_t)gtid * 8;
    for (; i + (U - 1) * st < n; i += U * st) {
        f32x4 a[U], b[U];
#pragma unroll
        for (int q = 0; q < U; ++q) { const float* p = src + i + q * st; a[q] = *(const f32x4*)p; b[q] = *(const f32x4*)(p + 4); }
        __builtin_amdgcn_sched_barrier(0);
#pragma unroll
        for (int q = 0; q < U; ++q) { const size_t o = i + q * st;
            if constexpr (F8) *(u32x2*)((unsigned char*)dst_ + o) = pg8::pack8_fp8(a[q], b[q]);
            else { u32x4 w; w.x = cvt_pk_bf16(a[q][0], a[q][1]); w.y = cvt_pk_bf16(a[q][2], a[q][3]); w.z = cvt_pk_bf16(b[q][0], b[q][1]); w.w = cvt_pk_bf16(b[q][2], b[q][3]); *(u32x4*)((bf16_t*)dst_ + o) = w; } }
    }
    for (; i < n; i += st) { const f32x4 a = *(const f32x4*)(src + i), b = *(const f32x4*)(src + i + 4);
        if constexpr (F8) *(u32x2*)((unsigned char*)dst_ + i) = pg8::pack8_fp8(a, b);
        else { u32x4 w; w.x = cvt_pk_bf16(a[0], a[1]); w.y = cvt_pk_bf16(a[2], a[3]); w.z = cvt_pk_bf16(b[0], b[1]); w.w = cvt_pk_bf16(b[2], b[3]); *(u32x4*)((bf16_t*)dst_ + i) = w; } }
}
struct P0Desc { const float* W; unsigned char* WT; int K, N, Npad, tile, f8; float s0, s1; int split; };
constexpr int P0_IN0 = 8 * (ZE / 256), P0_SQ = 8 * 4, P0_IN1 = 8 * (ZO / 256), P0_PLE = 2 * 4, P0_GU = 8 * 8;
constexpr int P0_IN1Q = FP8_IN1Q ? 8 * 6 : 0;
constexpr int P0_C0 = P0_IN0, P0_C1 = P0_C0 + P0_SQ, P0_C2 = P0_C1 + P0_IN1, P0_C3 = P0_C2 + P0_SQ, P0_C4 = P0_C3 + 2 * P0_SQ, P0_C5 = P0_C4 + 2 * P0_PLE, P0_C6 = P0_C5 + 64 * P0_GU, P0_C7Q = P0_C6 + 64 * P0_SQ, P0_C7 = P0_C7Q + P0_IN1Q;
__device__ __forceinline__ P0Desc p0_desc(const Args& a, int it) {
    unsigned char* ws = a.ws;
    if (it < P0_C0) return P0Desc{a.in[2], ws + WS_WIN0, DM, ZE, ZE, it, FP8_IN0, FP8_IN0 ? WSC : 1.f, FP8_IN0 ? WSC : 1.f, 0};
    if (it < P0_C1) return P0Desc{a.in[7], ws + WS_WO0, DM, DM, DM, it - P0_C0, FP8_OUT, FP8_OUT ? WSC : 1.f, FP8_OUT ? WSC : 1.f, 0};
    if (it < P0_C2) return P0Desc{a.in[8], ws + WS_WIN1, DM, ZO_REAL, ZO, it - P0_C1, FP8_IN1, FP8_IN1 ? WSC : 1.f, FP8_IN1 ? WSC : 1.f, 0};
    if (it < P0_C3) return P0Desc{a.in[9], ws + WS_WO1, DM, DM, DM, it - P0_C2, FP8_OUT, FP8_OUT ? WSC : 1.f, FP8_OUT ? WSC : 1.f, 0};
    if (it < P0_C4) { const int r = it - P0_C3, l = r / P0_SQ; return P0Desc{a.in[21] + (size_t)l * DM * DM, ws + WS_WG + (size_t)l * DM * DM * (FP8_GATE ? 1 : 2), DM, DM, DM, r % P0_SQ, FP8_GATE, FP8_GATE ? WSC : 1.f, FP8_GATE ? WSC : 1.f, 0}; }
    if (it < P0_C5) { const int r = it - P0_C4, l = r / P0_PLE; return P0Desc{a.in[20] + (size_t)l * PLE * DM, ws + WS_WPLE + (size_t)l * DM * PLE * 2, PLE, DM, DM, r % P0_PLE, 0, 1.f, 1.f, 0}; }
    if (it < P0_C6) { const int r = it - P0_C5, l = r / P0_GU; return P0Desc{a.in[14] + (size_t)l * DM * 2048, ws + WS_WGU + (size_t)l * 2048 * DM, DM, 2048, 2048, r % P0_GU, 1, WSC * pg8::SWC, WSC / pg8::SWC, 1024}; }
    if (it >= P0_C7Q) return P0Desc{a.in[8], ws + WS_WIN1Q, DM, ZO_REAL, 1536, it - P0_C7Q, 1, WSC, WSC, 0};
    const int r = it - P0_C6, l = r / P0_SQ; return P0Desc{a.in[16] + (size_t)l * DM * DM, ws + WS_WD + (size_t)l * DM * DM, DM, DM, DM, r % P0_SQ, 1, WSC, WSC, 0};
}
__device__ __forceinline__ void p0_tile_load(const P0Desc& d, int wave, int lane, f32x4 (&v)[16], float& sc) {
    const int nblk = d.Npad / 256, kb = d.tile / nblk, nb = d.tile % nblk;
    const int n = nb * 256 + 4 * lane; const bool ok = n < d.N;
    const float* src = d.W + (size_t)(kb * 128 + 16 * wave) * d.N + (ok ? n : 0);
#pragma unroll
    for (int i = 0; i < 16; ++i) v[i] = *(const f32x4*)(src + (size_t)i * d.N);
    sc = ok ? (n < d.split ? d.s0 : d.s1) : 0.f;
}
__device__ __forceinline__ void p0_tile_emit(const P0Desc& d, LAS float* img, int wave, int lane) {
    const int nblk = d.Npad / 256, kb = d.tile / nblk, nb = d.tile % nblk, k0 = 128 * kb, n0 = 256 * nb;
    const int c = lane & 7;
#pragma unroll
    for (int j = 0; j < 4; ++j) { const int nn = 32 * wave + (lane >> 3) + 8 * j; const LAS float* sp = img + (16 * c) * 256 + (nn ^ (c << 2));
        float t[16];
#pragma unroll
        for (int q = 0; q < 16; ++q) t[q] = sp[q * 256];
        const size_t o = (size_t)(n0 + nn) * d.K + k0 + 16 * c;
        if (d.f8) { const u32x2 lo = pg8::pack8_fp8(f32x4{t[0], t[1], t[2], t[3]}, f32x4{t[4], t[5], t[6], t[7]}), hi = pg8::pack8_fp8(f32x4{t[8], t[9], t[10], t[11]}, f32x4{t[12], t[13], t[14], t[15]});
            u32x4 w; w.x = lo.x; w.y = lo.y; w.z = hi.x; w.w = hi.y; *(u32x4*)(d.WT + o) = w; }
        else { u32x4 o0, o1; o0.x = cvt_pk_bf16(t[0], t[1]); o0.y = cvt_pk_bf16(t[2], t[3]); o0.z = cvt_pk_bf16(t[4], t[5]); o0.w = cvt_pk_bf16(t[6], t[7]);
            o1.x = cvt_pk_bf16(t[8], t[9]); o1.y = cvt_pk_bf16(t[10], t[11]); o1.z = cvt_pk_bf16(t[12], t[13]); o1.w = cvt_pk_bf16(t[14], t[15]);
            bf16_t* dp = (bf16_t*)d.WT + o; *(u32x4*)dp = o0; *(u32x4*)(dp + 8) = o1; } }
}
__device__ __forceinline__ void p0_prologue(Frame& F, const Args& a) {
    unsigned char* ws = a.ws;
    LAS float* img = (LAS float*)F.lds;
    { const int TOT = P0_C7 * PM(0);
      int it = F.bid; f32x4 v[16]; float sc = 0.f; P0Desc d = p0_desc(a, it % P0_C7);
      if (it < TOT) p0_tile_load(d, F.wave, F.lane, v, sc);
      for (; it < TOT; it += F.G) {
#pragma unroll
        for (int i = 0; i < 16; ++i) *(LAS f32x4*)(img + (16 * F.wave + i) * 256 + ((4 * F.lane) ^ (F.wave << 2))) = v[i] * sc;
        LDS_BARRIER();
        const P0Desc dc = d; const int nx = it + F.G;
        if (nx < TOT) { d = p0_desc(a, nx % P0_C7); p0_tile_load(d, F.wave, F.lane, v, sc); }
        __builtin_amdgcn_sched_barrier(0);
        p0_tile_emit(dc, img, F.wave, F.lane);
        LDS_BARRIER();
      } }
    {
      LAS float* scr = (LAS float*)(F.lds + F.wave * 16384);
      const int gw = F.bid * NWAVES + F.wave;
      if (gw < 16) p0_transpose_item<false>(a.in[12] + (size_t)(gw >> 3) * DM * NEXP, DM, NEXP, NEXP, (bf16_t*)(ws + WS_WRT) + (size_t)(gw >> 3) * NEXP * DM, scr, gw & 7, F.lane); }
    const int gtid = F.bid * NTHR + F.tid, gth = F.G * NTHR;
    if (!FP8_IN0) cvt_stream<8, false>(a.in[0], ws + WS_XB, (size_t)NTOK * DM, gtid, gth);
    else cvt_stream<8, true>(a.in[0], ws + WS_XQ, (size_t)NTOK * DM, gtid, gth);
    cvt_stream<8, false>(a.in[1], ws + WS_PB, (size_t)2 * NTOK * PLE, gtid, gth);
    for (int i = gtid; i < 8 * 128 * 128; i += gth) { const int t = (i >> 7) & 127, s = i & 127; const float v = (s <= t) ? a.in[5][i] : 0.f; ((bf16_t*)(ws + WS_WSB))[i] = (bf16_t)(cvt_pk_bf16(v, 0.f) & 0xffffu); }
}

__device__ __forceinline__ void gmlp_unit(Frame& F, const Args& a, int unit) {
    const bf16_t* z0 = (const bf16_t*)(a.ws + WS_Z); unsigned char* cat = (unsigned char*)(a.ws + WS_CAT); const bf16_t* wsb = (const bf16_t*)(a.ws + WS_WSB);
    const float* lng = a.in[3]; const float* lnb = a.in[4]; const float* bs = a.in[6];
    const size_t tok0 = (size_t)unit * 128;
    const int lane = F.lane, w = F.wave, r32 = lane & 31, hi = lane >> 5;
    LAS f32x2* stats = (LAS f32x2*)(F.lds + XTRA_OFF);
    for (int i = 0; i < 16; ++i) { const int tl = w * 16 + i;
        const u32x4 v = *(const u32x4*)(z0 + (tok0 + tl) * ZE + 512 + 8 * lane);
        float x[8] = {bf_lo(v.x), bf_hi(v.x), bf_lo(v.y), bf_hi(v.y), bf_lo(v.z), bf_hi(v.z), bf_lo(v.w), bf_hi(v.w)};
        float s = 0.f;
#pragma unroll
        for (int j = 0; j < 8; ++j) s += x[j];
        const float mean = wave_sum(s) * (1.f / 512.f); float q = 0.f;
#pragma unroll
        for (int j = 0; j < 8; ++j) { const float d = x[j] - mean; q += d * d; }
        const float rstd = 1.f / sqrtf(wave_sum(q) * (1.f / 512.f) + LN_EPS);
        if (lane == 0) stats[tl] = (f32x2){mean, rstd}; }
    __syncthreads();
    const int g = w;
    LAS unsigned char* vt = F.lds + w * 16384;
    { const int tl8 = lane >> 3, cc = lane & 7;
      float gg[8], bb[8];
#pragma unroll
      for (int j = 0; j < 8; ++j) { gg[j] = lng[g * 64 + 8 * cc + j]; bb[j] = lnb[g * 64 + 8 * cc + j]; }
      for (int it = 0; it < 16; ++it) { const int tl = 8 * it + tl8;
          const u32x4 v = *(const u32x4*)(z0 + (tok0 + tl) * ZE + 512 + g * 64 + 8 * cc);
          const f32x2 st = stats[tl];
          float x[8] = {bf_lo(v.x), bf_hi(v.x), bf_lo(v.y), bf_hi(v.y), bf_lo(v.z), bf_hi(v.z), bf_lo(v.w), bf_hi(v.w)};
#pragma unroll
          for (int j = 0; j < 8; ++j) { const int c = 8 * cc + j; const float y = (x[j] - st.x) * st.y * gg[j] + bb[j];
              *(LAS bf16_t*)(vt + c * 256 + ((((tl >> 3) ^ (c & 15))) << 4) + (tl & 7) * 2) = (bf16_t)(cvt_pk_bf16(y, 0.f) & 0xffffu); } } }
    LDS_WAIT(); asm volatile("" ::: "memory");
    for (int tb = 0; tb < 4; ++tb) {
        f32x16 d0 = {}, d1 = {};
        const bf16_t* wrow = wsb + ((size_t)g * 128 + tb * 32 + r32) * 128 + 8 * hi;
        bf16x8 afr[8];
#pragma unroll
        for (int ks = 0; ks < 8; ++ks) afr[ks] = *(const bf16x8*)(wrow + 16 * ks);
#pragma unroll
        for (int ks = 0; ks < 8; ++ks) { if (ks >= 2 * (tb + 1)) break;
            const bf16x8 af = afr[ks];
            const int chunk = 2 * ks + hi;
            const bf16x8 b0 = *(const LAS bf16x8*)(vt + r32 * 256 + ((chunk ^ (r32 & 15)) << 4));
            const bf16x8 b1 = *(const LAS bf16x8*)(vt + (32 + r32) * 256 + ((chunk ^ (r32 & 15)) << 4));
            d0 = __builtin_amdgcn_mfma_f32_32x32x16_bf16(af, b0, d0, 0, 0, 0);
            d1 = __builtin_amdgcn_mfma_f32_32x32x16_bf16(af, b1, d1, 0, 0, 0);
        }
#pragma unroll
        for (int r = 0; r < 16; ++r) { const int t = tb * 32 + (r & 3) + 8 * (r >> 2) + 4 * hi; const float bsv = bs[g * 128 + t];
            const size_t ro = (tok0 + t) * ZE + g * 64 + r32; const size_t co = (tok0 + t) * DM + g * 64 + r32;
            const float u0 = bf1(z0[ro]), u1 = bf1(z0[ro + 32]);
            CAT_ST(cat, co, u0 * (d0[r] + bsv)); CAT_ST(cat, co + 32, u1 * (d1[r] + bsv)); }
    }
    __syncthreads();
}

constexpr int SB_KST = 144;
constexpr int SB_TILE = 64 * SB_KST;
__device__ __forceinline__ void sb_unit(Frame& F, const Args& a, int b, int h, int qb) {
    const bf16_t* z0 = (const bf16_t*)(a.ws + WS_Z); unsigned char* cat = (unsigned char*)(a.ws + WS_CAT);
    const int tid = F.tid, lane = F.lane, wid = F.wave, r32 = lane & 31, hi = lane >> 5;
    const size_t rowbase = (size_t)b * SEQ;
    const int q0 = qb * 256, qw0 = q0 + wid * 32, tq = qw0 + r32;
    bf16x8 qr[4];
    { const bf16_t* qp = z0 + (rowbase + tq) * ZE + 1024 + h * 64 + hi * 8;
#pragma unroll
      for (int ks = 0; ks < 4; ++ks) qr[ks] = *(const bf16x8*)(qp + ks * 16); }
    f32x16 o0 = {}, o1 = {}; float C = 1.f;
    const int ntile = q0 / 64 + 4;
    LAS unsigned char* Kb = F.lds; LAS unsigned char* Vb = F.lds + 2 * SB_TILE;
    const bf16_t* kg = z0 + (rowbase + (tid >> 3)) * ZE + 1536 + h * 64 + (tid & 7) * 8;
    const unsigned ldst = (unsigned)(tid >> 3) * SB_KST + (unsigned)(tid & 7) * 16;
    { const size_t go = (size_t)(ntile - 1) * 64 * ZE; const u32x4 kn = *(const u32x4*)(kg + go), vn = *(const u32x4*)(kg + go + 512);
      *(LAS u32x4*)(Kb + ldst) = kn; *(LAS u32x4*)(Vb + ldst) = vn; }
    const int dh = (lane >> 4) & 1, q_ = (lane & 15) >> 2, p_ = lane & 3;
    for (int kt = ntile - 1; kt >= 0; --kt) {
        const int buf = (ntile - 1 - kt) & 1;
        u32x4 kn, vn;
        if (kt > 0) { const size_t go = (size_t)(kt - 1) * 64 * ZE; kn = *(const u32x4*)(kg + go); vn = *(const u32x4*)(kg + go + 512); }
        LDS_BARRIER();
        const LAS unsigned char* Kc = Kb + buf * SB_TILE; const LAS unsigned char* Vc = Vb + buf * SB_TILE;
        if (64 * kt <= qw0) {
            f32x16 p[2]; p[0] = (f32x16){}; p[1] = (f32x16){};
#pragma unroll
            for (int ks = 0; ks < 4; ++ks) {
                const bf16x8 k0 = *(const LAS bf16x8*)(Kc + r32 * SB_KST + (16 * ks + 8 * hi) * 2);
                const bf16x8 k1 = *(const LAS bf16x8*)(Kc + (32 + r32) * SB_KST + (16 * ks + 8 * hi) * 2);
                p[0] = __builtin_amdgcn_mfma_f32_32x32x16_bf16(k0, qr[ks], p[0], 0, 0, 0);
                p[1] = __builtin_amdgcn_mfma_f32_32x32x16_bf16(k1, qr[ks], p[1], 0, 0, 0);
            }
            const bool need_mask = (64 * kt + 64 > qw0);
            const int kb0 = 64 * kt + 4 * hi;
            float NB[2][16], BE[2][16];
            if (need_mask) {
#pragma unroll
                for (int bk = 0; bk < 2; ++bk)
#pragma unroll
                    for (int r = 0; r < 16; ++r) { const float rc = rcpf_(1.f + ex2(-p[bk][r]));
                        const int key = kb0 + 32 * bk + 8 * (r >> 2) + (r & 3); const bool ok = key < tq;
                        BE[bk][r] = ok ? rc : 0.f; NB[bk][r] = ok ? 1.f - rc : 1.f; }
            } else {
#pragma unroll
                for (int bk = 0; bk < 2; ++bk)
#pragma unroll
                    for (int r = 0; r < 16; ++r) { const float rc = rcpf_(1.f + ex2(-p[bk][r])); BE[bk][r] = rc; NB[bk][r] = 1.f - rc; }
            }
            float acc_c = C;
#pragma unroll
            for (int bk = 1; bk >= 0; --bk)
#pragma unroll
                for (int aa = 3; aa >= 0; --aa) {
                    const float R = (NB[bk][4 * aa] * NB[bk][4 * aa + 1]) * (NB[bk][4 * aa + 2] * NB[bk][4 * aa + 3]);
                    const auto rr = __builtin_amdgcn_permlane32_swap(__float_as_uint(R), __float_as_uint(R), false, false);
                    const float Rp = hi ? __uint_as_float(rr[0]) : __uint_as_float(rr[1]);
                    const float a3 = hi ? acc_c : acc_c * Rp, a2 = a3 * NB[bk][4 * aa + 3], a1 = a2 * NB[bk][4 * aa + 2], a0 = a1 * NB[bk][4 * aa + 1];
                    p[bk][4 * aa + 3] = BE[bk][4 * aa + 3] * a3; p[bk][4 * aa + 2] = BE[bk][4 * aa + 2] * a2;
                    p[bk][4 * aa + 1] = BE[bk][4 * aa + 1] * a1; p[bk][4 * aa + 0] = BE[bk][4 * aa + 0] * a0;
                    acc_c *= R * Rp;
                }
            C = acc_c;
            bf16x8 pa[2][2];
#pragma unroll
            for (int bk = 0; bk < 2; ++bk)
#pragma unroll
                for (int s = 0; s < 2; ++s) { u32x4 w; w.x = cvt_pk_bf16(p[bk][8 * s + 0], p[bk][8 * s + 1]); w.y = cvt_pk_bf16(p[bk][8 * s + 2], p[bk][8 * s + 3]);
                    w.z = cvt_pk_bf16(p[bk][8 * s + 4], p[bk][8 * s + 5]); w.w = cvt_pk_bf16(p[bk][8 * s + 6], p[bk][8 * s + 7]); pa[bk][s] = __builtin_bit_cast(bf16x8, w); }
#pragma unroll
            for (int bk = 0; bk < 2; ++bk)
#pragma unroll
                for (int s = 0; s < 2; ++s) {
                    const LAS unsigned char* vp = Vc + (32 * bk + 16 * s + 4 * hi + q_) * SB_KST + (16 * dh + 4 * p_) * 2;
                    const s16x4 l0 = __builtin_amdgcn_ds_read_tr16_b64_v4i16((LAS s16x4*)(vp));
                    const s16x4 h0 = __builtin_amdgcn_ds_read_tr16_b64_v4i16((LAS s16x4*)(vp + 8 * SB_KST));
                    const s16x4 l1 = __builtin_amdgcn_ds_read_tr16_b64_v4i16((LAS s16x4*)(vp + 64));
                    const s16x4 h1 = __builtin_amdgcn_ds_read_tr16_b64_v4i16((LAS s16x4*)(vp + 8 * SB_KST + 64));
                    const bf16x8 v0 = (bf16x8){l0[0], l0[1], l0[2], l0[3], h0[0], h0[1], h0[2], h0[3]};
                    const bf16x8 v1 = (bf16x8){l1[0], l1[1], l1[2], l1[3], h1[0], h1[1], h1[2], h1[3]};
                    o0 = __builtin_amdgcn_mfma_f32_32x32x16_bf16(pa[bk][s], v0, o0, 0, 0, 0);
                    o1 = __builtin_amdgcn_mfma_f32_32x32x16_bf16(pa[bk][s], v1, o1, 0, 0, 0);
                }
        }
        if (kt > 0) { *(LAS u32x4*)(Kb + (buf ^ 1) * SB_TILE + ldst) = kn; *(LAS u32x4*)(Vb + (buf ^ 1) * SB_TILE + ldst) = vn; }
    }
#pragma unroll
    for (int r = 0; r < 16; ++r) { const int q = (r & 3) + 8 * (r >> 2) + 4 * hi;
        const size_t oo = (rowbase + qw0 + q) * DM + 512 + h * 64 + r32;
        CAT_ST(cat, oo, o0[r]); CAT_ST(cat, oo + 32, o1[r]); }
    __syncthreads();
}

template <int I> struct SelStep {
    static __device__ __forceinline__ void run(const float (&v)[64], float thr, float lo, bool exact, int need_eq, int& eq_seen, unsigned& m0, unsigned& m1, int vis) {
        if constexpr ((I & 7) == 0) { if (I * 64 >= vis) return; }
        const bool gt = v[I] > thr; const bool eq = (!exact) && !gt && (v[I] > lo);
        const unsigned long long meq = __ballot(eq);
        const int eq_rank = eq_seen + __builtin_amdgcn_mbcnt_hi((unsigned)(meq >> 32), __builtin_amdgcn_mbcnt_lo((unsigned)meq, 0));
        const bool take = gt || (eq && eq_rank < need_eq);
        const unsigned long long mt = __ballot(take);
        const unsigned mlo = (unsigned)mt, mhi = (unsigned)(mt >> 32);
        asm volatile("s_nop 1\n\tv_writelane_b32 %0, %1, %2" : "+v"(m0) : "s"(mlo), "n"(I));
        asm volatile("s_nop 1\n\tv_writelane_b32 %0, %1, %2" : "+v"(m1) : "s"(mhi), "n"(I));
        eq_seen += __builtin_popcountll(meq);
        SelStep<I + 1>::run(v, thr, lo, exact, need_eq, eq_seen, m0, m1, vis);
    }
};
template <> struct SelStep<64> { static __device__ __forceinline__ void run(const float (&)[64], float, float, bool, int, int&, unsigned&, unsigned&, int) {} };

template <int I> struct SelExact {
    static __device__ __forceinline__ void run(const float (&v)[64], float thr, unsigned& m0, unsigned& m1, int vis) {
        if constexpr ((I & 7) == 0) { if (I * 64 >= vis) return; }
        const unsigned long long mt = __ballot(v[I] > thr);
        const unsigned mlo = (unsigned)mt, mhi = (unsigned)(mt >> 32);
        asm volatile("s_nop 1\n\tv_writelane_b32 %0, %1, %2" : "+v"(m0) : "s"(mlo), "n"(I));
        asm volatile("s_nop 1\n\tv_writelane_b32 %0, %1, %2" : "+v"(m1) : "s"(mhi), "n"(I));
        SelExact<I + 1>::run(v, thr, m0, m1, vis);
    }
};
template <> struct SelExact<64> { static __device__ __forceinline__ void run(const float (&)[64], float, unsigned&, unsigned&, int) {} };

__device__ __forceinline__ void dsa_select_unit(Frame& F, const Args& a, int unit) {
    const bf16_t* z1 = (const bf16_t*)(a.ws + WS_Z); unsigned* bm = (unsigned*)(a.ws + WS_BM);
    const int lane = F.lane, wid = F.wave, r32 = lane & 31, hi = lane >> 5;
    const int tok0 = unit * 8;
    const int b = tok0 / SEQ, t0 = tok0 % SEQ;
    const size_t rowbase = (size_t)b * SEQ;
    const int vis = (t0 / 64 + 1) * 64;
    LAS float* sc = (LAS float*)F.lds;
    if (vis > 256) {
        const int tl = 2 * (r32 >> 4) + ((r32 >> 2) & 1), hd = (r32 & 3) + 4 * ((r32 >> 3) & 1);
        bf16x8 af[2][4];
#pragma unroll
        for (int rt = 0; rt < 2; ++rt) { const bf16_t* qp = z1 + (size_t)(tok0 + 4 * rt + tl) * ZO + OQI + hd * 64 + 8 * hi;
#pragma unroll
            for (int ks = 0; ks < 4; ++ks) af[rt][ks] = *(const bf16x8*)(qp + 16 * ks); }
        float wv[4][8];
#pragma unroll
        for (int j = 0; j < 4; ++j) { const u32x4 w = *(const u32x4*)(z1 + (size_t)(tok0 + 2 * j + hi) * ZO + OWI);
            const float s = 0.35355339059f * 0.125f;
            wv[j][0] = bf_lo(w.x) * s; wv[j][1] = bf_hi(w.x) * s; wv[j][2] = bf_lo(w.y) * s; wv[j][3] = bf_hi(w.y) * s;
            wv[j][4] = bf_lo(w.z) * s; wv[j][5] = bf_hi(w.z) * s; wv[j][6] = bf_lo(w.w) * s; wv[j][7] = bf_hi(w.w) * s; }
        const int nkt = vis / 32;
        const bf16_t* kbase = (const bf16_t*)(a.ws + WS_KI1) + rowbase * 64 + (size_t)lane * 8;
        for (int rep14 = 0; rep14 < PM(14); ++rep14)
        for (int kt0 = wid; kt0 < nkt; kt0 += 8 * NWAVES) {
            bf16x8 kq[8][4];
#pragma unroll
            for (int pf = 0; pf < 8; ++pf) { const int kt = min(kt0 + pf * NWAVES, nkt - 1);
#pragma unroll
                for (int ks = 0; ks < 4; ++ks) kq[pf][ks] = *(const bf16x8*)(kbase + (size_t)(kt * 4 + ks) * 512); }
            __builtin_amdgcn_sched_barrier(0);
#pragma unroll
            for (int pf = 0; pf < 8; ++pf) { const int kt = kt0 + pf * NWAVES;
                if (kt < nkt) {
                    f32x16 d0 = {}, d1 = {};
#pragma unroll
                    for (int ks = 0; ks < 4; ++ks) { d0 = __builtin_amdgcn_mfma_f32_32x32x16_bf16(af[0][ks], kq[pf][ks], d0, 0, 0, 0); d1 = __builtin_amdgcn_mfma_f32_32x32x16_bf16(af[1][ks], kq[pf][ks], d1, 0, 0, 0); }
                    float s0 = 0.f, s1 = 0.f, s2 = 0.f, s3 = 0.f;
#pragma unroll
                    for (int r = 0; r < 8; ++r) { s0 += wv[0][r] * relu_i(d0[r]); s1 += wv[1][r] * relu_i(d0[8 + r]); s2 += wv[2][r] * relu_i(d1[r]); s3 += wv[3][r] * relu_i(d1[8 + r]); }
                    const int key = kt * 32 + r32;
                    sc[(hi) * 4096 + key] = s0; sc[(2 + hi) * 4096 + key] = s1; sc[(4 + hi) * 4096 + key] = s2; sc[(6 + hi) * 4096 + key] = s3;
                } }
        }
    }
    __syncthreads();
    for (int rep15 = 0; rep15 < PM(15); ++rep15) {
        unsigned m0 = 0u, m1 = 0u;
        if (vis <= 256) { m0 = 0xffffffffu; m1 = 0xffffffffu; }
        else {
            const LAS float* ms = sc + wid * 4096;
            float v[64];
            float mx = -INFINITY, mn = INFINITY;
#pragma unroll
            for (int i8 = 0; i8 < 8; ++i8) {
                if (i8 * 512 < vis) {
#pragma unroll
                    for (int j = 0; j < 8; ++j) { const int i = 8 * i8 + j; const bool in = (i * 64 < vis); v[i] = in ? ms[i * 64 + lane] : -INFINITY; if (in) { mx = fmaxf(mx, v[i]); mn = fminf(mn, v[i]); } }
                } else {
#pragma unroll
                    for (int j = 0; j < 8; ++j) v[8 * i8 + j] = -INFINITY;
                } }
            mx = wave_max_uniform(mx); mn = -wave_max_uniform(-mn);
            float lo = mn - 1.f - fabsf(mn), hiv = mx;
            float thr = hiv; int cgt = 0; bool exact = false;
            int c_lo = vis, c_hi = 0;
            bool dead = false;
            for (int it = 0; it < 64 && (c_lo - c_hi) > 512; ++it) {
                const float mid = 0.5f * (lo + hiv);
                if (!(mid > lo) || !(mid < hiv)) { dead = true; break; }
                int c = 0;
#pragma unroll
                for (int i8 = 0; i8 < 8; ++i8) { if (i8 * 512 >= vis) break;
#pragma unroll
                    for (int j = 0; j < 8; ++j) c += (v[8 * i8 + j] > mid) ? 1 : 0; }
                c = wave_sum_uniform(c);
                if (c == 256) { thr = mid; exact = true; break; }
                if (c > 256) { lo = mid; c_lo = c; } else { hiv = mid; c_hi = c; }
            }
            if (!exact && !dead) {
                LAS float* cand = sc + wid * 4096; int base = 0;
#pragma unroll
                for (int i8 = 0; i8 < 8; ++i8) { if (i8 * 512 >= vis) break;
#pragma unroll
                  for (int j = 0; j < 8; ++j) { const int i = 8 * i8 + j; const bool in = (v[i] > lo) && !(v[i] > hiv);
                    const unsigned long long mk = __ballot(in);
                    const int pos = base + __builtin_amdgcn_mbcnt_hi((unsigned)(mk >> 32), __builtin_amdgcn_mbcnt_lo((unsigned)mk, 0));
                    if (in) cand[pos] = v[i];
                    base += __builtin_popcountll(mk); } }
                const int nc = c_lo - c_hi, c_hi0 = c_hi;
                float cv[8];
#pragma unroll
                for (int j = 0; j < 8; ++j) cv[j] = (lane + 64 * j < nc) ? cand[lane + 64 * j] : -INFINITY;
                for (int it = 0; it < 64; ++it) {
                    const float mid = 0.5f * (lo + hiv);
                    if (!(mid > lo) || !(mid < hiv)) break;
                    int c = 0;
#pragma unroll
                    for (int j = 0; j < 8; ++j) c += (cv[j] > mid) ? 1 : 0;
                    c = c_hi0 + wave_sum_uniform(c);
                    if (c == 256) { thr = mid; exact = true; break; }
                    if (c > 256) { lo = mid; c_lo = c; } else { hiv = mid; c_hi = c; }
                }
            }
            if (!exact) { thr = hiv; cgt = c_hi; }
            const int need_eq = exact ? 0 : (256 - cgt); int eq_seen = 0;
            if (exact) SelExact<0>::run(v, thr, m0, m1, vis); else SelStep<0>::run(v, thr, lo, exact, need_eq, eq_seen, m0, m1, vis);
        }
        if (lane * 64 < vis) *(u32x2*)(bm + (size_t)(tok0 + wid) * 128 + 2 * lane) = (u32x2){m0, m1};
    }
    __syncthreads();
}

template <int I> struct MaskInit {
    static __device__ __forceinline__ void run(f32x16 (&p)[2], int nw0, int nw1, float slope2, float T, int ninf) {
        constexpr int bk = I >> 4, r = I & 15, pos = 8 * (r >> 2) + (r & 3);
        const float vb = __builtin_fmaf(slope2, (float)(32 * bk + pos), T);
        int off; asm("v_bfe_i32 %0, %1, %2, 1" : "=v"(off) : "v"(bk ? nw1 : nw0), "n"(pos));
        float o; asm("v_bfi_b32 %0, %1, %2, %3" : "=v"(o) : "v"(off), "s"(ninf), "v"(vb));
        p[bk][r] = o;
        MaskInit<I + 1>::run(p, nw0, nw1, slope2, T, ninf);
    }
};
template <> struct MaskInit<32> { static __device__ __forceinline__ void run(f32x16 (&)[2], int, int, float, float, int) {} };
__device__ __forceinline__ float max3_asm(float a, float b, float c) { float r; asm("v_max3_f32 %0, %1, %2, %3" : "=v"(r) : "v"(a), "v"(b), "v"(c)); return r; }
__device__ __forceinline__ void dsa_attn_unit(Frame& F, const Args& a, int b, int ch, int g) {
    const bf16_t* z1 = (const bf16_t*)(a.ws + WS_Z); unsigned char* cat = (unsigned char*)(a.ws + WS_CAT); const unsigned* bm = (const unsigned*)(a.ws + WS_BM);
    const int tid = F.tid, lane = F.lane, wid = F.wave, r32 = lane & 31, hi = lane >> 5;
    const int hr = wid >> 1, qh = wid & 1, head = g * 4 + hr;
    const size_t rowbase = (size_t)b * SEQ;
    const int tq = ch * 64 + 32 * qh + r32;
    const float slope2 = ex2(-0.5f * (float)(head + 1)) * LOG2E;
    bf16x8 qr[4];
    { const bf16_t* qp = z1 + (rowbase + tq) * ZO + OQ + head * 64 + hi * 8;
#pragma unroll
      for (int ks = 0; ks < 4; ++ks) qr[ks] = *(const bf16x8*)(qp + ks * 16); }
    const unsigned* mrow = bm + (rowbase + tq) * 128;
    f32x16 o0 = {}, o1 = {}; float m = 0.f, l = 0.f;
    const int ntile = ch + 1;
    LAS unsigned char* Kb = F.lds; LAS unsigned char* Vb = F.lds + 2 * SB_TILE;
    LAS float* wsf = (LAS float*)(F.lds + 4 * SB_TILE) + wid * 32;
    const bf16_t* kg = (const bf16_t*)(a.ws + WS_KV1) + (rowbase + (tid >> 3)) * 512 + g * 64 + (tid & 7) * 8;
    const unsigned ldst = (unsigned)(tid >> 3) * SB_KST + (unsigned)(tid & 7) * 16;
    { const u32x4 kn = *(const u32x4*)(kg), vn = *(const u32x4*)(kg + 256);
      *(LAS u32x4*)(Kb + ldst) = kn; *(LAS u32x4*)(Vb + ldst) = vn; }
    const int dh = (lane >> 4) & 1, q_ = (lane & 15) >> 2, p_ = lane & 3;
    u32x2 mw = *(const u32x2*)(mrow);
    for (int kt = 0; kt < ntile; ++kt) {
        const int buf = kt & 1;
        u32x4 kn, vn; u32x2 mwn = mw;
        if (kt + 1 < ntile) { const size_t go = (size_t)(kt + 1) * 64 * 512; kn = *(const u32x4*)(kg + go); vn = *(const u32x4*)(kg + go + 256); mwn = *(const u32x2*)(mrow + 2 * (kt + 1)); }
        LDS_BARRIER();
        const LAS unsigned char* Kc = Kb + buf * SB_TILE; const LAS unsigned char* Vc = Vb + buf * SB_TILE;
        const float T = slope2 * (float)(64 * kt + 4 * hi) - m;
        const int nw0 = (int)~(mw.x >> (4 * hi)), nw1 = (int)~(mw.y >> (4 * hi));
        f32x16 p[2];
        MaskInit<0>::run(p, nw0, nw1, slope2, T, (int)0xff800000);
#pragma unroll
        for (int ks = 0; ks < 4; ++ks) {
            const bf16x8 k0 = *(const LAS bf16x8*)(Kc + r32 * SB_KST + (16 * ks + 8 * hi) * 2);
            const bf16x8 k1 = *(const LAS bf16x8*)(Kc + (32 + r32) * SB_KST + (16 * ks + 8 * hi) * 2);
            p[0] = __builtin_amdgcn_mfma_f32_32x32x16_bf16(k0, qr[ks], p[0], 0, 0, 0);
            p[1] = __builtin_amdgcn_mfma_f32_32x32x16_bf16(k1, qr[ks], p[1], 0, 0, 0);
        }
        if (kt == ntile - 1) {
            const float basef = (float)(tq - (64 * kt + 4 * hi));
#pragma unroll
            for (int bk = 0; bk < 2; ++bk)
#pragma unroll
                for (int r = 0; r < 16; ++r) { const float rel = (float)(32 * bk + 8 * (r >> 2) + (r & 3)) - basef; p[bk][r] -= 2.f * slope2 * fmaxf(rel, 0.f); }
        } else asm volatile("s_nop 15\n\ts_nop 7" : "+v"(p[0]), "+v"(p[1]));
        float rm;
        { float a0 = max3_asm(p[0][0], p[0][1], p[1][0]), b0 = max3_asm(p[0][2], p[0][3], p[1][1]); a0 = max3_asm(a0, p[1][2], p[1][3]);
#pragma unroll
          for (int r = 4; r < 16; r += 4) { a0 = max3_asm(a0, p[0][r], p[0][r + 1]); b0 = max3_asm(b0, p[0][r + 2], p[0][r + 3]); a0 = max3_asm(a0, p[1][r], p[1][r + 1]); b0 = max3_asm(b0, p[1][r + 2], p[1][r + 3]); }
          rm = fmaxf(a0, b0); }
        rm = fmaxf(rm, sxf<32>(rm));
        if (__any(rm > 6.f) || kt == 0) {
            const float d = (kt == 0) ? ((rm > -1e30f) ? rm : 0.f) : ((rm > 6.f) ? rm : 0.f);
            const float alpha = ex2(-d);
            l *= alpha; m += d;
#pragma unroll
            for (int bk = 0; bk < 2; ++bk)
#pragma unroll
                for (int r = 0; r < 16; ++r) p[bk][r] -= d;
            if (hi == 0) wsf[r32] = alpha;
#pragma unroll
            for (int r = 0; r < 16; ++r) { const float al = wsf[(r & 3) + 8 * (r >> 2) + 4 * hi]; o0[r] *= al; o1[r] *= al; }
        }
        float ls = 0.f;
#pragma unroll
        for (int bk = 0; bk < 2; ++bk)
#pragma unroll
            for (int r = 0; r < 16; ++r) { const float e = ex2(p[bk][r]); p[bk][r] = e; ls += e; }
        l += ls;
        bf16x8 pa[2][2];
#pragma unroll
        for (int bk = 0; bk < 2; ++bk)
#pragma unroll
            for (int s = 0; s < 2; ++s) { u32x4 w; w.x = cvt_pk_bf16(p[bk][8 * s + 0], p[bk][8 * s + 1]); w.y = cvt_pk_bf16(p[bk][8 * s + 2], p[bk][8 * s + 3]);
                w.z = cvt_pk_bf16(p[bk][8 * s + 4], p[bk][8 * s + 5]); w.w = cvt_pk_bf16(p[bk][8 * s + 6], p[bk][8 * s + 7]); pa[bk][s] = __builtin_bit_cast(bf16x8, w); }
#pragma unroll
        for (int bk = 0; bk < 2; ++bk)
#pragma unroll
            for (int s = 0; s < 2; ++s) {
                const LAS unsigned char* vp = Vc + (32 * bk + 16 * s + 4 * hi + q_) * SB_KST + (16 * dh + 4 * p_) * 2;
                const s16x4 l0 = __builtin_amdgcn_ds_read_tr16_b64_v4i16((LAS s16x4*)(vp));
                const s16x4 h0 = __builtin_amdgcn_ds_read_tr16_b64_v4i16((LAS s16x4*)(vp + 8 * SB_KST));
                const s16x4 l1 = __builtin_amdgcn_ds_read_tr16_b64_v4i16((LAS s16x4*)(vp + 64));
                const s16x4 h1 = __builtin_amdgcn_ds_read_tr16_b64_v4i16((LAS s16x4*)(vp + 8 * SB_KST + 64));
                const bf16x8 v0 = (bf16x8){l0[0], l0[1], l0[2], l0[3], h0[0], h0[1], h0[2], h0[3]};
                const bf16x8 v1 = (bf16x8){l1[0], l1[1], l1[2], l1[3], h1[0], h1[1], h1[2], h1[3]};
                o0 = __builtin_amdgcn_mfma_f32_32x32x16_bf16(pa[bk][s], v0, o0, 0, 0, 0);
                o1 = __builtin_amdgcn_mfma_f32_32x32x16_bf16(pa[bk][s], v1, o1, 0, 0, 0);
            }
        if (kt + 1 < ntile) { *(LAS u32x4*)(Kb + (buf ^ 1) * SB_TILE + ldst) = kn; *(LAS u32x4*)(Vb + (buf ^ 1) * SB_TILE + ldst) = vn; }
        mw = mwn;
    }
    l += sxf<32>(l);
    if (hi == 0) wsf[r32] = 1.f / l;
#pragma unroll
    for (int r = 0; r < 16; ++r) { const int q = (r & 3) + 8 * (r >> 2) + 4 * hi; const float inv = wsf[q];
        const size_t oo = (rowbase + ch * 64 + 32 * qh + q) * DM + head * 64 + r32;
        CAT_ST(cat, oo, o0[r] * inv); CAT_ST(cat, oo + 32, o1[r] * inv); }
    __syncthreads();
}

__device__ __forceinline__ void ln_row16(const bf16_t* src, float (&x)[16], int lane) {
    const u32x4 a = *(const u32x4*)(src + 8 * lane), b = *(const u32x4*)(src + 512 + 8 * lane);
    x[0] = bf_lo(a.x); x[1] = bf_hi(a.x); x[2] = bf_lo(a.y); x[3] = bf_hi(a.y); x[4] = bf_lo(a.z); x[5] = bf_hi(a.z); x[6] = bf_lo(a.w); x[7] = bf_hi(a.w);
    x[8] = bf_lo(b.x); x[9] = bf_hi(b.x); x[10] = bf_lo(b.y); x[11] = bf_hi(b.y); x[12] = bf_lo(b.z); x[13] = bf_hi(b.z); x[14] = bf_lo(b.w); x[15] = bf_hi(b.w);
}
__device__ __forceinline__ void ln_norm16(float (&x)[16], const float* g, const float* bta, int lane) {
    float s = 0.f;
#pragma unroll
    for (int j = 0; j < 16; ++j) s += x[j];
    const float mean = wave_sum(s) * (1.f / DM); float q = 0.f;
#pragma unroll
    for (int j = 0; j < 16; ++j) { x[j] -= mean; q += x[j] * x[j]; }
    const float rstd = 1.f / sqrtf(wave_sum(q) * (1.f / DM) + LN_EPS);
    const f32x4 g0 = *(const f32x4*)(g + 8 * lane), g1 = *(const f32x4*)(g + 8 * lane + 4), g2 = *(const f32x4*)(g + 512 + 8 * lane), g3 = *(const f32x4*)(g + 512 + 8 * lane + 4);
    const f32x4 b0 = *(const f32x4*)(bta + 8 * lane), b1 = *(const f32x4*)(bta + 8 * lane + 4), b2 = *(const f32x4*)(bta + 512 + 8 * lane), b3 = *(const f32x4*)(bta + 512 + 8 * lane + 4);
#pragma unroll
    for (int j = 0; j < 4; ++j) { x[j] = x[j] * rstd * g0[j] + b0[j]; x[4 + j] = x[4 + j] * rstd * g1[j] + b1[j]; x[8 + j] = x[8 + j] * rstd * g2[j] + b2[j]; x[12 + j] = x[12 + j] * rstd * g3[j] + b3[j]; }
}
__device__ __forceinline__ void store16bf(bf16_t* dst, const float (&x)[16], int lane) {
    u32x4 a, b; a.x = cvt_pk_bf16(x[0], x[1]); a.y = cvt_pk_bf16(x[2], x[3]); a.z = cvt_pk_bf16(x[4], x[5]); a.w = cvt_pk_bf16(x[6], x[7]);
    b.x = cvt_pk_bf16(x[8], x[9]); b.y = cvt_pk_bf16(x[10], x[11]); b.z = cvt_pk_bf16(x[12], x[13]); b.w = cvt_pk_bf16(x[14], x[15]);
    *(u32x4*)(dst + 8 * lane) = a; *(u32x4*)(dst + 512 + 8 * lane) = b;
}
__device__ __forceinline__ void store16f8(unsigned char* dst, const float (&x)[16], int lane) {
    *(u32x2*)(dst + 8 * lane) = pg8::pack8_fp8((f32x4){x[0], x[1], x[2], x[3]}, (f32x4){x[4], x[5], x[6], x[7]});
    *(u32x2*)(dst + 512 + 8 * lane) = pg8::pack8_fp8((f32x4){x[8], x[9], x[10], x[11]}, (f32x4){x[12], x[13], x[14], x[15]});
}
constexpr int HS_STRIDE = 2064;
__device__ __forceinline__ void ln1_router_phase(Frame& F, const Args& a, int layer) {
    const bf16_t* t1 = (const bf16_t*)(a.ws + WS_T1); bf16_t* hb = (bf16_t*)(a.ws + WS_HB);
    const bf16_t* wrt = (const bf16_t*)(a.ws + WS_WRT) + (size_t)layer * NEXP * DM;
    const float* g = a.in[10] + layer * DM; const float* bta = a.in[11] + layer * DM; const float* br = a.in[13] + layer * NEXP;
    int* topi = (int*)(a.ws + WS_TOPI); float* gate = (float*)(a.ws + WS_GATE); int* cnt = (int*)(a.ws + WS_CNT);
    const int lane = F.lane, w = F.wave, tid = F.tid;
    LAS unsigned char* hs = F.lds;
    LAS float* part = (LAS float*)(F.lds + 36864);
    LAS float* logit = (LAS float*)(F.lds + 36864 + 16384);
    LAS int* hist = (LAS int*)(F.lds + 36864 + 16384 + 2048);
    LAS int* topk_i = (LAS int*)(F.lds + 36864 + 16384 + 2048 + 256); LAS float* topk_v = (LAS float*)(F.lds + 36864 + 16384 + 2048 + 512);
    const int n16 = lane & 15, kg4 = lane >> 4;
    bf16x8 bw[2][4];
#pragma unroll
    for (int n = 0; n < 2; ++n)
#pragma unroll
        for (int ks = 0; ks < 4; ++ks) bw[n][ks] = *(const bf16x8*)(wrt + (size_t)(16 * n + n16) * DM + 128 * w + 32 * ks + 8 * kg4);
    for (int grp2 = F.bid; grp2 < NGRP * PM(6); grp2 += F.G) { const int grp = grp2 % NGRP;
        if (tid < 32) hist[tid] = 0;
        __syncthreads();
        for (int it = 0; it < 8; ++it) {
            const int r0 = grp * 128 + it * 16;
#pragma unroll
            for (int rr = 0; rr < 2; ++rr) { const int rl = 2 * w + rr; float x[16];
                ln_row16(t1 + (size_t)(r0 + rl) * DM, x, lane); ln_norm16(x, g, bta, lane);
                store16bf(hb + (size_t)(r0 + rl) * DM, x, lane); store16f8((unsigned char*)(a.ws + WS_HQ) + (size_t)(r0 + rl) * DM, x, lane);
                u32x4 p, q; p.x = cvt_pk_bf16(x[0], x[1]); p.y = cvt_pk_bf16(x[2], x[3]); p.z = cvt_pk_bf16(x[4], x[5]); p.w = cvt_pk_bf16(x[6], x[7]);
                q.x = cvt_pk_bf16(x[8], x[9]); q.y = cvt_pk_bf16(x[10], x[11]); q.z = cvt_pk_bf16(x[12], x[13]); q.w = cvt_pk_bf16(x[14], x[15]);
                *(LAS u32x4*)(hs + rl * HS_STRIDE + 16 * lane) = p; *(LAS u32x4*)(hs + rl * HS_STRIDE + 1024 + 16 * lane) = q; }
            __syncthreads();
            { f32x4 d0 = {0.f, 0.f, 0.f, 0.f}, d1 = {0.f, 0.f, 0.f, 0.f};
#pragma unroll
              for (int ks = 0; ks < 4; ++ks) { const bf16x8 af = *(const LAS bf16x8*)(hs + n16 * HS_STRIDE + (128 * w + 32 * ks + 8 * kg4) * 2);
                  d0 = __builtin_amdgcn_mfma_f32_16x16x32_bf16(af, bw[0][ks], d0, 0, 0, 0); d1 = __builtin_amdgcn_mfma_f32_16x16x32_bf16(af, bw[1][ks], d1, 0, 0, 0); }
#pragma unroll
              for (int r = 0; r < 4; ++r) { part[(w * 16 + 4 * kg4 + r) * 32 + n16] = d0[r]; part[(w * 16 + 4 * kg4 + r) * 32 + 16 + n16] = d1[r]; } }
            __syncthreads();
            { const int row = tid >> 5, e = tid & 31; float s = br[e];
#pragma unroll
              for (int ww = 0; ww < 8; ++ww) s += part[(ww * 16 + row) * 32 + e];
              logit[row * 32 + e] = s; }
            __syncthreads();
            { const int row = tid >> 5, e = tid & 31; const float lv = logit[row * 32 + e]; int rank = 0;
#pragma unroll
              for (int e2 = 0; e2 < 32; ++e2) { const float o = logit[row * 32 + e2]; rank += (o > lv || (o == lv && e2 < e)) ? 1 : 0; }
              if (rank < 4) { topk_i[row * 4 + rank] = e; topk_v[row * 4 + rank] = lv; } }
            __syncthreads();
            if (tid < 16) { const int tok = r0 + tid;
                const int t0 = topk_i[tid * 4 + 0], t1 = topk_i[tid * 4 + 1], t2 = topk_i[tid * 4 + 2], t3 = topk_i[tid * 4 + 3];
                const float v0 = topk_v[tid * 4 + 0];
                const float e0 = 1.f, e1 = __expf(topk_v[tid * 4 + 1] - v0), e2 = __expf(topk_v[tid * 4 + 2] - v0), e3 = __expf(topk_v[tid * 4 + 3] - v0); const float inv = 1.f / (e0 + e1 + e2 + e3);
                *(int4*)(topi + (size_t)tok * 4) = make_int4(t0, t1, t2, t3);
                *(float4*)(gate + (size_t)tok * 4) = make_float4(e0 * inv, e1 * inv, e2 * inv, e3 * inv);
                atomicAdd((int*)&hist[t0], 1); atomicAdd((int*)&hist[t1], 1); atomicAdd((int*)&hist[t2], 1); atomicAdd((int*)&hist[t3], 1); }
        }
        __syncthreads();
        if (tid < 32) cnt[grp * 32 + tid] = hist[tid];
        __syncthreads();
    }
}

__device__ __forceinline__ void moe_tables(Frame& F, const Args& a, int grp) {
    const int* cnt = (const int*)(a.ws + WS_CNT);
    LAS int* T = (LAS int*)(F.lds + TAB_OFF);
    const int tid = F.tid, e = tid & 31, j = tid >> 5;
    { int s = 0, bf = 0;
      for (int gg = j * 16; gg < j * 16 + 16; ++gg) { const int c = cnt[gg * 32 + e]; s += c; if (gg < grp) bf += c; }
      T[TB_TOT16 / 4 + j * 32 + e] = s; T[TB_BEF16 / 4 + j * 32 + e] = bf; }
    __syncthreads();
    if (tid < 32) { int s = 0, bf = 0;
#pragma unroll
        for (int jj = 0; jj < 16; ++jj) { s += T[TB_TOT16 / 4 + jj * 32 + tid]; bf += T[TB_BEF16 / 4 + jj * 32 + tid]; }
        T[TB_TOTAL / 4 + tid] = s; T[TB_BEFORE / 4 + tid] = bf; T[TB_LCUR / 4 + tid] = 0; }
    __syncthreads();
    if (tid < 32) {
        int ps = 0;
#pragma nounroll
        for (int ee = 0; ee < tid; ++ee) ps += ((T[TB_TOTAL / 4 + ee] + 255) >> 8) << 8;
        T[TB_PADST / 4 + tid] = ps; T[TB_BASE / 4 + tid] = ps + T[TB_BEFORE / 4 + tid];
        if (tid == 31) { const int end = ps + (((T[TB_TOTAL / 4 + 31] + 255) >> 8) << 8); T[TB_PADST / 4 + 32] = end; T[TB_NTL / 4] = end >> 8; } }
    __syncthreads();
    { LAS unsigned char* t2e = (LAS unsigned char*)(F.lds + TAB_OFF + TB_T2E); const int ntl = T[TB_NTL / 4];
      for (int rt = tid; rt < ntl; rt += NTHR) { int e = 0;
#pragma nounroll
          for (int ee = 1; ee < 32; ++ee) e += (T[TB_PADST / 4 + ee] <= rt * 256) ? 1 : 0;
          t2e[rt] = (unsigned char)e; } }
    __syncthreads();
}
__device__ __forceinline__ void scatter_phase(Frame& F, const Args& a) {
    const int* topi = (const int*)(a.ws + WS_TOPI);
    int* slot = (int*)(a.ws + WS_SLOT); int* rowtok = (int*)(a.ws + WS_ROWG);
    LAS int* T = (LAS int*)(F.lds + TAB_OFF);
    const int tid = F.tid;
    if (F.bid >= NGRP) moe_tables(F, a, -1);
    for (int grp2 = F.bid; grp2 < NGRP * PM(7); grp2 += F.G) { const int grp = grp2 % NGRP;
        moe_tables(F, a, grp);
        { const int tok = grp * 128 + (tid >> 2), k = tid & 3; const int e = topi[(size_t)tok * 4 + k];
          const int rank = atomicAdd((int*)&T[TB_LCUR / 4 + e], 1); const int row = T[TB_BASE / 4 + e] + rank;
          slot[(size_t)tok * 4 + k] = row; rowtok[row] = tok; }
        if (grp < NEXP) {
            const int tot = T[TB_TOTAL / 4 + grp], st = T[TB_PADST / 4 + grp], en = T[TB_PADST / 4 + grp + 1];
            for (int r = st + tot + tid; r < en; r += NTHR) rowtok[r] = 0; }
        __syncthreads();
    }
}
__device__ __forceinline__ void combine_phase(Frame& F, const Args& a) {
    const bf16_t* hb = (const bf16_t*)(a.ws + WS_HB); const bf16_t* yb = (const bf16_t*)(a.ws + WS_XS); bf16_t* mid = (bf16_t*)(a.ws + WS_MIDB);
    const int* slot = (const int*)(a.ws + WS_SLOT);
    const int lane = F.lane;
    for (int tok2 = F.bid * NWAVES + F.wave; tok2 < NTOK * PM(10); tok2 += F.G * NWAVES) { const int tok = tok2 % NTOK;
        float x[16]; ln_row16(hb + (size_t)tok * DM, x, lane);
#pragma unroll
        for (int j = 0; j < 16; ++j) x[j] *= ALPHA;
        const int4 sl = *(const int4*)(slot + (size_t)tok * 4);
        const int s4[4] = {sl.x, sl.y, sl.z, sl.w};
        const float4 gt4 = *(const float4*)((const float*)(a.ws + WS_GATE) + (size_t)tok * 4);
        const float g4[4] = {gt4.x * 0.0625f, gt4.y * 0.0625f, gt4.z * 0.0625f, gt4.w * 0.0625f};
#pragma unroll
        for (int k = 0; k < 4; ++k) {
            if (Y_FP8) { const unsigned char* yr = (const unsigned char*)yb + (size_t)s4[k] * DM;
                const u32x2 p = *(const u32x2*)(yr + 8 * lane), q = *(const u32x2*)(yr + 512 + 8 * lane);
                const unsigned w4[4] = {p.x, p.y, q.x, q.y};
#pragma unroll
                for (int i = 0; i < 4; ++i) { const f32x2 lo = __builtin_amdgcn_cvt_pk_f32_fp8((int)w4[i], false), hi2 = __builtin_amdgcn_cvt_pk_f32_fp8((int)w4[i], true);
                    x[4 * i + 0] += lo.x * g4[k]; x[4 * i + 1] += lo.y * g4[k]; x[4 * i + 2] += hi2.x * g4[k]; x[4 * i + 3] += hi2.y * g4[k]; } }
            else { float y[16]; ln_row16(yb + (size_t)s4[k] * DM, y, lane);
#pragma unroll
                for (int j = 0; j < 16; ++j) x[j] += y[j] * (16.f * g4[k]); } }
        store16bf(mid + (size_t)tok * DM, x, lane); store16f8((unsigned char*)(a.ws + WS_MIDQ) + (size_t)tok * DM, x, lane);
    }
}
__device__ __forceinline__ void ln2_phase(Frame& F, const Args& a, int layer) {
    const bf16_t* t2 = (const bf16_t*)(a.ws + WS_T1); bf16_t* xb = (bf16_t*)(a.ws + WS_XB);
    const float* g = a.in[18] + layer * DM; const float* bta = a.in[19] + layer * DM;
    const int lane = F.lane;
    for (int tok2 = F.bid * NWAVES + F.wave; tok2 < NTOK * PM(12); tok2 += F.G * NWAVES) { const int tok = tok2 % NTOK;
        float x[16]; ln_row16(t2 + (size_t)tok * DM, x, lane); ln_norm16(x, g, bta, lane);
        if (layer == 0) { store16bf(xb + (size_t)tok * DM, x, lane); if (FP8_IN1 || FP8_IN1Q) store16f8((unsigned char*)(a.ws + WS_XQ) + (size_t)tok * DM, x, lane); }
        else { float* o = a.out + (size_t)tok * DM;
            *(f32x4*)(o + 8 * lane) = (f32x4){x[0], x[1], x[2], x[3]}; *(f32x4*)(o + 8 * lane + 4) = (f32x4){x[4], x[5], x[6], x[7]};
            *(f32x4*)(o + 512 + 8 * lane) = (f32x4){x[8], x[9], x[10], x[11]}; *(f32x4*)(o + 512 + 8 * lane + 4) = (f32x4){x[12], x[13], x[14], x[15]}; }
    }
}

__global__ void __launch_bounds__(NTHR, 2) __attribute__((target("no-packed-fp32-ops"))) hybrid_fwd(Args args) {
    extern __shared__ __attribute__((aligned(16))) unsigned char lds_raw[];
    Frame F;
    F.lds = (LAS unsigned char*)lds_raw;
    F.tid = threadIdx.x; F.lane = F.tid & 63; F.wave = __builtin_amdgcn_readfirstlane(F.tid >> 6); F.G = gridDim.x; F.bid = blockIdx.x;
    volatile LAS unsigned* MISC = (volatile LAS unsigned*)(F.lds + MISC_OFF);
    for (int u = F.tid; u < 128; u += NTHR) MISC[u] = 0u;
    __syncthreads();
    XcdBarrier bar = xcd_barrier_post((unsigned*)(args.ws + WS_CTL) + 4096, MISC + 8);
    const int lo = args.ph_lo; int ph = 0; (void)lo; (void)ph;
#ifndef PHMASK
#define PHMASK 0xfffff
#endif
#ifndef PROBE_DUP
#define PROBE_DUP 0
#endif
#define SITE(k) if constexpr ((PHMASK >> (k)) & 1)
typedef const __attribute__((address_space(4))) Args* KArgs;
#define PHASE_REFRESH int t_ = threadIdx.x; asm volatile("" : "+v"(t_)); F.tid = t_; F.lane = t_ & 63; F.wave = __builtin_amdgcn_readfirstlane(t_ >> 6); \
    { int b_ = blockIdx.x; asm volatile("" : "+s"(b_)); F.bid = b_; } \
    { unsigned l_ = 0; asm volatile("" : "+s"(l_)); F.lds = (LAS unsigned char*)lds_raw + l_; } LAS unsigned char* const ring = F.lds; \
    LOAD_ARGS unsigned char* const ws = A.ws;
#if defined(__HIP_DEVICE_COMPILE__)
#define LOAD_ARGS KArgs ap_ = (KArgs)__builtin_amdgcn_kernarg_segment_ptr(); asm volatile("" : "+s"(ap_)); const Args A = *ap_;
#else
#define LOAD_ARGS const Args A = args;
#endif
#ifdef MK_LAUNCHES_PER_PHASE
#define PHASE_BEGIN if (ph == lo) { PHASE_REFRESH
#define PHASE_END   } ++ph;
#define PHASE_END_LAST } ++ph;
#else
#define PHASE_BEGIN { PHASE_REFRESH
#ifdef PROBE_BAR2
#define PHASE_END   xcd_barrier(bar); xcd_barrier(bar); }
#else
#define PHASE_END   xcd_barrier(bar); }
#endif
#define PHASE_END_LAST if (layer == 0) xcd_barrier(bar); }
#endif
    using namespace pg8;

    PHASE_BEGIN SITE(0) p0_prologue(F, A); PHASE_END

    for (int layer = 0; layer < 2; ++layer) {
        PHASE_BEGIN
        SITE(1) {
        if (layer == 0) {
            SITE(16) { DenseOrder S; S.initp(ws + (FP8_IN0 ? WS_XQ : WS_XB), ws + WS_WIN0, NTOK, ZE, FP8_IN0 ? DM : 2 * DM, F.G, F.bid, PM(1)); EpiIn0 E{(bf16_t*)(ws + WS_Z), 0.125f * LOG2E}; int p8 = FP8_IN0 ? DM : 2 * DM; asm volatile("" : "+s"(p8)); gemm_phase<EpiIn0, DenseOrder, FP8_IN0 != 0>(ring, F.tid, p8, S, E); }
            SITE(17) { PleOrder S; S.D.init(ws + WS_PB, ws + WS_WPLE, 2 * NTOK, DM, PLE, F.G, F.bid, PM(1));
              int kple = 2 * PLE; asm volatile("" : "+s"(kple));
              EpiPlain E{(bf16_t*)(ws + WS_PPLE), DM}; gemm_phase(ring, F.tid, kple, S, E); }
        } else {
#if FP8_IN1Q
            SITE(18) { { DenseOrder S; S.initp(ws + WS_XQ, ws + WS_WIN1Q, NTOK, 1536, DM, F.G, F.bid, PM(1)); if (F.G == 256 && PM(1) == 1) S.rep = -1; EpiIn1 E{(bf16_t*)(ws + WS_Z), (bf16_t*)(ws + WS_KV1), (bf16_t*)(ws + WS_KI1), 0}; int p8 = DM; asm volatile("" : "+s"(p8)); gemm_phase<EpiIn1, DenseOrder, true>(ring, F.tid, p8, S, E); }
                       { DenseOrder S; S.initp(ws + WS_XB, ws + WS_WIN1 + (size_t)1536 * DM * 2, NTOK, ZO - 1536, 2 * DM, F.G, F.bid, PM(1)); if (F.G == 256 && PM(1) == 1) S.rep = -2; EpiIn1 E{(bf16_t*)(ws + WS_Z), (bf16_t*)(ws + WS_KV1), (bf16_t*)(ws + WS_KI1), 6}; int p8 = 2 * DM; asm volatile("" : "+s"(p8)); gemm_phase<EpiIn1, DenseOrder, false>(ring, F.tid, p8, S, E); } }
#else
            SITE(18) { DenseOrder S; S.initp(ws + (FP8_IN1 ? WS_XQ : WS_XB), ws + WS_WIN1, NTOK, ZO, FP8_IN1 ? DM : 2 * DM, F.G, F.bid, PM(1)); EpiIn1 E{(bf16_t*)(ws + WS_Z), (bf16_t*)(ws + WS_KV1), (bf16_t*)(ws + WS_KI1), 0}; int p8 = FP8_IN1 ? DM : 2 * DM; asm volatile("" : "+s"(p8)); gemm_phase<EpiIn1, DenseOrder, FP8_IN1 != 0>(ring, F.tid, p8, S, E); }
#endif
        }
        }
        PHASE_END
        PHASE_BEGIN
        if (layer == 0) {
            SITE(2) for (long L = F.bid; L < 1024 * PM(2); L += F.G) { const int v = (int)(L & 255), rnd = (int)((L >> 8) & 3), s = v & 3, bh = v >> 2;
                const int qb = rnd == 0 ? 15 - s : (rnd == 1 ? 8 + s : (rnd == 2 ? 7 - s : s));
                sb_unit(F, A, bh >> 3, bh & 7, qb); }
            SITE(3) for (int u = F.bid; u < PM(3) * NTOK / 128; u += F.G) gmlp_unit(F, A, u % (NTOK / 128));
        } else {
            SITE(4) for (int L = F.bid; L < PM(4) * NTOK / 8; L += F.G) { const int Lm = L % (NTOK / 8), r = Lm >> 8, cc = Lm & 255;
                const int j = (r & 1) ? 511 - cc : cc; dsa_select_unit(F, A, (r >> 1) * 512 + j); }
        }
        PHASE_END
        if (layer == 1) {
        PHASE_BEGIN
            SITE(13) for (int L = F.bid; L < 1024 * PM(13); L += F.G) { const int idx = L & 1023, pp = idx & 31, g = (idx >> 5) & 3, b = idx >> 7;
                dsa_attn_unit(F, A, b, 63 - pp, g); dsa_attn_unit(F, A, b, pp, g); }
        PHASE_END
        }
        PHASE_BEGIN
        SITE(5) { DenseOrder S; S.initp(ws + WS_CAT, ws + (layer == 0 ? WS_WO0 : WS_WO1), NTOK, DM, FP8_OUT ? DM : 2 * DM, F.G, F.bid, PM(5));
          EpiOut E{layer == 0 ? A.in[0] : nullptr, (const bf16_t*)(ws + WS_XB), (bf16_t*)(ws + WS_T1)}; int p8 = FP8_OUT ? DM : 2 * DM; asm volatile("" : "+s"(p8)); gemm_phase<EpiOut, DenseOrder, FP8_OUT != 0>(ring, F.tid, p8, S, E); }
        PHASE_END
        PHASE_BEGIN SITE(6) ln1_router_phase(F, A, layer); PHASE_END
        PHASE_BEGIN SITE(7) scatter_phase(F, A); PHASE_END
        PHASE_BEGIN
        SITE(8) {
#ifdef MK_LAUNCHES_PER_PHASE
          moe_tables(F, A, -1);
#endif
          const int ntl = __builtin_amdgcn_readfirstlane(((LAS int*)(F.lds + TAB_OFF))[TB_NTL / 4]);
          MoeOrder<8, true> S; S.nunits = ntl * 8; S.G = F.G; S.c = F.bid; S.rep = PM(8); S.t2e = (const LAS unsigned char*)(F.lds + TAB_OFF + TB_T2E);
          S.A = (const char*)(ws + WS_HQ); S.rowtok = (const int*)(ws + WS_ROWG); S.W = (const char*)(ws + WS_WGU) + (size_t)layer * 32 * 2048 * DM;
          EpiSwiglu E{(unsigned char*)(ws + WS_ACT), A.in[15] + (size_t)layer * 32 * 2048}; int p8 = DM; asm volatile("" : "+s"(p8)); gemm_phase<EpiSwiglu, MoeOrder<8, true>, true, MOE_ALIGN>(ring, F.tid, p8, S, E); }
        PHASE_END
        PHASE_BEGIN
        SITE(9) {
#ifdef MK_LAUNCHES_PER_PHASE
          moe_tables(F, A, -1);
#endif
          const int ntl = __builtin_amdgcn_readfirstlane(((LAS int*)(F.lds + TAB_OFF))[TB_NTL / 4]);
          MoeOrder<4, false> S; S.nunits = ntl * 4; S.G = F.G; S.c = F.bid; S.rep = PM(9); S.t2e = (const LAS unsigned char*)(F.lds + TAB_OFF + TB_T2E);
          S.A = (const char*)(ws + WS_ACT); S.rowtok = nullptr; S.W = (const char*)(ws + WS_WD) + (size_t)layer * 32 * DM * DM;
          EpiDown E{(unsigned char*)(ws + WS_XS), A.in[17] + (size_t)layer * 32 * DM}; int p8 = DM; asm volatile("" : "+s"(p8)); gemm_phase<EpiDown, MoeOrder<4, false>, true, MOE_ALIGN>(ring, F.tid, p8, S, E); }
        PHASE_END
        PHASE_BEGIN SITE(10) combine_phase(F, A); PHASE_END
        PHASE_BEGIN
        SITE(11) { DenseOrder S; S.initp(ws + (FP8_GATE ? WS_MIDQ : WS_MIDB), ws + WS_WG + (size_t)layer * DM * DM * (FP8_GATE ? 1 : 2), NTOK, DM, FP8_GATE ? DM : 2 * DM, F.G, F.bid, PM(11));
          EpiGate E{(const bf16_t*)(ws + WS_MIDB), (const bf16_t*)(ws + WS_PPLE) + (size_t)layer * NTOK * DM, A.in[22] + layer * DM, (bf16_t*)(ws + WS_T1)}; int p8 = FP8_GATE ? DM : 2 * DM; asm volatile("" : "+s"(p8)); gemm_phase<EpiGate, DenseOrder, FP8_GATE != 0>(ring, F.tid, p8, S, E); }
        PHASE_END
        PHASE_BEGIN SITE(12) ln2_phase(F, A, layer); PHASE_END_LAST
    }
#undef PHASE_BEGIN
#undef PHASE_END
#undef PHASE_END_LAST
}
constexpr int N_PHASES = 22;

extern "C" void kernel_launch(void* const* d_in, const int* in_sizes, int n_in, void* d_out, int out_size, void* d_ws, size_t ws_size, hipStream_t stream) {
    static int grid = 0;
    if (grid == 0) {
        if (n_in != 23 || out_size != NTOK * DM || ws_size < WS_END) { fprintf(stderr, "kernel_launch: unexpected problem: n_in %d out %d ws %zu (need %zu)\n", n_in, out_size, ws_size, (size_t)WS_END); grid = -1; return; }
        int dev = 0, cus = 0, per_cu = 0;
        if (hipGetDevice(&dev) != hipSuccess || hipDeviceGetAttribute(&cus, hipDeviceAttributeMultiprocessorCount, dev) != hipSuccess) { grid = -1; return; }
        if (hipFuncSetAttribute((const void*)hybrid_fwd, hipFuncAttributeMaxDynamicSharedMemorySize, LDS_BYTES) != hipSuccess) { fprintf(stderr, "kernel_launch: hipFuncSetAttribute failed\n"); grid = -1; return; }
        if (hipOccupancyMaxActiveBlocksPerMultiprocessor(&per_cu, (const void*)hybrid_fwd, NTHR, LDS_BYTES) != hipSuccess || per_cu < 1) fprintf(stderr, "kernel_launch: occupancy query says %d\n", per_cu);
        (void)hipGetLastError();
        grid = cus;
    }
    if (grid < 0) return;
    (void)hipMemsetAsync((char*)d_ws + WS_CTL, 0, CTL_ZERO_BYTES, stream);
    Args a{};
    for (int i = 0; i < 23; ++i) a.in[i] = (const float*)d_in[i];
    a.out = (float*)d_out; a.ws = (unsigned char*)d_ws;
#ifndef MK_LAUNCHES_PER_PHASE
    a.ph_lo = 0; a.ph_hi = N_PHASES;
    hipLaunchKernelGGL(hybrid_fwd, dim3(grid), dim3(NTHR), LDS_BYTES, stream, a);
#else
    for (int p = 0; p < N_PHASES; ++p) { a.ph_lo = p; a.ph_hi = p + 1; hipLaunchKernelGGL(hybrid_fwd, dim3(grid), dim3(NTHR), LDS_BYTES, stream, a); }
#endif
}
```

```cpp
#include <hip/hip_runtime.h>
#include <cstdio>
#include <cstdint>

#define LAS __attribute__((address_space(3)))
#define GAS __attribute__((address_space(1)))
typedef unsigned short bf16_t;
typedef short bf16x8 __attribute__((ext_vector_type(8)));
typedef short s16x4 __attribute__((ext_vector_type(4)));
typedef float f32x2 __attribute__((ext_vector_type(2)));
typedef float f32x4 __attribute__((ext_vector_type(4)));
typedef float f32x16 __attribute__((ext_vector_type(16)));
typedef unsigned u32x2 __attribute__((ext_vector_type(2)));
typedef unsigned u32x4 __attribute__((ext_vector_type(4)));

constexpr int DM = 1024, NB = 8, SEQ = 4096, NTOK = NB * SEQ;
constexpr int ZE = 2560;
constexpr int ZO = 2304, ZO_REAL = 2120;
constexpr int OQ = 0, OK_ = 1024, OV = 1280, OQI = 1536, OKI = 2048, OWI = 2112;
constexpr int NEXP = 32, PLE = 256;
constexpr int NGRP = NTOK / 128;
constexpr int MAXTILES = NTOK * 4 / 256 + NEXP;
constexpr int MAXROWS = MAXTILES * 256;
constexpr float LN_EPS = 1e-5f;
constexpr float ALPHA = 1.4142135623730951f;
constexpr float LOG2E = 1.4426950408889634f;
constexpr float WSC = 64.f, WSC_INV = 1.f / 64.f;

#ifndef FP8_IN0
#define FP8_IN0 1
#endif
#ifndef Y_FP8
#define Y_FP8 1
#endif
#ifndef MOE_ALIGN
#define MOE_ALIGN true
#endif
#ifndef FP8_IN1Q
#define FP8_IN1Q 1
#endif
#ifndef FP8_IN1
#define FP8_IN1 0
#endif
#ifndef FP8_OUT
#define FP8_OUT 1
#endif
#ifndef FP8_GATE
#define FP8_GATE 1
#endif
#ifndef PROBE_DUP
#define PROBE_DUP 0
#endif
#define PM(k) (((PROBE_DUP >> (k)) & 1) ? 2 : 1)

constexpr size_t MiB = 1u << 20;
constexpr size_t WS_CTL = 0, CTL_ZERO_BYTES = 1 * MiB;
constexpr size_t WS_WRT = 1 * MiB;
constexpr size_t WS_WSB = WS_WRT + 256 * 1024;
constexpr size_t WS_CNT = WS_WSB + 256 * 1024;
constexpr size_t WS_TOPI = 2 * MiB;
constexpr size_t WS_GATE = WS_TOPI + 512 * 1024;
constexpr size_t WS_SLOT = 3 * MiB;
constexpr size_t WS_ROWG = WS_SLOT + 512 * 1024;
constexpr size_t WS_HQ = 1056 * MiB + 160 * MiB;
constexpr size_t WS_WIN0 = 8 * MiB, WS_WO0 = 13 * MiB, WS_WIN1 = 15 * MiB, WS_WO1 = 20 * MiB, WS_WG = 22 * MiB, WS_WPLE = 26 * MiB;
constexpr size_t WS_WGU = 32 * MiB, WS_WD = 288 * MiB;
constexpr size_t WS_WIN1Q = 28 * MiB;
constexpr size_t WS_XB = 416 * MiB, WS_PB = 480 * MiB, WS_PPLE = 512 * MiB, WS_Z = 640 * MiB, WS_CAT = 800 * MiB, WS_T1 = 864 * MiB;
constexpr size_t WS_BM = 1328 * MiB;
constexpr size_t WS_KV1 = WS_BM + 16 * MiB;
constexpr size_t WS_KI1 = WS_KV1 + 32 * MiB;
constexpr size_t WS_HB = 928 * MiB, WS_MIDB = 992 * MiB, WS_XS = 1056 * MiB, WS_ACT = 1328 * MiB;
constexpr size_t WS_XQ = 1600 * MiB, WS_MIDQ = 1632 * MiB, WS_END = 1664 * MiB;
static_assert(WS_ROWG + (size_t)MAXROWS * 4 <= WS_WIN0, "small buffers");
static_assert(WS_XS + (size_t)MAXROWS * DM * 2 <= WS_ACT && WS_ACT + (size_t)MAXROWS * DM * 2 <= WS_END, "moe buffers");

constexpr int RING_BYTES = 131072;
constexpr int MISC_OFF = RING_BYTES;
constexpr int TAB_OFF = MISC_OFF + 512;
constexpr int XTRA_OFF = TAB_OFF + 6144;
constexpr int LDS_BYTES = 147456;
static_assert(XTRA_OFF + 8192 <= LDS_BYTES, "LDS map");
constexpr int TB_TOT16 = 0, TB_BEF16 = 2048, TB_TOTAL = 4096, TB_BEFORE = 4224, TB_PADST = 4352  , TB_NTL = 4488, TB_LCUR = 4608  , TB_BASE = 4736  , TB_T2E = 5120  ;
static_assert(TB_T2E + 544 <= 6144, "tab");

#define RLX_AGENT __ATOMIC_RELAXED, __HIP_MEMORY_SCOPE_AGENT
typedef __bf16 bf16x2_t __attribute__((ext_vector_type(2)));
__device__ __forceinline__ unsigned cvt_pk_bf16(float lo, float hi) { const f32x2 v = {lo, hi}; const bf16x2_t b = __builtin_convertvector(v, bf16x2_t); return __builtin_bit_cast(unsigned, b); }
__device__ __forceinline__ unsigned char f8_1(float v) { return (unsigned char)(__builtin_amdgcn_cvt_pk_fp8_f32(v, v, 0, false) & 0xff); }
#if FP8_OUT
#define CAT_ST(cat, idx, v) ((cat)[idx] = f8_1(v))
#else
#define CAT_ST(cat, idx, v) (((bf16_t*)(cat))[idx] = (bf16_t)(cvt_pk_bf16((v), 0.f) & 0xffffu))
#endif
__device__ __forceinline__ float bf_lo(unsigned u) { return __uint_as_float(u << 16); }
__device__ __forceinline__ float bf_hi(unsigned u) { return __uint_as_float(u & 0xffff0000u); }
__device__ __forceinline__ float bf1(bf16_t u) { return __uint_as_float(((unsigned)u) << 16); }
template <int K> __device__ __forceinline__ int sxi(int v) {
    if constexpr (K == 32) { const auto rr = __builtin_amdgcn_permlane32_swap((unsigned)v, (unsigned)v, false, false); return (int)(rr[0] ^ rr[1] ^ (unsigned)v); }
    else return __builtin_amdgcn_ds_swizzle(v, (K << 10) | 0x1f);
}
template <int K> __device__ __forceinline__ float sxf(float v) { return __int_as_float(sxi<K>(__float_as_int(v))); }
__device__ __forceinline__ float wave_sum(float x) {
    int v = __float_as_int(x);
#define WSF_STEP(ctrl, rm) { const int o = __builtin_amdgcn_update_dpp(0, v, ctrl, rm, 0xf, false); v = __float_as_int(__int_as_float(v) + __int_as_float(o)); }
    WSF_STEP(0x111, 0xf) WSF_STEP(0x112, 0xf) WSF_STEP(0x114, 0xf) WSF_STEP(0x118, 0xf) WSF_STEP(0x142, 0xa) WSF_STEP(0x143, 0xc)
#undef WSF_STEP
    return __int_as_float(__builtin_amdgcn_readlane(v, 63));
}
__device__ __forceinline__ float wave_max(float v) {
    v = fmaxf(v, sxf<1>(v)); v = fmaxf(v, sxf<2>(v)); v = fmaxf(v, sxf<4>(v)); v = fmaxf(v, sxf<8>(v)); v = fmaxf(v, sxf<16>(v)); v = fmaxf(v, sxf<32>(v));
    return v;
}
__device__ __forceinline__ float wave_min(float v) {
    v = fminf(v, sxf<1>(v)); v = fminf(v, sxf<2>(v)); v = fminf(v, sxf<4>(v)); v = fminf(v, sxf<8>(v)); v = fminf(v, sxf<16>(v)); v = fminf(v, sxf<32>(v));
    return v;
}
__device__ __forceinline__ int wave_sumi(int v) {
    v += sxi<1>(v); v += sxi<2>(v); v += sxi<4>(v); v += sxi<8>(v); v += sxi<16>(v); v += sxi<32>(v);
    return v;
}
__device__ __forceinline__ int wave_sum_uniform(int v) {
    v += __builtin_amdgcn_update_dpp(0, v, 0x111, 0xf, 0xf, false);
    v += __builtin_amdgcn_update_dpp(0, v, 0x112, 0xf, 0xf, false);
    v += __builtin_amdgcn_update_dpp(0, v, 0x114, 0xf, 0xf, false);
    v += __builtin_amdgcn_update_dpp(0, v, 0x118, 0xf, 0xf, false);
    v += __builtin_amdgcn_update_dpp(0, v, 0x142, 0xa, 0xf, false);
    v += __builtin_amdgcn_update_dpp(0, v, 0x143, 0xc, 0xf, false);
    return __builtin_amdgcn_readlane(v, 63);
}
__device__ __forceinline__ float wave_max_uniform(float x) {
    int v = __float_as_int(x);
#define WMX_STEP(ctrl, rm) { const int o = __builtin_amdgcn_update_dpp(v, v, ctrl, rm, 0xf, false); v = __float_as_int(fmaxf(__int_as_float(v), __int_as_float(o))); }
    WMX_STEP(0x111, 0xf) WMX_STEP(0x112, 0xf) WMX_STEP(0x114, 0xf) WMX_STEP(0x118, 0xf) WMX_STEP(0x142, 0xa) WMX_STEP(0x143, 0xc)
#undef WMX_STEP
    return __int_as_float(__builtin_amdgcn_readlane(v, 63));
}
__device__ __forceinline__ float relu_i(float x) { const int i = __float_as_int(x); return __int_as_float(i > 0 ? i : 0); }
__device__ __forceinline__ float ex2(float x) { return __builtin_amdgcn_exp2f(x); }
__device__ __forceinline__ float lg2(float x) { return __builtin_amdgcn_logf(x); }
__device__ __forceinline__ float rcpf_(float x) { return __builtin_amdgcn_rcpf(x); }
__device__ __forceinline__ float sigmoidf_(float x) { return rcpf_(1.f + ex2(-LOG2E * x)); }
__device__ __forceinline__ float gelu_tanh(float x) { return x * rcpf_(1.f + ex2(-2.302208198f * (x + 0.044715f * x * x * x))); }

namespace pg8 {
constexpr int BM = 256, BK = 64, HALF = 128, HTB = HALF * BK * 2, STAGE_BYTES = 8 * HTB, NXCD = 8, WGM = 8;
__host__ __device__ __forceinline__ int lds_byte(int r, int c) { const int st = (r >> 4) * 2 + (c >> 5), rr = r & 15, cc = c & 31, ob = rr * 64 + cc * 2; return st * 1024 + (ob ^ (((ob >> 9) & 1) << 5)); }
__host__ __device__ __forceinline__ void stage_rc(int b, int& R, int& C) { const int st = b / 1024, sb = b % 1024, swz = sb ^ (((sb >> 9) & 1) << 5); R = (st >> 1) * 16 + swz / 64; C = (st & 1) * 32 + (swz % 64) / 2; }
__host__ __device__ __forceinline__ int perm32(int rho) { const int n = rho >> 4, i = rho & 15; return 8 * (i >> 2) + 4 * n + (i & 3); }

struct Unit { int pm, pn, e; const char* b0; };
typedef int v8i_t __attribute__((ext_vector_type(8)));
typedef int v4i_t __attribute__((ext_vector_type(4)));
__device__ __forceinline__ v8i_t cat8(const bf16x8 a, const bf16x8 b) { const v4i_t x = __builtin_bit_cast(v4i_t, a), y = __builtin_bit_cast(v4i_t, b); return __builtin_shufflevector(x, y, 0, 1, 2, 3, 4, 5, 6, 7); }

struct DenseOrder {
    static constexpr bool GATHER = false;
    int nM, nN, nwg, G, c, rep; const char* A; const char* B; size_t tstep, hstep;
    __device__ __forceinline__ void init(const void* A_, const void* B_, int M, int N, int K, int G_, int c_, int rep_ = 1) { initp(A_, B_, M, N, 2 * K, G_, c_, rep_); }
    __device__ __forceinline__ void initp(const void* A_, const void* B_, int M, int N, int pitch, int G_, int c_, int rep_ = 1) { A = (const char*)A_; B = (const char*)B_; nM = M / BM; nN = N / BM; nwg = nM * nN; G = G_; c = c_; rep = rep_; hstep = (size_t)HALF * pitch; tstep = 2 * hstep; }
    __device__ __forceinline__ bool next(int i, Unit& u) const {
        const int mode = rep < 0 ? -rep : 0, rp = rep < 0 ? 1 : rep;
        int L = i * G + c, ok = 1;
        if (mode == 1) { const int hG = G >> 1; if (i >= 2) { ok = (c >= hG && i < 4) ? 1 : 0; L = 2 * G + (i - 2) * hG + (c - hG); } }
        else if (mode == 2) { if (i >= 1) { ok = (i == 1 && c < (G >> 1)) ? 1 : 0; L = G + c; } }
        if (L >= nwg * rp) ok = 0;
        if (!__builtin_amdgcn_readfirstlane(ok)) return false;
        if (L >= nwg) L -= nwg;
        int wgid = __builtin_amdgcn_readfirstlane(L); { const int q = nwg / NXCD, r = nwg % NXCD, xcd = wgid % NXCD, off = wgid / NXCD; wgid = (xcd < r ? xcd * (q + 1) : r * (q + 1) + (xcd - r) * q) + off; }
        const int nig = WGM * nN, gid = wgid / nig, fm = gid * WGM, gsz = (nM - fm) < WGM ? (nM - fm) : WGM;
        u.pm = fm + ((wgid % nig) % gsz); u.pn = (wgid % nig) / gsz; u.e = 0;
        u.b0 = B + (size_t)u.pn * tstep; return true;
    }
    __device__ __forceinline__ const char* aptr(const Unit& u) const { return A + (size_t)u.pm * tstep; }
    __device__ __forceinline__ size_t b1off() const { return hstep; }
    __device__ __forceinline__ int rowtok_at(int) const { return 0; }
};
struct PleOrder {
    static constexpr bool GATHER = false;
    DenseOrder D;
    __device__ __forceinline__ bool next(int i, Unit& u) const { if (!D.next(i, u)) return false; if (u.pm >= 32768 / BM) u.b0 += (size_t)1024 * 256 * 2; return true; }
    __device__ __forceinline__ const char* aptr(const Unit& u) const { return D.aptr(u); }
    __device__ __forceinline__ size_t b1off() const { return D.b1off(); }
    __device__ __forceinline__ int rowtok_at(int) const { return 0; }
};
template <int NT, bool SWIGLU>
struct MoeOrder {
    static constexpr bool GATHER = SWIGLU;
    int nunits, G, c, rep; const LAS unsigned char* t2e; const char* A; const char* W; const int* rowtok;
    static constexpr size_t hstep = (size_t)HALF * 1024, tstep = 2 * hstep;
    __device__ __forceinline__ bool next(int i, Unit& u) const {
        const int vc = ((G & 7) == 0) ? (c & 7) * (G >> 3) + (c >> 3) : c;
        int L = i * G + vc; if (L >= nunits * rep) return false; if (L >= nunits) L -= nunits;
        const int rt = L / NT, pn = L % NT;
        const int e = __builtin_amdgcn_readfirstlane((int)t2e[rt]);
        u.pm = rt; u.pn = pn; u.e = e;
        if (SWIGLU) u.b0 = W + (size_t)e * (16 * hstep) + (size_t)pn * hstep;
        else u.b0 = W + (size_t)e * (8 * hstep) + (size_t)pn * tstep;
        return true;
    }
    __device__ __forceinline__ const char* aptr(const Unit& u) const { return GATHER ? A : A + (size_t)u.pm * tstep; }
    __device__ __forceinline__ size_t b1off() const { return SWIGLU ? 8 * hstep : hstep; }
    __device__ __forceinline__ int rowtok_at(int row) const { return rowtok[row]; }
};

template <class Epi, class Sched, bool FP8 = false, bool ALIGN_EPI = true>
__device__ __forceinline__ void gemm_phase(LAS unsigned char* lds, const int tid, const int pitch, const Sched& S, const Epi& E) {
    const int wid = __builtin_amdgcn_readfirstlane(tid >> 6), lane = tid & 63, wr = wid >> 2, wc = wid & 3, fr = lane & 15, fq = lane >> 4;
    const int nt = pitch / (BK * 2);
    unsigned voffA[2], voffB[2];
#pragma unroll
    for (int i = 0; i < 2; ++i) { int R, C; stage_rc(tid * 16 + i * 8192, R, C); const int Rb = (R & ~31) + perm32(R & 31);
        voffA[i] = (unsigned)(R * pitch + C * 2); voffB[i] = (unsigned)(Rb * pitch + C * 2); }
    const size_t kstep = (size_t)(BK * 2);
    const size_t hstep = (size_t)HALF * pitch;
    constexpr bool GATHER = Sched::GATHER;
    unsigned vA[2][2], vAn[2][2]; int gR[2], gC[2];
    if constexpr (GATHER) {
#pragma unroll
        for (int i = 0; i < 2; ++i) { int R, C; stage_rc(tid * 16 + i * 8192, R, C); gR[i] = R; gC[i] = C * 2; } }
    auto gather_tok = [&](const Unit& u, int (&tk)[2][2]) {
#pragma unroll
        for (int h = 0; h < 2; ++h)
#pragma unroll
            for (int i = 0; i < 2; ++i) tk[h][i] = S.rowtok_at(u.pm * BM + h * HALF + gR[i]); };
    auto gather_off = [&](const int (&tk)[2][2], unsigned (&v)[2][2]) {
#pragma unroll
        for (int h = 0; h < 2; ++h)
#pragma unroll
            for (int i = 0; i < 2; ++i) v[h][i] = (unsigned)(tk[h][i] * pitch + gC[i]); };
    const unsigned ldsw = (unsigned)wid * 1024u;
    int sc127 = 127, scw = Epi::SCALE_EXP; asm volatile("" : "+v"(sc127), "+v"(scw));
    const unsigned ldsu = (unsigned)__builtin_amdgcn_readfirstlane((int)(unsigned)(uintptr_t)lds) + ldsw;
    const int aoff = lds_byte(wr * 64 + fr, fq * 8), boff = lds_byte(wc * 32 + fr, fq * 8);
#define PG8_SA(b, h) (((b) * 2 + (h)) * HTB)
#define PG8_SB(b, h) ((4 + (b) * 2 + (h)) * HTB)
#define PG8_STAGE(bufoff, gbase, voff) do { _Pragma("unroll") for (int _i = 0; _i < 2; ++_i) { unsigned _keep; \
        asm volatile("s_mov_b32 %0, m0\n\ts_mov_b32 m0, %3\n\ts_nop 0\n\tglobal_load_lds_dwordx4 %1, %2\n\ts_mov_b32 m0, %0" : "=&s"(_keep) : "v"((voff)[_i]), "s"((const char*)(gbase)), "s"(ldsu + (unsigned)((bufoff) + _i * 8192)) : "memory"); } } while (0)
#define PG8_STAGE_A(b, h, base, VG) do { if constexpr (GATHER) { PG8_STAGE(PG8_SA(b, h), base, (VG)[h]); } else { PG8_STAGE(PG8_SA(b, h), (base) + (h) * hstep, voffA); } } while (0)
#define PG8_LDA(dst, b, h) do { _Pragma("unroll") for (int m = 0; m < 4; ++m) _Pragma("unroll") for (int k = 0; k < 2; ++k) dst[m][k] = *(const LAS bf16x8*)(lds + PG8_SA(b, h) + aoff + m * 2048 + k * 1024); } while (0)
#define PG8_LDB(dst, b, h) do { _Pragma("unroll") for (int n = 0; n < 2; ++n) _Pragma("unroll") for (int k = 0; k < 2; ++k) dst[n][k] = *(const LAS bf16x8*)(lds + PG8_SB(b, h) + boff + n * 2048 + k * 1024); } while (0)
#define PG8_MMA(ai, bj, At, Bt) do { __builtin_amdgcn_s_setprio(1); _Pragma("unroll") for (int m = 0; m < 4; ++m) _Pragma("unroll") for (int n = 0; n < 2; ++n) { \
        if constexpr (FP8) { const v8i_t _a = cat8(Bt[n][0], Bt[n][1]), _b = cat8(At[m][0], At[m][1]); \
            asm volatile("v_mfma_scale_f32_16x16x128_f8f6f4 %0, %1, %2, %0, %3, %4 op_sel_hi:[0,0,0]" : "+v"(acc[ai][bj][m][n]) : "v"(_a), "v"(_b), "v"(scw), "v"(sc127)); } \
        else { _Pragma("unroll") for (int k = 0; k < 2; ++k) acc[ai][bj][m][n] = __builtin_amdgcn_mfma_f32_16x16x32_bf16(Bt[n][k], At[m][k], acc[ai][bj][m][n], 0, 0, 0); } } __builtin_amdgcn_s_setprio(0); } while (0)
#define PG8_WAIT_V(n) asm volatile("s_waitcnt vmcnt(" #n ")" ::: "memory")
#define PG8_WAIT_L(n) asm volatile("s_waitcnt lgkmcnt(" #n ")" ::: "memory")
#define PG8_BAR __builtin_amdgcn_s_barrier()
#define PG8_SCHED __builtin_amdgcn_sched_barrier(0)
    Unit cur, nxt; int ui = 0;
    if (!S.next(0, cur)) return;
    f32x4 acc[2][2][4][2];
    { typename Epi::Pre pre0; E.prefetch(pre0, cur, wr, wc, fr, fq); E.init(acc, pre0); }
    bf16x8 At[4][2], B0[2][2], B1[2][2];
    const char* cA = S.aptr(cur); const char* cB0 = cur.b0; const char* cB1 = cB0 + S.b1off();
    if constexpr (GATHER) { int tk[2][2]; gather_tok(cur, tk); gather_off(tk, vA); Unit u1; const bool h1 = S.next(1, u1); gather_tok(h1 ? u1 : cur, tk); gather_off(tk, vAn); }
    PG8_STAGE(PG8_SB(0, 0), cB0, voffB); PG8_STAGE(PG8_SB(0, 1), cB1, voffB); PG8_STAGE_A(0, 0, cA, vA); PG8_STAGE_A(0, 1, cA, vA);
    if (wr == 1) PG8_BAR;
    PG8_WAIT_V(2); PG8_BAR;
    PG8_STAGE(PG8_SB(1, 0), cB0 + kstep, voffB); PG8_STAGE_A(1, 0, cA + kstep, vA); PG8_STAGE(PG8_SB(1, 1), cB1 + kstep, voffB);
    PG8_WAIT_V(6); PG8_BAR;
    for (;;) {
        const bool has_next = S.next(ui + 1, nxt);
        const char* nA = has_next ? S.aptr(nxt) : cA; const char* nB0 = has_next ? nxt.b0 : cB0; const char* nB1 = nB0 + S.b1off();
        for (int t = 0; t < nt; t += 2) {
            const bool last = (t == nt - 2);
            const char* a1 = cA + (size_t)(t + 1) * kstep;
            const char* a2 = last ? nA : cA + (size_t)(t + 2) * kstep;
            const char* b20 = last ? nB0 : cB0 + (size_t)(t + 2) * kstep; const char* b21 = last ? nB1 : cB1 + (size_t)(t + 2) * kstep;
            const char* a3 = a2 + kstep; const char* b30 = b20 + kstep; const char* b31 = b21 + kstep;
            unsigned vS[2][2];
            if constexpr (GATHER) {
#pragma unroll
                for (int h = 0; h < 2; ++h)
#pragma unroll
                    for (int i = 0; i < 2; ++i) vS[h][i] = last ? vAn[h][i] : vA[h][i]; }
            PG8_LDB(B0, 0, 0); PG8_LDB(B1, 0, 1); PG8_SCHED; PG8_LDA(At, 0, 0); PG8_STAGE_A(1, 1, a1, vA);
            PG8_WAIT_V(8); PG8_WAIT_L(0); PG8_BAR; PG8_MMA(0, 0, At, B0); PG8_MMA(0, 1, At, B1); PG8_BAR; PG8_SCHED;
            PG8_LDA(At, 0, 1); PG8_STAGE(PG8_SB(0, 0), b20, voffB); PG8_STAGE(PG8_SB(0, 1), b21, voffB); PG8_STAGE_A(0, 0, a2, vS);
            PG8_WAIT_V(8); PG8_WAIT_L(0); PG8_BAR; PG8_MMA(1, 0, At, B0); PG8_MMA(1, 1, At, B1); PG8_BAR; PG8_SCHED;
            PG8_LDB(B0, 1, 0); PG8_LDB(B1, 1, 1); PG8_SCHED; PG8_LDA(At, 1, 0); PG8_STAGE_A(0, 1, a2, vS);
            PG8_WAIT_V(8); PG8_WAIT_L(0); PG8_BAR; PG8_MMA(0, 0, At, B0); PG8_MMA(0, 1, At, B1); PG8_BAR; PG8_SCHED;
            PG8_LDA(At, 1, 1); PG8_STAGE(PG8_SB(1, 0), b30, voffB); PG8_STAGE(PG8_SB(1, 1), b31, voffB); PG8_STAGE_A(1, 0, a3, vS);
            PG8_WAIT_V(8); PG8_WAIT_L(0); PG8_BAR; PG8_MMA(1, 0, At, B0); PG8_MMA(1, 1, At, B1); PG8_BAR; PG8_SCHED;
        }
        if constexpr (ALIGN_EPI) { if (wr == 0) PG8_BAR; }
        typename Epi::Pre pre; E.prefetch(pre, has_next ? nxt : cur, wr, wc, fr, fq);
        int tkn[2][2];
        if constexpr (GATHER) { Unit u2; const bool h2 = S.next(ui + 2, u2); gather_tok(h2 ? u2 : cur, tkn); }
        PG8_SCHED;
        E(acc, cur, wr, wc, fr, fq);
        if (!has_next) break;
        E.init(acc, pre);
        if constexpr (GATHER) { asm volatile("" : "+v"(tkn[0][0]), "+v"(tkn[0][1]), "+v"(tkn[1][0]), "+v"(tkn[1][1]));
#pragma unroll
            for (int h = 0; h < 2; ++h)
#pragma unroll
                for (int i = 0; i < 2; ++i) vA[h][i] = vAn[h][i];
            gather_off(tkn, vAn); }
        cur = nxt; cA = nA; cB0 = nB0; cB1 = nB1; ++ui;
        if constexpr (ALIGN_EPI) { if (wr == 1) PG8_BAR; }
    }
    PG8_WAIT_V(0);
    if constexpr (!ALIGN_EPI) { if (wr == 0) PG8_BAR; }
    PG8_BAR;
#undef PG8_SA
#undef PG8_SB
#undef PG8_STAGE
#undef PG8_STAGE_A
#undef PG8_LDA
#undef PG8_LDB
#undef PG8_MMA
#undef PG8_WAIT_V
#undef PG8_WAIT_L
#undef PG8_BAR
#undef PG8_SCHED
}

#define EPI_ROWS_BEGIN const int row0 = u.pm * BM + wr * 64 + fr; const int cl = wc * 32 + 8 * fq;
__device__ __forceinline__ void store8(bf16_t* p, const f32x4 v0, const f32x4 v1) {
    u32x4 w; w.x = cvt_pk_bf16(v0[0], v0[1]); w.y = cvt_pk_bf16(v0[2], v0[3]); w.z = cvt_pk_bf16(v1[0], v1[1]); w.w = cvt_pk_bf16(v1[2], v1[3]); *(u32x4*)p = w;
}
__device__ __forceinline__ u32x2 pack8_fp8(const f32x4 v0, const f32x4 v1) {
    int a = 0, b = 0; a = __builtin_amdgcn_cvt_pk_fp8_f32(v0[0], v0[1], a, false); a = __builtin_amdgcn_cvt_pk_fp8_f32(v0[2], v0[3], a, true);
    b = __builtin_amdgcn_cvt_pk_fp8_f32(v1[0], v1[1], b, false); b = __builtin_amdgcn_cvt_pk_fp8_f32(v1[2], v1[3], b, true); return (u32x2){(unsigned)a, (unsigned)b};
}
__device__ __forceinline__ void store8_fp8(unsigned char* p, const f32x4 v0, const f32x4 v1) { *(u32x2*)p = pack8_fp8(v0, v1); }
__device__ __forceinline__ void load8bf(const bf16_t* p, f32x4& v0, f32x4& v1) {
    const u32x4 w = *(const u32x4*)p; v0 = (f32x4){bf_lo(w.x), bf_hi(w.x), bf_lo(w.y), bf_hi(w.y)}; v1 = (f32x4){bf_lo(w.z), bf_hi(w.z), bf_lo(w.w), bf_hi(w.w)};
}
__device__ __forceinline__ void acc_zero(f32x4 (&acc)[2][2][4][2]) {
#pragma unroll
    for (int a = 0; a < 2; ++a)
#pragma unroll
        for (int b = 0; b < 2; ++b)
#pragma unroll
            for (int m = 0; m < 4; ++m)
#pragma unroll
                for (int n = 0; n < 2; ++n) acc[a][b][m][n] = (f32x4){0.f, 0.f, 0.f, 0.f};
}
#define EPI_NO_PRE static constexpr int SCALE_EXP = 121; struct Pre {}; \
    __device__ __forceinline__ void prefetch(Pre&, const Unit&, int, int, int, int) const {} \
    __device__ __forceinline__ void init(f32x4 (&acc)[2][2][4][2], const Pre&) const { acc_zero(acc); }
struct EpiPlain {
    EPI_NO_PRE
    bf16_t* O; int ldc;
    __device__ __forceinline__ void operator()(const f32x4 (&acc)[2][2][4][2], const Unit& u, int wr, int wc, int fr, int fq) const {
        EPI_ROWS_BEGIN
#pragma unroll
        for (int ai = 0; ai < 2; ++ai)
#pragma unroll
            for (int m = 0; m < 4; ++m) { bf16_t* rowp = O + (unsigned)((row0 + ai * HALF + m * 16) * ldc + u.pn * BM + cl);
#pragma unroll
                for (int bj = 0; bj < 2; ++bj) store8(rowp + bj * HALF, acc[ai][bj][m][0], acc[ai][bj][m][1]); asm volatile("" ::: "memory"); }
    }
};
struct EpiIn0 {
    EPI_NO_PRE
    static constexpr float WSI = 1.f;
    bf16_t* O; float qscale;
    __device__ __forceinline__ void operator()(const f32x4 (&acc)[2][2][4][2], const Unit& u, int wr, int wc, int fr, int fq) const {
        EPI_ROWS_BEGIN
        if (u.pn < 4) {
#pragma unroll
            for (int ai = 0; ai < 2; ++ai)
#pragma unroll
                for (int m = 0; m < 4; ++m) { bf16_t* rowp = O + (unsigned)((row0 + ai * HALF + m * 16) * ZE + u.pn * BM + cl);
#pragma unroll
                    for (int bj = 0; bj < 2; ++bj) { f32x4 v0 = acc[ai][bj][m][0] * WSI, v1 = acc[ai][bj][m][1] * WSI;
#pragma unroll
                        for (int j = 0; j < 4; ++j) { v0[j] = gelu_tanh(v0[j]); v1[j] = gelu_tanh(v1[j]); }
                        store8(rowp + bj * HALF, v0, v1); asm volatile("" ::: "memory"); } }
        } else {
            const float sc = (u.pn < 6 ? qscale : 1.f) * WSI;
#pragma unroll
            for (int ai = 0; ai < 2; ++ai)
#pragma unroll
                for (int m = 0; m < 4; ++m) { bf16_t* rowp = O + (unsigned)((row0 + ai * HALF + m * 16) * ZE + u.pn * BM + cl);
#pragma unroll
                    for (int bj = 0; bj < 2; ++bj) store8(rowp + bj * HALF, acc[ai][bj][m][0] * sc, acc[ai][bj][m][1] * sc);
                    asm volatile("" ::: "memory"); }
        }
    }
};
struct EpiIn1 {
    EPI_NO_PRE
    static constexpr float WSI = 1.f;
    bf16_t* O; bf16_t* KV; bf16_t* KI; int pn0;
    __device__ __forceinline__ void operator()(const f32x4 (&acc)[2][2][4][2], const Unit& u_, int wr, int wc, int fr, int fq) const {
        Unit u = u_; u.pn += pn0;
        EPI_ROWS_BEGIN
        if (u.pn == 4 || u.pn == 5) {
            bf16_t* base = KV + (u.pn - 4) * 256 + cl;
#pragma unroll
            for (int ai = 0; ai < 2; ++ai)
#pragma unroll
                for (int m = 0; m < 4; ++m) { bf16_t* rowp = base + (unsigned)((row0 + ai * HALF + m * 16) * 512);
#pragma unroll
                    for (int bj = 0; bj < 2; ++bj) store8(rowp + bj * HALF, acc[ai][bj][m][0] * WSI, acc[ai][bj][m][1] * WSI);
                    asm volatile("" ::: "memory"); }
        } else {
            const float sc = (u.pn < 4 ? 0.125f * LOG2E : 1.f) * WSI;
#pragma unroll
            for (int ai = 0; ai < 2; ++ai)
#pragma unroll
                for (int m = 0; m < 4; ++m) { bf16_t* rowp = O + (unsigned)((row0 + ai * HALF + m * 16) * ZO + u.pn * BM + cl);
#pragma unroll
                    for (int bj = 0; bj < 2; ++bj) store8(rowp + bj * HALF, acc[ai][bj][m][0] * sc, acc[ai][bj][m][1] * sc);
                    asm volatile("" ::: "memory"); }
            if (u.pn == 8 && wc < 2) {
#pragma unroll
                for (int ai = 0; ai < 2; ++ai)
#pragma unroll
                    for (int m = 0; m < 4; ++m) { const int row = row0 + ai * HALF + m * 16;
                        store8(KI + (unsigned)(((((row >> 5) * 4 + (cl >> 4)) * 64) + (((cl >> 3) & 1) * 32 + (row & 31))) * 8), acc[ai][0][m][0] * WSI, acc[ai][0][m][1] * WSI); asm volatile("" ::: "memory"); }
            }
        }
    }
};
struct EpiOut {
    EPI_NO_PRE
    const float* xf; const bf16_t* xb; bf16_t* O;
    __device__ __forceinline__ void operator()(const f32x4 (&acc)[2][2][4][2], const Unit& u, int wr, int wc, int fr, int fq) const {
        EPI_ROWS_BEGIN
#pragma unroll
        for (int ai = 0; ai < 2; ++ai) {
            f32x4 xr[4][2][2];
#pragma unroll
            for (int m = 0; m < 4; ++m) { const unsigned off = (unsigned)((row0 + ai * HALF + m * 16) * DM + u.pn * BM + cl);
#pragma unroll
                for (int bj = 0; bj < 2; ++bj) {
                    if (xf) { xr[m][bj][0] = *(const f32x4*)(xf + off + bj * HALF); xr[m][bj][1] = *(const f32x4*)(xf + off + bj * HALF + 4); }
                    else load8bf(xb + off + bj * HALF, xr[m][bj][0], xr[m][bj][1]); } }
            asm volatile("" ::: "memory");
#pragma unroll
            for (int m = 0; m < 4; ++m) { const unsigned off = (unsigned)((row0 + ai * HALF + m * 16) * DM + u.pn * BM + cl);
#pragma unroll
                for (int bj = 0; bj < 2; ++bj)
                    store8(O + off + bj * HALF, xr[m][bj][0] * ALPHA + acc[ai][bj][m][0], xr[m][bj][1] * ALPHA + acc[ai][bj][m][1]); }
            asm volatile("" ::: "memory");
        }
    }
};
constexpr float SWC = -1.702f * LOG2E;
struct EpiSwiglu {
    static constexpr int SCALE_EXP = 121;
    unsigned char* O; const float* bgu;
    struct Pre { f32x4 b[4]; };
    __device__ __forceinline__ void prefetch(Pre& p, const Unit& u, int wr, int wc, int fr, int fq) const {
        const float* bp = bgu + (unsigned)(u.e * 2048 + u.pn * HALF + wc * 32 + 8 * fq);
        p.b[0] = *(const f32x4*)bp; p.b[1] = *(const f32x4*)(bp + 4); p.b[2] = *(const f32x4*)(bp + 1024); p.b[3] = *(const f32x4*)(bp + 1028);
    }
    __device__ __forceinline__ void init(f32x4 (&acc)[2][2][4][2], const Pre& p) const {
        const f32x4 g0 = p.b[0] * SWC, g1 = p.b[1] * SWC, u0 = (p.b[2] + 1.0f) * (1.0f / SWC), u1 = (p.b[3] + 1.0f) * (1.0f / SWC);
#pragma unroll
        for (int ai = 0; ai < 2; ++ai)
#pragma unroll
            for (int m = 0; m < 4; ++m) { acc[ai][0][m][0] = g0; acc[ai][0][m][1] = g1; acc[ai][1][m][0] = u0; acc[ai][1][m][1] = u1; }
    }
    __device__ __forceinline__ void operator()(const f32x4 (&acc)[2][2][4][2], const Unit& u, int wr, int wc, int fr, int fq) const {
        EPI_ROWS_BEGIN
        const int col = u.pn * HALF + cl;
        float c7 = 7.0f * SWC, ya = -6.0f / SWC, yb = 8.0f / SWC; asm volatile("" : "+v"(c7), "+v"(ya), "+v"(yb));
#pragma unroll
        for (int ai = 0; ai < 2; ++ai)
#pragma unroll
            for (int m = 0; m < 4; ++m) { float t[8], y[8], e[8];
#pragma unroll
                for (int j = 0; j < 8; ++j) { asm("v_max_f32 %0, %1, %2" : "=v"(t[j]) : "v"(acc[ai][0][m][j >> 2][j & 3]), "v"(c7)); }
#pragma unroll
                for (int j = 0; j < 8; ++j) e[j] = __builtin_amdgcn_exp2f(t[j]);
#pragma unroll
                for (int j = 0; j < 8; ++j) { asm("v_med3_f32 %0, %1, %2, %3" : "=v"(y[j]) : "v"(acc[ai][1][m][j >> 2][j & 3]), "v"(ya), "v"(yb)); }
                __builtin_amdgcn_sched_barrier(0);
#pragma unroll
                for (int j = 0; j < 8; ++j) e[j] += 1.0f;
#pragma unroll
                for (int j = 0; j < 8; ++j) e[j] = __builtin_amdgcn_rcpf(e[j]);
#pragma unroll
                for (int j = 0; j < 8; ++j) y[j] *= t[j];
                __builtin_amdgcn_sched_barrier(0);
#pragma unroll
                for (int j = 0; j < 8; ++j) y[j] *= e[j];
                store8_fp8(O + (unsigned)((row0 + ai * HALF + m * 16) * DM + col), (f32x4){y[0], y[1], y[2], y[3]}, (f32x4){y[4], y[5], y[6], y[7]}); asm volatile("" ::: "memory"); }
    }
};
struct EpiDown {
    static constexpr int SCALE_EXP = 125;
    unsigned char* O; const float* bd;
    struct Pre { f32x4 b[2][2]; };
    __device__ __forceinline__ void prefetch(Pre& p, const Unit& u, int wr, int wc, int fr, int fq) const {
        const float* bp = bd + (unsigned)(u.e * DM + u.pn * BM + wc * 32 + 8 * fq);
#pragma unroll
        for (int bj = 0; bj < 2; ++bj) { p.b[bj][0] = *(const f32x4*)(bp + bj * HALF); p.b[bj][1] = *(const f32x4*)(bp + bj * HALF + 4); }
    }
    __device__ __forceinline__ void init(f32x4 (&acc)[2][2][4][2], const Pre& p) const {
#pragma unroll
        for (int bj = 0; bj < 2; ++bj) { const f32x4 b0 = p.b[bj][0] * 16.f, b1 = p.b[bj][1] * 16.f;
#pragma unroll
            for (int ai = 0; ai < 2; ++ai)
#pragma unroll
                for (int m = 0; m < 4; ++m) { acc[ai][bj][m][0] = b0; acc[ai][bj][m][1] = b1; } }
    }
    __device__ __forceinline__ void operator()(const f32x4 (&acc)[2][2][4][2], const Unit& u, int wr, int wc, int fr, int fq) const {
        EPI_ROWS_BEGIN
        const int col = u.pn * BM + cl;
#pragma unroll
        for (int ai = 0; ai < 2; ++ai)
#pragma unroll
            for (int m = 0; m < 4; ++m) { const int row = row0 + ai * HALF + m * 16;
#pragma unroll
                for (int bj = 0; bj < 2; ++bj) store8_fp8(O + (unsigned)(row * DM + col + bj * HALF), acc[ai][bj][m][0], acc[ai][bj][m][1]);
                asm volatile("" ::: "memory"); }
    }
};
struct EpiGate {
    EPI_NO_PRE
    const bf16_t* mid; const bf16_t* P; const float* bg; bf16_t* O;
    __device__ __forceinline__ void operator()(const f32x4 (&acc)[2][2][4][2], const Unit& u, int wr, int wc, int fr, int fq) const {
        EPI_ROWS_BEGIN
        const int col = u.pn * BM + cl;
        f32x4 bv[2][2];
#pragma unroll
        for (int bj = 0; bj < 2; ++bj) { bv[bj][0] = *(const f32x4*)(bg + col + bj * HALF); bv[bj][1] = *(const f32x4*)(bg + col + bj * HALF + 4); }
#pragma unroll
        for (int ai = 0; ai < 2; ++ai) {
            u32x4 mr[4][2], pr[4][2];
#pragma unroll
            for (int m = 0; m < 4; ++m) { const unsigned off = (unsigned)((row0 + ai * HALF + m * 16) * DM + col);
#pragma unroll
                for (int bj = 0; bj < 2; ++bj) { mr[m][bj] = *(const u32x4*)(mid + off + bj * HALF); pr[m][bj] = *(const u32x4*)(P + off + bj * HALF); } }
            asm volatile("" ::: "memory");
#pragma unroll
            for (int m = 0; m < 4; ++m) { const unsigned off = (unsigned)((row0 + ai * HALF + m * 16) * DM + col);
#pragma unroll
                for (int bj = 0; bj < 2; ++bj) { const u32x4 mw = mr[m][bj], pw = pr[m][bj];
                    const f32x4 m0 = {bf_lo(mw.x), bf_hi(mw.x), bf_lo(mw.y), bf_hi(mw.y)}, m1 = {bf_lo(mw.z), bf_hi(mw.z), bf_lo(mw.w), bf_hi(mw.w)};
                    const f32x4 p0 = {bf_lo(pw.x), bf_hi(pw.x), bf_lo(pw.y), bf_hi(pw.y)}, p1 = {bf_lo(pw.z), bf_hi(pw.z), bf_lo(pw.w), bf_hi(pw.w)};
                    f32x4 r0, r1;
                    const f32x4 a0 = acc[ai][bj][m][0] + bv[bj][0], a1 = acc[ai][bj][m][1] + bv[bj][1];
#pragma unroll
                    for (int j = 0; j < 4; ++j) { r0[j] = m0[j] + sigmoidf_(a0[j]) * p0[j]; r1[j] = m1[j] + sigmoidf_(a1[j]) * p1[j]; }
                    store8(O + off + bj * HALF, r0, r1); } }
            asm volatile("" ::: "memory");
        }
    }
};
}

#define XB_TMO      128
#define XB_XCNT(j)  (256  + 64 * (j))
#define XB_XSUB(j)  (1280 + 64 * (j))
#define XB_XGEN(j)  (2304 + 64 * (j))
#define XB_TOP      3328
#define XB_TOPGEN   3392
#define XCD_BAR_WORDS 3456
#define XB_SPIN_CAP (1u << 18)
__device__ __forceinline__ unsigned xb_ld(unsigned* p)              { return __hip_atomic_load(p, __ATOMIC_RELAXED, __HIP_MEMORY_SCOPE_AGENT); }
__device__ __forceinline__ unsigned xb_add(unsigned* p, unsigned v) { return __hip_atomic_fetch_add(p, v, __ATOMIC_RELAXED, __HIP_MEMORY_SCOPE_AGENT); }
__device__ __forceinline__ unsigned xb_xcc_id() { return (unsigned)__builtin_amdgcn_s_getreg((3 << 11) | 20) & 0xFu; }
#define XB_SPIN(cond, bar) do { unsigned _sp = 0; while (cond) { __builtin_amdgcn_s_sleep(1); \
    if ((++_sp & 255u) == 0u) { if (xb_ld(&(bar)[XB_TMO])) break; if (_sp > XB_SPIN_CAP) { atomicAdd(&(bar)[XB_TMO], 1u); break; } } } } while (0)
struct XcdBarrier { unsigned* bar; unsigned x; volatile LAS unsigned* st; };
__device__ __forceinline__ XcdBarrier xcd_barrier_post(unsigned* bar, volatile LAS unsigned* st) {
    XcdBarrier b; b.bar = bar; b.x = xb_xcc_id(); b.st = st;
    if (threadIdx.x == 0) (void)xb_add(&bar[XB_XCNT(b.x)], 1u);
    return b;
}
__device__ __forceinline__ void xcd_barrier_complete(unsigned* bar, unsigned x, unsigned& nloc, unsigned& nx) {
    const unsigned G = gridDim.x * gridDim.y * gridDim.z;
    unsigned sum, cnt, mine, sp = 0u;
    for (;;) {
        sum = 0u; cnt = 0u; mine = 0u;
#pragma unroll
        for (unsigned j = 0; j < 16; ++j) { const unsigned c = xb_ld(&bar[XB_XCNT(j)]); sum += c; cnt += (c > 0u) ? 1u : 0u; mine = (j == x) ? c : mine; }
        if (sum == G) break;
        __builtin_amdgcn_s_sleep(1);
        if ((++sp & 255u) == 0u) { if (xb_ld(&bar[XB_TMO])) break; if (sp > XB_SPIN_CAP) { atomicAdd(&bar[XB_TMO], 1u); break; } }
    }
    nloc = mine > 0u ? mine : 1u; nx = cnt > 0u ? cnt : 1u;
}
__device__ __forceinline__ void xcd_barrier(const XcdBarrier& b) {
    asm volatile("s_waitcnt vmcnt(0)" ::: "memory");
    __syncthreads();
    if (threadIdx.x == 0) {
        unsigned* bar = b.bar; asm volatile("" : "+s"(bar));
        unsigned bx = b.x; asm volatile("" : "+s"(bx));
        __builtin_amdgcn_s_waitcnt(0);
        unsigned nloc = b.st[0], nx = b.st[1];
        if (nloc == 0u) { xcd_barrier_complete(bar, bx, nloc, nx); b.st[0] = nloc; b.st[1] = nx; }
        const unsigned old = xb_add(&bar[XB_XSUB(bx)], 1u);
        const unsigned gen = old / nloc;
        if (old + 1u == (gen + 1u) * nloc) {
            __builtin_amdgcn_fence(__ATOMIC_RELEASE, "agent");
            asm volatile("s_waitcnt vmcnt(0)" ::: "memory");
            const unsigned og = xb_add(&bar[XB_TOP], 1u);
            const unsigned tg = og / nx;
            if (og + 1u == (tg + 1u) * nx) xb_add(&bar[XB_TOPGEN], 1u);
            else XB_SPIN(xb_ld(&bar[XB_TOPGEN]) == tg, bar);
            __builtin_amdgcn_fence(__ATOMIC_ACQUIRE, "agent");
            xb_add(&bar[XB_XGEN(bx)], 1u);
            asm volatile("s_waitcnt vmcnt(0)" ::: "memory");
        } else {
            XB_SPIN(xb_ld(&bar[XB_XGEN(bx)]) == gen, bar);
            __builtin_amdgcn_fence(__ATOMIC_ACQUIRE, "agent");
            asm volatile("s_waitcnt vmcnt(0)" ::: "memory");
        }
    }
    __syncthreads();
}

constexpr int NWAVES = 8, NTHR = 512;
struct Args { const float* in[23]; float* out; unsigned char* ws; int ph_lo, ph_hi; };
struct Frame { LAS unsigned char* lds; int tid, lane, wave, G, bid; };
#define LDS_WAIT() asm volatile("s_waitcnt lgkmcnt(0)" ::: "memory")
#define LDS_BARRIER() asm volatile("s_waitcnt lgkmcnt(0)\n\ts_barrier" ::: "memory")

template <bool F8>
__device__ __forceinline__ void p0_transpose_item(const float* W, int K, int N, int Npad, void* WT_, LAS float* scr, int item, int lane) {
    const int nblk = Npad / 32, kb = item / nblk, nb = item % nblk, k0 = 128 * kb, n0 = 32 * nb;
    const int r = lane >> 3, c4 = (lane & 7) * 4;
    const bool ok = n0 + c4 < N;
    const float* src = W + (size_t)(k0 + r) * N + (ok ? n0 + c4 : 0);
    f32x4 v[16];
#pragma unroll
    for (int i = 0; i < 16; ++i) v[i] = *(const f32x4*)(src + (size_t)(8 * i) * N);
    __builtin_amdgcn_sched_barrier(0);
    const float sc = ok ? (F8 ? WSC : 1.f) : 0.f;
#pragma unroll
    for (int i = 0; i < 16; ++i) *(LAS f32x4*)(scr + (8 * i + r) * 32 + (c4 ^ ((i >> 1) << 2))) = v[i] * sc;
    LDS_WAIT(); asm volatile("" ::: "memory");
    const int c = lane & 7;
#pragma unroll
    for (int j = 0; j < 4; ++j) { const int nn = (lane >> 3) + 8 * j; const LAS float* sp = scr + (16 * c) * 32 + (nn ^ (c << 2));
        float t[16];
#pragma unroll
        for (int q = 0; q < 16; ++q) t[q] = sp[q * 32];
        if constexpr (F8) { const u32x2 lo = pg8::pack8_fp8(f32x4{t[0], t[1], t[2], t[3]}, f32x4{t[4], t[5], t[6], t[7]}), hi = pg8::pack8_fp8(f32x4{t[8], t[9], t[10], t[11]}, f32x4{t[12], t[13], t[14], t[15]});
            u32x4 o; o.x = lo.x; o.y = lo.y; o.z = hi.x; o.w = hi.y; *(u32x4*)((unsigned char*)WT_ + (size_t)(n0 + nn) * K + k0 + 16 * c) = o; }
        else { u32x4 o0, o1; o0.x = cvt_pk_bf16(t[0], t[1]); o0.y = cvt_pk_bf16(t[2], t[3]); o0.z = cvt_pk_bf16(t[4], t[5]); o0.w = cvt_pk_bf16(t[6], t[7]);
            o1.x = cvt_pk_bf16(t[8], t[9]); o1.y = cvt_pk_bf16(t[10], t[11]); o1.z = cvt_pk_bf16(t[12], t[13]); o1.w = cvt_pk_bf16(t[14], t[15]);
            bf16_t* d = (bf16_t*)WT_ + (size_t)(n0 + nn) * K + k0 + 16 * c; *(u32x4*)d = o0; *(u32x4*)(d + 8) = o1; } }
    LDS_WAIT(); asm volatile("" ::: "memory");
}
template <int U, bool F8>
__device__ __forceinline__ void cvt_stream(const float* src, void* dst_, size_t n, int gtid, int gthreads) {
    const size_t st = (size_t)gthreads * 8;
    size_t i = (size_t)gtid * 8;
    for (; i + (U - 1) * st < n; i += U * st) {
        f32x4 a[U], b[U];
#pragma unroll
        for (int q = 0; q < U; ++q) { const float* p = src + i + q * st; a[q] = *(const f32x4*)p; b[q] = *(const f32x4*)(p + 4); }
        __builtin_amdgcn_sched_barrier(0);
#pragma unroll
        for (int q = 0; q < U; ++q) { const size_t o = i + q * st;
            if constexpr (F8) *(u32x2*)((unsigned char*)dst_ + o) = pg8::pack8_fp8(a[q], b[q]);
            else { u32x4 w; w.x = cvt_pk_bf16(a[q][0], a[q][1]); w.y = cvt_pk_bf16(a[q][2], a[q][3]); w.z = cvt_pk_bf16(b[q][0], b[q][1]); w.w = cvt_pk_bf16(b[q][2], b[q][3]); *(u32x4*)((bf16_t*)dst_ + o) = w; } }
    }
    for (; i < n; i += st) { const f32x4 a = *(const f32x4*)(src + i), b = *(const f32x4*)(src + i + 4);
        if constexpr (F8) *(u32x2*)((unsigned char*)dst_ + i) = pg8::pack8_fp8(a, b);
        else { u32x4 w; w.x = cvt_pk_bf16(a[0], a[1]); w.y = cvt_pk_bf16(a[2], a[3]); w.z = cvt_pk_bf16(b[0], b[1]); w.w = cvt_pk_bf16(b[2], b[3]); *(u32x4*)((bf16_t*)dst_ + i) = w; } }
}
struct P0Desc { const float* W; unsigned char* WT; int K, N, Npad, tile, f8; float s0, s1; int split; };
constexpr int P0_IN0 = 8 * (ZE / 256), P0_SQ = 8 * 4, P0_IN1 = 8 * (ZO / 256), P0_PLE = 2 * 4, P0_GU = 8 * 8;
constexpr int P0_IN1Q = FP8_IN1Q ? 8 * 6 : 0;
constexpr int P0_C0 = P0_IN0, P0_C1 = P0_C0 + P0_SQ, P0_C2 = P0_C1 + P0_IN1, P0_C3 = P0_C2 + P0_SQ, P0_C4 = P0_C3 + 2 * P0_SQ, P0_C5 = P0_C4 + 2 * P0_PLE, P0_C6 = P0_C5 + 64 * P0_GU, P0_C7Q = P0_C6 + 64 * P0_SQ, P0_C7 = P0_C7Q + P0_IN1Q;
__device__ __forceinline__ P0Desc p0_desc(const Args& a, int it) {
    unsigned char* ws = a.ws;
    if (it < P0_C0) return P0Desc{a.in[2], ws + WS_WIN0, DM, ZE, ZE, it, FP8_IN0, FP8_IN0 ? WSC : 1.f, FP8_IN0 ? WSC : 1.f, 0};
    if (it < P0_C1) return P0Desc{a.in[7], ws + WS_WO0, DM, DM, DM, it - P0_C0, FP8_OUT, FP8_OUT ? WSC : 1.f, FP8_OUT ? WSC : 1.f, 0};
    if (it < P0_C2) return P0Desc{a.in[8], ws + WS_WIN1, DM, ZO_REAL, ZO, it - P0_C1, FP8_IN1, FP8_IN1 ? WSC : 1.f, FP8_IN1 ? WSC : 1.f, 0};
    if (it < P0_C3) return P0Desc{a.in[9], ws + WS_WO1, DM, DM, DM, it - P0_C2, FP8_OUT, FP8_OUT ? WSC : 1.f, FP8_OUT ? WSC : 1.f, 0};
    if (it < P0_C4) { const int r = it - P0_C3, l = r / P0_SQ; return P0Desc{a.in[21] + (size_t)l * DM * DM, ws + WS_WG + (size_t)l * DM * DM * (FP8_GATE ? 1 : 2), DM, DM, DM, r % P0_SQ, FP8_GATE, FP8_GATE ? WSC : 1.f, FP8_GATE ? WSC : 1.f, 0}; }
    if (it < P0_C5) { const int r = it - P0_C4, l = r / P0_PLE; return P0Desc{a.in[20] + (size_t)l * PLE * DM, ws + WS_WPLE + (size_t)l * DM * PLE * 2, PLE, DM, DM, r % P0_PLE, 0, 1.f, 1.f, 0}; }
    if (it < P0_C6) { const int r = it - P0_C5, l = r / P0_GU; return P0Desc{a.in[14] + (size_t)l * DM * 2048, ws + WS_WGU + (size_t)l * 2048 * DM, DM, 2048, 2048, r % P0_GU, 1, WSC * pg8::SWC, WSC / pg8::SWC, 1024}; }
    if (it >= P0_C7Q) return P0Desc{a.in[8], ws + WS_WIN1Q, DM, ZO_REAL, 1536, it - P0_C7Q, 1, WSC, WSC, 0};
    const int r = it - P0_C6, l = r / P0_SQ; return P0Desc{a.in[16] + (size_t)l * DM * DM, ws + WS_WD + (size_t)l * DM * DM, DM, DM, DM, r % P0_SQ, 1, WSC, WSC, 0};
}
__device__ __forceinline__ void p0_tile_load(const P0Desc& d, int wave, int lane, f32x4 (&v)[16], float& sc) {
    const int nblk = d.Npad / 256, kb = d.tile / nblk, nb = d.tile % nblk;
    const int n = nb * 256 + 4 * lane; const bool ok = n < d.N;
    const float* src = d.W + (size_t)(kb * 128 + 16 * wave) * d.N + (ok ? n : 0);
#pragma unroll
    for (int i = 0; i < 16; ++i) v[i] = *(const f32x4*)(src + (size_t)i * d.N);
    sc = ok ? (n < d.split ? d.s0 : d.s1) : 0.f;
}
__device__ __forceinline__ void p0_tile_emit(const P0Desc& d, LAS float* img, int wave, int lane) {
    const int nblk = d.Npad / 256, kb = d.tile / nblk, nb = d.tile % nblk, k0 = 128 * kb, n0 = 256 * nb;
    const int c = lane & 7;
#pragma unroll
    for (int j = 0; j < 4; ++j) { const int nn = 32 * wave + (lane >> 3) + 8 * j; const LAS float* sp = img + (16 * c) * 256 + (nn ^ (c << 2));
        float t[16];
#pragma unroll
        for (int q = 0; q < 16; ++q) t[q] = sp[q * 256];
        const size_t o = (size_t)(n0 + nn) * d.K + k0 + 16 * c;
        if (d.f8) { const u32x2 lo = pg8::pack8_fp8(f32x4{t[0], t[1], t[2], t[3]}, f32x4{t[4], t[5], t[6], t[7]}), hi = pg8::pack8_fp8(f32x4{t[8], t[9], t[10], t[11]}, f32x4{t[12], t[13], t[14], t[15]});
            u32x4 w; w.x = lo.x; w.y = lo.y; w.z = hi.x; w.w = hi.y; *(u32x4*)(d.WT + o) = w; }
        else { u32x4 o0, o1; o0.x = cvt_pk_bf16(t[0], t[1]); o0.y = cvt_pk_bf16(t[2], t[3]); o0.z = cvt_pk_bf16(t[4], t[5]); o0.w = cvt_pk_bf16(t[6], t[7]);
            o1.x = cvt_pk_bf16(t[8], t[9]); o1.y = cvt_pk_bf16(t[10], t[11]); o1.z = cvt_pk_bf16(t[12], t[13]); o1.w = cvt_pk_bf16(t[14], t[15]);
            bf16_t* dp = (bf16_t*)d.WT + o; *(u32x4*)dp = o0; *(u32x4*)(dp + 8) = o1; } }
}
constexpr int P0_DEF_GU = 32 * P0_GU, P0_DEF_D = 32 * P0_SQ, P0_NDEF = P0_DEF_GU + P0_DEF_D, P0_NPRO = P0_C5 + P0_IN1Q;
template <int WHICH> __device__ __forceinline__ int p0_map(int idx) {
    if (WHICH == 0) return idx < P0_C5 ? idx : P0_C7Q + (idx - P0_C5);
    return idx < P0_DEF_GU ? P0_C5 + (WHICH - 1) * P0_DEF_GU + idx : P0_C6 + (WHICH - 1) * P0_DEF_D + (idx - P0_DEF_GU);
}
template <int WHICH> __device__ __forceinline__ void p0_tiles(Frame& F, const Args& a, int reps) {
    LAS float* img = (LAS float*)F.lds;
    constexpr int N = WHICH == 0 ? P0_NPRO : P0_NDEF;
    const int TOT = N * reps, G2 = 2 * F.G;
    f32x4 v0[16], v1[16]; float sc0 = 0.f, sc1 = 0.f;
    int it0 = F.bid, it1 = F.bid + F.G;
    P0Desc d0 = p0_desc(a, p0_map<WHICH>(it0 % N)), d1 = p0_desc(a, p0_map<WHICH>(it1 % N));
    if (it0 < TOT) p0_tile_load(d0, F.wave, F.lane, v0, sc0);
    if (it1 < TOT) p0_tile_load(d1, F.wave, F.lane, v1, sc1);
#define P0_STEP(V, SC, D, IT) do { \
        _Pragma("unroll") for (int i = 0; i < 16; ++i) *(LAS f32x4*)(img + (16 * F.wave + i) * 256 + ((4 * F.lane) ^ (F.wave << 2))) = V[i] * SC; \
        LDS_BARRIER(); \
        const P0Desc dc = D; const int nx = IT + G2; \
        if (nx < TOT) { D = p0_desc(a, p0_map<WHICH>(nx % N)); p0_tile_load(D, F.wave, F.lane, V, SC); } \
        __builtin_amdgcn_sched_barrier(0); \
        p0_tile_emit(dc, img, F.wave, F.lane); \
        LDS_BARRIER(); } while (0)
    for (; it0 < TOT; it0 += G2, it1 += G2) {
        P0_STEP(v0, sc0, d0, it0);
        if (it1 < TOT) P0_STEP(v1, sc1, d1, it1);
    }
#undef P0_STEP
}
__device__ __forceinline__ void p0_prologue(Frame& F, const Args& a) {
    unsigned char* ws = a.ws;
    p0_tiles<0>(F, a, PM(0));
    {
      LAS float* scr = (LAS float*)(F.lds + F.wave * 16384);
      const int gw = F.bid * NWAVES + F.wave;
      if (gw < 16) p0_transpose_item<false>(a.in[12] + (size_t)(gw >> 3) * DM * NEXP, DM, NEXP, NEXP, (bf16_t*)(ws + WS_WRT) + (size_t)(gw >> 3) * NEXP * DM, scr, gw & 7, F.lane); }
    const int gtid = F.bid * NTHR + F.tid, gth = F.G * NTHR;
    if (!FP8_IN0) cvt_stream<8, false>(a.in[0], ws + WS_XB, (size_t)NTOK * DM, gtid, gth);
    else cvt_stream<8, true>(a.in[0], ws + WS_XQ, (size_t)NTOK * DM, gtid, gth);
    cvt_stream<8, false>(a.in[1], ws + WS_PB, (size_t)2 * NTOK * PLE, gtid, gth);
    for (int i = gtid; i < 8 * 128 * 128; i += gth) { const int t = (i >> 7) & 127, s = i & 127; const float v = (s <= t) ? a.in[5][i] : 0.f; ((bf16_t*)(ws + WS_WSB))[i] = (bf16_t)(cvt_pk_bf16(v, 0.f) & 0xffffu); }
}

__device__ __forceinline__ void gmlp_unit(Frame& F, const Args& a, int unit) {
    const bf16_t* z0 = (const bf16_t*)(a.ws + WS_Z); unsigned char* cat = (unsigned char*)(a.ws + WS_CAT); const bf16_t* wsb = (const bf16_t*)(a.ws + WS_WSB);
    const float* lng = a.in[3]; const float* lnb = a.in[4]; const float* bs = a.in[6];
    const size_t tok0 = (size_t)unit * 128;
    const int lane = F.lane, w = F.wave, r32 = lane & 31, hi = lane >> 5;
    LAS f32x2* stats = (LAS f32x2*)(F.lds + XTRA_OFF);
    for (int i = 0; i < 16; ++i) { const int tl = w * 16 + i;
        const u32x4 v = *(const u32x4*)(z0 + (tok0 + tl) * ZE + 512 + 8 * lane);
        float x[8] = {bf_lo(v.x), bf_hi(v.x), bf_lo(v.y), bf_hi(v.y), bf_lo(v.z), bf_hi(v.z), bf_lo(v.w), bf_hi(v.w)};
        float s = 0.f;
#pragma unroll
        for (int j = 0; j < 8; ++j) s += x[j];
        const float mean = wave_sum(s) * (1.f / 512.f); float q = 0.f;
#pragma unroll
        for (int j = 0; j < 8; ++j) { const float d = x[j] - mean; q += d * d; }
        const float rstd = 1.f / sqrtf(wave_sum(q) * (1.f / 512.f) + LN_EPS);
        if (lane == 0) stats[tl] = (f32x2){mean, rstd}; }
    __syncthreads();
    const int g = w;
    LAS unsigned char* vt = F.lds + w * 16384;
    { const int tl8 = lane >> 3, cc = lane & 7;
      float gg[8], bb[8];
#pragma unroll
      for (int j = 0; j < 8; ++j) { gg[j] = lng[g * 64 + 8 * cc + j]; bb[j] = lnb[g * 64 + 8 * cc + j]; }
      for (int it = 0; it < 16; ++it) { const int tl = 8 * it + tl8;
          const u32x4 v = *(const u32x4*)(z0 + (tok0 + tl) * ZE + 512 + g * 64 + 8 * cc);
          const f32x2 st = stats[tl];
          float x[8] = {bf_lo(v.x), bf_hi(v.x), bf_lo(v.y), bf_hi(v.y), bf_lo(v.z), bf_hi(v.z), bf_lo(v.w), bf_hi(v.w)};
#pragma unroll
          for (int j = 0; j < 8; ++j) { const int c = 8 * cc + j; const float y = (x[j] - st.x) * st.y * gg[j] + bb[j];
              *(LAS bf16_t*)(vt + c * 256 + ((((tl >> 3) ^ (c & 15))) << 4) + (tl & 7) * 2) = (bf16_t)(cvt_pk_bf16(y, 0.f) & 0xffffu); } } }
    LDS_WAIT(); asm volatile("" ::: "memory");
    for (int tb = 0; tb < 4; ++tb) {
        f32x16 d0 = {}, d1 = {};
        const bf16_t* wrow = wsb + ((size_t)g * 128 + tb * 32 + r32) * 128 + 8 * hi;
        bf16x8 afr[8];
#pragma unroll
        for (int ks = 0; ks < 8; ++ks) afr[ks] = *(const bf16x8*)(wrow + 16 * ks);
#pragma unroll
        for (int ks = 0; ks < 8; ++ks) { if (ks >= 2 * (tb + 1)) break;
            const bf16x8 af = afr[ks];
            const int chunk = 2 * ks + hi;
            const bf16x8 b0 = *(const LAS bf16x8*)(vt + r32 * 256 + ((chunk ^ (r32 & 15)) << 4));
            const bf16x8 b1 = *(const LAS bf16x8*)(vt + (32 + r32) * 256 + ((chunk ^ (r32 & 15)) << 4));
            d0 = __builtin_amdgcn_mfma_f32_32x32x16_bf16(af, b0, d0, 0, 0, 0);
            d1 = __builtin_amdgcn_mfma_f32_32x32x16_bf16(af, b1, d1, 0, 0, 0);
        }
#pragma unroll
        for (int r = 0; r < 16; ++r) { const int t = tb * 32 + (r & 3) + 8 * (r >> 2) + 4 * hi; const float bsv = bs[g * 128 + t];
            const size_t ro = (tok0 + t) * ZE + g * 64 + r32; const size_t co = (tok0 + t) * DM + g * 64 + r32;
            const float u0 = bf1(z0[ro]), u1 = bf1(z0[ro + 32]);
            CAT_ST(cat, co, u0 * (d0[r] + bsv)); CAT_ST(cat, co + 32, u1 * (d1[r] + bsv)); }
    }
    __syncthreads();
}

constexpr int SB_KST = 144;
constexpr int SB_TILE = 64 * SB_KST;
__device__ __forceinline__ void sb_unit(Frame& F, const Args& a, int b, int h, int qb) {
    const bf16_t* z0 = (const bf16_t*)(a.ws + WS_Z); unsigned char* cat = (unsigned char*)(a.ws + WS_CAT);
    const int tid = F.tid, lane = F.lane, wid = F.wave, r32 = lane & 31, hi = lane >> 5;
    const size_t rowbase = (size_t)b * SEQ;
    const int q0 = qb * 256, qw0 = q0 + wid * 32, tq = qw0 + r32;
    bf16x8 qr[4];
    { const bf16_t* qp = z0 + (rowbase + tq) * ZE + 1024 + h * 64 + hi * 8;
#pragma unroll
      for (int ks = 0; ks < 4; ++ks) qr[ks] = *(const bf16x8*)(qp + ks * 16); }
    f32x16 o0 = {}, o1 = {}; float C = 1.f;
    const int ntile = q0 / 64 + 4;
    LAS unsigned char* Kb = F.lds; LAS unsigned char* Vb = F.lds + 2 * SB_TILE;
    const bf16_t* kg = z0 + (rowbase + (tid >> 3)) * ZE + 1536 + h * 64 + (tid & 7) * 8;
    const unsigned ldst = (unsigned)(tid >> 3) * SB_KST + (unsigned)(tid & 7) * 16;
    { const size_t go = (size_t)(ntile - 1) * 64 * ZE; const u32x4 kn = *(const u32x4*)(kg + go), vn = *(const u32x4*)(kg + go + 512);
      *(LAS u32x4*)(Kb + ldst) = kn; *(LAS u32x4*)(Vb + ldst) = vn; }
    const int dh = (lane >> 4) & 1, q_ = (lane & 15) >> 2, p_ = lane & 3;
    for (int kt = ntile - 1; kt >= 0; --kt) {
        const int buf = (ntile - 1 - kt) & 1;
        u32x4 kn, vn;
        if (kt > 0) { const size_t go = (size_t)(kt - 1) * 64 * ZE; kn = *(const u32x4*)(kg + go); vn = *(const u32x4*)(kg + go + 512); }
        LDS_BARRIER();
        const LAS unsigned char* Kc = Kb + buf * SB_TILE; const LAS unsigned char* Vc = Vb + buf * SB_TILE;
        if (64 * kt <= qw0) {
            f32x16 p[2]; p[0] = (f32x16){}; p[1] = (f32x16){};
#pragma unroll
            for (int ks = 0; ks < 4; ++ks) {
                const bf16x8 k0 = *(const LAS bf16x8*)(Kc + r32 * SB_KST + (16 * ks + 8 * hi) * 2);
                const bf16x8 k1 = *(const LAS bf16x8*)(Kc + (32 + r32) * SB_KST + (16 * ks + 8 * hi) * 2);
                p[0] = __builtin_amdgcn_mfma_f32_32x32x16_bf16(k0, qr[ks], p[0], 0, 0, 0);
                p[1] = __builtin_amdgcn_mfma_f32_32x32x16_bf16(k1, qr[ks], p[1], 0, 0, 0);
            }
            const bool need_mask = (64 * kt + 64 > qw0);
            const int kb0 = 64 * kt + 4 * hi;
            float NB[2][16], BE[2][16];
            if (need_mask) {
#pragma unroll
                for (int bk = 0; bk < 2; ++bk)
#pragma unroll
                    for (int r = 0; r < 16; ++r) { const float rc = rcpf_(1.f + ex2(-p[bk][r]));
                        const int key = kb0 + 32 * bk + 8 * (r >> 2) + (r & 3); const bool ok = key < tq;
                        BE[bk][r] = ok ? rc : 0.f; NB[bk][r] = ok ? 1.f - rc : 1.f; }
            } else {
#pragma unroll
                for (int bk = 0; bk < 2; ++bk)
#pragma unroll
                    for (int r = 0; r < 16; ++r) { const float rc = rcpf_(1.f + ex2(-p[bk][r])); BE[bk][r] = rc; NB[bk][r] = 1.f - rc; }
            }
            float acc_c = C;
#pragma unroll
            for (int bk = 1; bk >= 0; --bk)
#pragma unroll
                for (int aa = 3; aa >= 0; --aa) {
                    const float R = (NB[bk][4 * aa] * NB[bk][4 * aa + 1]) * (NB[bk][4 * aa + 2] * NB[bk][4 * aa + 3]);
                    const auto rr = __builtin_amdgcn_permlane32_swap(__float_as_uint(R), __float_as_uint(R), false, false);
                    const float Rp = hi ? __uint_as_float(rr[0]) : __uint_as_float(rr[1]);
                    const float a3 = hi ? acc_c : acc_c * Rp, a2 = a3 * NB[bk][4 * aa + 3], a1 = a2 * NB[bk][4 * aa + 2], a0 = a1 * NB[bk][4 * aa + 1];
                    p[bk][4 * aa + 3] = BE[bk][4 * aa + 3] * a3; p[bk][4 * aa + 2] = BE[bk][4 * aa + 2] * a2;
                    p[bk][4 * aa + 1] = BE[bk][4 * aa + 1] * a1; p[bk][4 * aa + 0] = BE[bk][4 * aa + 0] * a0;
                    acc_c *= R * Rp;
                }
            C = acc_c;
            bf16x8 pa[2][2];
#pragma unroll
            for (int bk = 0; bk < 2; ++bk)
#pragma unroll
                for (int s = 0; s < 2; ++s) { u32x4 w; w.x = cvt_pk_bf16(p[bk][8 * s + 0], p[bk][8 * s + 1]); w.y = cvt_pk_bf16(p[bk][8 * s + 2], p[bk][8 * s + 3]);
                    w.z = cvt_pk_bf16(p[bk][8 * s + 4], p[bk][8 * s + 5]); w.w = cvt_pk_bf16(p[bk][8 * s + 6], p[bk][8 * s + 7]); pa[bk][s] = __builtin_bit_cast(bf16x8, w); }
#pragma unroll
            for (int bk = 0; bk < 2; ++bk)
#pragma unroll
                for (int s = 0; s < 2; ++s) {
                    const LAS unsigned char* vp = Vc + (32 * bk + 16 * s + 4 * hi + q_) * SB_KST + (16 * dh + 4 * p_) * 2;
                    const s16x4 l0 = __builtin_amdgcn_ds_read_tr16_b64_v4i16((LAS s16x4*)(vp));
                    const s16x4 h0 = __builtin_amdgcn_ds_read_tr16_b64_v4i16((LAS s16x4*)(vp + 8 * SB_KST));
                    const s16x4 l1 = __builtin_amdgcn_ds_read_tr16_b64_v4i16((LAS s16x4*)(vp + 64));
                    const s16x4 h1 = __builtin_amdgcn_ds_read_tr16_b64_v4i16((LAS s16x4*)(vp + 8 * SB_KST + 64));
                    const bf16x8 v0 = (bf16x8){l0[0], l0[1], l0[2], l0[3], h0[0], h0[1], h0[2], h0[3]};
                    const bf16x8 v1 = (bf16x8){l1[0], l1[1], l1[2], l1[3], h1[0], h1[1], h1[2], h1[3]};
                    o0 = __builtin_amdgcn_mfma_f32_32x32x16_bf16(pa[bk][s], v0, o0, 0, 0, 0);
                    o1 = __builtin_amdgcn_mfma_f32_32x32x16_bf16(pa[bk][s], v1, o1, 0, 0, 0);
                }
        }
        if (kt > 0) { *(LAS u32x4*)(Kb + (buf ^ 1) * SB_TILE + ldst) = kn; *(LAS u32x4*)(Vb + (buf ^ 1) * SB_TILE + ldst) = vn; }
    }
#pragma unroll
    for (int r = 0; r < 16; ++r) { const int q = (r & 3) + 8 * (r >> 2) + 4 * hi;
        const size_t oo = (rowbase + qw0 + q) * DM + 512 + h * 64 + r32;
        CAT_ST(cat, oo, o0[r]); CAT_ST(cat, oo + 32, o1[r]); }
    __syncthreads();
}

template <int I> struct SelStep {
    static __device__ __forceinline__ void run(const float (&v)[64], float thr, float lo, bool exact, int need_eq, int& eq_seen, unsigned& m0, unsigned& m1, int vis) {
        if constexpr ((I & 7) == 0) { if (I * 64 >= vis) return; }
        const bool gt = v[I] > thr; const bool eq = (!exact) && !gt && (v[I] > lo);
        const unsigned long long meq = __ballot(eq);
        const int eq_rank = eq_seen + __builtin_amdgcn_mbcnt_hi((unsigned)(meq >> 32), __builtin_amdgcn_mbcnt_lo((unsigned)meq, 0));
        const bool take = gt || (eq && eq_rank < need_eq);
        const unsigned long long mt = __ballot(take);
        const unsigned mlo = (unsigned)mt, mhi = (unsigned)(mt >> 32);
        asm volatile("s_nop 1\n\tv_writelane_b32 %0, %1, %2" : "+v"(m0) : "s"(mlo), "n"(I));
        asm volatile("s_nop 1\n\tv_writelane_b32 %0, %1, %2" : "+v"(m1) : "s"(mhi), "n"(I));
        eq_seen += __builtin_popcountll(meq);
        SelStep<I + 1>::run(v, thr, lo, exact, need_eq, eq_seen, m0, m1, vis);
    }
};
template <> struct SelStep<64> { static __device__ __forceinline__ void run(const float (&)[64], float, float, bool, int, int&, unsigned&, unsigned&, int) {} };

template <int I> struct SelExact {
    static __device__ __forceinline__ void run(const float (&v)[64], float thr, unsigned& m0, unsigned& m1, int vis) {
        if constexpr ((I & 7) == 0) { if (I * 64 >= vis) return; }
        const unsigned long long mt = __ballot(v[I] > thr);
        const unsigned mlo = (unsigned)mt, mhi = (unsigned)(mt >> 32);
        asm volatile("s_nop 1\n\tv_writelane_b32 %0, %1, %2" : "+v"(m0) : "s"(mlo), "n"(I));
        asm volatile("s_nop 1\n\tv_writelane_b32 %0, %1, %2" : "+v"(m1) : "s"(mhi), "n"(I));
        SelExact<I + 1>::run(v, thr, m0, m1, vis);
    }
};
template <> struct SelExact<64> { static __device__ __forceinline__ void run(const float (&)[64], float, unsigned&, unsigned&, int) {} };

__device__ __forceinline__ void dsa_select_unit(Frame& F, const Args& a, int unit) {
    const bf16_t* z1 = (const bf16_t*)(a.ws + WS_Z); unsigned* bm = (unsigned*)(a.ws + WS_BM);
    const int lane = F.lane, wid = F.wave, r32 = lane & 31, hi = lane >> 5;
    const int tok0 = unit * 8;
    const int b = tok0 / SEQ, t0 = tok0 % SEQ;
    const size_t rowbase = (size_t)b * SEQ;
    const int vis = (t0 / 64 + 1) * 64;
    LAS float* sc = (LAS float*)F.lds;
    if (vis > 256) {
        const int tl = 2 * (r32 >> 4) + ((r32 >> 2) & 1), hd = (r32 & 3) + 4 * ((r32 >> 3) & 1);
        bf16x8 af[2][4];
#pragma unroll
        for (int rt = 0; rt < 2; ++rt) { const bf16_t* qp = z1 + (size_t)(tok0 + 4 * rt + tl) * ZO + OQI + hd * 64 + 8 * hi;
#pragma unroll
            for (int ks = 0; ks < 4; ++ks) af[rt][ks] = *(const bf16x8*)(qp + 16 * ks); }
        float wv[4][8];
#pragma unroll
        for (int j = 0; j < 4; ++j) { const u32x4 w = *(const u32x4*)(z1 + (size_t)(tok0 + 2 * j + hi) * ZO + OWI);
            const float s = 0.35355339059f * 0.125f;
            wv[j][0] = bf_lo(w.x) * s; wv[j][1] = bf_hi(w.x) * s; wv[j][2] = bf_lo(w.y) * s; wv[j][3] = bf_hi(w.y) * s;
            wv[j][4] = bf_lo(w.z) * s; wv[j][5] = bf_hi(w.z) * s; wv[j][6] = bf_lo(w.w) * s; wv[j][7] = bf_hi(w.w) * s; }
        const int nkt = vis / 32;
        const bf16_t* kbase = (const bf16_t*)(a.ws + WS_KI1) + rowbase * 64 + (size_t)lane * 8;
        for (int rep14 = 0; rep14 < PM(14); ++rep14)
        for (int kt0 = wid; kt0 < nkt; kt0 += 8 * NWAVES) {
            bf16x8 kq[8][4];
#pragma unroll
            for (int pf = 0; pf < 8; ++pf) { const int kt = min(kt0 + pf * NWAVES, nkt - 1);
#pragma unroll
                for (int ks = 0; ks < 4; ++ks) kq[pf][ks] = *(const bf16x8*)(kbase + (size_t)(kt * 4 + ks) * 512); }
            __builtin_amdgcn_sched_barrier(0);
#pragma unroll
            for (int pf = 0; pf < 8; ++pf) { const int kt = kt0 + pf * NWAVES;
                if (kt < nkt) {
                    f32x16 d0 = {}, d1 = {};
#pragma unroll
                    for (int ks = 0; ks < 4; ++ks) { d0 = __builtin_amdgcn_mfma_f32_32x32x16_bf16(af[0][ks], kq[pf][ks], d0, 0, 0, 0); d1 = __builtin_amdgcn_mfma_f32_32x32x16_bf16(af[1][ks], kq[pf][ks], d1, 0, 0, 0); }
                    float s0 = 0.f, s1 = 0.f, s2 = 0.f, s3 = 0.f;
#pragma unroll
                    for (int r = 0; r < 8; ++r) { s0 += wv[0][r] * relu_i(d0[r]); s1 += wv[1][r] * relu_i(d0[8 + r]); s2 += wv[2][r] * relu_i(d1[r]); s3 += wv[3][r] * relu_i(d1[8 + r]); }
                    const int key = kt * 32 + r32;
                    sc[(hi) * 4096 + key] = s0; sc[(2 + hi) * 4096 + key] = s1; sc[(4 + hi) * 4096 + key] = s2; sc[(6 + hi) * 4096 + key] = s3;
                } }
        }
    }
    __syncthreads();
    for (int rep15 = 0; rep15 < PM(15); ++rep15) {
        unsigned m0 = 0u, m1 = 0u;
        if (vis <= 256) { m0 = 0xffffffffu; m1 = 0xffffffffu; }
        else {
            const LAS float* ms = sc + wid * 4096;
            float v[64];
            float mx = -INFINITY, mn = INFINITY;
#pragma unroll
            for (int i8 = 0; i8 < 8; ++i8) {
                if (i8 * 512 < vis) {
#pragma unroll
                    for (int j = 0; j < 8; ++j) { const int i = 8 * i8 + j; const bool in = (i * 64 < vis); v[i] = in ? ms[i * 64 + lane] : -INFINITY; if (in) { mx = fmaxf(mx, v[i]); mn = fminf(mn, v[i]); } }
                } else {
#pragma unroll
                    for (int j = 0; j < 8; ++j) v[8 * i8 + j] = -INFINITY;
                } }
            mx = wave_max_uniform(mx); mn = -wave_max_uniform(-mn);
            float lo = mn - 1.f - fabsf(mn), hiv = mx;
            float thr = hiv; int cgt = 0; bool exact = false;
            int c_lo = vis, c_hi = 0;
            bool dead = false;
            for (int it = 0; it < 64 && (c_lo - c_hi) > 512; ++it) {
                const float mid = 0.5f * (lo + hiv);
                if (!(mid > lo) || !(mid < hiv)) { dead = true; break; }
                int c = 0;
#pragma unroll
                for (int i8 = 0; i8 < 8; ++i8) { if (i8 * 512 >= vis) break;
#pragma unroll
                    for (int j = 0; j < 8; ++j) c += (v[8 * i8 + j] > mid) ? 1 : 0; }
                c = wave_sum_uniform(c);
                if (c == 256) { thr = mid; exact = true; break; }
                if (c > 256) { lo = mid; c_lo = c; } else { hiv = mid; c_hi = c; }
            }
            if (!exact && !dead) {
                LAS float* cand = sc + wid * 4096; int base = 0;
#pragma unroll
                for (int i8 = 0; i8 < 8; ++i8) { if (i8 * 512 >= vis) break;
#pragma unroll
                  for (int j = 0; j < 8; ++j) { const int i = 8 * i8 + j; const bool in = (v[i] > lo) && !(v[i] > hiv);
                    const unsigned long long mk = __ballot(in);
                    const int pos = base + __builtin_amdgcn_mbcnt_hi((unsigned)(mk >> 32), __builtin_amdgcn_mbcnt_lo((unsigned)mk, 0));
                    if (in) cand[pos] = v[i];
                    base += __builtin_popcountll(mk); } }
                const int nc = c_lo - c_hi, c_hi0 = c_hi;
                float cv[8];
#pragma unroll
                for (int j = 0; j < 8; ++j) cv[j] = (lane + 64 * j < nc) ? cand[lane + 64 * j] : -INFINITY;
                for (int it = 0; it < 64; ++it) {
                    const float mid = 0.5f * (lo + hiv);
                    if (!(mid > lo) || !(mid < hiv)) break;
                    int c = 0;
#pragma unroll
                    for (int j = 0; j < 8; ++j) c += (cv[j] > mid) ? 1 : 0;
                    c = c_hi0 + wave_sum_uniform(c);
                    if (c == 256) { thr = mid; exact = true; break; }
                    if (c > 256) { lo = mid; c_lo = c; } else { hiv = mid; c_hi = c; }
                }
            }
            if (!exact) { thr = hiv; cgt = c_hi; }
            const int need_eq = exact ? 0 : (256 - cgt); int eq_seen = 0;
            if (exact) SelExact<0>::run(v, thr, m0, m1, vis); else SelStep<0>::run(v, thr, lo, exact, need_eq, eq_seen, m0, m1, vis);
        }
        if (lane * 64 < vis) *(u32x2*)(bm + (size_t)(tok0 + wid) * 128 + 2 * lane) = (u32x2){m0, m1};
    }
    __syncthreads();
}

template <int I> struct MaskInit {
    static __device__ __forceinline__ void run(f32x16 (&p)[2], int nw0, int nw1, float slope2, float T, int ninf) {
        constexpr int bk = I >> 4, r = I & 15, pos = 8 * (r >> 2) + (r & 3);
        const float vb = __builtin_fmaf(slope2, (float)(32 * bk + pos), T);
        int off; asm("v_bfe_i32 %0, %1, %2, 1" : "=v"(off) : "v"(bk ? nw1 : nw0), "n"(pos));
        float o; asm("v_bfi_b32 %0, %1, %2, %3" : "=v"(o) : "v"(off), "s"(ninf), "v"(vb));
        p[bk][r] = o;
        MaskInit<I + 1>::run(p, nw0, nw1, slope2, T, ninf);
    }
};
template <> struct MaskInit<32> { static __device__ __forceinline__ void run(f32x16 (&)[2], int, int, float, float, int) {} };
__device__ __forceinline__ float max3_asm(float a, float b, float c) { float r; asm("v_max3_f32 %0, %1, %2, %3" : "=v"(r) : "v"(a), "v"(b), "v"(c)); return r; }
__device__ __forceinline__ void dsa_attn_unit(Frame& F, const Args& a, int b, int ch, int g) {
    const bf16_t* z1 = (const bf16_t*)(a.ws + WS_Z); unsigned char* cat = (unsigned char*)(a.ws + WS_CAT); const unsigned* bm = (const unsigned*)(a.ws + WS_BM);
    const int tid = F.tid, lane = F.lane, wid = F.wave, r32 = lane & 31, hi = lane >> 5;
    const int hr = wid >> 1, qh = wid & 1, head = g * 4 + hr;
    const size_t rowbase = (size_t)b * SEQ;
    const int tq = ch * 64 + 32 * qh + r32;
    const float slope2 = ex2(-0.5f * (float)(head + 1)) * LOG2E;
    bf16x8 qr[4];
    { const bf16_t* qp = z1 + (rowbase + tq) * ZO + OQ + head * 64 + hi * 8;
#pragma unroll
      for (int ks = 0; ks < 4; ++ks) qr[ks] = *(const bf16x8*)(qp + ks * 16); }
    const unsigned* mrow = bm + (rowbase + tq) * 128;
    f32x16 o0 = {}, o1 = {}; float m = 0.f, l = 0.f;
    const int ntile = ch + 1;
    LAS unsigned char* Kb = F.lds; LAS unsigned char* Vb = F.lds + 2 * SB_TILE;
    LAS float* wsf = (LAS float*)(F.lds + 4 * SB_TILE) + wid * 32;
    const bf16_t* kg = (const bf16_t*)(a.ws + WS_KV1) + (rowbase + (tid >> 3)) * 512 + g * 64 + (tid & 7) * 8;
    const unsigned ldst = (unsigned)(tid >> 3) * SB_KST + (unsigned)(tid & 7) * 16;
    { const u32x4 kn = *(const u32x4*)(kg), vn = *(const u32x4*)(kg + 256);
      *(LAS u32x4*)(Kb + ldst) = kn; *(LAS u32x4*)(Vb + ldst) = vn; }
    const int dh = (lane >> 4) & 1, q_ = (lane & 15) >> 2, p_ = lane & 3;
    u32x2 mw = *(const u32x2*)(mrow);
    for (int kt = 0; kt < ntile; ++kt) {
        const int buf = kt & 1;
        u32x4 kn, vn; u32x2 mwn = mw;
        if (kt + 1 < ntile) { const size_t go = (size_t)(kt + 1) * 64 * 512; kn = *(const u32x4*)(kg + go); vn = *(const u32x4*)(kg + go + 256); mwn = *(const u32x2*)(mrow + 2 * (kt + 1)); }
        LDS_BARRIER();
        const LAS unsigned char* Kc = Kb + buf * SB_TILE; const LAS unsigned char* Vc = Vb + buf * SB_TILE;
        const float T = slope2 * (float)(64 * kt + 4 * hi) - m;
        const int nw0 = (int)~(mw.x >> (4 * hi)), nw1 = (int)~(mw.y >> (4 * hi));
        f32x16 p[2];
        MaskInit<0>::run(p, nw0, nw1, slope2, T, (int)0xff800000);
#pragma unroll
        for (int ks = 0; ks < 4; ++ks) {
            const bf16x8 k0 = *(const LAS bf16x8*)(Kc + r32 * SB_KST + (16 * ks + 8 * hi) * 2);
            const bf16x8 k1 = *(const LAS bf16x8*)(Kc + (32 + r32) * SB_KST + (16 * ks + 8 * hi) * 2);
            p[0] = __builtin_amdgcn_mfma_f32_32x32x16_bf16(k0, qr[ks], p[0], 0, 0, 0);
            p[1] = __builtin_amdgcn_mfma_f32_32x32x16_bf16(k1, qr[ks], p[1], 0, 0, 0);
        }
        if (kt == ntile - 1) {
            const float basef = (float)(tq - (64 * kt + 4 * hi));
#pragma unroll
            for (int bk = 0; bk < 2; ++bk)
#pragma unroll
                for (int r = 0; r < 16; ++r) { const float rel = (float)(32 * bk + 8 * (r >> 2) + (r & 3)) - basef; p[bk][r] -= 2.f * slope2 * fmaxf(rel, 0.f); }
        } else asm volatile("s_nop 15\n\ts_nop 7" : "+v"(p[0]), "+v"(p[1]));
        float rm;
        { float a0 = max3_asm(p[0][0], p[0][1], p[1][0]), b0 = max3_asm(p[0][2], p[0][3], p[1][1]); a0 = max3_asm(a0, p[1][2], p[1][3]);
#pragma unroll
          for (int r = 4; r < 16; r += 4) { a0 = max3_asm(a0, p[0][r], p[0][r + 1]); b0 = max3_asm(b0, p[0][r + 2], p[0][r + 3]); a0 = max3_asm(a0, p[1][r], p[1][r + 1]); b0 = max3_asm(b0, p[1][r + 2], p[1][r + 3]); }
          rm = fmaxf(a0, b0); }
        rm = fmaxf(rm, sxf<32>(rm));
        if (__any(rm > 6.f) || kt == 0) {
            const float d = (kt == 0) ? ((rm > -1e30f) ? rm : 0.f) : ((rm > 6.f) ? rm : 0.f);
            const float alpha = ex2(-d);
            l *= alpha; m += d;
#pragma unroll
            for (int bk = 0; bk < 2; ++bk)
#pragma unroll
                for (int r = 0; r < 16; ++r) p[bk][r] -= d;
            if (hi == 0) wsf[r32] = alpha;
#pragma unroll
            for (int r = 0; r < 16; ++r) { const float al = wsf[(r & 3) + 8 * (r >> 2) + 4 * hi]; o0[r] *= al; o1[r] *= al; }
        }
        float ls = 0.f;
#pragma unroll
        for (int bk = 0; bk < 2; ++bk)
#pragma unroll
            for (int r = 0; r < 16; ++r) { const float e = ex2(p[bk][r]); p[bk][r] = e; ls += e; }
        l += ls;
        bf16x8 pa[2][2];
#pragma unroll
        for (int bk = 0; bk < 2; ++bk)
#pragma unroll
            for (int s = 0; s < 2; ++s) { u32x4 w; w.x = cvt_pk_bf16(p[bk][8 * s + 0], p[bk][8 * s + 1]); w.y = cvt_pk_bf16(p[bk][8 * s + 2], p[bk][8 * s + 3]);
                w.z = cvt_pk_bf16(p[bk][8 * s + 4], p[bk][8 * s + 5]); w.w = cvt_pk_bf16(p[bk][8 * s + 6], p[bk][8 * s + 7]); pa[bk][s] = __builtin_bit_cast(bf16x8, w); }
#pragma unroll
        for (int bk = 0; bk < 2; ++bk)
#pragma unroll
            for (int s = 0; s < 2; ++s) {
                const LAS unsigned char* vp = Vc + (32 * bk + 16 * s + 4 * hi + q_) * SB_KST + (16 * dh + 4 * p_) * 2;
                const s16x4 l0 = __builtin_amdgcn_ds_read_tr16_b64_v4i16((LAS s16x4*)(vp));
                const s16x4 h0 = __builtin_amdgcn_ds_read_tr16_b64_v4i16((LAS s16x4*)(vp + 8 * SB_KST));
                const s16x4 l1 = __builtin_amdgcn_ds_read_tr16_b64_v4i16((LAS s16x4*)(vp + 64));
                const s16x4 h1 = __builtin_amdgcn_ds_read_tr16_b64_v4i16((LAS s16x4*)(vp + 8 * SB_KST + 64));
                const bf16x8 v0 = (bf16x8){l0[0], l0[1], l0[2], l0[3], h0[0], h0[1], h0[2], h0[3]};
                const bf16x8 v1 = (bf16x8){l1[0], l1[1], l1[2], l1[3], h1[0], h1[1], h1[2], h1[3]};
                o0 = __builtin_amdgcn_mfma_f32_32x32x16_bf16(pa[bk][s], v0, o0, 0, 0, 0);
                o1 = __builtin_amdgcn_mfma_f32_32x32x16_bf16(pa[bk][s], v1, o1, 0, 0, 0);
            }
        if (kt + 1 < ntile) { *(LAS u32x4*)(Kb + (buf ^ 1) * SB_TILE + ldst) = kn; *(LAS u32x4*)(Vb + (buf ^ 1) * SB_TILE + ldst) = vn; }
        mw = mwn;
    }
    l += sxf<32>(l);
    if (hi == 0) wsf[r32] = 1.f / l;
#pragma unroll
    for (int r = 0; r < 16; ++r) { const int q = (r & 3) + 8 * (r >> 2) + 4 * hi; const float inv = wsf[q];
        const size_t oo = (rowbase + ch * 64 + 32 * qh + q) * DM + head * 64 + r32;
        CAT_ST(cat, oo, o0[r] * inv); CAT_ST(cat, oo + 32, o1[r] * inv); }
    __syncthreads();
}

__device__ __forceinline__ void ln_row16(const bf16_t* src, float (&x)[16], int lane) {
    const u32x4 a = *(const u32x4*)(src + 8 * lane), b = *(const u32x4*)(src + 512 + 8 * lane);
    x[0] = bf_lo(a.x); x[1] = bf_hi(a.x); x[2] = bf_lo(a.y); x[3] = bf_hi(a.y); x[4] = bf_lo(a.z); x[5] = bf_hi(a.z); x[6] = bf_lo(a.w); x[7] = bf_hi(a.w);
    x[8] = bf_lo(b.x); x[9] = bf_hi(b.x); x[10] = bf_lo(b.y); x[11] = bf_hi(b.y); x[12] = bf_lo(b.z); x[13] = bf_hi(b.z); x[14] = bf_lo(b.w); x[15] = bf_hi(b.w);
}
__device__ __forceinline__ void ln_norm16(float (&x)[16], const float* g, const float* bta, int lane) {
    float s = 0.f;
#pragma unroll
    for (int j = 0; j < 16; ++j) s += x[j];
    const float mean = wave_sum(s) * (1.f / DM); float q = 0.f;
#pragma unroll
    for (int j = 0; j < 16; ++j) { x[j] -= mean; q += x[j] * x[j]; }
    const float rstd = 1.f / sqrtf(wave_sum(q) * (1.f / DM) + LN_EPS);
    const f32x4 g0 = *(const f32x4*)(g + 8 * lane), g1 = *(const f32x4*)(g + 8 * lane + 4), g2 = *(const f32x4*)(g + 512 + 8 * lane), g3 = *(const f32x4*)(g + 512 + 8 * lane + 4);
    const f32x4 b0 = *(const f32x4*)(bta + 8 * lane), b1 = *(const f32x4*)(bta + 8 * lane + 4), b2 = *(const f32x4*)(bta + 512 + 8 * lane), b3 = *(const f32x4*)(bta + 512 + 8 * lane + 4);
#pragma unroll
    for (int j = 0; j < 4; ++j) { x[j] = x[j] * rstd * g0[j] + b0[j]; x[4 + j] = x[4 + j] * rstd * g1[j] + b1[j]; x[8 + j] = x[8 + j] * rstd * g2[j] + b2[j]; x[12 + j] = x[12 + j] * rstd * g3[j] + b3[j]; }
}
__device__ __forceinline__ void store16bf(bf16_t* dst, const float (&x)[16], int lane) {
    u32x4 a, b; a.x = cvt_pk_bf16(x[0], x[1]); a.y = cvt_pk_bf16(x[2], x[3]); a.z = cvt_pk_bf16(x[4], x[5]); a.w = cvt_pk_bf16(x[6], x[7]);
    b.x = cvt_pk_bf16(x[8], x[9]); b.y = cvt_pk_bf16(x[10], x[11]); b.z = cvt_pk_bf16(x[12], x[13]); b.w = cvt_pk_bf16(x[14], x[15]);
    *(u32x4*)(dst + 8 * lane) = a; *(u32x4*)(dst + 512 + 8 * lane) = b;
}
__device__ __forceinline__ void store16f8(unsigned char* dst, const float (&x)[16], int lane) {
    *(u32x2*)(dst + 8 * lane) = pg8::pack8_fp8((f32x4){x[0], x[1], x[2], x[3]}, (f32x4){x[4], x[5], x[6], x[7]});
    *(u32x2*)(dst + 512 + 8 * lane) = pg8::pack8_fp8((f32x4){x[8], x[9], x[10], x[11]}, (f32x4){x[12], x[13], x[14], x[15]});
}
constexpr int HS_STRIDE = 2064;
__device__ __forceinline__ void ln1_router_phase(Frame& F, const Args& a, int layer) {
    const bf16_t* t1 = (const bf16_t*)(a.ws + WS_T1); bf16_t* hb = (bf16_t*)(a.ws + WS_HB);
    const bf16_t* wrt = (const bf16_t*)(a.ws + WS_WRT) + (size_t)layer * NEXP * DM;
    const float* g = a.in[10] + layer * DM; const float* bta = a.in[11] + layer * DM; const float* br = a.in[13] + layer * NEXP;
    int* topi = (int*)(a.ws + WS_TOPI); float* gate = (float*)(a.ws + WS_GATE); int* cnt = (int*)(a.ws + WS_CNT);
    const int lane = F.lane, w = F.wave, tid = F.tid;
    LAS unsigned char* hs = F.lds;
    LAS float* part = (LAS float*)(F.lds + 36864);
    LAS float* logit = (LAS float*)(F.lds + 36864 + 16384);
    LAS int* hist = (LAS int*)(F.lds + 36864 + 16384 + 2048);
    LAS int* topk_i = (LAS int*)(F.lds + 36864 + 16384 + 2048 + 256); LAS float* topk_v = (LAS float*)(F.lds + 36864 + 16384 + 2048 + 512);
    const int n16 = lane & 15, kg4 = lane >> 4;
    bf16x8 bw[2][4];
#pragma unroll
    for (int n = 0; n < 2; ++n)
#pragma unroll
        for (int ks = 0; ks < 4; ++ks) bw[n][ks] = *(const bf16x8*)(wrt + (size_t)(16 * n + n16) * DM + 128 * w + 32 * ks + 8 * kg4);
    for (int grp2 = F.bid; grp2 < NGRP * PM(6); grp2 += F.G) { const int grp = grp2 % NGRP;
        if (tid < 32) hist[tid] = 0;
        __syncthreads();
        for (int it = 0; it < 8; ++it) {
            const int r0 = grp * 128 + it * 16;
#pragma unroll
            for (int rr = 0; rr < 2; ++rr) { const int rl = 2 * w + rr; float x[16];
                ln_row16(t1 + (size_t)(r0 + rl) * DM, x, lane); ln_norm16(x, g, bta, lane);
                store16bf(hb + (size_t)(r0 + rl) * DM, x, lane); store16f8((unsigned char*)(a.ws + WS_HQ) + (size_t)(r0 + rl) * DM, x, lane);
                u32x4 p, q; p.x = cvt_pk_bf16(x[0], x[1]); p.y = cvt_pk_bf16(x[2], x[3]); p.z = cvt_pk_bf16(x[4], x[5]); p.w = cvt_pk_bf16(x[6], x[7]);
                q.x = cvt_pk_bf16(x[8], x[9]); q.y = cvt_pk_bf16(x[10], x[11]); q.z = cvt_pk_bf16(x[12], x[13]); q.w = cvt_pk_bf16(x[14], x[15]);
                *(LAS u32x4*)(hs + rl * HS_STRIDE + 16 * lane) = p; *(LAS u32x4*)(hs + rl * HS_STRIDE + 1024 + 16 * lane) = q; }
            __syncthreads();
            { f32x4 d0 = {0.f, 0.f, 0.f, 0.f}, d1 = {0.f, 0.f, 0.f, 0.f};
#pragma unroll
              for (int ks = 0; ks < 4; ++ks) { const bf16x8 af = *(const LAS bf16x8*)(hs + n16 * HS_STRIDE + (128 * w + 32 * ks + 8 * kg4) * 2);
                  d0 = __builtin_amdgcn_mfma_f32_16x16x32_bf16(af, bw[0][ks], d0, 0, 0, 0); d1 = __builtin_amdgcn_mfma_f32_16x16x32_bf16(af, bw[1][ks], d1, 0, 0, 0); }
#pragma unroll
              for (int r = 0; r < 4; ++r) { part[(w * 16 + 4 * kg4 + r) * 32 + n16] = d0[r]; part[(w * 16 + 4 * kg4 + r) * 32 + 16 + n16] = d1[r]; } }
            __syncthreads();
            { const int row = tid >> 5, e = tid & 31; float s = br[e];
#pragma unroll
              for (int ww = 0; ww < 8; ++ww) s += part[(ww * 16 + row) * 32 + e];
              logit[row * 32 + e] = s; }
            __syncthreads();
            { const int row = tid >> 5, e = tid & 31; const float lv = logit[row * 32 + e]; int rank = 0;
#pragma unroll
              for (int e2 = 0; e2 < 32; ++e2) { const float o = logit[row * 32 + e2]; rank += (o > lv || (o == lv && e2 < e)) ? 1 : 0; }
              if (rank < 4) { topk_i[row * 4 + rank] = e; topk_v[row * 4 + rank] = lv; } }
            __syncthreads();
            if (tid < 16) { const int tok = r0 + tid;
                const int t0 = topk_i[tid * 4 + 0], t1 = topk_i[tid * 4 + 1], t2 = topk_i[tid * 4 + 2], t3 = topk_i[tid * 4 + 3];
                const float v0 = topk_v[tid * 4 + 0];
                const float e0 = 1.f, e1 = __expf(topk_v[tid * 4 + 1] - v0), e2 = __expf(topk_v[tid * 4 + 2] - v0), e3 = __expf(topk_v[tid * 4 + 3] - v0); const float inv = 1.f / (e0 + e1 + e2 + e3);
                *(int4*)(topi + (size_t)tok * 4) = make_int4(t0, t1, t2, t3);
                *(float4*)(gate + (size_t)tok * 4) = make_float4(e0 * inv, e1 * inv, e2 * inv, e3 * inv);
                atomicAdd((int*)&hist[t0], 1); atomicAdd((int*)&hist[t1], 1); atomicAdd((int*)&hist[t2], 1); atomicAdd((int*)&hist[t3], 1); }
        }
        __syncthreads();
        if (tid < 32) cnt[grp * 32 + tid] = hist[tid];
        __syncthreads();
    }
}

__device__ __forceinline__ void moe_tables(Frame& F, const Args& a, int grp) {
    const int* cnt = (const int*)(a.ws + WS_CNT);
    LAS int* T = (LAS int*)(F.lds + TAB_OFF);
    const int tid = F.tid, e = tid & 31, j = tid >> 5;
    { int s = 0, bf = 0;
      for (int gg = j * 16; gg < j * 16 + 16; ++gg) { const int c = cnt[gg * 32 + e]; s += c; if (gg < grp) bf += c; }
      T[TB_TOT16 / 4 + j * 32 + e] = s; T[TB_BEF16 / 4 + j * 32 + e] = bf; }
    __syncthreads();
    if (tid < 32) { int s = 0, bf = 0;
#pragma unroll
        for (int jj = 0; jj < 16; ++jj) { s += T[TB_TOT16 / 4 + jj * 32 + tid]; bf += T[TB_BEF16 / 4 + jj * 32 + tid]; }
        T[TB_TOTAL / 4 + tid] = s; T[TB_BEFORE / 4 + tid] = bf; T[TB_LCUR / 4 + tid] = 0; }
    __syncthreads();
    if (tid < 32) {
        int ps = 0;
#pragma nounroll
        for (int ee = 0; ee < tid; ++ee) ps += ((T[TB_TOTAL / 4 + ee] + 255) >> 8) << 8;
        T[TB_PADST / 4 + tid] = ps; T[TB_BASE / 4 + tid] = ps + T[TB_BEFORE / 4 + tid];
        if (tid == 31) { const int end = ps + (((T[TB_TOTAL / 4 + 31] + 255) >> 8) << 8); T[TB_PADST / 4 + 32] = end; T[TB_NTL / 4] = end >> 8; } }
    __syncthreads();
    { LAS unsigned char* t2e = (LAS unsigned char*)(F.lds + TAB_OFF + TB_T2E); const int ntl = T[TB_NTL / 4];
      for (int rt = tid; rt < ntl; rt += NTHR) { int e = 0;
#pragma nounroll
          for (int ee = 1; ee < 32; ++ee) e += (T[TB_PADST / 4 + ee] <= rt * 256) ? 1 : 0;
          t2e[rt] = (unsigned char)e; } }
    __syncthreads();
}
__device__ __forceinline__ void scatter_phase(Frame& F, const Args& a) {
    const int* topi = (const int*)(a.ws + WS_TOPI);
    int* slot = (int*)(a.ws + WS_SLOT); int* rowtok = (int*)(a.ws + WS_ROWG);
    LAS int* T = (LAS int*)(F.lds + TAB_OFF);
    const int tid = F.tid;
    if (F.bid >= NGRP) moe_tables(F, a, -1);
    for (int grp2 = F.bid; grp2 < NGRP * PM(7); grp2 += F.G) { const int grp = grp2 % NGRP;
        moe_tables(F, a, grp);
        { const int tok = grp * 128 + (tid >> 2), k = tid & 3; const int e = topi[(size_t)tok * 4 + k];
          const int rank = atomicAdd((int*)&T[TB_LCUR / 4 + e], 1); const int row = T[TB_BASE / 4 + e] + rank;
          slot[(size_t)tok * 4 + k] = row; rowtok[row] = tok; }
        if (grp < NEXP) {
            const int tot = T[TB_TOTAL / 4 + grp], st = T[TB_PADST / 4 + grp], en = T[TB_PADST / 4 + grp + 1];
            for (int r = st + tot + tid; r < en; r += NTHR) rowtok[r] = 0; }
        __syncthreads();
    }
}
__device__ __forceinline__ void combine_phase(Frame& F, const Args& a) {
    const bf16_t* hb = (const bf16_t*)(a.ws + WS_HB); const bf16_t* yb = (const bf16_t*)(a.ws + WS_XS); bf16_t* mid = (bf16_t*)(a.ws + WS_MIDB);
    const int* slot = (const int*)(a.ws + WS_SLOT);
    const int lane = F.lane;
    for (int tok2 = F.bid * NWAVES + F.wave; tok2 < NTOK * PM(10); tok2 += F.G * NWAVES) { const int tok = tok2 % NTOK;
        float x[16]; ln_row16(hb + (size_t)tok * DM, x, lane);
#pragma unroll
        for (int j = 0; j < 16; ++j) x[j] *= ALPHA;
        const int4 sl = *(const int4*)(slot + (size_t)tok * 4);
        const int s4[4] = {sl.x, sl.y, sl.z, sl.w};
        const float4 gt4 = *(const float4*)((const float*)(a.ws + WS_GATE) + (size_t)tok * 4);
        const float g4[4] = {gt4.x * 0.0625f, gt4.y * 0.0625f, gt4.z * 0.0625f, gt4.w * 0.0625f};
#pragma unroll
        for (int k = 0; k < 4; ++k) {
            if (Y_FP8) { const unsigned char* yr = (const unsigned char*)yb + (size_t)s4[k] * DM;
                const u32x2 p = *(const u32x2*)(yr + 8 * lane), q = *(const u32x2*)(yr + 512 + 8 * lane);
                const unsigned w4[4] = {p.x, p.y, q.x, q.y};
#pragma unroll
                for (int i = 0; i < 4; ++i) { const f32x2 lo = __builtin_amdgcn_cvt_pk_f32_fp8((int)w4[i], false), hi2 = __builtin_amdgcn_cvt_pk_f32_fp8((int)w4[i], true);
                    x[4 * i + 0] += lo.x * g4[k]; x[4 * i + 1] += lo.y * g4[k]; x[4 * i + 2] += hi2.x * g4[k]; x[4 * i + 3] += hi2.y * g4[k]; } }
            else { float y[16]; ln_row16(yb + (size_t)s4[k] * DM, y, lane);
#pragma unroll
                for (int j = 0; j < 16; ++j) x[j] += y[j] * (16.f * g4[k]); } }
        store16bf(mid + (size_t)tok * DM, x, lane); store16f8((unsigned char*)(a.ws + WS_MIDQ) + (size_t)tok * DM, x, lane);
    }
}
__device__ __forceinline__ void ln2_phase(Frame& F, const Args& a, int layer) {
    const bf16_t* t2 = (const bf16_t*)(a.ws + WS_T1); bf16_t* xb = (bf16_t*)(a.ws + WS_XB);
    const float* g = a.in[18] + layer * DM; const float* bta = a.in[19] + layer * DM;
    const int lane = F.lane;
    for (int tok2 = F.bid * NWAVES + F.wave; tok2 < NTOK * PM(12); tok2 += F.G * NWAVES) { const int tok = tok2 % NTOK;
        float x[16]; ln_row16(t2 + (size_t)tok * DM, x, lane); ln_norm16(x, g, bta, lane);
        if (layer == 0) { store16bf(xb + (size_t)tok * DM, x, lane); if (FP8_IN1 || FP8_IN1Q) store16f8((unsigned char*)(a.ws + WS_XQ) + (size_t)tok * DM, x, lane); }
        else { float* o = a.out + (size_t)tok * DM;
            *(f32x4*)(o + 8 * lane) = (f32x4){x[0], x[1], x[2], x[3]}; *(f32x4*)(o + 8 * lane + 4) = (f32x4){x[4], x[5], x[6], x[7]};
            *(f32x4*)(o + 512 + 8 * lane) = (f32x4){x[8], x[9], x[10], x[11]}; *(f32x4*)(o + 512 + 8 * lane + 4) = (f32x4){x[12], x[13], x[14], x[15]}; }
    }
}

__global__ void __launch_bounds__(NTHR, 2) __attribute__((target("no-packed-fp32-ops"))) hybrid_fwd(Args args) {
    extern __shared__ __attribute__((aligned(16))) unsigned char lds_raw[];
    Frame F;
    F.lds = (LAS unsigned char*)lds_raw;
    F.tid = threadIdx.x; F.lane = F.tid & 63; F.wave = __builtin_amdgcn_readfirstlane(F.tid >> 6); F.G = gridDim.x; F.bid = blockIdx.x;
    volatile LAS unsigned* MISC = (volatile LAS unsigned*)(F.lds + MISC_OFF);
    for (int u = F.tid; u < 128; u += NTHR) MISC[u] = 0u;
    __syncthreads();
    XcdBarrier bar = xcd_barrier_post((unsigned*)(args.ws + WS_CTL) + 4096, MISC + 8);
    const int lo = args.ph_lo; int ph = 0; (void)lo; (void)ph;
#ifndef PHMASK
#define PHMASK 0xfffff
#endif
#ifndef PROBE_DUP
#define PROBE_DUP 0
#endif
#define SITE(k) if constexpr ((PHMASK >> (k)) & 1)
typedef const __attribute__((address_space(4))) Args* KArgs;
#define PHASE_REFRESH int t_ = threadIdx.x; asm volatile("" : "+v"(t_)); F.tid = t_; F.lane = t_ & 63; F.wave = __builtin_amdgcn_readfirstlane(t_ >> 6); \
    { int b_ = blockIdx.x; asm volatile("" : "+s"(b_)); F.bid = b_; } \
    { unsigned l_ = 0; asm volatile("" : "+s"(l_)); F.lds = (LAS unsigned char*)lds_raw + l_; } LAS unsigned char* const ring = F.lds; \
    LOAD_ARGS unsigned char* const ws = A.ws;
#if defined(__HIP_DEVICE_COMPILE__)
#define LOAD_ARGS KArgs ap_ = (KArgs)__builtin_amdgcn_kernarg_segment_ptr(); asm volatile("" : "+s"(ap_)); const Args A = *ap_;
#else
#define LOAD_ARGS const Args A = args;
#endif
#ifdef MK_LAUNCHES_PER_PHASE
#define PHASE_BEGIN if (ph == lo) { PHASE_REFRESH
#define PHASE_END   } ++ph;
#define PHASE_END_LAST } ++ph;
#else
#define PHASE_BEGIN { PHASE_REFRESH
#ifdef PROBE_BAR2
#define PHASE_END   xcd_barrier(bar); xcd_barrier(bar); }
#else
#define PHASE_END   xcd_barrier(bar); }
#endif
#define PHASE_END_LAST if (layer == 0) xcd_barrier(bar); }
#endif
    using namespace pg8;

    PHASE_BEGIN SITE(0) p0_prologue(F, A); PHASE_END

    for (int layer = 0; layer < 2; ++layer) {
        PHASE_BEGIN
        SITE(1) {
        if (layer == 0) {
            SITE(16) { DenseOrder S; S.initp(ws + (FP8_IN0 ? WS_XQ : WS_XB), ws + WS_WIN0, NTOK, ZE, FP8_IN0 ? DM : 2 * DM, F.G, F.bid, PM(1)); EpiIn0 E{(bf16_t*)(ws + WS_Z), 0.125f * LOG2E}; int p8 = FP8_IN0 ? DM : 2 * DM; asm volatile("" : "+s"(p8)); gemm_phase<EpiIn0, DenseOrder, FP8_IN0 != 0>(ring, F.tid, p8, S, E); }
            SITE(17) { PleOrder S; S.D.init(ws + WS_PB, ws + WS_WPLE, 2 * NTOK, DM, PLE, F.G, F.bid, PM(1));
              int kple = 2 * PLE; asm volatile("" : "+s"(kple));
              EpiPlain E{(bf16_t*)(ws + WS_PPLE), DM}; gemm_phase(ring, F.tid, kple, S, E); }
        } else {
#if FP8_IN1Q
            SITE(18) { { DenseOrder S; S.initp(ws + WS_XQ, ws + WS_WIN1Q, NTOK, 1536, DM, F.G, F.bid, PM(1)); if (F.G == 256 && PM(1) == 1) S.rep = -1; EpiIn1 E{(bf16_t*)(ws + WS_Z), (bf16_t*)(ws + WS_KV1), (bf16_t*)(ws + WS_KI1), 0}; int p8 = DM; asm volatile("" : "+s"(p8)); gemm_phase<EpiIn1, DenseOrder, true>(ring, F.tid, p8, S, E); }
                       { DenseOrder S; S.initp(ws + WS_XB, ws + WS_WIN1 + (size_t)1536 * DM * 2, NTOK, ZO - 1536, 2 * DM, F.G, F.bid, PM(1)); if (F.G == 256 && PM(1) == 1) S.rep = -2; EpiIn1 E{(bf16_t*)(ws + WS_Z), (bf16_t*)(ws + WS_KV1), (bf16_t*)(ws + WS_KI1), 6}; int p8 = 2 * DM; asm volatile("" : "+s"(p8)); gemm_phase<EpiIn1, DenseOrder, false>(ring, F.tid, p8, S, E); } }
#else
            SITE(18) { DenseOrder S; S.initp(ws + (FP8_IN1 ? WS_XQ : WS_XB), ws + WS_WIN1, NTOK, ZO, FP8_IN1 ? DM : 2 * DM, F.G, F.bid, PM(1)); EpiIn1 E{(bf16_t*)(ws + WS_Z), (bf16_t*)(ws + WS_KV1), (bf16_t*)(ws + WS_KI1), 0}; int p8 = FP8_IN1 ? DM : 2 * DM; asm volatile("" : "+s"(p8)); gemm_phase<EpiIn1, DenseOrder, FP8_IN1 != 0>(ring, F.tid, p8, S, E); }
#endif
        }
        }
        PHASE_END
        PHASE_BEGIN
        if (layer == 0) {
            SITE(2) { bool conv = false; int kit = 0;
              for (long L = F.bid; L < 1024 * PM(2); L += F.G, ++kit) { const int v = (int)(L & 255), rnd = (int)((L >> 8) & 3), s = v & 3, bh = v >> 2;
                const int qb = rnd == 0 ? 15 - s : (rnd == 1 ? 8 + s : (rnd == 2 ? 7 - s : s));
                sb_unit(F, A, bh >> 3, bh & 7, qb);
                if (!conv && kit == ((F.bid >> 3) & 3)) { p0_tiles<1>(F, A, 1); conv = true; } }
              if (!conv) p0_tiles<1>(F, A, 1); }
            SITE(3) for (int u = F.bid; u < PM(3) * NTOK / 128; u += F.G) gmlp_unit(F, A, u % (NTOK / 128));
        } else {
            SITE(4) for (int L = F.bid; L < PM(4) * NTOK / 8; L += F.G) { const int Lm = L % (NTOK / 8), r = Lm >> 8, cc = Lm & 255;
                const int j = (r & 1) ? 511 - cc : cc; dsa_select_unit(F, A, (r >> 1) * 512 + j); }
        }
        PHASE_END
        if (layer == 1) {
        PHASE_BEGIN
            SITE(13) { bool conv = false; int kit = 0;
              for (int L = F.bid; L < 1024 * PM(13); L += F.G, ++kit) { const int idx = L & 1023, pp = idx & 31, g = (idx >> 5) & 3, b = idx >> 7;
                dsa_attn_unit(F, A, b, 63 - pp, g); dsa_attn_unit(F, A, b, pp, g);
                if (!conv && kit == ((F.bid >> 3) & 3)) { p0_tiles<2>(F, A, 1); conv = true; } }
              if (!conv) p0_tiles<2>(F, A, 1); }
        PHASE_END
        }
        PHASE_BEGIN
        SITE(5) { DenseOrder S; S.initp(ws + WS_CAT, ws + (layer == 0 ? WS_WO0 : WS_WO1), NTOK, DM, FP8_OUT ? DM : 2 * DM, F.G, F.bid, PM(5));
          EpiOut E{layer == 0 ? A.in[0] : nullptr, (const bf16_t*)(ws + WS_XB), (bf16_t*)(ws + WS_T1)}; int p8 = FP8_OUT ? DM : 2 * DM; asm volatile("" : "+s"(p8)); gemm_phase<EpiOut, DenseOrder, FP8_OUT != 0>(ring, F.tid, p8, S, E); }
        PHASE_END
        PHASE_BEGIN SITE(6) ln1_router_phase(F, A, layer); PHASE_END
        PHASE_BEGIN SITE(7) scatter_phase(F, A); PHASE_END
        PHASE_BEGIN
        SITE(8) {
#ifdef MK_LAUNCHES_PER_PHASE
          moe_tables(F, A, -1);
#endif
          const int ntl = __builtin_amdgcn_readfirstlane(((LAS int*)(F.lds + TAB_OFF))[TB_NTL / 4]);
          MoeOrder<8, true> S; S.nunits = ntl * 8; S.G = F.G; S.c = F.bid; S.rep = PM(8); S.t2e = (const LAS unsigned char*)(F.lds + TAB_OFF + TB_T2E);
          S.A = (const char*)(ws + WS_HQ); S.rowtok = (const int*)(ws + WS_ROWG); S.W = (const char*)(ws + WS_WGU) + (size_t)layer * 32 * 2048 * DM;
          EpiSwiglu E{(unsigned char*)(ws + WS_ACT), A.in[15] + (size_t)layer * 32 * 2048}; int p8 = DM; asm volatile("" : "+s"(p8)); gemm_phase<EpiSwiglu, MoeOrder<8, true>, true, MOE_ALIGN>(ring, F.tid, p8, S, E); }
        PHASE_END
        PHASE_BEGIN
        SITE(9) {
#ifdef MK_LAUNCHES_PER_PHASE
          moe_tables(F, A, -1);
#endif
          const int ntl = __builtin_amdgcn_readfirstlane(((LAS int*)(F.lds + TAB_OFF))[TB_NTL / 4]);
          MoeOrder<4, false> S; S.nunits = ntl * 4; S.G = F.G; S.c = F.bid; S.rep = PM(9); S.t2e = (const LAS unsigned char*)(F.lds + TAB_OFF + TB_T2E);
          S.A = (const char*)(ws + WS_ACT); S.rowtok = nullptr; S.W = (const char*)(ws + WS_WD) + (size_t)layer * 32 * DM * DM;
          EpiDown E{(unsigned char*)(ws + WS_XS), A.in[17] + (size_t)layer * 32 * DM}; int p8 = DM; asm volatile("" : "+s"(p8)); gemm_phase<EpiDown, MoeOrder<4, false>, true, MOE_ALIGN>(ring, F.tid, p8, S, E); }
        PHASE_END
        PHASE_BEGIN SITE(10) combine_phase(F, A); PHASE_END
        PHASE_BEGIN
        SITE(11) { DenseOrder S; S.initp(ws + (FP8_GATE ? WS_MIDQ : WS_MIDB), ws + WS_WG + (size_t)layer * DM * DM * (FP8_GATE ? 1 : 2), NTOK, DM, FP8_GATE ? DM : 2 * DM, F.G, F.bid, PM(11));
          EpiGate E{(const bf16_t*)(ws + WS_MIDB), (const bf16_t*)(ws + WS_PPLE) + (size_t)layer * NTOK * DM, A.in[22] + layer * DM, (bf16_t*)(ws + WS_T1)}; int p8 = FP8_GATE ? DM : 2 * DM; asm volatile("" : "+s"(p8)); gemm_phase<EpiGate, DenseOrder, FP8_GATE != 0>(ring, F.tid, p8, S, E); }
        PHASE_END
        PHASE_BEGIN SITE(12) ln2_phase(F, A, layer); PHASE_END_LAST
    }
#undef PHASE_BEGIN
#undef PHASE_END
#undef PHASE_END_LAST
}
constexpr int N_PHASES = 22;

extern "C" void kernel_launch(void* const* d_in, const int* in_sizes, int n_in, void* d_out, int out_size, void* d_ws, size_t ws_size, hipStream_t stream) {
    static int grid = 0;
    if (grid == 0) {
        if (n_in != 23 || out_size != NTOK * DM || ws_size < WS_END) { fprintf(stderr, "kernel_launch: unexpected problem: n_in %d out %d ws %zu (need %zu)\n", n_in, out_size, ws_size, (size_t)WS_END); grid = -1; return; }
        int dev = 0, cus = 0, per_cu = 0;
        if (hipGetDevice(&dev) != hipSuccess || hipDeviceGetAttribute(&cus, hipDeviceAttributeMultiprocessorCount, dev) != hipSuccess) { grid = -1; return; }
        if (hipFuncSetAttribute((const void*)hybrid_fwd, hipFuncAttributeMaxDynamicSharedMemorySize, LDS_BYTES) != hipSuccess) { fprintf(stderr, "kernel_launch: hipFuncSetAttribute failed\n"); grid = -1; return; }
        if (hipOccupancyMaxActiveBlocksPerMultiprocessor(&per_cu, (const void*)hybrid_fwd, NTHR, LDS_BYTES) != hipSuccess || per_cu < 1) fprintf(stderr, "kernel_launch: occupancy query says %d\n", per_cu);
        (void)hipGetLastError();
        grid = cus;
    }
    if (grid < 0) return;
    (void)hipMemsetAsync((char*)d_ws + WS_CTL, 0, CTL_ZERO_BYTES, stream);
    Args a{};
    for (int i = 0; i < 23; ++i) a.in[i] = (const float*)d_in[i];
    a.out = (float*)d_out; a.ws = (unsigned char*)d_ws;
#ifndef MK_LAUNCHES_PER_PHASE
    a.ph_lo = 0; a.ph_hi = N_PHASES;
    hipLaunchKernelGGL(hybrid_fwd, dim3(grid), dim3(NTHR), LDS_BYTES, stream, a);
#else
    for (int p = 0; p < N_PHASES; ++p) { a.ph_lo = p; a.ph_hi = p + 1; hipLaunchKernelGGL(hybrid_fwd, dim3(grid), dim3(NTHR), LDS_BYTES, stream, a); }
#endif
}
```
